# Optimizing an MI355X kernel written in HIP

```python
import jax, jax.numpy as jnp
from jax import lax
import numpy as np

D_MODEL = 1024
BATCH = 4
SEQ = 4096
DEPTH = 4

HEAD_DIM = 64
ROPE_THETA = 10000.0
NORM_EPS = 1e-6
GMLP_GROUPS = 4
GMLP_WIDTH = GMLP_GROUPS * HEAD_DIM
GMLP_CHUNK = 128
DIL_CONFIGS = ((128, 1), (512, 4), (2048, 16))
DIL_HEADS_PER_GROUP = 4
DIL_HEADS = DIL_HEADS_PER_GROUP * len(DIL_CONFIGS)
DIL_WIDTH = DIL_HEADS * HEAD_DIM
DIL_OUT_WIDTH = DIL_HEADS_PER_GROUP * HEAD_DIM
EVEN_IN = 2 * GMLP_WIDTH + 3 * DIL_WIDTH
EVEN_OUT = GMLP_WIDTH + DIL_OUT_WIDTH
MOBA_HEADS = 12
MOBA_WIDTH = MOBA_HEADS * HEAD_DIM
MOBA_BLOCK = 256
MOBA_TOPK = 3
MOBA_Q_CHUNK = 16
CONV_WIDTH = 256
CONV_TAPS = 3
ODD_IN = 3 * MOBA_WIDTH + 3 * CONV_WIDTH
ODD_OUT = MOBA_WIDTH + CONV_WIDTH
D_FF = 2816
N_EXPERTS = 8
TOP_K = 2
D_FF_EXPERT = 3584
N_EVEN = (DEPTH + 1) // 2
N_ODD = DEPTH // 2

kernel_name = "hybrid_gmlp_dilated_moba_shortconv_moe"


def rms_norm(x, g):
    xf = x.astype(jnp.float32)
    y = xf * lax.rsqrt(jnp.mean(xf * xf, axis=-1, keepdims=True) + NORM_EPS)
    return (y * g.astype(jnp.float32)).astype(x.dtype)


def rope_tables(seq):
    inv = 1.0 / (ROPE_THETA ** (jnp.arange(0, HEAD_DIM, 2, dtype=jnp.float32) / HEAD_DIM))
    ang = jnp.arange(seq, dtype=jnp.float32)[:, None] * inv[None, :]
    ang = jnp.concatenate([ang, ang], axis=-1)
    return jnp.cos(ang)[:, None, :], jnp.sin(ang)[:, None, :]


def apply_rope(x, cos, sin):
    xf = x.astype(jnp.float32)
    half = HEAD_DIM // 2
    rot = jnp.concatenate([-xf[..., half:], xf[..., :half]], axis=-1)
    return (xf * cos + rot * sin).astype(x.dtype)


def prep_qk(q, k, gq, gk, cos, sin):
    return apply_rope(rms_norm(q, gq), cos, sin), apply_rope(rms_norm(k, gk), cos, sin)


def swiglu(h, wg, wu, wd):
    return (jax.nn.silu(h @ wg) * (h @ wu)) @ wd


def gmlp_spatial_gating(z, v_gain, ws, bs):
    b, s, _ = z.shape
    z = jax.nn.gelu(z)
    u, v = z[..., :GMLP_WIDTH], z[..., GMLP_WIDTH:]
    v = rms_norm(v.reshape(b, s, GMLP_GROUPS, HEAD_DIM), v_gain.reshape(GMLP_GROUPS, HEAD_DIM))
    v = v.reshape(b, s // GMLP_CHUNK, GMLP_CHUNK, GMLP_GROUPS, HEAD_DIM)
    causal = jnp.tril(jnp.ones((GMLP_CHUNK, GMLP_CHUNK), dtype=bool))
    w = jnp.where(causal[None], ws, jnp.zeros_like(ws))
    y = jnp.einsum('gij,bcjgd->bcigd', w, v) + jnp.swapaxes(bs, 0, 1)[:, :, None]
    return u * y.reshape(b, s, GMLP_WIDTH)


def banded_causal_attention(q, k, v, band):
    n, L, h, dh = q.shape
    nb = -(-L // band)
    pad = nb * band - L

    def blocks(t):
        return jnp.pad(t, ((0, 0), (0, pad), (0, 0), (0, 0))).reshape(n, nb, band, h, dh)

    def with_prev(t):
        prev = jnp.pad(t[:, :-1], ((0, 0), (1, 0), (0, 0), (0, 0), (0, 0)))
        return jnp.concatenate([prev, t], axis=2)

    qb, kw, vw = blocks(q), with_prev(blocks(k)), with_prev(blocks(v))
    sc = jnp.einsum('nbqhd,nbkhd->nbhqk', qb, kw, preferred_element_type=jnp.float32) * (HEAD_DIM ** -0.5)
    qi = jnp.arange(band)[:, None] + band
    kj = jnp.arange(2 * band)[None, :]
    dist = qi - kj
    blk = jnp.arange(nb)[:, None, None]
    mask = (dist >= 0) & (dist <= band) & (blk * band - band + kj >= 0)
    sc = jnp.where(mask[None, :, None], sc, -jnp.inf)
    m = jnp.max(sc, axis=-1, keepdims=True)
    p = jnp.exp(sc - m)
    l = jnp.sum(p, axis=-1, keepdims=True)
    o = jnp.einsum('nbhqk,nbkhd->nbhqd', p, vw.astype(jnp.float32)) / l
    lse = (m + jnp.log(l))[..., 0]
    o = o.transpose(0, 1, 3, 2, 4).reshape(n, nb * band, h, dh)[:, :L]
    lse = lse.transpose(0, 1, 3, 2).reshape(n, nb * band, h)[:, :L]
    return o, lse


def to_strided(t, dil):
    b, s, h, dh = t.shape
    return t.reshape(b, s // dil, dil, h, dh).transpose(0, 2, 1, 3, 4).reshape(b * dil, s // dil, h, dh)


def from_strided(t, b, dil):
    rest = t.shape[2:]
    L = t.shape[1]
    t = t.reshape((b, dil, L) + rest)
    t = jnp.moveaxis(t, 1, 2)
    return t.reshape((b, L * dil) + rest)


def dilated_attention(q, k, v):
    b = q.shape[0]
    outs, lses = [], []
    for g, (window, dil) in enumerate(DIL_CONFIGS):
        hs = slice(g * DIL_HEADS_PER_GROUP, (g + 1) * DIL_HEADS_PER_GROUP)
        o, lse = banded_causal_attention(to_strided(q[:, :, hs], dil), to_strided(k[:, :, hs], dil),
                                         to_strided(v[:, :, hs], dil), window // dil)
        outs.append(from_strided(o, b, dil))
        lses.append(from_strided(lse, b, dil))
    w = jax.nn.softmax(jnp.stack(lses, axis=0), axis=0)
    return jnp.sum(w[..., None] * jnp.stack(outs, axis=0), axis=0)


def moba_attention(q, k, v):
    b, s, h, dh = q.shape
    q, k, v = (t.transpose(0, 2, 1, 3) for t in (q, k, v))
    nblk = -(-s // MOBA_BLOCK)
    pad = nblk * MOBA_BLOCK - s
    kb = jnp.pad(k, ((0, 0), (0, 0), (0, pad), (0, 0))).reshape(b, h, nblk, MOBA_BLOCK, dh)
    vb = jnp.pad(v, ((0, 0), (0, 0), (0, pad), (0, 0))).reshape(b, h, nblk, MOBA_BLOCK, dh)
    kmean = jnp.mean(kb.astype(jnp.float32), axis=3)
    pos = jnp.arange(s)
    own = pos // MOBA_BLOCK
    gate = jnp.einsum('bhsd,bhnd->bhsn', q.astype(jnp.float32), kmean)
    fully_past = jnp.arange(nblk)[None, :] < own[:, None]
    gate = jnp.where(fully_past, gate, -jnp.inf)
    top_val, top_idx = lax.top_k(gate, min(MOBA_TOPK, nblk))
    idx = jnp.concatenate([top_idx.astype(jnp.int32),
                           jnp.broadcast_to(own[None, None, :, None], (b, h, s, 1)).astype(jnp.int32)], axis=-1)
    valid = jnp.concatenate([jnp.isfinite(top_val), jnp.ones((b, h, s, 1), dtype=bool)], axis=-1)
    nc = s // MOBA_Q_CHUNK

    def chunks(t):
        return jnp.moveaxis(t.reshape((b, h, nc, MOBA_Q_CHUNK) + t.shape[3:]), 2, 0)

    bi = jnp.arange(b)[:, None, None, None]
    hi = jnp.arange(h)[None, :, None, None]
    offs = jnp.arange(MOBA_BLOCK)

    def attend(args):
        qc, ic, vc, pc = args
        kg = kb[bi, hi, ic]
        vg = vb[bi, hi, ic]
        sc = jnp.einsum('bhqd,bhqjnd->bhqjn', qc, kg, preferred_element_type=jnp.float32) * (HEAD_DIM ** -0.5)
        kpos = ic[..., None] * MOBA_BLOCK + offs
        mask = vc[..., None] & (kpos <= pc[None, None, :, None, None])
        sc = jnp.where(mask, sc, -jnp.inf)
        shp = sc.shape
        p = jax.nn.softmax(sc.reshape(shp[:3] + (-1,)), axis=-1).reshape(shp)
        return jnp.einsum('bhqjn,bhqjnd->bhqd', p, vg.astype(jnp.float32))

    out = lax.map(attend, (chunks(q), chunks(idx), chunks(valid), pos.reshape(nc, MOBA_Q_CHUNK)))
    out = jnp.moveaxis(out, 0, 2).reshape(b, h, s, dh)
    return out.transpose(0, 2, 1, 3)


def short_conv_mixer(bg, cg, xz, w):
    z = cg * xz
    s = z.shape[1]
    zp = jnp.pad(z, ((0, 0), (CONV_TAPS - 1, 0), (0, 0)))
    y = sum(w[t] * zp[:, t:t + s] for t in range(CONV_TAPS))
    return bg * y


def moe_swiglu(h, router_w, wg, wu, wd):
    logits = jnp.einsum('bsd,de->bse', h, router_w, preferred_element_type=jnp.float32)
    top_val, top_idx = lax.top_k(logits, TOP_K)
    gates = jax.nn.softmax(top_val, axis=-1)
    gate = jnp.einsum('bske,bsk->bse', jax.nn.one_hot(top_idx, N_EXPERTS, dtype=jnp.float32), gates).astype(h.dtype)
    out = jnp.zeros_like(h)
    for e in range(N_EXPERTS):
        out = out + gate[..., e:e + 1] * swiglu(h, wg[e], wu[e], wd[e])
    return out


def setup_inputs(seed: int = 0) -> dict:
    key = jax.random.key(seed)
    ks = jax.random.split(key, 22)

    def nrm(k, shape, scale):
        return jax.random.normal(k, shape, jnp.float32) * scale

    def gain(k, shape):
        return 1.0 + 0.02 * jax.random.normal(k, shape, jnp.float32)

    ne, no = N_EVEN, N_ODD
    return {
        'x': nrm(ks[0], (BATCH, SEQ, D_MODEL), 1.0),
        'norm_mix': gain(ks[1], (DEPTH, D_MODEL)),
        'norm_ffn': gain(ks[2], (DEPTH, D_MODEL)),
        'w_in_ab': nrm(ks[3], (ne, D_MODEL, EVEN_IN), D_MODEL ** -0.5),
        'gmlp_v_gain': gain(ks[4], (ne, GMLP_WIDTH)),
        'gmlp_ws': nrm(ks[5], (ne, GMLP_GROUPS, GMLP_CHUNK, GMLP_CHUNK), GMLP_CHUNK ** -0.5),
        'gmlp_bs': 1.0 + 0.1 * jax.random.normal(ks[6], (ne, GMLP_GROUPS, GMLP_CHUNK), jnp.float32),
        'dil_q_gain': gain(ks[7], (ne, HEAD_DIM)),
        'dil_k_gain': gain(ks[8], (ne, HEAD_DIM)),
        'w_out_ab': nrm(ks[9], (ne, EVEN_OUT, D_MODEL), EVEN_OUT ** -0.5),
        'ffn_w_gate': nrm(ks[10], (ne, D_MODEL, D_FF), D_MODEL ** -0.5),
        'ffn_w_up': nrm(ks[11], (ne, D_MODEL, D_FF), D_MODEL ** -0.5),
        'ffn_w_down': nrm(ks[12], (ne, D_FF, D_MODEL), D_FF ** -0.5),
        'w_in_cd': nrm(ks[13], (no, D_MODEL, ODD_IN), D_MODEL ** -0.5),
        'moba_q_gain': gain(ks[14], (no, HEAD_DIM)),
        'moba_k_gain': gain(ks[15], (no, HEAD_DIM)),
        'conv_w': nrm(ks[16], (no, CONV_TAPS, CONV_WIDTH), CONV_TAPS ** -0.5),
        'w_out_cd': nrm(ks[17], (no, ODD_OUT, D_MODEL), ODD_OUT ** -0.5),
        'router_w': nrm(ks[18], (no, D_MODEL, N_EXPERTS), D_MODEL ** -0.5),
        'moe_w_gate': nrm(ks[19], (no, N_EXPERTS, D_MODEL, D_FF_EXPERT), D_MODEL ** -0.5),
        'moe_w_up': nrm(ks[20], (no, N_EXPERTS, D_MODEL, D_FF_EXPERT), D_MODEL ** -0.5),
        'moe_w_down': nrm(ks[21], (no, N_EXPERTS, D_FF_EXPERT, D_MODEL), D_FF_EXPERT ** -0.5),
    }


def reference(x, norm_mix, norm_ffn, w_in_ab, gmlp_v_gain, gmlp_ws, gmlp_bs, dil_q_gain, dil_k_gain,
              w_out_ab, ffn_w_gate, ffn_w_up, ffn_w_down, w_in_cd, moba_q_gain, moba_k_gain, conv_w,
              w_out_cd, router_w, moe_w_gate, moe_w_up, moe_w_down):
    b, s, _ = x.shape
    cos, sin = rope_tables(s)
    for layer in range(DEPTH):
        i = layer // 2
        h = rms_norm(x, norm_mix[layer])
        if layer % 2 == 0:
            p = h @ w_in_ab[i]
            o1 = 2 * GMLP_WIDTH
            o2 = o1 + DIL_WIDTH
            o3 = o2 + DIL_WIDTH
            a_out = gmlp_spatial_gating(p[..., :o1], gmlp_v_gain[i], gmlp_ws[i], gmlp_bs[i])
            q = p[..., o1:o2].reshape(b, s, DIL_HEADS, HEAD_DIM)
            k = p[..., o2:o3].reshape(b, s, DIL_HEADS, HEAD_DIM)
            v = p[..., o3:].reshape(b, s, DIL_HEADS, HEAD_DIM)
            q, k = prep_qk(q, k, dil_q_gain[i], dil_k_gain[i], cos, sin)
            b_out = dilated_attention(q, k, v).reshape(b, s, DIL_OUT_WIDTH).astype(h.dtype)
            x = x + jnp.concatenate([a_out, b_out], axis=-1) @ w_out_ab[i]
            x = x + swiglu(rms_norm(x, norm_ffn[layer]), ffn_w_gate[i], ffn_w_up[i], ffn_w_down[i])
        else:
            p = h @ w_in_cd[i]
            o1 = MOBA_WIDTH
            o2 = 2 * MOBA_WIDTH
            o3 = 3 * MOBA_WIDTH
            o4 = o3 + CONV_WIDTH
            o5 = o4 + CONV_WIDTH
            q = p[..., :o1].reshape(b, s, MOBA_HEADS, HEAD_DIM)
            k = p[..., o1:o2].reshape(b, s, MOBA_HEADS, HEAD_DIM)
            v = p[..., o2:o3].reshape(b, s, MOBA_HEADS, HEAD_DIM)
            q, k = prep_qk(q, k, moba_q_gain[i], moba_k_gain[i], cos, sin)
            c_out = moba_attention(q, k, v).reshape(b, s, MOBA_WIDTH).astype(h.dtype)
            d_out = short_conv_mixer(p[..., o3:o4], p[..., o4:o5], p[..., o5:], conv_w[i])
            x = x + jnp.concatenate([c_out, d_out], axis=-1) @ w_out_cd[i]
            x = x + moe_swiglu(rms_norm(x, norm_ffn[layer]), router_w[i], moe_w_gate[i], moe_w_up[i], moe_w_down[i])
    return x
```

```cpp
#include <hip/hip_runtime.h>
#include <cstdio>
#include <cstdint>

#ifndef MK_PER_PHASE
#define MK_PER_PHASE 1
#endif

namespace pg8 {
#define PG8_LAS __attribute__((address_space(3)))
typedef unsigned short bf16_t;
typedef short bf16x8 __attribute__((ext_vector_type(8)));
typedef float f32x4 __attribute__((ext_vector_type(4)));
typedef float f32x2 __attribute__((ext_vector_type(2)));
typedef unsigned u32x4 __attribute__((ext_vector_type(4)));
constexpr int BM = 256, BK = 64, HALF = 128, HTB = HALF * BK * 2, STAGE_BYTES = 8 * HTB, NXCD = 8, WGM = 8;

__host__ __device__ __forceinline__ int lds_byte(int r, int c) { const int st = (r >> 4) * 2 + (c >> 5), rr = r & 15, cc = c & 31, ob = rr * 64 + cc * 2; return st * 1024 + (ob ^ (((ob >> 9) & 1) << 5)); }
__host__ __device__ __forceinline__ void stage_rc(int b, int& R, int& C) { const int st = b / 1024, sb = b % 1024, swz = sb ^ (((sb >> 9) & 1) << 5); R = (st >> 1) * 16 + swz / 64; C = (st & 1) * 32 + (swz % 64) / 2; }
__host__ __device__ __forceinline__ int perm32(int rho) { const int n = rho >> 4, i = rho & 15; return 8 * (i >> 2) + 4 * n + (i & 3); }

struct Unit { int pm, pn; };
struct Gemm { const bf16_t* A; const bf16_t* Bt; int M, N, K; };

struct StaticOrder {
    int nM, nN, nwg, G, c;
    __device__ void init(int M, int N, int G_, int c_) { nM = M / BM; nN = N / BM; nwg = nM * nN; G = G_; c = c_; }
    __device__ bool next(int i, Unit& u) const {
        const long L = (long)i * G + c; if (L >= nwg) return false;
        int wgid = (int)L; { const int q = nwg / NXCD, r = nwg % NXCD, xcd = wgid % NXCD, off = wgid / NXCD; wgid = (xcd < r ? xcd * (q + 1) : r * (q + 1) + (xcd - r) * q) + off; }
        const int nig = WGM * nN, gid = wgid / nig, fm = gid * WGM, gsz = (nM - fm) < WGM ? (nM - fm) : WGM;
        u.pm = fm + ((wgid % nig) % gsz); u.pn = (wgid % nig) / gsz; return true;
    }
    __device__ __forceinline__ const char* bbase(const Unit&, const bf16_t* Bt) const { return (const char*)Bt; }
};
struct MoeOrder : StaticOrder {
    int tb[8]; size_t estride;
    __device__ __forceinline__ const char* bbase(const Unit& u, const bf16_t* Bt) const {
        int e = 0;
#pragma unroll
        for (int k = 1; k < 8; ++k) e += (u.pm >= tb[k]) ? 1 : 0;
        return (const char*)Bt + (size_t)e * estride;
    }
};

__device__ __forceinline__ unsigned cvt_pk_bf16(float lo, float hi) { unsigned r; asm volatile("v_cvt_pk_bf16_f32 %0, %1, %2" : "=v"(r) : "v"(lo), "v"(hi)); return r; }

struct EpiBf16Plain {
    static constexpr bool PERM = true;
    bf16_t* O; int ldc;
    __device__ __forceinline__ void operator()(const f32x4 (&acc)[2][2][4][2], const Unit& u, int wr, int wc, int fr, int fq) const {
        const int row0 = u.pm * BM + wr * 64 + fr, col0 = u.pn * BM + wc * 32 + 8 * fq;
#pragma unroll
        for (int ai = 0; ai < 2; ++ai)
#pragma unroll
            for (int m = 0; m < 4; ++m) { bf16_t* rowp = O + (size_t)(row0 + ai * HALF + m * 16) * ldc + col0;
#pragma unroll
                for (int bj = 0; bj < 2; ++bj) { const f32x4 v0 = acc[ai][bj][m][0], v1 = acc[ai][bj][m][1];
                    u32x4 w; w.x = cvt_pk_bf16(v0[0], v0[1]); w.y = cvt_pk_bf16(v0[2], v0[3]); w.z = cvt_pk_bf16(v1[0], v1[1]); w.w = cvt_pk_bf16(v1[2], v1[3]);
                    *(u32x4*)(rowp + bj * HALF) = w; } }
    }
};
struct EpiF32Res {
    static constexpr bool PERM = false;
    const float* base; float* out; int ldc;
    __device__ __forceinline__ void operator()(const f32x4 (&acc)[2][2][4][2], const Unit& u, int wr, int wc, int fr, int fq) const {
        const int row0 = u.pm * BM + wr * 64 + fr, col0 = u.pn * BM + wc * 32 + 4 * fq;
#pragma unroll
        for (int ai = 0; ai < 2; ++ai)
#pragma unroll
            for (int m = 0; m < 4; ++m) { const size_t off = (size_t)(row0 + ai * HALF + m * 16) * ldc + col0;
#pragma unroll
                for (int bj = 0; bj < 2; ++bj)
#pragma unroll
                    for (int n = 0; n < 2; ++n) { const f32x4 bs = *(const f32x4*)(base + off + bj * HALF + n * 16); *(f32x4*)(out + off + bj * HALF + n * 16) = bs + acc[ai][bj][m][n]; }
                asm volatile("" ::: "memory"); }
    }
};
__device__ __forceinline__ float silu_mul(float g, float u) { return g * __builtin_amdgcn_rcpf(1.0f + __builtin_amdgcn_exp2f(-1.4426950408889634f * g)) * u; }
struct EpiSwiGLU {
    static constexpr bool PERM = true;
    bf16_t* O; int ldc;
    __device__ __forceinline__ void operator()(const f32x4 (&acc)[2][2][4][2], const Unit& u, int wr, int wc, int fr, int fq) const {
        const int row0 = u.pm * BM + wr * 64 + fr, col0 = u.pn * HALF + wc * 32 + 8 * fq;
#pragma unroll
        for (int ai = 0; ai < 2; ++ai)
#pragma unroll
            for (int m = 0; m < 4; ++m) { bf16_t* rowp = O + (size_t)(row0 + ai * HALF + m * 16) * ldc + col0;
                const f32x4 g0 = acc[ai][0][m][0], g1 = acc[ai][0][m][1], u0 = acc[ai][1][m][0], u1 = acc[ai][1][m][1];
                u32x4 w; w.x = cvt_pk_bf16(silu_mul(g0[0], u0[0]), silu_mul(g0[1], u0[1])); w.y = cvt_pk_bf16(silu_mul(g0[2], u0[2]), silu_mul(g0[3], u0[3]));
                w.z = cvt_pk_bf16(silu_mul(g1[0], u1[0]), silu_mul(g1[1], u1[1])); w.w = cvt_pk_bf16(silu_mul(g1[2], u1[2]), silu_mul(g1[3], u1[3]));
                *(u32x4*)rowp = w; }
    }
};

template <class Epi, class Sched, bool ALIGN_EPI = true, bool SP2 = true>
__device__ __forceinline__ void gemm_phase(PG8_LAS unsigned char* lds, const Gemm g, const Sched& S, const Epi& E) {
    int tid_ = threadIdx.x; asm volatile("" : "+v"(tid_));
    const int tid = tid_, wid = __builtin_amdgcn_readfirstlane(tid >> 6), lane = tid & 63, wr = wid >> 2, wc = wid & 3, fr = lane & 15, fq = lane >> 4;
    const int K = g.K, nt = K / BK;
    unsigned voffA[2], voffB[2];
#pragma unroll
    for (int i = 0; i < 2; ++i) { int R, C; stage_rc(tid * 16 + i * 8192, R, C); const int Rb = Epi::PERM ? ((R & ~31) + perm32(R & 31)) : R;
        voffA[i] = (unsigned)(R * K + C) * 2u; voffB[i] = (unsigned)(Rb * K + C) * 2u; }
    const size_t kstep = (size_t)(BK * 2);
    const size_t hstep = (size_t)HALF * K * 2;
    const size_t tstep = 2 * hstep;
    const unsigned ldsw = (unsigned)wid * 1024u;
    const int aoff = lds_byte(wr * 64 + fr, fq * 8), boff = lds_byte(wc * 32 + fr, fq * 8);
#define PG8_SA(b, h) (((b) * 2 + (h)) * HTB)
#define PG8_SB(b, h) ((4 + (b) * 2 + (h)) * HTB)
#define PG8_STAGE(bufoff, gbase, voff) do { _Pragma("unroll") for (int _i = 0; _i < 2; ++_i) \
        __builtin_amdgcn_global_load_lds((const unsigned*)((const char*)(gbase) + (voff)[_i]), (PG8_LAS unsigned*)(lds + (bufoff) + ldsw + _i * 8192), 16, 0, 0); } while (0)
#define PG8_LDA(dst, b, h) do { _Pragma("unroll") for (int m = 0; m < 4; ++m) _Pragma("unroll") for (int k = 0; k < 2; ++k) dst[m][k] = *(const PG8_LAS bf16x8*)(lds + PG8_SA(b, h) + aoff + m * 2048 + k * 1024); } while (0)
#define PG8_LDB(dst, b, h) do { _Pragma("unroll") for (int n = 0; n < 2; ++n) _Pragma("unroll") for (int k = 0; k < 2; ++k) dst[n][k] = *(const PG8_LAS bf16x8*)(lds + PG8_SB(b, h) + boff + n * 2048 + k * 1024); } while (0)
#define PG8_MMA(ai, bj, At, Bt) do { __builtin_amdgcn_s_setprio(1); _Pragma("unroll") for (int m = 0; m < 4; ++m) _Pragma("unroll") for (int n = 0; n < 2; ++n) _Pragma("unroll") for (int k = 0; k < 2; ++k) \
        acc[ai][bj][m][n] = __builtin_amdgcn_mfma_f32_16x16x32_bf16(Bt[n][k], At[m][k], acc[ai][bj][m][n], 0, 0, 0); __builtin_amdgcn_s_setprio(0); } while (0)
#define PG8_WAIT_V(n) asm volatile("s_waitcnt vmcnt(" #n ")" ::: "memory")
#define PG8_WAIT_L(n) asm volatile("s_waitcnt lgkmcnt(" #n ")" ::: "memory")
#define PG8_BAR __builtin_amdgcn_s_barrier()
#define PG8_SCHED __builtin_amdgcn_sched_barrier(0)
    Unit cur, nxt; int ui = 0;
    if (!S.next(0, cur)) return;
    f32x4 acc[2][2][4][2];
#pragma unroll
    for (int a = 0; a < 2; ++a)
#pragma unroll
        for (int b = 0; b < 2; ++b)
#pragma unroll
            for (int m = 0; m < 4; ++m)
#pragma unroll
                for (int n = 0; n < 2; ++n) acc[a][b][m][n] = (f32x4){0.f, 0.f, 0.f, 0.f};
    bf16x8 At[4][2], B0[2][2], B1[2][2];
    const char* cA = (const char*)g.A + (size_t)cur.pm * tstep; const char* cB = S.bbase(cur, g.Bt) + (size_t)cur.pn * tstep;
    if constexpr (SP2) {
        PG8_STAGE(PG8_SB(0, 0), cB, voffB); PG8_STAGE(PG8_SB(0, 1), cB + hstep, voffB); PG8_STAGE(PG8_SA(0, 0), cA, voffA); PG8_STAGE(PG8_SA(0, 1), cA + hstep, voffA);
        if (wr == 1) PG8_BAR;
        PG8_WAIT_V(2); PG8_BAR;
        PG8_STAGE(PG8_SB(1, 0), cB + kstep, voffB); PG8_STAGE(PG8_SA(1, 0), cA + kstep, voffA); PG8_STAGE(PG8_SB(1, 1), cB + hstep + kstep, voffB);
        PG8_WAIT_V(6); PG8_BAR;
    } else {
        PG8_STAGE(PG8_SB(0, 0), cB, voffB); PG8_STAGE(PG8_SA(0, 0), cA, voffA); PG8_STAGE(PG8_SB(0, 1), cB + hstep, voffB); PG8_STAGE(PG8_SA(0, 1), cA + hstep, voffA);
        if (wr == 1) PG8_BAR;
        PG8_WAIT_V(4); PG8_BAR;
        PG8_STAGE(PG8_SB(1, 0), cB + kstep, voffB); PG8_STAGE(PG8_SA(1, 0), cA + kstep, voffA); PG8_STAGE(PG8_SB(1, 1), cB + hstep + kstep, voffB);
        PG8_WAIT_V(6); PG8_BAR;
    }
    for (;;) {
        const bool has_next = S.next(ui + 1, nxt);
        const char* nA = has_next ? (const char*)g.A + (size_t)nxt.pm * tstep : cA; const char* nB = has_next ? S.bbase(nxt, g.Bt) + (size_t)nxt.pn * tstep : cB;
        for (int t = 0; t < nt; t += 2) {
            const bool last = (t == nt - 2);
            const char* a1 = cA + (size_t)(t + 1) * kstep;
            const char* a2 = last ? nA : cA + (size_t)(t + 2) * kstep; const char* b2 = last ? nB : cB + (size_t)(t + 2) * kstep;
            const char* a3 = a2 + kstep; const char* b3 = b2 + kstep;
            if constexpr (SP2) {
            PG8_LDB(B0, 0, 0); PG8_LDB(B1, 0, 1); PG8_SCHED; PG8_LDA(At, 0, 0); PG8_STAGE(PG8_SA(1, 1), a1 + hstep, voffA);
            PG8_WAIT_V(8); PG8_WAIT_L(0); PG8_BAR; PG8_MMA(0, 0, At, B0); PG8_MMA(0, 1, At, B1); PG8_BAR; PG8_SCHED;
            PG8_LDA(At, 0, 1); PG8_STAGE(PG8_SB(0, 0), b2, voffB); PG8_STAGE(PG8_SB(0, 1), b2 + hstep, voffB); PG8_STAGE(PG8_SA(0, 0), a2, voffA);
            PG8_WAIT_V(8); PG8_WAIT_L(0); PG8_BAR; PG8_MMA(1, 0, At, B0); PG8_MMA(1, 1, At, B1); PG8_BAR; PG8_SCHED;
            PG8_LDB(B0, 1, 0); PG8_LDB(B1, 1, 1); PG8_SCHED; PG8_LDA(At, 1, 0); PG8_STAGE(PG8_SA(0, 1), a2 + hstep, voffA);
            PG8_WAIT_V(8); PG8_WAIT_L(0); PG8_BAR; PG8_MMA(0, 0, At, B0); PG8_MMA(0, 1, At, B1); PG8_BAR; PG8_SCHED;
            PG8_LDA(At, 1, 1); PG8_STAGE(PG8_SB(1, 0), b3, voffB); PG8_STAGE(PG8_SB(1, 1), b3 + hstep, voffB); PG8_STAGE(PG8_SA(1, 0), a3, voffA);
            PG8_WAIT_V(8); PG8_WAIT_L(0); PG8_BAR; PG8_MMA(1, 0, At, B0); PG8_MMA(1, 1, At, B1); PG8_BAR; PG8_SCHED;
            } else {
            PG8_LDB(B0, 0, 0); PG8_SCHED; PG8_LDA(At, 0, 0); PG8_STAGE(PG8_SA(1, 1), a1 + hstep, voffA);
            PG8_WAIT_L(8); PG8_BAR; PG8_WAIT_L(0); PG8_MMA(0, 0, At, B0); PG8_BAR; PG8_SCHED;
            PG8_LDB(B1, 0, 1); PG8_STAGE(PG8_SB(0, 0), b2, voffB);
            PG8_BAR; PG8_WAIT_L(0); PG8_MMA(0, 1, At, B1); PG8_BAR;
            PG8_LDA(At, 0, 1); PG8_STAGE(PG8_SA(0, 0), a2, voffA);
            PG8_BAR; PG8_WAIT_L(0); PG8_MMA(1, 0, At, B0); PG8_BAR; PG8_SCHED;
            PG8_STAGE(PG8_SB(0, 1), b2 + hstep, voffB);
            PG8_WAIT_V(6); PG8_BAR; PG8_MMA(1, 1, At, B1); PG8_BAR;
            PG8_LDB(B0, 1, 0); PG8_SCHED; PG8_LDA(At, 1, 0); PG8_STAGE(PG8_SA(0, 1), a2 + hstep, voffA);
            PG8_WAIT_L(8); PG8_BAR; PG8_WAIT_L(0); PG8_MMA(0, 0, At, B0); PG8_BAR; PG8_SCHED;
            PG8_LDB(B1, 1, 1); PG8_STAGE(PG8_SB(1, 0), b3, voffB);
            PG8_BAR; PG8_WAIT_L(0); PG8_MMA(0, 1, At, B1); PG8_BAR;
            PG8_LDA(At, 1, 1); PG8_STAGE(PG8_SA(1, 0), a3, voffA);
            PG8_BAR; PG8_WAIT_L(0); PG8_MMA(1, 0, At, B0); PG8_BAR; PG8_SCHED;
            PG8_STAGE(PG8_SB(1, 1), b3 + hstep, voffB);
            PG8_WAIT_V(6); PG8_BAR; PG8_MMA(1, 1, At, B1); PG8_BAR;
            }
        }
        if constexpr (ALIGN_EPI) { if (wr == 0) PG8_BAR; }
        E(acc, cur, wr, wc, fr, fq);
        if (!has_next) break;
#pragma unroll
        for (int a = 0; a < 2; ++a)
#pragma unroll
            for (int b = 0; b < 2; ++b)
#pragma unroll
                for (int m = 0; m < 4; ++m)
#pragma unroll
                    for (int n = 0; n < 2; ++n) acc[a][b][m][n] = (f32x4){0.f, 0.f, 0.f, 0.f};
        cur = nxt; cA = nA; cB = nB; ++ui;
        if constexpr (ALIGN_EPI) { if (wr == 1) PG8_BAR; }
    }
    PG8_WAIT_V(0);
    if constexpr (!ALIGN_EPI) { if (wr == 0) PG8_BAR; }
    PG8_BAR;
#undef PG8_SA
#undef PG8_SB
#undef PG8_STAGE
#undef PG8_LDA
#undef PG8_LDB
#undef PG8_MMA
#undef PG8_WAIT_V
#undef PG8_WAIT_L
#undef PG8_BAR
#undef PG8_SCHED
}
}

constexpr int NWAVES = 8;
constexpr int NB = 4, SEQ = 4096, T = NB * SEQ, D = 1024;
constexpr int EVEN_IN = 2816, EVEN_OUT = 512, ODD_IN = 3072, ODD_OUT = 1024, DFF = 2816, NEXP = 8, DFFE = 3584;
constexpr int MOE_ROWS = 2 * T + NEXP * 256;
constexpr float EPS = 1e-6f;
constexpr size_t MiB = 1u << 20;
constexpr size_t WS_CTL = 0, CTL_ZERO_BYTES = 2 * MiB;
constexpr size_t WS_ROPE = 2 * MiB;
constexpr size_t WS_MISC = 3 * MiB;
constexpr size_t WS_KMEAN = 4 * MiB;
constexpr size_t WS_WT = 8 * MiB;
constexpr size_t WT_EVEN_BYTES = 23 * MiB, WT_ODD_BYTES = 176 * MiB;
constexpr size_t WTE_IN = 0, WTE_OUT = 5 * MiB + MiB / 2, WTE_GU = 6 * MiB + MiB / 2, WTE_DN = 17 * MiB + MiB / 2;
constexpr size_t WTO_IN = 0, WTO_OUT = 6 * MiB, WTO_MGU = 8 * MiB, WTO_MD = 120 * MiB;
constexpr size_t WS_WT_EVEN0 = WS_WT, WS_WT_ODD0 = WS_WT + 2 * WT_EVEN_BYTES;
constexpr size_t WS_HN = WS_WT + 2 * WT_EVEN_BYTES + 2 * WT_ODD_BYTES;
constexpr size_t WS_P = WS_HN + 32 * MiB;
constexpr size_t WS_MIX = WS_P + 96 * MiB;
constexpr size_t WS_HID = WS_MIX + 32 * MiB;
constexpr size_t WS_END = WS_HID + 238 * MiB;
static_assert(WS_HN == 406 * MiB && WS_END == 804 * MiB, "ws map");
constexpr size_t P_UV = 0, P_QS = 16 * MiB, P_KS = 40 * MiB, P_VS = 64 * MiB, P_QM = 0, P_KM = 24 * MiB, P_VM = 48 * MiB;
constexpr size_t H_RAWP = 0, H_OG = 96 * MiB, H_LSE = 120 * MiB;
constexpr int CW_TMO = 0, CW_CODE = 1, CW_BAR = 4096;
constexpr int RING_OFF = 0, RING_BYTES = 131072, LDSCTL_OFF = RING_BYTES, MISC_OFF = LDSCTL_OFF + 320, LDS_BYTES = 147456;

#define GAS __attribute__((address_space(1)))
#define LAS __attribute__((address_space(3)))
typedef unsigned short bf16;
typedef unsigned v4u __attribute__((ext_vector_type(4)));
typedef unsigned v2u __attribute__((ext_vector_type(2)));
typedef float f32x4 __attribute__((ext_vector_type(4)));
typedef GAS unsigned gu32;
#define RLX_AGENT __ATOMIC_RELAXED, __HIP_MEMORY_SCOPE_AGENT
#define LDS_WAIT() asm volatile("s_waitcnt lgkmcnt(0)" ::: "memory")
#define VM_WAIT() asm volatile("s_waitcnt vmcnt(0)" ::: "memory")
__device__ __forceinline__ unsigned f2bf(float f) { unsigned u = __builtin_bit_cast(unsigned, f); return (u + 0x7fffu + ((u >> 16) & 1u)) >> 16; }
__device__ __forceinline__ unsigned pk2(float lo, float hi) { return f2bf(lo) | (f2bf(hi) << 16); }
__device__ __forceinline__ float bf2f(unsigned short b) { return __builtin_bit_cast(float, ((unsigned)b) << 16); }
__device__ __forceinline__ float bflo(unsigned w) { return __builtin_bit_cast(float, w << 16); }
__device__ __forceinline__ float bfhi(unsigned w) { return __builtin_bit_cast(float, w & 0xffff0000u); }

#define XB_TMO      128
#define XB_XCNT(j)  (256  + 64 * (j))
#define XB_XSUB(j)  (1280 + 64 * (j))
#define XB_XGEN(j)  (2304 + 64 * (j))
#define XB_TOP      3328
#define XB_TOPGEN   3392
#define XCD_BAR_WORDS 3456
#define XB_SPIN_CAP (1u << 18)
__device__ __forceinline__ unsigned xb_ld(unsigned* p)              { return __hip_atomic_load(p, __ATOMIC_RELAXED, __HIP_MEMORY_SCOPE_AGENT); }
__device__ __forceinline__ unsigned xb_add(unsigned* p, unsigned v) { return __hip_atomic_fetch_add(p, v, __ATOMIC_RELAXED, __HIP_MEMORY_SCOPE_AGENT); }
__device__ __forceinline__ unsigned xb_xcc_id() { return (unsigned)__builtin_amdgcn_s_getreg((3 << 11) | 20) & 0xFu; }
#define XB_SPIN(cond, bar) do { unsigned _sp = 0; while (cond) { __builtin_amdgcn_s_sleep(1); \
    if ((++_sp & 255u) == 0u) { if (xb_ld(&(bar)[XB_TMO])) break; if (_sp > XB_SPIN_CAP) { atomicAdd(&(bar)[XB_TMO], 1u); break; } } } } while (0)
struct XcdBarrier { unsigned* bar; unsigned x; volatile LAS unsigned* st; };
__device__ __forceinline__ XcdBarrier xcd_barrier_post(unsigned* bar, volatile LAS unsigned* st) {
    XcdBarrier b; b.bar = bar; b.x = xb_xcc_id(); b.st = st;
    if (threadIdx.x == 0) (void)xb_add(&bar[XB_XCNT(b.x)], 1u);
    return b;
}
__device__ __forceinline__ void xcd_barrier_complete(unsigned* bar, unsigned x, unsigned& nloc, unsigned& nx) {
    const unsigned G = gridDim.x * gridDim.y * gridDim.z;
    unsigned sum, cnt, mine, sp = 0u;
    for (;;) {
        sum = 0u; cnt = 0u; mine = 0u;
#pragma unroll
        for (unsigned j = 0; j < 16; ++j) { const unsigned c = xb_ld(&bar[XB_XCNT(j)]); sum += c; cnt += (c > 0u) ? 1u : 0u; mine = (j == x) ? c : mine; }
        if (sum == G) break;
        __builtin_amdgcn_s_sleep(1);
        if ((++sp & 255u) == 0u) { if (xb_ld(&bar[XB_TMO])) break; if (sp > XB_SPIN_CAP) { atomicAdd(&bar[XB_TMO], 1u); break; } }
    }
    nloc = mine > 0u ? mine : 1u; nx = cnt > 0u ? cnt : 1u;
}
__device__ __forceinline__ void xcd_barrier(const XcdBarrier& b) {
    asm volatile("s_waitcnt vmcnt(0)" ::: "memory");
    __syncthreads();
    if (threadIdx.x == 0) {
        unsigned* bar = b.bar;
        __builtin_amdgcn_s_waitcnt(0);
        unsigned nloc = b.st[0], nx = b.st[1];
        if (nloc == 0u) { xcd_barrier_complete(bar, b.x, nloc, nx); b.st[0] = nloc; b.st[1] = nx; }
        const unsigned old = xb_add(&bar[XB_XSUB(b.x)], 1u);
        const unsigned gen = old / nloc;
        if (old + 1u == (gen + 1u) * nloc) {
            __builtin_amdgcn_fence(__ATOMIC_RELEASE, "agent");
            asm volatile("s_waitcnt vmcnt(0)" ::: "memory");
            const unsigned og = xb_add(&bar[XB_TOP], 1u);
            const unsigned tg = og / nx;
            if (og + 1u == (tg + 1u) * nx) xb_add(&bar[XB_TOPGEN], 1u);
            else XB_SPIN(xb_ld(&bar[XB_TOPGEN]) == tg, bar);
            __builtin_amdgcn_fence(__ATOMIC_ACQUIRE, "agent");
            xb_add(&bar[XB_XGEN(b.x)], 1u);
            asm volatile("s_waitcnt vmcnt(0)" ::: "memory");
        } else {
            XB_SPIN(xb_ld(&bar[XB_XGEN(b.x)]) == gen, bar);
            __builtin_amdgcn_fence(__ATOMIC_ACQUIRE, "agent");
            asm volatile("s_waitcnt vmcnt(0)" ::: "memory");
        }
    }
    __syncthreads();
}

struct Args { const float* in[22]; float* out; unsigned char* ws; int ph_lo, ph_hi; };
struct Frame {
    LAS unsigned char* lds; volatile LAS unsigned* MISC; gu32* ctl;
    int tid, lane, wave, G, blk;
    unsigned char* ws; float* out;
};
struct Route { int e1, e2; float g1, g2; };

__device__ __forceinline__ float wave_sum(float v) {
#pragma unroll
    for (int o = 1; o < 64; o <<= 1) v += __shfl_xor(v, o);
    return v;
}
__device__ __forceinline__ float wave_max(float v) {
#pragma unroll
    for (int o = 1; o < 64; o <<= 1) v = fmaxf(v, __shfl_xor(v, o));
    return v;
}
__device__ __forceinline__ float gelu_tanh(float x) {
    const float y = 0.7978845608028654f * (x + 0.044715f * x * x * x);
    const float e = __expf(2.0f * y);
    const float th = 1.0f - 2.0f / (e + 1.0f);
    return 0.5f * x * (1.0f + th);
}

__device__ __forceinline__ int rowmap(int mode, int n) { return mode == 0 ? n : (256 * (n >> 7) + (n & 127) + (mode == 2 ? 128 : 0)); }
__device__ __forceinline__ void p0_transpose_item(const float* W, int K, int N, bf16* WT, int mode, LAS float* scr, int item, int lane) {
    const int nblk = N / 32, kb = item / nblk, nb = item % nblk, k0 = 64 * kb, n0 = 32 * nb;
#pragma unroll 8
    for (int i = 0; i < 32; ++i) { const int kk = 2 * i + (lane >> 5); scr[kk * 33 + (lane & 31)] = W[(size_t)(k0 + kk) * N + n0 + (lane & 31)]; }
    LDS_WAIT(); asm volatile("" ::: "memory");
    const int c = lane & 7;
#pragma unroll
    for (int j = 0; j < 4; ++j) { const int n = (lane >> 3) + 8 * j; const LAS float* s = scr + (8 * c) * 33 + n;
        v4u o; o.x = pk2(s[0 * 33], s[1 * 33]); o.y = pk2(s[2 * 33], s[3 * 33]); o.z = pk2(s[4 * 33], s[5 * 33]); o.w = pk2(s[6 * 33], s[7 * 33]);
        *(GAS v4u*)(WT + (size_t)rowmap(mode, n0 + n) * K + k0 + 8 * c) = o; }
    LDS_WAIT(); asm volatile("" ::: "memory");
}
struct WDesc { const float* src; bf16* dst; int K, N, nbatch, mode; size_t dst_bstride; };
__device__ __forceinline__ WDesc get_desc(const Args& a, int d) {
    const int layer = d / 10, k = d % 10; unsigned char* ws = a.ws;
    bf16* we = (bf16*)(ws + WS_WT_EVEN0 + (size_t)layer * WT_EVEN_BYTES); bf16* wo = (bf16*)(ws + WS_WT_ODD0 + (size_t)layer * WT_ODD_BYTES);
    WDesc w; w.nbatch = 1; w.mode = 0; w.dst_bstride = 0;
    switch (k) {
    case 0: w.src = a.in[3] + (size_t)layer * D * EVEN_IN; w.dst = we + WTE_IN / 2; w.K = D; w.N = EVEN_IN; break;
    case 1: w.src = a.in[9] + (size_t)layer * EVEN_OUT * D; w.dst = we + WTE_OUT / 2; w.K = EVEN_OUT; w.N = D; break;
    case 2: w.src = a.in[10] + (size_t)layer * D * DFF; w.dst = we + WTE_GU / 2; w.K = D; w.N = DFF; w.mode = 1; break;
    case 3: w.src = a.in[11] + (size_t)layer * D * DFF; w.dst = we + WTE_GU / 2; w.K = D; w.N = DFF; w.mode = 2; break;
    case 4: w.src = a.in[12] + (size_t)layer * DFF * D; w.dst = we + WTE_DN / 2; w.K = DFF; w.N = D; break;
    case 5: w.src = a.in[13] + (size_t)layer * D * ODD_IN; w.dst = wo + WTO_IN / 2; w.K = D; w.N = ODD_IN; break;
    case 6: w.src = a.in[17] + (size_t)layer * ODD_OUT * D; w.dst = wo + WTO_OUT / 2; w.K = ODD_OUT; w.N = D; break;
    case 7: w.src = a.in[19] + (size_t)layer * NEXP * D * DFFE; w.dst = wo + WTO_MGU / 2; w.K = D; w.N = DFFE; w.mode = 1; w.nbatch = NEXP; w.dst_bstride = (size_t)2 * DFFE * D; break;
    case 8: w.src = a.in[20] + (size_t)layer * NEXP * D * DFFE; w.dst = wo + WTO_MGU / 2; w.K = D; w.N = DFFE; w.mode = 2; w.nbatch = NEXP; w.dst_bstride = (size_t)2 * DFFE * D; break;
    default: w.src = a.in[21] + (size_t)layer * NEXP * DFFE * D; w.dst = wo + WTO_MD / 2; w.K = DFFE; w.N = D; w.nbatch = NEXP; w.dst_bstride = (size_t)DFFE * D; break;
    }
    return w;
}
__device__ __forceinline__ void p0_prologue(Frame& F, const Args& a) {
    LAS float* scr = (LAS float*)(F.lds + RING_OFF + F.wave * 16384);
    const int gw = F.blk * NWAVES + F.wave, NGW = F.G * NWAVES;
    for (int d = 0; d < 20; ++d) {
        const WDesc w = get_desc(a, d);
        const int per = (w.K / 64) * (w.N / 32), nitems = per * w.nbatch;
        for (int it = gw; it < nitems; it += NGW) { const int bt = it / per, r = it % per;
            p0_transpose_item(w.src + (size_t)bt * w.K * w.N, w.K, w.N, w.dst + (size_t)bt * w.dst_bstride, w.mode, scr, r, F.lane); }
    }
    float* cs = (float*)(a.ws + WS_ROPE); float* sn = cs + SEQ * 32;
    for (int i = F.blk * 512 + F.tid; i < SEQ * 32; i += F.G * 512) { const int pos = i >> 5, j = i & 31;
        const float inv = 1.0f / powf(10000.0f, (float)j * (1.0f / 32.0f)); const float ang = (float)pos * inv;
        cs[i] = cosf(ang); sn[i] = sinf(ang); }
}

__device__ __forceinline__ void norm_phase(Frame& F, const float* xsrc, float* xdst, const float* gain, bf16* hn, bool do_combine, bool do_router, bool write_hn, const float* router_w) {
    unsigned char* ws = F.ws;
    const Route* route = (const Route*)(ws + WS_MISC); const int* slots = (const int*)(ws + WS_MISC + 256 * 1024); int* ccnt = (int*)(ws + WS_MISC + 384 * 1024);
    const bf16* Y = (const bf16*)(ws + WS_P);
    LAS float* wr = (LAS float*)(F.lds + RING_OFF);
    LAS int* lcnt = (LAS int*)(F.lds + RING_OFF + 32768);
    if (do_router) { for (int i = F.tid; i < 8192; i += 512) { const int d = i >> 3, e = i & 7; wr[e * 1024 + d] = router_w[i]; } }
    const int lane = F.lane;
    f32x4 gv[4];
#pragma unroll
    for (int j = 0; j < 4; ++j) gv[j] = *((const f32x4*)gain + lane + 64 * j);
    for (int c = F.blk; c < T / 64; c += F.G) {
        if (do_router) { if (F.tid < 8) lcnt[F.tid] = 0; }
        __syncthreads();
        for (int k = 0; k < 8; ++k) {
            const int row = c * 64 + F.wave * 8 + k;
            const f32x4* xr = (const f32x4*)(xsrc + (size_t)row * D) + lane;
            f32x4 v[4];
#pragma unroll
            for (int j = 0; j < 4; ++j) v[j] = xr[64 * j];
            if (do_combine) {
                const Route r = route[row]; const int s1 = slots[2 * row], s2 = slots[2 * row + 1];
                const v2u* y1 = (const v2u*)(Y + (size_t)s1 * D) + lane; const v2u* y2 = (const v2u*)(Y + (size_t)s2 * D) + lane;
#pragma unroll
                for (int j = 0; j < 4; ++j) { const v2u a = y1[64 * j], b = y2[64 * j];
                    v[j].x += r.g1 * bflo(a.x) + r.g2 * bflo(b.x); v[j].y += r.g1 * bfhi(a.x) + r.g2 * bfhi(b.x);
                    v[j].z += r.g1 * bflo(a.y) + r.g2 * bflo(b.y); v[j].w += r.g1 * bfhi(a.y) + r.g2 * bfhi(b.y); }
                f32x4* xo = (f32x4*)(xdst + (size_t)row * D) + lane;
#pragma unroll
                for (int j = 0; j < 4; ++j) xo[64 * j] = v[j];
            }
            if (write_hn) {
                float ss = 0.f;
#pragma unroll
                for (int j = 0; j < 4; ++j) ss += (v[j].x * v[j].x + v[j].y * v[j].y) + (v[j].z * v[j].z + v[j].w * v[j].w);
                ss = wave_sum(ss);
                const float rstd = 1.0f / sqrtf(ss * (1.0f / D) + EPS);
#pragma unroll
                for (int j = 0; j < 4; ++j) v[j] = v[j] * rstd * gv[j];
                v2u* o8 = (v2u*)(hn + (size_t)row * D) + lane;
#pragma unroll
                for (int j = 0; j < 4; ++j) { v2u o; o.x = pk2(v[j].x, v[j].y); o.y = pk2(v[j].z, v[j].w); o8[64 * j] = o; }
                if (do_router) {
                    float lg[8];
#pragma unroll
                    for (int e = 0; e < 8; ++e) { float s = 0.f;
#pragma unroll
                        for (int j = 0; j < 4; ++j) { const f32x4 w = *((const LAS f32x4*)(wr + e * 1024) + lane + 64 * j); s += (v[j].x * w.x + v[j].y * w.y) + (v[j].z * w.z + v[j].w * w.w); }
                        lg[e] = wave_sum(s); }
                    int e1 = 0; float v1 = lg[0];
#pragma unroll
                    for (int e = 1; e < 8; ++e) if (lg[e] > v1) { v1 = lg[e]; e1 = e; }
                    int e2 = -1; float v2 = -INFINITY;
#pragma unroll
                    for (int e = 0; e < 8; ++e) if (e != e1 && lg[e] > v2) { v2 = lg[e]; e2 = e; }
                    const float g2 = 1.0f / (1.0f + __expf(v1 - v2)), g1 = 1.0f - g2;
                    if (lane == 0) { Route r; r.e1 = e1; r.e2 = e2; r.g1 = g1; r.g2 = g2; ((Route*)route)[row] = r; __hip_atomic_fetch_add(&lcnt[e1], 1, __ATOMIC_RELAXED, __HIP_MEMORY_SCOPE_WORKGROUP); __hip_atomic_fetch_add(&lcnt[e2], 1, __ATOMIC_RELAXED, __HIP_MEMORY_SCOPE_WORKGROUP); }
                }
            }
        }
        __syncthreads();
        if (do_router) { if (F.tid < 8) ccnt[c * 8 + F.tid] = lcnt[F.tid]; }
        __syncthreads();
    }
}

__device__ __forceinline__ void route_phase(Frame& F, const bf16* hn, bf16* hsort) {
    unsigned char* ws = F.ws;
    const Route* route = (const Route*)(ws + WS_MISC); int* slots = (int*)(ws + WS_MISC + 256 * 1024); const int* ccnt = (const int*)(ws + WS_MISC + 384 * 1024); int* tile_base = (int*)(ws + WS_MISC + 512 * 1024);
    LAS int* tot = (LAS int*)(F.lds + RING_OFF); LAS int* bef = tot + 8; LAS int* base = tot + 16; LAS int* sl = tot + 32;
    for (int c = F.blk; c < T / 64; c += F.G) {
        { const int e = F.wave; int t = 0, b = 0;
#pragma unroll
            for (int q = 0; q < 4; ++q) { const int ch = F.lane * 4 + q; const int v = ccnt[ch * 8 + e]; t += v; b += (ch < c) ? v : 0; }
#pragma unroll
            for (int o = 1; o < 64; o <<= 1) { t += __shfl_xor(t, o); b += __shfl_xor(b, o); }
            if (F.lane == 0) { tot[e] = t; bef[e] = b; } }
        __syncthreads();
        if (F.tid == 0) { int acc = 0;
            for (int e = 0; e < 8; ++e) { base[e] = acc; if (c == 0) tile_base[e] = acc >> 8; acc += (tot[e] + 255) & ~255; }
            if (c == 0) tile_base[8] = acc >> 8; }
        __syncthreads();
        if (F.wave == 0) {
            const int row = c * 64 + F.lane; const Route r = route[row];
            int run[8];
#pragma unroll
            for (int e = 0; e < 8; ++e) run[e] = base[e] + bef[e];
#pragma unroll
            for (int k = 0; k < 2; ++k) { const int me = k ? r.e2 : r.e1; int myslot = 0;
#pragma unroll
                for (int e = 0; e < 8; ++e) { const unsigned long long m = __ballot(me == e); const int rank = __popcll(m & ((1ull << F.lane) - 1ull));
                    if (me == e) myslot = run[e] + rank; run[e] += __popcll(m); }
                slots[2 * row + k] = myslot; sl[2 * F.lane + k] = myslot; }
        }
        __syncthreads();
        for (int p = F.wave; p < 128; p += NWAVES) { const int row = c * 64 + (p >> 1); const int s = sl[p];
            const v4u* src = (const v4u*)(hn + (size_t)row * D); v4u* dst = (v4u*)(hsort + (size_t)s * D);
            dst[F.lane] = src[F.lane]; dst[F.lane + 64] = src[F.lane + 64]; }
        __syncthreads();
    }
}

__device__ __forceinline__ int srow(int s, int g) { return g == 0 ? s : (g == 1 ? ((s & 3) * 1024 + (s >> 2)) : ((s & 15) * 256 + (s >> 4))); }
__device__ __forceinline__ float rope_apply(float n, int lane, const float* cs, const float* sn, int s) {
    const float partner = __shfl_xor(n, 32); const int j = lane & 31; const float c = cs[s * 32 + j], si = sn[s * 32 + j];
    return lane < 32 ? n * c - partner * si : n * c + partner * si;
}
__device__ __forceinline__ void post_even(Frame& F, const bf16* rawp, const float* vgain, const float* qgain, const float* kgain) {
    unsigned char* ws = F.ws; bf16* UV = (bf16*)(ws + WS_P + P_UV); bf16* Qs = (bf16*)(ws + WS_P + P_QS); bf16* Ks = (bf16*)(ws + WS_P + P_KS); bf16* Vs = (bf16*)(ws + WS_P + P_VS);
    const float* cs = (const float*)(ws + WS_ROPE); const float* sn = cs + SEQ * 32;
    const int lane = F.lane; const float qg = qgain[lane], kg = kgain[lane];
    const long nitems = (long)T * 44;
    for (long it = (long)F.blk * NWAVES + F.wave; it < nitems; it += (long)F.G * NWAVES) {
        const int row = (int)(it / 44), u = (int)(it % 44), b = row >> 12, s = row & 4095;
        const float v = bf2f(rawp[(size_t)row * EVEN_IN + 64 * u + lane]);
        if (u < 4) { UV[(size_t)row * 512 + 64 * u + lane] = (bf16)f2bf(gelu_tanh(v)); }
        else if (u < 8) { const float z = gelu_tanh(v); const float ss = wave_sum(z * z); const float o = z * (1.0f / sqrtf(ss * (1.0f / 64) + EPS)) * vgain[(u - 4) * 64 + lane];
            UV[(size_t)row * 512 + 64 * u + lane] = (bf16)f2bf(o); }
        else if (u < 32) { const bool isq = u < 20; const int h = isq ? u - 8 : u - 20; const float ss = wave_sum(v * v);
            const float n = v * (1.0f / sqrtf(ss * (1.0f / 64) + EPS)) * (isq ? qg : kg); const float o = rope_apply(n, lane, cs, sn, s);
            (isq ? Qs : Ks)[((size_t)(b * 12 + h) * SEQ + srow(s, h >> 2)) * 64 + lane] = (bf16)f2bf(o); }
        else { const int h = u - 32; Vs[((size_t)(b * 12 + h) * SEQ + srow(s, h >> 2)) * 64 + lane] = (bf16)f2bf(v); }
    }
}
__device__ __forceinline__ void post_odd(Frame& F, const bf16* rawp, const float* qgain, const float* kgain) {
    unsigned char* ws = F.ws; bf16* Qm = (bf16*)(ws + WS_P + P_QM); bf16* Km = (bf16*)(ws + WS_P + P_KM); bf16* Vm = (bf16*)(ws + WS_P + P_VM);
    const float* cs = (const float*)(ws + WS_ROPE); const float* sn = cs + SEQ * 32;
    const int lane = F.lane; const float qg = qgain[lane], kg = kgain[lane];
    const long nitems = (long)T * 36;
    for (long it = (long)F.blk * NWAVES + F.wave; it < nitems; it += (long)F.G * NWAVES) {
        const int row = (int)(it / 36), u = (int)(it % 36), b = row >> 12, s = row & 4095;
        const float v = bf2f(rawp[(size_t)row * ODD_IN + 64 * u + lane]);
        if (u < 24) { const bool isq = u < 12; const int h = isq ? u : u - 12; const float ss = wave_sum(v * v);
            const float n = v * (1.0f / sqrtf(ss * (1.0f / 64) + EPS)) * (isq ? qg : kg); const float o = rope_apply(n, lane, cs, sn, s);
            (isq ? Qm : Km)[((size_t)(b * 12 + h) * SEQ + s) * 64 + lane] = (bf16)f2bf(o); }
        else { const int h = u - 24; Vm[((size_t)(b * 12 + h) * SEQ + s) * 64 + lane] = (bf16)f2bf(v); }
    }
}
__device__ __forceinline__ void kmean_phase(Frame& F) {
    const bf16* Km = (const bf16*)(F.ws + WS_P + P_KM); float* km = (float*)(F.ws + WS_KMEAN);
    for (int it = F.blk * NWAVES + F.wave; it < 48 * 16; it += F.G * NWAVES) {
        const bf16* k = Km + (size_t)it * 256 * 64 + F.lane; float s = 0.f;
        for (int r = 0; r < 256; ++r) s += bf2f(k[r * 64]);
        km[it * 64 + F.lane] = s * (1.0f / 256.0f);
    }
}

__device__ __forceinline__ void load_row64(const bf16* p, float (&q)[64]) {
    const v4u* p4 = (const v4u*)p;
#pragma unroll
    for (int i = 0; i < 8; ++i) { const v4u w = p4[i]; q[8 * i + 0] = bflo(w.x); q[8 * i + 1] = bfhi(w.x); q[8 * i + 2] = bflo(w.y); q[8 * i + 3] = bfhi(w.y); q[8 * i + 4] = bflo(w.z); q[8 * i + 5] = bfhi(w.z); q[8 * i + 6] = bflo(w.w); q[8 * i + 7] = bfhi(w.w); }
}
__device__ __forceinline__ float dot_row64(const bf16* p, const float (&q)[64]) {
    const v4u* p4 = (const v4u*)p; float s = 0.f;
#pragma unroll
    for (int i = 0; i < 8; ++i) { const v4u w = p4[i]; s += q[8 * i + 0] * bflo(w.x) + q[8 * i + 1] * bfhi(w.x) + q[8 * i + 2] * bflo(w.y) + q[8 * i + 3] * bfhi(w.y) + q[8 * i + 4] * bflo(w.z) + q[8 * i + 5] * bfhi(w.z) + q[8 * i + 6] * bflo(w.w) + q[8 * i + 7] * bfhi(w.w); }
    return s;
}
__device__ __forceinline__ void banded_naive(Frame& F) {
    unsigned char* ws = F.ws; const bf16* Qs = (const bf16*)(ws + WS_P + P_QS); const bf16* Ks = (const bf16*)(ws + WS_P + P_KS); const bf16* Vs = (const bf16*)(ws + WS_P + P_VS);
    bf16* OG = (bf16*)(ws + WS_HID + H_OG); float* LSE = (float*)(ws + WS_HID + H_LSE);
    LAS float* pl = (LAS float*)(F.lds + RING_OFF) + F.wave * 256;
    const int lane = F.lane;
    for (int it = F.blk * NWAVES + F.wave; it < 48 * SEQ; it += F.G * NWAVES) {
        const int bh = it >> 12, rp = it & 4095, b = bh / 12, h = bh % 12, g = h >> 2, dil = g == 0 ? 1 : (g == 1 ? 4 : 16), L = SEQ / dil;
        const int i = rp % L, r = rp / L, s = i * dil + r, nk = (i < 128 ? i : 128) + 1, first = rp - (nk - 1);
        float q[64]; load_row64(Qs + ((size_t)bh * SEQ + rp) * 64, q);
        float sc[3]; float m = -INFINITY;
#pragma unroll
        for (int kk = 0; kk < 3; ++kk) { const int j = lane + 64 * kk; sc[kk] = -INFINITY; if (j < nk) { sc[kk] = 0.125f * dot_row64(Ks + ((size_t)bh * SEQ + first + j) * 64, q); } m = fmaxf(m, sc[kk]); }
        m = wave_max(m); float l = 0.f;
#pragma unroll
        for (int kk = 0; kk < 3; ++kk) { const float p = (lane + 64 * kk < nk) ? __expf(sc[kk] - m) : 0.f; pl[lane + 64 * kk] = p; l += p; }
        l = wave_sum(l); LDS_WAIT();
        float acc = 0.f; const bf16* vb = Vs + ((size_t)bh * SEQ + first) * 64 + lane;
        for (int j = 0; j < nk; ++j) acc += pl[j] * bf2f(vb[(size_t)j * 64]);
        const size_t orow = ((size_t)g * T + (size_t)b * SEQ + s) * 4 + (h & 3);
        OG[orow * 64 + lane] = (bf16)f2bf(acc / l);
        if (lane == 0) LSE[orow] = m + __logf(l);
        LDS_WAIT();
    }
}
__device__ __forceinline__ void merge_even(Frame& F, bf16* mix) {
    const bf16* OG = (const bf16*)(F.ws + WS_HID + H_OG); const float* LSE = (const float*)(F.ws + WS_HID + H_LSE);
    for (int it = F.blk * NWAVES + F.wave; it < T * 4; it += F.G * NWAVES) {
        const float l0 = LSE[it], l1 = LSE[(size_t)T * 4 + it], l2 = LSE[(size_t)2 * T * 4 + it]; const float m = fmaxf(l0, fmaxf(l1, l2));
        const float w0 = __expf(l0 - m), w1 = __expf(l1 - m), w2 = __expf(l2 - m), inv = 1.0f / (w0 + w1 + w2);
        const float o = (w0 * bf2f(OG[(size_t)it * 64 + F.lane]) + w1 * bf2f(OG[((size_t)T * 4 + it) * 64 + F.lane]) + w2 * bf2f(OG[((size_t)2 * T * 4 + it) * 64 + F.lane])) * inv;
        mix[(size_t)(it >> 2) * EVEN_OUT + 256 + (it & 3) * 64 + F.lane] = (bf16)f2bf(o);
    }
}
__device__ __forceinline__ void gmlp_phase(Frame& F, const float* wsp, const float* bsp, bf16* mix) {
    const bf16* UV = (const bf16*)(F.ws + WS_P + P_UV);
    LAS float* WT = (LAS float*)(F.lds + RING_OFF);
    LAS float* VL = WT + 128 * 128;
    const int tid = F.tid;
    for (int unit = F.blk; unit < (T / 128) * 4; unit += F.G) {
        const int c = unit >> 2, g = unit & 3, row0 = c * 128;
        __syncthreads();
        { const int i = tid & 127; const float* wrow = wsp + ((size_t)g * 128 + i) * 128;
          for (int jq = tid >> 7; jq < 32; jq += 4) { const f32x4 w = *(const f32x4*)(wrow + 4 * jq);
              WT[(4 * jq + 0) * 128 + i] = (4 * jq + 0 <= i) ? w.x : 0.f; WT[(4 * jq + 1) * 128 + i] = (4 * jq + 1 <= i) ? w.y : 0.f;
              WT[(4 * jq + 2) * 128 + i] = (4 * jq + 2 <= i) ? w.z : 0.f; WT[(4 * jq + 3) * 128 + i] = (4 * jq + 3 <= i) ? w.w : 0.f; } }
        for (int e = tid; e < 128 * 64; e += 512) { const int j = e >> 6, d = e & 63; VL[e] = bf2f(UV[(size_t)(row0 + j) * 512 + 256 + g * 64 + d]); }
        __syncthreads();
        const int i0 = 4 * (tid >> 4), d0 = 4 * (tid & 15);
        f32x4 acc[4];
#pragma unroll
        for (int a = 0; a < 4; ++a) acc[a] = (f32x4){0.f, 0.f, 0.f, 0.f};
        const int jmax = i0 + 3;
        for (int j = 0; j <= jmax; ++j) { const f32x4 w = *(const LAS f32x4*)(WT + j * 128 + i0); const f32x4 v = *(const LAS f32x4*)(VL + j * 64 + d0);
            acc[0] += w.x * v; acc[1] += w.y * v; acc[2] += w.z * v; acc[3] += w.w * v; }
#pragma unroll
        for (int a = 0; a < 4; ++a) { const int i = i0 + a; const float bb = bsp[g * 128 + i]; const size_t row = row0 + i;
            const v2u uu = *(const v2u*)(UV + row * 512 + g * 64 + d0);
            v2u o; o.x = pk2(bflo(uu.x) * (acc[a].x + bb), bfhi(uu.x) * (acc[a].y + bb)); o.y = pk2(bflo(uu.y) * (acc[a].z + bb), bfhi(uu.y) * (acc[a].w + bb));
            *(v2u*)(mix + row * EVEN_OUT + g * 64 + d0) = o; }
    }
    __syncthreads();
}
__device__ __forceinline__ void moba_naive(Frame& F, bf16* mix) {
    unsigned char* ws = F.ws; const bf16* Qm = (const bf16*)(ws + WS_P + P_QM); const bf16* Km = (const bf16*)(ws + WS_P + P_KM); const bf16* Vm = (const bf16*)(ws + WS_P + P_VM);
    const float* km = (const float*)(ws + WS_KMEAN);
    LAS float* sc = (LAS float*)(F.lds + RING_OFF) + F.wave * 1024;
    const int lane = F.lane;
    for (int it = F.blk * NWAVES + F.wave; it < 48 * SEQ; it += F.G * NWAVES) {
        const int bh = it >> 12, s = it & 4095, b = bh / 12, h = bh % 12, qb = s >> 8;
        float q[64]; load_row64(Qm + ((size_t)bh * SEQ + s) * 64, q);
        float gate = -INFINITY;
        if (lane < qb) { const f32x4* kp = (const f32x4*)(km + ((size_t)bh * 16 + lane) * 64); float a = 0.f;
#pragma unroll
            for (int i = 0; i < 16; ++i) { const f32x4 w = kp[i]; a += q[4 * i] * w.x + q[4 * i + 1] * w.y + q[4 * i + 2] * w.z + q[4 * i + 3] * w.w; }
            gate = a; }
        unsigned sel = 1u << qb;
        for (int r = 0; r < 3; ++r) { float v = gate; int idx = lane;
#pragma unroll
            for (int o = 1; o < 64; o <<= 1) { const float ov = __shfl_xor(v, o); const int oi = __shfl_xor(idx, o); if (ov > v || (ov == v && oi < idx)) { v = ov; idx = oi; } }
            if (v > -INFINITY) { sel |= 1u << idx; if (lane == idx) gate = -INFINITY; } }
        int cnt = 0; float m = -INFINITY;
        for (int n = 0; n <= qb; ++n) { if (!((sel >> n) & 1u)) continue;
#pragma unroll
            for (int kk = 0; kk < 4; ++kk) { const int key = n * 256 + kk * 64 + lane; float x = -INFINITY;
                if (key <= s) x = 0.125f * dot_row64(Km + ((size_t)bh * SEQ + key) * 64, q);
                sc[cnt * 256 + kk * 64 + lane] = x; m = fmaxf(m, x); }
            ++cnt; }
        m = wave_max(m); float l = 0.f; LDS_WAIT();
        for (int i = lane; i < cnt * 256; i += 64) { const float p = __expf(sc[i] - m); sc[i] = p; l += p; }
        l = wave_sum(l); LDS_WAIT();
        float acc = 0.f; int c2 = 0;
        for (int n = 0; n <= qb; ++n) { if (!((sel >> n) & 1u)) continue;
            const bf16* vb = Vm + ((size_t)bh * SEQ + n * 256) * 64 + lane; const int kend = (n == qb) ? (s & 255) + 1 : 256;
            for (int kk = 0; kk < kend; ++kk) acc += sc[c2 * 256 + kk] * bf2f(vb[(size_t)kk * 64]);
            ++c2; }
        mix[((size_t)b * SEQ + s) * ODD_OUT + h * 64 + lane] = (bf16)f2bf(acc / l);
        LDS_WAIT();
    }
}
__device__ __forceinline__ void conv_phase(Frame& F, const bf16* rawp, const float* cw, bf16* mix) {
    for (int it = F.blk * 512 + F.tid; it < T * 256; it += F.G * 512) {
        const int row = it >> 8, c = it & 255, s = row & 4095;
        const bf16* p = rawp + (size_t)row * ODD_IN;
        const float z0 = bf2f(p[2560 + c]) * bf2f(p[2816 + c]);
        const float z1 = s >= 1 ? bf2f(p[2560 + c - ODD_IN]) * bf2f(p[2816 + c - ODD_IN]) : 0.f;
        const float z2 = s >= 2 ? bf2f(p[2560 + c - 2 * ODD_IN]) * bf2f(p[2816 + c - 2 * ODD_IN]) : 0.f;
        const float y = cw[c] * z2 + cw[256 + c] * z1 + cw[512 + c] * z0;
        mix[(size_t)row * ODD_OUT + 768 + c] = (bf16)f2bf(bf2f(p[2304 + c]) * y);
    }
}

constexpr int PH_PER_PAIR = 19, NPH = 1 + 2 * PH_PER_PAIR + 1;
__global__ void __launch_bounds__(NWAVES * 64, 2) fwd(Args args) {
    extern __shared__ __attribute__((aligned(16))) unsigned char lds[];
#define MKFRAME() Frame F; { int t_ = threadIdx.x; asm volatile("" : "+v"(t_)); int b_ = blockIdx.x; asm volatile("" : "+s"(b_)); \
    F.lds = (LAS unsigned char*)lds; F.MISC = (volatile LAS unsigned*)(F.lds + MISC_OFF); F.tid = t_; F.lane = t_ & 63; F.wave = __builtin_amdgcn_readfirstlane(t_ >> 6); \
    F.G = gridDim.x; F.blk = b_; F.ws = args.ws; F.out = args.out; F.ctl = (gu32*)(args.ws + WS_CTL); }
    for (int u = threadIdx.x; u < (LDS_BYTES - LDSCTL_OFF) / 4; u += NWAVES * 64) ((LAS unsigned*)((LAS unsigned char*)lds + LDSCTL_OFF))[u] = 0u;
    __syncthreads();
    const int lo = args.ph_lo, hi = args.ph_hi;
    XcdBarrier bar; bar.bar = (unsigned*)(args.ws + WS_CTL) + CW_BAR; bar.x = 0; bar.st = nullptr;
    if (hi - lo > 1) bar = xcd_barrier_post((unsigned*)(args.ws + WS_CTL) + CW_BAR, (volatile LAS unsigned*)((LAS unsigned char*)lds + MISC_OFF) + 8);
#ifndef PHMASK
#define PHMASK 0xFFFFFF
#endif
#define PHEN(k) (((PHMASK) >> (k)) & 1)
#define IN(k) (lo <= (k) && (k) < hi)
#define SEAM(k) do { if (IN(k) && IN((k) + 1)) xcd_barrier(bar); } while (0)
#define HN ((bf16*)(args.ws + WS_HN))
#define MIX ((bf16*)(args.ws + WS_MIX))
#define HID ((bf16*)(args.ws + WS_HID))
#define RAWP ((bf16*)(args.ws + WS_HID + H_RAWP))
#define HSORT ((bf16*)(args.ws + WS_P))
#define YB ((bf16*)(args.ws + WS_P))
#define x_in (args.in[0])

    if (PHEN(19) && IN(0)) { MKFRAME(); p0_prologue(F, args); SEAM(0); }

    for (int lp = 0; lp < 2; ++lp) {
        const int pb = 1 + lp * PH_PER_PAIR;
        const int le = 2 * lp, lo_ = 2 * lp + 1;
#define we ((const pg8::bf16_t*)(args.ws + WS_WT_EVEN0 + (size_t)lp * WT_EVEN_BYTES))
#define wo ((const pg8::bf16_t*)(args.ws + WS_WT_ODD0 + (size_t)lp * WT_ODD_BYTES))
        if (PHEN(0) && IN(pb + 0)) { MKFRAME();
            norm_phase(F, lp == 0 ? x_in : F.out, F.out, args.in[1] + (size_t)le * D, HN, lp != 0, false, true, nullptr);
            SEAM(pb + 0); }
        if (PHEN(1) && IN(pb + 1)) { MKFRAME();
            pg8::Gemm g{HN, we + WTE_IN / 2, T, EVEN_IN, D}; pg8::StaticOrder S; S.init(T, EVEN_IN, F.G, F.blk);
            pg8::EpiBf16Plain E{RAWP, EVEN_IN};
            pg8::gemm_phase<pg8::EpiBf16Plain, pg8::StaticOrder>(F.lds + RING_OFF, g, S, E);
            SEAM(pb + 1); }
        if (PHEN(2) && IN(pb + 2)) { MKFRAME(); post_even(F, RAWP, args.in[4] + (size_t)lp * 256, args.in[7] + (size_t)lp * 64, args.in[8] + (size_t)lp * 64); SEAM(pb + 2); }
        if (PHEN(3) && IN(pb + 3)) { MKFRAME(); banded_naive(F); gmlp_phase(F, args.in[5] + (size_t)lp * 4 * 128 * 128, args.in[6] + (size_t)lp * 4 * 128, MIX); SEAM(pb + 3); }
        if (PHEN(4) && IN(pb + 4)) { MKFRAME(); merge_even(F, MIX); SEAM(pb + 4); }
        if (PHEN(5) && IN(pb + 5)) { MKFRAME();
            pg8::Gemm g{MIX, we + WTE_OUT / 2, T, D, EVEN_OUT}; pg8::StaticOrder S; S.init(T, D, F.G, F.blk);
            pg8::EpiF32Res E{lp == 0 ? x_in : F.out, F.out, D};
            pg8::gemm_phase<pg8::EpiF32Res, pg8::StaticOrder>(F.lds + RING_OFF, g, S, E);
            SEAM(pb + 5); }
        if (PHEN(6) && IN(pb + 6)) { MKFRAME(); norm_phase(F, F.out, F.out, args.in[2] + (size_t)le * D, HN, false, false, true, nullptr); SEAM(pb + 6); }
        if (PHEN(7) && IN(pb + 7)) { MKFRAME();
            pg8::Gemm g{HN, we + WTE_GU / 2, T, 2 * DFF, D}; pg8::StaticOrder S; S.init(T, 2 * DFF, F.G, F.blk);
            pg8::EpiSwiGLU E{HID, DFF};
            pg8::gemm_phase<pg8::EpiSwiGLU, pg8::StaticOrder>(F.lds + RING_OFF, g, S, E);
            SEAM(pb + 7); }
        if (PHEN(8) && IN(pb + 8)) { MKFRAME();
            pg8::Gemm g{HID, we + WTE_DN / 2, T, D, DFF}; pg8::StaticOrder S; S.init(T, D, F.G, F.blk);
            pg8::EpiF32Res E{F.out, F.out, D};
            pg8::gemm_phase<pg8::EpiF32Res, pg8::StaticOrder>(F.lds + RING_OFF, g, S, E);
            SEAM(pb + 8); }
        if (PHEN(9) && IN(pb + 9)) { MKFRAME(); norm_phase(F, F.out, F.out, args.in[1] + (size_t)lo_ * D, HN, false, false, true, nullptr); SEAM(pb + 9); }
        if (PHEN(10) && IN(pb + 10)) { MKFRAME();
            pg8::Gemm g{HN, wo + WTO_IN / 2, T, ODD_IN, D}; pg8::StaticOrder S; S.init(T, ODD_IN, F.G, F.blk);
            pg8::EpiBf16Plain E{RAWP, ODD_IN};
            pg8::gemm_phase<pg8::EpiBf16Plain, pg8::StaticOrder>(F.lds + RING_OFF, g, S, E);
            SEAM(pb + 10); }
        if (PHEN(11) && IN(pb + 11)) { MKFRAME(); post_odd(F, RAWP, args.in[14] + (size_t)lp * 64, args.in[15] + (size_t)lp * 64); SEAM(pb + 11); }
        if (PHEN(12) && IN(pb + 12)) { MKFRAME(); kmean_phase(F); SEAM(pb + 12); }
        if (PHEN(13) && IN(pb + 13)) { MKFRAME(); moba_naive(F, MIX); conv_phase(F, RAWP, args.in[16] + (size_t)lp * 3 * 256, MIX); SEAM(pb + 13); }
        if (PHEN(14) && IN(pb + 14)) { MKFRAME();
            pg8::Gemm g{MIX, wo + WTO_OUT / 2, T, D, ODD_OUT}; pg8::StaticOrder S; S.init(T, D, F.G, F.blk);
            pg8::EpiF32Res E{F.out, F.out, D};
            pg8::gemm_phase<pg8::EpiF32Res, pg8::StaticOrder>(F.lds + RING_OFF, g, S, E);
            SEAM(pb + 14); }
        if (PHEN(15) && IN(pb + 15)) { MKFRAME(); norm_phase(F, F.out, F.out, args.in[2] + (size_t)lo_ * D, HN, false, true, true, args.in[18] + (size_t)lp * D * NEXP); SEAM(pb + 15); }
        if (PHEN(16) && IN(pb + 16)) { MKFRAME(); route_phase(F, HN, HSORT); SEAM(pb + 16); }
        if (PHEN(17) && IN(pb + 17)) { MKFRAME();
            const int* tbp = (const int*)(args.ws + WS_MISC + 512 * 1024);
            pg8::MoeOrder S; const int ntiles = tbp[8]; S.init(ntiles * 256, 2 * DFFE, F.G, F.blk);
#pragma unroll
            for (int k = 0; k < 8; ++k) S.tb[k] = tbp[k];
            S.estride = (size_t)2 * DFFE * D * 2;
            pg8::Gemm g{HSORT, wo + WTO_MGU / 2, ntiles * 256, 2 * DFFE, D};
            pg8::EpiSwiGLU E{HID, DFFE};
            pg8::gemm_phase<pg8::EpiSwiGLU, pg8::MoeOrder>(F.lds + RING_OFF, g, S, E);
            SEAM(pb + 17); }
        if (PHEN(18) && IN(pb + 18)) { MKFRAME();
            const int* tbp = (const int*)(args.ws + WS_MISC + 512 * 1024);
            pg8::MoeOrder S; const int ntiles = tbp[8]; S.init(ntiles * 256, D, F.G, F.blk);
#pragma unroll
            for (int k = 0; k < 8; ++k) S.tb[k] = tbp[k];
            S.estride = (size_t)DFFE * D * 2;
            pg8::Gemm g{HID, wo + WTO_MD / 2, ntiles * 256, D, DFFE};
            pg8::EpiBf16Plain E{YB, D};
            pg8::gemm_phase<pg8::EpiBf16Plain, pg8::MoeOrder>(F.lds + RING_OFF, g, S, E);
            SEAM(pb + 18); }
    }
    if (PHEN(20) && IN(NPH - 1)) { MKFRAME(); norm_phase(F, F.out, F.out, args.in[1], HN, true, false, false, nullptr); }
#undef IN
#undef SEAM
#undef HN
#undef MIX
#undef HID
#undef RAWP
#undef HSORT
#undef YB
#undef x_in
#undef we
#undef wo
}

extern "C" void kernel_launch(void* const* d_in, const int* in_sizes, int n_in, void* d_out, int out_size, void* d_ws, size_t ws_size, hipStream_t stream) {
    static int grid = 0;
    if (grid == 0) {
        if (n_in != 22 || out_size != T * D || ws_size < WS_END) { fprintf(stderr, "kernel_launch: unexpected shapes (n_in %d out %d ws %zu)\n", n_in, out_size, ws_size); grid = -1; return; }
        int dev = 0, cus = 0, per_cu = 0;
        if (hipGetDevice(&dev) != hipSuccess || hipDeviceGetAttribute(&cus, hipDeviceAttributeMultiprocessorCount, dev) != hipSuccess) { grid = -1; return; }
        if (hipFuncSetAttribute((const void*)fwd, hipFuncAttributeMaxDynamicSharedMemorySize, LDS_BYTES) != hipSuccess) { fprintf(stderr, "kernel_launch: hipFuncSetAttribute failed\n"); grid = -1; return; }
        if (hipOccupancyMaxActiveBlocksPerMultiprocessor(&per_cu, (const void*)fwd, NWAVES * 64, LDS_BYTES) != hipSuccess || per_cu < 1) fprintf(stderr, "kernel_launch: occupancy query says %d\n", per_cu);
        (void)hipGetLastError();
        grid = cus;
    }
    if (grid < 0) return;
    (void)hipMemsetAsync((char*)d_ws + WS_CTL, 0, CTL_ZERO_BYTES, stream);
    Args a{};
    for (int i = 0; i < 22; ++i) a.in[i] = (const float*)d_in[i];
    a.out = (float*)d_out; a.ws = (unsigned char*)d_ws;
#if MK_PER_PHASE
    for (int p = 0; p < NPH; ++p) { a.ph_lo = p; a.ph_hi = p + 1; hipLaunchKernelGGL(fwd, dim3(grid), dim3(NWAVES * 64), LDS_BYTES, stream, a); }
#else
    a.ph_lo = 0; a.ph_hi = NPH; hipLaunchKernelGGL(fwd, dim3(grid), dim3(NWAVES * 64), LDS_BYTES, stream, a);
#endif
}
```

```cpp
#include <hip/hip_runtime.h>
#include <cstdio>
#include <cstdint>

#ifndef MK_PER_PHASE
#define MK_PER_PHASE 0
#endif

namespace pg8 {
#define PG8_LAS __attribute__((address_space(3)))
typedef unsigned short bf16_t;
typedef short bf16x8 __attribute__((ext_vector_type(8)));
typedef float f32x4 __attribute__((ext_vector_type(4)));
typedef float f32x2 __attribute__((ext_vector_type(2)));
typedef unsigned u32x4 __attribute__((ext_vector_type(4)));
constexpr int BM = 256, BK = 64, HALF = 128, HTB = HALF * BK * 2, STAGE_BYTES = 8 * HTB, NXCD = 8, WGM = 8;

__host__ __device__ __forceinline__ int lds_byte(int r, int c) { const int st = (r >> 4) * 2 + (c >> 5), rr = r & 15, cc = c & 31, ob = rr * 64 + cc * 2; return st * 1024 + (ob ^ (((ob >> 9) & 1) << 5)); }
__host__ __device__ __forceinline__ void stage_rc(int b, int& R, int& C) { const int st = b / 1024, sb = b % 1024, swz = sb ^ (((sb >> 9) & 1) << 5); R = (st >> 1) * 16 + swz / 64; C = (st & 1) * 32 + (swz % 64) / 2; }
__host__ __device__ __forceinline__ int perm32(int rho) { const int n = rho >> 4, i = rho & 15; return 8 * (i >> 2) + 4 * n + (i & 3); }

struct Unit { int pm, pn; };
struct Gemm { const bf16_t* A; const bf16_t* Bt; int M, N, K; };

struct StaticOrder {
    int nM, nN, nwg, G, c;
    __device__ void init(int M, int N, int G_, int c_) { nM = M / BM; nN = N / BM; nwg = nM * nN; G = G_; c = c_; }
    __device__ bool next(int i, Unit& u) const {
        const long L = (long)i * G + c; if (L >= nwg) return false;
        int wgid = (int)L; { const int q = nwg / NXCD, r = nwg % NXCD, xcd = wgid % NXCD, off = wgid / NXCD; wgid = (xcd < r ? xcd * (q + 1) : r * (q + 1) + (xcd - r) * q) + off; }
        const int nig = WGM * nN, gid = wgid / nig, fm = gid * WGM, gsz = (nM - fm) < WGM ? (nM - fm) : WGM;
        u.pm = fm + ((wgid % nig) % gsz); u.pn = (wgid % nig) / gsz; return true;
    }
    __device__ __forceinline__ const char* bbase(const Unit&, const bf16_t* Bt) const { return (const char*)Bt; }
};
struct MoeOrder : StaticOrder {
    int tb[8]; size_t estride;
    __device__ __forceinline__ const char* bbase(const Unit& u, const bf16_t* Bt) const {
        int e = 0;
#pragma unroll
        for (int k = 1; k < 8; ++k) e += (u.pm >= tb[k]) ? 1 : 0;
        return (const char*)Bt + (size_t)e * estride;
    }
};

__device__ __forceinline__ unsigned cvt_pk_bf16(float lo, float hi) { unsigned r; asm volatile("v_cvt_pk_bf16_f32 %0, %1, %2" : "=v"(r) : "v"(lo), "v"(hi)); return r; }

struct EpiBf16Plain {
    static constexpr bool PERM = true;
    bf16_t* O; int ldc;
    __device__ __forceinline__ void operator()(const f32x4 (&acc)[2][2][4][2], const Unit& u, int wr, int wc, int fr, int fq) const {
        const int row0 = u.pm * BM + wr * 64 + fr, col0 = u.pn * BM + wc * 32 + 8 * fq;
#pragma unroll
        for (int ai = 0; ai < 2; ++ai)
#pragma unroll
            for (int m = 0; m < 4; ++m) { bf16_t* rowp = O + (size_t)(row0 + ai * HALF + m * 16) * ldc + col0;
#pragma unroll
                for (int bj = 0; bj < 2; ++bj) { const f32x4 v0 = acc[ai][bj][m][0], v1 = acc[ai][bj][m][1];
                    u32x4 w; w.x = cvt_pk_bf16(v0[0], v0[1]); w.y = cvt_pk_bf16(v0[2], v0[3]); w.z = cvt_pk_bf16(v1[0], v1[1]); w.w = cvt_pk_bf16(v1[2], v1[3]);
                    *(u32x4*)(rowp + bj * HALF) = w; } }
    }
};
struct EpiF32Res {
    static constexpr bool PERM = false;
    const float* base; float* out; int ldc;
    __device__ __forceinline__ void operator()(const f32x4 (&acc)[2][2][4][2], const Unit& u, int wr, int wc, int fr, int fq) const {
        const int row0 = u.pm * BM + wr * 64 + fr, col0 = u.pn * BM + wc * 32 + 4 * fq;
#pragma unroll
        for (int ai = 0; ai < 2; ++ai)
#pragma unroll
            for (int m = 0; m < 4; ++m) { const size_t off = (size_t)(row0 + ai * HALF + m * 16) * ldc + col0;
#pragma unroll
                for (int bj = 0; bj < 2; ++bj)
#pragma unroll
                    for (int n = 0; n < 2; ++n) { const f32x4 bs = *(const f32x4*)(base + off + bj * HALF + n * 16); *(f32x4*)(out + off + bj * HALF + n * 16) = bs + acc[ai][bj][m][n]; }
                asm volatile("" ::: "memory"); }
    }
};
__device__ __forceinline__ float silu_mul(float g, float u) { return g * __builtin_amdgcn_rcpf(1.0f + __builtin_amdgcn_exp2f(-1.4426950408889634f * g)) * u; }
struct EpiSwiGLU {
    static constexpr bool PERM = true;
    bf16_t* O; int ldc;
    __device__ __forceinline__ void operator()(const f32x4 (&acc)[2][2][4][2], const Unit& u, int wr, int wc, int fr, int fq) const {
        const int row0 = u.pm * BM + wr * 64 + fr, col0 = u.pn * HALF + wc * 32 + 8 * fq;
#pragma unroll
        for (int ai = 0; ai < 2; ++ai)
#pragma unroll
            for (int m = 0; m < 4; ++m) { bf16_t* rowp = O + (size_t)(row0 + ai * HALF + m * 16) * ldc + col0;
                const f32x4 g0 = acc[ai][0][m][0], g1 = acc[ai][0][m][1], u0 = acc[ai][1][m][0], u1 = acc[ai][1][m][1];
                u32x4 w; w.x = cvt_pk_bf16(silu_mul(g0[0], u0[0]), silu_mul(g0[1], u0[1])); w.y = cvt_pk_bf16(silu_mul(g0[2], u0[2]), silu_mul(g0[3], u0[3]));
                w.z = cvt_pk_bf16(silu_mul(g1[0], u1[0]), silu_mul(g1[1], u1[1])); w.w = cvt_pk_bf16(silu_mul(g1[2], u1[2]), silu_mul(g1[3], u1[3]));
                *(u32x4*)rowp = w; }
    }
};

template <class Epi, class Sched, bool ALIGN_EPI = true, bool SP2 = true>
__device__ __forceinline__ void gemm_phase(PG8_LAS unsigned char* lds, const Gemm g, const Sched& S, const Epi& E) {
    int tid_ = threadIdx.x; asm volatile("" : "+v"(tid_));
    const int tid = tid_, wid = __builtin_amdgcn_readfirstlane(tid >> 6), lane = tid & 63, wr = wid >> 2, wc = wid & 3, fr = lane & 15, fq = lane >> 4;
    const int K = g.K, nt = K / BK;
    unsigned voffA[2], voffB[2];
#pragma unroll
    for (int i = 0; i < 2; ++i) { int R, C; stage_rc(tid * 16 + i * 8192, R, C); const int Rb = Epi::PERM ? ((R & ~31) + perm32(R & 31)) : R;
        voffA[i] = (unsigned)(R * K + C) * 2u; voffB[i] = (unsigned)(Rb * K + C) * 2u; }
    const size_t kstep = (size_t)(BK * 2);
    const size_t hstep = (size_t)HALF * K * 2;
    const size_t tstep = 2 * hstep;
    const unsigned ldsw = (unsigned)wid * 1024u;
    const int aoff = lds_byte(wr * 64 + fr, fq * 8), boff = lds_byte(wc * 32 + fr, fq * 8);
#define PG8_SA(b, h) (((b) * 2 + (h)) * HTB)
#define PG8_SB(b, h) ((4 + (b) * 2 + (h)) * HTB)
#define PG8_STAGE(bufoff, gbase, voff) do { _Pragma("unroll") for (int _i = 0; _i < 2; ++_i) \
        __builtin_amdgcn_global_load_lds((const unsigned*)((const char*)(gbase) + (voff)[_i]), (PG8_LAS unsigned*)(lds + (bufoff) + ldsw + _i * 8192), 16, 0, 0); } while (0)
#define PG8_LDA(dst, b, h) do { _Pragma("unroll") for (int m = 0; m < 4; ++m) _Pragma("unroll") for (int k = 0; k < 2; ++k) dst[m][k] = *(const PG8_LAS bf16x8*)(lds + PG8_SA(b, h) + aoff + m * 2048 + k * 1024); } while (0)
#define PG8_LDB(dst, b, h) do { _Pragma("unroll") for (int n = 0; n < 2; ++n) _Pragma("unroll") for (int k = 0; k < 2; ++k) dst[n][k] = *(const PG8_LAS bf16x8*)(lds + PG8_SB(b, h) + boff + n * 2048 + k * 1024); } while (0)
#define PG8_MMA(ai, bj, At, Bt) do { __builtin_amdgcn_s_setprio(1); _Pragma("unroll") for (int m = 0; m < 4; ++m) _Pragma("unroll") for (int n = 0; n < 2; ++n) _Pragma("unroll") for (int k = 0; k < 2; ++k) \
        acc[ai][bj][m][n] = __builtin_amdgcn_mfma_f32_16x16x32_bf16(Bt[n][k], At[m][k], acc[ai][bj][m][n], 0, 0, 0); __builtin_amdgcn_s_setprio(0); } while (0)
#define PG8_WAIT_V(n) asm volatile("s_waitcnt vmcnt(" #n ")" ::: "memory")
#define PG8_WAIT_L(n) asm volatile("s_waitcnt lgkmcnt(" #n ")" ::: "memory")
#define PG8_BAR __builtin_amdgcn_s_barrier()
#define PG8_SCHED __builtin_amdgcn_sched_barrier(0)
    Unit cur, nxt; int ui = 0;
    if (!S.next(0, cur)) return;
    f32x4 acc[2][2][4][2];
#pragma unroll
    for (int a = 0; a < 2; ++a)
#pragma unroll
        for (int b = 0; b < 2; ++b)
#pragma unroll
            for (int m = 0; m < 4; ++m)
#pragma unroll
                for (int n = 0; n < 2; ++n) acc[a][b][m][n] = (f32x4){0.f, 0.f, 0.f, 0.f};
    bf16x8 At[4][2], B0[2][2], B1[2][2];
    const char* cA = (const char*)g.A + (size_t)cur.pm * tstep; const char* cB = S.bbase(cur, g.Bt) + (size_t)cur.pn * tstep;
    if constexpr (SP2) {
        PG8_STAGE(PG8_SB(0, 0), cB, voffB); PG8_STAGE(PG8_SB(0, 1), cB + hstep, voffB); PG8_STAGE(PG8_SA(0, 0), cA, voffA); PG8_STAGE(PG8_SA(0, 1), cA + hstep, voffA);
        if (wr == 1) PG8_BAR;
        PG8_WAIT_V(2); PG8_BAR;
        PG8_STAGE(PG8_SB(1, 0), cB + kstep, voffB); PG8_STAGE(PG8_SA(1, 0), cA + kstep, voffA); PG8_STAGE(PG8_SB(1, 1), cB + hstep + kstep, voffB);
        PG8_WAIT_V(6); PG8_BAR;
    } else {
        PG8_STAGE(PG8_SB(0, 0), cB, voffB); PG8_STAGE(PG8_SA(0, 0), cA, voffA); PG8_STAGE(PG8_SB(0, 1), cB + hstep, voffB); PG8_STAGE(PG8_SA(0, 1), cA + hstep, voffA);
        if (wr == 1) PG8_BAR;
        PG8_WAIT_V(4); PG8_BAR;
        PG8_STAGE(PG8_SB(1, 0), cB + kstep, voffB); PG8_STAGE(PG8_SA(1, 0), cA + kstep, voffA); PG8_STAGE(PG8_SB(1, 1), cB + hstep + kstep, voffB);
        PG8_WAIT_V(6); PG8_BAR;
    }
    for (;;) {
        const bool has_next = S.next(ui + 1, nxt);
        const char* nA = has_next ? (const char*)g.A + (size_t)nxt.pm * tstep : cA; const char* nB = has_next ? S.bbase(nxt, g.Bt) + (size_t)nxt.pn * tstep : cB;
        for (int t = 0; t < nt; t += 2) {
            const bool last = (t == nt - 2);
            const char* a1 = cA + (size_t)(t + 1) * kstep;
            const char* a2 = last ? nA : cA + (size_t)(t + 2) * kstep; const char* b2 = last ? nB : cB + (size_t)(t + 2) * kstep;
            const char* a3 = a2 + kstep; const char* b3 = b2 + kstep;
            if constexpr (SP2) {
            PG8_LDB(B0, 0, 0); PG8_LDB(B1, 0, 1); PG8_SCHED; PG8_LDA(At, 0, 0); PG8_STAGE(PG8_SA(1, 1), a1 + hstep, voffA);
            PG8_WAIT_V(8); PG8_WAIT_L(0); PG8_BAR; PG8_MMA(0, 0, At, B0); PG8_MMA(0, 1, At, B1); PG8_BAR; PG8_SCHED;
            PG8_LDA(At, 0, 1); PG8_STAGE(PG8_SB(0, 0), b2, voffB); PG8_STAGE(PG8_SB(0, 1), b2 + hstep, voffB); PG8_STAGE(PG8_SA(0, 0), a2, voffA);
            PG8_WAIT_V(8); PG8_WAIT_L(0); PG8_BAR; PG8_MMA(1, 0, At, B0); PG8_MMA(1, 1, At, B1); PG8_BAR; PG8_SCHED;
            PG8_LDB(B0, 1, 0); PG8_LDB(B1, 1, 1); PG8_SCHED; PG8_LDA(At, 1, 0); PG8_STAGE(PG8_SA(0, 1), a2 + hstep, voffA);
            PG8_WAIT_V(8); PG8_WAIT_L(0); PG8_BAR; PG8_MMA(0, 0, At, B0); PG8_MMA(0, 1, At, B1); PG8_BAR; PG8_SCHED;
            PG8_LDA(At, 1, 1); PG8_STAGE(PG8_SB(1, 0), b3, voffB); PG8_STAGE(PG8_SB(1, 1), b3 + hstep, voffB); PG8_STAGE(PG8_SA(1, 0), a3, voffA);
            PG8_WAIT_V(8); PG8_WAIT_L(0); PG8_BAR; PG8_MMA(1, 0, At, B0); PG8_MMA(1, 1, At, B1); PG8_BAR; PG8_SCHED;
            } else {
            PG8_LDB(B0, 0, 0); PG8_SCHED; PG8_LDA(At, 0, 0); PG8_STAGE(PG8_SA(1, 1), a1 + hstep, voffA);
            PG8_WAIT_L(8); PG8_BAR; PG8_WAIT_L(0); PG8_MMA(0, 0, At, B0); PG8_BAR; PG8_SCHED;
            PG8_LDB(B1, 0, 1); PG8_STAGE(PG8_SB(0, 0), b2, voffB);
            PG8_BAR; PG8_WAIT_L(0); PG8_MMA(0, 1, At, B1); PG8_BAR;
            PG8_LDA(At, 0, 1); PG8_STAGE(PG8_SA(0, 0), a2, voffA);
            PG8_BAR; PG8_WAIT_L(0); PG8_MMA(1, 0, At, B0); PG8_BAR; PG8_SCHED;
            PG8_STAGE(PG8_SB(0, 1), b2 + hstep, voffB);
            PG8_WAIT_V(6); PG8_BAR; PG8_MMA(1, 1, At, B1); PG8_BAR;
            PG8_LDB(B0, 1, 0); PG8_SCHED; PG8_LDA(At, 1, 0); PG8_STAGE(PG8_SA(0, 1), a2 + hstep, voffA);
            PG8_WAIT_L(8); PG8_BAR; PG8_WAIT_L(0); PG8_MMA(0, 0, At, B0); PG8_BAR; PG8_SCHED;
            PG8_LDB(B1, 1, 1); PG8_STAGE(PG8_SB(1, 0), b3, voffB);
            PG8_BAR; PG8_WAIT_L(0); PG8_MMA(0, 1, At, B1); PG8_BAR;
            PG8_LDA(At, 1, 1); PG8_STAGE(PG8_SA(1, 0), a3, voffA);
            PG8_BAR; PG8_WAIT_L(0); PG8_MMA(1, 0, At, B0); PG8_BAR; PG8_SCHED;
            PG8_STAGE(PG8_SB(1, 1), b3 + hstep, voffB);
            PG8_WAIT_V(6); PG8_BAR; PG8_MMA(1, 1, At, B1); PG8_BAR;
            }
        }
        if constexpr (ALIGN_EPI) { if (wr == 0) PG8_BAR; }
        E(acc, cur, wr, wc, fr, fq);
        if (!has_next) break;
#pragma unroll
        for (int a = 0; a < 2; ++a)
#pragma unroll
            for (int b = 0; b < 2; ++b)
#pragma unroll
                for (int m = 0; m < 4; ++m)
#pragma unroll
                    for (int n = 0; n < 2; ++n) acc[a][b][m][n] = (f32x4){0.f, 0.f, 0.f, 0.f};
        cur = nxt; cA = nA; cB = nB; ++ui;
        if constexpr (ALIGN_EPI) { if (wr == 1) PG8_BAR; }
    }
    PG8_WAIT_V(0);
    if constexpr (!ALIGN_EPI) { if (wr == 0) PG8_BAR; }
    PG8_BAR;
#undef PG8_SA
#undef PG8_SB
#undef PG8_STAGE
#undef PG8_LDA
#undef PG8_LDB
#undef PG8_MMA
#undef PG8_WAIT_V
#undef PG8_WAIT_L
#undef PG8_BAR
#undef PG8_SCHED
}
}

constexpr int NWAVES = 8;
constexpr int NB = 4, SEQ = 4096, T = NB * SEQ, D = 1024;
constexpr int EVEN_IN = 2816, EVEN_OUT = 512, ODD_IN = 3072, ODD_OUT = 1024, DFF = 2816, NEXP = 8, DFFE = 3584;
constexpr int MOE_ROWS = 2 * T + NEXP * 256;
constexpr float EPS = 1e-6f;
constexpr size_t MiB = 1u << 20;
constexpr size_t WS_CTL = 0, CTL_ZERO_BYTES = 2 * MiB;
constexpr size_t WS_ROPE = 2 * MiB;
constexpr size_t WS_MISC = 3 * MiB;
constexpr size_t WS_KMEAN = 4 * MiB;
constexpr size_t WS_WT = 8 * MiB;
constexpr size_t WT_EVEN_BYTES = 23 * MiB, WT_ODD_BYTES = 176 * MiB;
constexpr size_t WTE_IN = 0, WTE_OUT = 5 * MiB + MiB / 2, WTE_GU = 6 * MiB + MiB / 2, WTE_DN = 17 * MiB + MiB / 2;
constexpr size_t WTO_IN = 0, WTO_OUT = 6 * MiB, WTO_MGU = 8 * MiB, WTO_MD = 120 * MiB;
constexpr size_t WS_WT_EVEN0 = WS_WT, WS_WT_ODD0 = WS_WT + 2 * WT_EVEN_BYTES;
constexpr size_t WS_HN = WS_WT + 2 * WT_EVEN_BYTES + 2 * WT_ODD_BYTES;
constexpr size_t WS_P = WS_HN + 32 * MiB;
constexpr size_t WS_MIX = WS_P + 96 * MiB;
constexpr size_t WS_HID = WS_MIX + 32 * MiB;
constexpr size_t WS_END = WS_HID + 238 * MiB;
static_assert(WS_HN == 406 * MiB && WS_END == 804 * MiB, "ws map");
constexpr size_t P_UV = 0, P_QS = 16 * MiB, P_KS = 40 * MiB, P_VS = 64 * MiB, P_QM = 0, P_KM = 24 * MiB, P_VM = 48 * MiB;
constexpr size_t H_RAWP = 0, H_OG = 96 * MiB, H_LSE = 120 * MiB;
constexpr int CW_TMO = 0, CW_CODE = 1, CW_BAR = 4096;
constexpr int RING_OFF = 0, RING_BYTES = 131072, LDSCTL_OFF = RING_BYTES, MISC_OFF = LDSCTL_OFF + 320, LDS_BYTES = 147456;

#define GAS __attribute__((address_space(1)))
#define LAS __attribute__((address_space(3)))
typedef unsigned short bf16;
typedef unsigned v4u __attribute__((ext_vector_type(4)));
typedef unsigned v2u __attribute__((ext_vector_type(2)));
typedef float f32x4 __attribute__((ext_vector_type(4)));
typedef GAS unsigned gu32;
#define RLX_AGENT __ATOMIC_RELAXED, __HIP_MEMORY_SCOPE_AGENT
#define LDS_WAIT() asm volatile("s_waitcnt lgkmcnt(0)" ::: "memory")
#define VM_WAIT() asm volatile("s_waitcnt vmcnt(0)" ::: "memory")
__device__ __forceinline__ unsigned f2bf(float f) { unsigned u = __builtin_bit_cast(unsigned, f); return (u + 0x7fffu + ((u >> 16) & 1u)) >> 16; }
__device__ __forceinline__ unsigned pk2(float lo, float hi) { return f2bf(lo) | (f2bf(hi) << 16); }
__device__ __forceinline__ float bf2f(unsigned short b) { return __builtin_bit_cast(float, ((unsigned)b) << 16); }
__device__ __forceinline__ float bflo(unsigned w) { return __builtin_bit_cast(float, w << 16); }
__device__ __forceinline__ float bfhi(unsigned w) { return __builtin_bit_cast(float, w & 0xffff0000u); }

#define XB_TMO      128
#define XB_XCNT(j)  (256  + 64 * (j))
#define XB_XSUB(j)  (1280 + 64 * (j))
#define XB_XGEN(j)  (2304 + 64 * (j))
#define XB_TOP      3328
#define XB_TOPGEN   3392
#define XCD_BAR_WORDS 3456
#define XB_SPIN_CAP (1u << 22)
__device__ __forceinline__ unsigned xb_ld(unsigned* p)              { return __hip_atomic_load(p, __ATOMIC_RELAXED, __HIP_MEMORY_SCOPE_AGENT); }
__device__ __forceinline__ unsigned xb_add(unsigned* p, unsigned v) { return __hip_atomic_fetch_add(p, v, __ATOMIC_RELAXED, __HIP_MEMORY_SCOPE_AGENT); }
__device__ __forceinline__ unsigned xb_xcc_id() { return (unsigned)__builtin_amdgcn_s_getreg((3 << 11) | 20) & 0xFu; }
#define XB_SPIN(cond, bar) do { unsigned _sp = 0; while (cond) { __builtin_amdgcn_s_sleep(1); \
    if ((++_sp & 255u) == 0u) { if (xb_ld(&(bar)[XB_TMO])) break; if (_sp > XB_SPIN_CAP) { atomicAdd(&(bar)[XB_TMO], 1u); break; } } } } while (0)
struct XcdBarrier { unsigned* bar; unsigned x; volatile LAS unsigned* st; };
__device__ __forceinline__ XcdBarrier xcd_barrier_post(unsigned* bar, volatile LAS unsigned* st) {
    XcdBarrier b; b.bar = bar; b.x = xb_xcc_id(); b.st = st;
    if (threadIdx.x == 0) (void)xb_add(&bar[XB_XCNT(b.x)], 1u);
    return b;
}
__device__ __forceinline__ void xcd_barrier_complete(unsigned* bar, unsigned x, unsigned& nloc, unsigned& nx) {
    const unsigned G = gridDim.x * gridDim.y * gridDim.z;
    unsigned sum, cnt, mine, sp = 0u;
    for (;;) {
        sum = 0u; cnt = 0u; mine = 0u;
#pragma unroll
        for (unsigned j = 0; j < 16; ++j) { const unsigned c = xb_ld(&bar[XB_XCNT(j)]); sum += c; cnt += (c > 0u) ? 1u : 0u; mine = (j == x) ? c : mine; }
        if (sum == G) break;
        __builtin_amdgcn_s_sleep(1);
        if ((++sp & 255u) == 0u) { if (xb_ld(&bar[XB_TMO])) break; if (sp > XB_SPIN_CAP) { atomicAdd(&bar[XB_TMO], 1u); break; } }
    }
    nloc = mine > 0u ? mine : 1u; nx = cnt > 0u ? cnt : 1u;
}
__device__ __forceinline__ void xcd_barrier(const XcdBarrier& b) {
    asm volatile("s_waitcnt vmcnt(0)" ::: "memory");
    __syncthreads();
    if (threadIdx.x == 0) {
        unsigned* bar = b.bar;
        __builtin_amdgcn_s_waitcnt(0);
        unsigned nloc = b.st[0], nx = b.st[1];
        if (nloc == 0u) { xcd_barrier_complete(bar, b.x, nloc, nx); b.st[0] = nloc; b.st[1] = nx; }
        const unsigned old = xb_add(&bar[XB_XSUB(b.x)], 1u);
        const unsigned gen = old / nloc;
        if (old + 1u == (gen + 1u) * nloc) {
            __builtin_amdgcn_fence(__ATOMIC_RELEASE, "agent");
            asm volatile("s_waitcnt vmcnt(0)" ::: "memory");
            const unsigned og = xb_add(&bar[XB_TOP], 1u);
            const unsigned tg = og / nx;
            if (og + 1u == (tg + 1u) * nx) xb_add(&bar[XB_TOPGEN], 1u);
            else XB_SPIN(xb_ld(&bar[XB_TOPGEN]) == tg, bar);
            __builtin_amdgcn_fence(__ATOMIC_ACQUIRE, "agent");
            xb_add(&bar[XB_XGEN(b.x)], 1u);
            asm volatile("s_waitcnt vmcnt(0)" ::: "memory");
        } else {
            XB_SPIN(xb_ld(&bar[XB_XGEN(b.x)]) == gen, bar);
            __builtin_amdgcn_fence(__ATOMIC_ACQUIRE, "agent");
            asm volatile("s_waitcnt vmcnt(0)" ::: "memory");
        }
    }
    __syncthreads();
}

struct Args { const float* in[22]; float* out; unsigned char* ws; int ph_lo, ph_hi; };
struct Frame {
    LAS unsigned char* lds; volatile LAS unsigned* MISC; gu32* ctl;
    int tid, lane, wave, G, blk;
    unsigned char* ws; float* out;
};
struct Route { int e1, e2; float g1, g2; };

__device__ __forceinline__ float wave_sum(float v) {
#pragma unroll
    for (int o = 1; o < 64; o <<= 1) v += __shfl_xor(v, o);
    return v;
}
__device__ __forceinline__ float wave_max(float v) {
#pragma unroll
    for (int o = 1; o < 64; o <<= 1) v = fmaxf(v, __shfl_xor(v, o));
    return v;
}
__device__ __forceinline__ float gelu_tanh(float x) {
    const float y = 0.7978845608028654f * (x + 0.044715f * x * x * x);
    const float e = __expf(2.0f * y);
    const float th = 1.0f - 2.0f / (e + 1.0f);
    return 0.5f * x * (1.0f + th);
}

__device__ __forceinline__ int rowmap(int mode, int n) { return mode == 0 ? n : (256 * (n >> 7) + (n & 127) + (mode == 2 ? 128 : 0)); }
__device__ __forceinline__ void p0_transpose_item(const float* W, int K, int N, bf16* WT, int mode, LAS float* scr, int item, int lane) {
    const int nblk = N / 32, kb = item / nblk, nb = item % nblk, k0 = 64 * kb, n0 = 32 * nb;
#pragma unroll 8
    for (int i = 0; i < 32; ++i) { const int kk = 2 * i + (lane >> 5); scr[kk * 33 + (lane & 31)] = W[(size_t)(k0 + kk) * N + n0 + (lane & 31)]; }
    LDS_WAIT(); asm volatile("" ::: "memory");
    const int c = lane & 7;
#pragma unroll
    for (int j = 0; j < 4; ++j) { const int n = (lane >> 3) + 8 * j; const LAS float* s = scr + (8 * c) * 33 + n;
        v4u o; o.x = pk2(s[0 * 33], s[1 * 33]); o.y = pk2(s[2 * 33], s[3 * 33]); o.z = pk2(s[4 * 33], s[5 * 33]); o.w = pk2(s[6 * 33], s[7 * 33]);
        *(GAS v4u*)(WT + (size_t)rowmap(mode, n0 + n) * K + k0 + 8 * c) = o; }
    LDS_WAIT(); asm volatile("" ::: "memory");
}
struct WDesc { const float* src; bf16* dst; int K, N, nbatch, mode; size_t dst_bstride; };
__device__ __forceinline__ WDesc get_desc(const Args& a, int d) {
    const int layer = d / 10, k = d % 10; unsigned char* ws = a.ws;
    bf16* we = (bf16*)(ws + WS_WT_EVEN0 + (size_t)layer * WT_EVEN_BYTES); bf16* wo = (bf16*)(ws + WS_WT_ODD0 + (size_t)layer * WT_ODD_BYTES);
    WDesc w; w.nbatch = 1; w.mode = 0; w.dst_bstride = 0;
    switch (k) {
    case 0: w.src = a.in[3] + (size_t)layer * D * EVEN_IN; w.dst = we + WTE_IN / 2; w.K = D; w.N = EVEN_IN; break;
    case 1: w.src = a.in[9] + (size_t)layer * EVEN_OUT * D; w.dst = we + WTE_OUT / 2; w.K = EVEN_OUT; w.N = D; break;
    case 2: w.src = a.in[10] + (size_t)layer * D * DFF; w.dst = we + WTE_GU / 2; w.K = D; w.N = DFF; w.mode = 1; break;
    case 3: w.src = a.in[11] + (size_t)layer * D * DFF; w.dst = we + WTE_GU / 2; w.K = D; w.N = DFF; w.mode = 2; break;
    case 4: w.src = a.in[12] + (size_t)layer * DFF * D; w.dst = we + WTE_DN / 2; w.K = DFF; w.N = D; break;
    case 5: w.src = a.in[13] + (size_t)layer * D * ODD_IN; w.dst = wo + WTO_IN / 2; w.K = D; w.N = ODD_IN; break;
    case 6: w.src = a.in[17] + (size_t)layer * ODD_OUT * D; w.dst = wo + WTO_OUT / 2; w.K = ODD_OUT; w.N = D; break;
    case 7: w.src = a.in[19] + (size_t)layer * NEXP * D * DFFE; w.dst = wo + WTO_MGU / 2; w.K = D; w.N = DFFE; w.mode = 1; w.nbatch = NEXP; w.dst_bstride = (size_t)2 * DFFE * D; break;
    case 8: w.src = a.in[20] + (size_t)layer * NEXP * D * DFFE; w.dst = wo + WTO_MGU / 2; w.K = D; w.N = DFFE; w.mode = 2; w.nbatch = NEXP; w.dst_bstride = (size_t)2 * DFFE * D; break;
    default: w.src = a.in[21] + (size_t)layer * NEXP * DFFE * D; w.dst = wo + WTO_MD / 2; w.K = DFFE; w.N = D; w.nbatch = NEXP; w.dst_bstride = (size_t)DFFE * D; break;
    }
    return w;
}
__device__ __forceinline__ void p0_prologue(Frame& F, const Args& a) {
    LAS float* scr = (LAS float*)(F.lds + RING_OFF + F.wave * 16384);
    const int gw = F.blk * NWAVES + F.wave, NGW = F.G * NWAVES;
    for (int d = 0; d < 20; ++d) {
        const WDesc w = get_desc(a, d);
        const int per = (w.K / 64) * (w.N / 32), nitems = per * w.nbatch;
        for (int it = gw; it < nitems; it += NGW) { const int bt = it / per, r = it % per;
            p0_transpose_item(w.src + (size_t)bt * w.K * w.N, w.K, w.N, w.dst + (size_t)bt * w.dst_bstride, w.mode, scr, r, F.lane); }
    }
    float* cs = (float*)(a.ws + WS_ROPE); float* sn = cs + SEQ * 32;
    for (int i = F.blk * 512 + F.tid; i < SEQ * 32; i += F.G * 512) { const int pos = i >> 5, j = i & 31;
        const float inv = 1.0f / powf(10000.0f, (float)j * (1.0f / 32.0f)); const float ang = (float)pos * inv;
        cs[i] = cosf(ang); sn[i] = sinf(ang); }
}

__device__ __forceinline__ void norm_phase(Frame& F, const float* xsrc, float* xdst, const float* gain, bf16* hn, bool do_combine, bool do_router, bool write_hn, const float* router_w) {
    unsigned char* ws = F.ws;
    const Route* route = (const Route*)(ws + WS_MISC); const int* slots = (const int*)(ws + WS_MISC + 256 * 1024); int* ccnt = (int*)(ws + WS_MISC + 384 * 1024);
    const bf16* Y = (const bf16*)(ws + WS_P);
    LAS float* wr = (LAS float*)(F.lds + RING_OFF);
    LAS int* lcnt = (LAS int*)(F.lds + RING_OFF + 32768);
    if (do_router) { for (int i = F.tid; i < 8192; i += 512) { const int d = i >> 3, e = i & 7; wr[e * 1024 + d] = router_w[i]; } }
    const int lane = F.lane;
    f32x4 gv[4];
#pragma unroll
    for (int j = 0; j < 4; ++j) gv[j] = *((const f32x4*)gain + lane + 64 * j);
    for (int c = F.blk; c < T / 64; c += F.G) {
        if (do_router) { if (F.tid < 8) lcnt[F.tid] = 0; }
        __syncthreads();
        for (int k = 0; k < 8; ++k) {
            const int row = c * 64 + F.wave * 8 + k;
            const f32x4* xr = (const f32x4*)(xsrc + (size_t)row * D) + lane;
            f32x4 v[4];
#pragma unroll
            for (int j = 0; j < 4; ++j) v[j] = xr[64 * j];
            if (do_combine) {
                const Route r = route[row]; const int s1 = slots[2 * row], s2 = slots[2 * row + 1];
                const v2u* y1 = (const v2u*)(Y + (size_t)s1 * D) + lane; const v2u* y2 = (const v2u*)(Y + (size_t)s2 * D) + lane;
#pragma unroll
                for (int j = 0; j < 4; ++j) { const v2u a = y1[64 * j], b = y2[64 * j];
                    v[j].x += r.g1 * bflo(a.x) + r.g2 * bflo(b.x); v[j].y += r.g1 * bfhi(a.x) + r.g2 * bfhi(b.x);
                    v[j].z += r.g1 * bflo(a.y) + r.g2 * bflo(b.y); v[j].w += r.g1 * bfhi(a.y) + r.g2 * bfhi(b.y); }
                f32x4* xo = (f32x4*)(xdst + (size_t)row * D) + lane;
#pragma unroll
                for (int j = 0; j < 4; ++j) xo[64 * j] = v[j];
            }
            if (write_hn) {
                float ss = 0.f;
#pragma unroll
                for (int j = 0; j < 4; ++j) ss += (v[j].x * v[j].x + v[j].y * v[j].y) + (v[j].z * v[j].z + v[j].w * v[j].w);
                ss = wave_sum(ss);
                const float rstd = 1.0f / sqrtf(ss * (1.0f / D) + EPS);
#pragma unroll
                for (int j = 0; j < 4; ++j) v[j] = v[j] * rstd * gv[j];
                v2u* o8 = (v2u*)(hn + (size_t)row * D) + lane;
#pragma unroll
                for (int j = 0; j < 4; ++j) { v2u o; o.x = pk2(v[j].x, v[j].y); o.y = pk2(v[j].z, v[j].w); o8[64 * j] = o; }
                if (do_router) {
                    float lg[8];
#pragma unroll
                    for (int e = 0; e < 8; ++e) { float s = 0.f;
#pragma unroll
                        for (int j = 0; j < 4; ++j) { const f32x4 w = *((const LAS f32x4*)(wr + e * 1024) + lane + 64 * j); s += (v[j].x * w.x + v[j].y * w.y) + (v[j].z * w.z + v[j].w * w.w); }
                        lg[e] = wave_sum(s); }
                    int e1 = 0; float v1 = lg[0];
#pragma unroll
                    for (int e = 1; e < 8; ++e) if (lg[e] > v1) { v1 = lg[e]; e1 = e; }
                    int e2 = -1; float v2 = -INFINITY;
#pragma unroll
                    for (int e = 0; e < 8; ++e) if (e != e1 && lg[e] > v2) { v2 = lg[e]; e2 = e; }
                    const float g2 = 1.0f / (1.0f + __expf(v1 - v2)), g1 = 1.0f - g2;
                    if (lane == 0) { Route r; r.e1 = e1; r.e2 = e2; r.g1 = g1; r.g2 = g2; ((Route*)route)[row] = r; __hip_atomic_fetch_add(&lcnt[e1], 1, __ATOMIC_RELAXED, __HIP_MEMORY_SCOPE_WORKGROUP); __hip_atomic_fetch_add(&lcnt[e2], 1, __ATOMIC_RELAXED, __HIP_MEMORY_SCOPE_WORKGROUP); }
                }
            }
        }
        __syncthreads();
        if (do_router) { if (F.tid < 8) ccnt[c * 8 + F.tid] = lcnt[F.tid]; }
        __syncthreads();
    }
}

__device__ __forceinline__ void route_phase(Frame& F, const bf16* hn, bf16* hsort) {
    unsigned char* ws = F.ws;
    const Route* route = (const Route*)(ws + WS_MISC); int* slots = (int*)(ws + WS_MISC + 256 * 1024); const int* ccnt = (const int*)(ws + WS_MISC + 384 * 1024); int* tile_base = (int*)(ws + WS_MISC + 512 * 1024);
    LAS int* tot = (LAS int*)(F.lds + RING_OFF); LAS int* bef = tot + 8; LAS int* base = tot + 16; LAS int* sl = tot + 32;
    for (int c = F.blk; c < T / 64; c += F.G) {
        { const int e = F.wave; int t = 0, b = 0;
#pragma unroll
            for (int q = 0; q < 4; ++q) { const int ch = F.lane * 4 + q; const int v = ccnt[ch * 8 + e]; t += v; b += (ch < c) ? v : 0; }
#pragma unroll
            for (int o = 1; o < 64; o <<= 1) { t += __shfl_xor(t, o); b += __shfl_xor(b, o); }
            if (F.lane == 0) { tot[e] = t; bef[e] = b; } }
        __syncthreads();
        if (F.tid == 0) { int acc = 0;
            for (int e = 0; e < 8; ++e) { base[e] = acc; if (c == 0) tile_base[e] = acc >> 8; acc += (tot[e] + 255) & ~255; }
            if (c == 0) tile_base[8] = acc >> 8; }
        __syncthreads();
        if (F.wave == 0) {
            const int row = c * 64 + F.lane; const Route r = route[row];
            int run[8];
#pragma unroll
            for (int e = 0; e < 8; ++e) run[e] = base[e] + bef[e];
#pragma unroll
            for (int k = 0; k < 2; ++k) { const int me = k ? r.e2 : r.e1; int myslot = 0;
#pragma unroll
                for (int e = 0; e < 8; ++e) { const unsigned long long m = __ballot(me == e); const int rank = __popcll(m & ((1ull << F.lane) - 1ull));
                    if (me == e) myslot = run[e] + rank; run[e] += __popcll(m); }
                slots[2 * row + k] = myslot; sl[2 * F.lane + k] = myslot; }
        }
        __syncthreads();
        for (int p = F.wave; p < 128; p += NWAVES) { const int row = c * 64 + (p >> 1); const int s = sl[p];
            const v4u* src = (const v4u*)(hn + (size_t)row * D); v4u* dst = (v4u*)(hsort + (size_t)s * D);
            dst[F.lane] = src[F.lane]; dst[F.lane + 64] = src[F.lane + 64]; }
        __syncthreads();
    }
}

__device__ __forceinline__ int srow(int s, int g) { return g == 0 ? s : (g == 1 ? ((s & 3) * 1024 + (s >> 2)) : ((s & 15) * 256 + (s >> 4))); }
__device__ __forceinline__ float rope_apply(float n, int lane, const float* cs, const float* sn, int s) {
    const float partner = __shfl_xor(n, 32); const int j = lane & 31; const float c = cs[s * 32 + j], si = sn[s * 32 + j];
    return lane < 32 ? n * c - partner * si : n * c + partner * si;
}
__device__ __forceinline__ void post_even(Frame& F, const bf16* rawp, const float* vgain, const float* qgain, const float* kgain) {
    unsigned char* ws = F.ws; bf16* UV = (bf16*)(ws + WS_P + P_UV); bf16* Qs = (bf16*)(ws + WS_P + P_QS); bf16* Ks = (bf16*)(ws + WS_P + P_KS); bf16* Vs = (bf16*)(ws + WS_P + P_VS);
    const float* cs = (const float*)(ws + WS_ROPE); const float* sn = cs + SEQ * 32;
    const int lane = F.lane; const float qg = qgain[lane], kg = kgain[lane];
    const long nitems = (long)T * 44;
    for (long it = (long)F.blk * NWAVES + F.wave; it < nitems; it += (long)F.G * NWAVES) {
        const int row = (int)(it / 44), u = (int)(it % 44), b = row >> 12, s = row & 4095;
        const float v = bf2f(rawp[(size_t)row * EVEN_IN + 64 * u + lane]);
        if (u < 4) { UV[(size_t)row * 512 + 64 * u + lane] = (bf16)f2bf(gelu_tanh(v)); }
        else if (u < 8) { const float z = gelu_tanh(v); const float ss = wave_sum(z * z); const float o = z * (1.0f / sqrtf(ss * (1.0f / 64) + EPS)) * vgain[(u - 4) * 64 + lane];
            UV[(size_t)row * 512 + 64 * u + lane] = (bf16)f2bf(o); }
        else if (u < 32) { const bool isq = u < 20; const int h = isq ? u - 8 : u - 20; const float ss = wave_sum(v * v);
            const float n = v * (1.0f / sqrtf(ss * (1.0f / 64) + EPS)) * (isq ? qg : kg); const float o = rope_apply(n, lane, cs, sn, s);
            (isq ? Qs : Ks)[((size_t)(b * 12 + h) * SEQ + srow(s, h >> 2)) * 64 + lane] = (bf16)f2bf(o); }
        else { const int h = u - 32; Vs[((size_t)(b * 12 + h) * SEQ + srow(s, h >> 2)) * 64 + lane] = (bf16)f2bf(v); }
    }
}
__device__ __forceinline__ void post_odd(Frame& F, const bf16* rawp, const float* qgain, const float* kgain) {
    unsigned char* ws = F.ws; bf16* Qm = (bf16*)(ws + WS_P + P_QM); bf16* Km = (bf16*)(ws + WS_P + P_KM); bf16* Vm = (bf16*)(ws + WS_P + P_VM);
    const float* cs = (const float*)(ws + WS_ROPE); const float* sn = cs + SEQ * 32;
    const int lane = F.lane; const float qg = qgain[lane], kg = kgain[lane];
    const long nitems = (long)T * 36;
    for (long it = (long)F.blk * NWAVES + F.wave; it < nitems; it += (long)F.G * NWAVES) {
        const int row = (int)(it / 36), u = (int)(it % 36), b = row >> 12, s = row & 4095;
        const float v = bf2f(rawp[(size_t)row * ODD_IN + 64 * u + lane]);
        if (u < 24) { const bool isq = u < 12; const int h = isq ? u : u - 12; const float ss = wave_sum(v * v);
            const float n = v * (1.0f / sqrtf(ss * (1.0f / 64) + EPS)) * (isq ? qg : kg); const float o = rope_apply(n, lane, cs, sn, s);
            (isq ? Qm : Km)[((size_t)(b * 12 + h) * SEQ + s) * 64 + lane] = (bf16)f2bf(o); }
        else { const int h = u - 24; Vm[((size_t)(b * 12 + h) * SEQ + s) * 64 + lane] = (bf16)f2bf(v); }
    }
}
__device__ __forceinline__ void kmean_phase(Frame& F) {
    const bf16* Km = (const bf16*)(F.ws + WS_P + P_KM); float* km = (float*)(F.ws + WS_KMEAN);
    for (int it = F.blk * NWAVES + F.wave; it < 48 * 16; it += F.G * NWAVES) {
        const bf16* k = Km + (size_t)it * 256 * 64 + F.lane; float s = 0.f;
        for (int r = 0; r < 256; ++r) s += bf2f(k[r * 64]);
        km[it * 64 + F.lane] = s * (1.0f / 256.0f);
    }
}

__device__ __forceinline__ void load_row64(const bf16* p, float (&q)[64]) {
    const v4u* p4 = (const v4u*)p;
#pragma unroll
    for (int i = 0; i < 8; ++i) { const v4u w = p4[i]; q[8 * i + 0] = bflo(w.x); q[8 * i + 1] = bfhi(w.x); q[8 * i + 2] = bflo(w.y); q[8 * i + 3] = bfhi(w.y); q[8 * i + 4] = bflo(w.z); q[8 * i + 5] = bfhi(w.z); q[8 * i + 6] = bflo(w.w); q[8 * i + 7] = bfhi(w.w); }
}
__device__ __forceinline__ float dot_row64(const bf16* p, const float (&q)[64]) {
    const v4u* p4 = (const v4u*)p; float s = 0.f;
#pragma unroll
    for (int i = 0; i < 8; ++i) { const v4u w = p4[i]; s += q[8 * i + 0] * bflo(w.x) + q[8 * i + 1] * bfhi(w.x) + q[8 * i + 2] * bflo(w.y) + q[8 * i + 3] * bfhi(w.y) + q[8 * i + 4] * bflo(w.z) + q[8 * i + 5] * bfhi(w.z) + q[8 * i + 6] * bflo(w.w) + q[8 * i + 7] * bfhi(w.w); }
    return s;
}
__device__ __forceinline__ void banded_naive(Frame& F) {
    unsigned char* ws = F.ws; const bf16* Qs = (const bf16*)(ws + WS_P + P_QS); const bf16* Ks = (const bf16*)(ws + WS_P + P_KS); const bf16* Vs = (const bf16*)(ws + WS_P + P_VS);
    bf16* OG = (bf16*)(ws + WS_HID + H_OG); float* LSE = (float*)(ws + WS_HID + H_LSE);
    LAS float* pl = (LAS float*)(F.lds + RING_OFF) + F.wave * 256;
    const int lane = F.lane;
    for (int it = F.blk * NWAVES + F.wave; it < 48 * SEQ; it += F.G * NWAVES) {
        const int bh = it >> 12, rp = it & 4095, b = bh / 12, h = bh % 12, g = h >> 2, dil = g == 0 ? 1 : (g == 1 ? 4 : 16), L = SEQ / dil;
        const int i = rp % L, r = rp / L, s = i * dil + r, nk = (i < 128 ? i : 128) + 1, first = rp - (nk - 1);
        float q[64]; load_row64(Qs + ((size_t)bh * SEQ + rp) * 64, q);
        float sc[3]; float m = -INFINITY;
#pragma unroll
        for (int kk = 0; kk < 3; ++kk) { const int j = lane + 64 * kk; sc[kk] = -INFINITY; if (j < nk) { sc[kk] = 0.125f * dot_row64(Ks + ((size_t)bh * SEQ + first + j) * 64, q); } m = fmaxf(m, sc[kk]); }
        m = wave_max(m); float l = 0.f;
#pragma unroll
        for (int kk = 0; kk < 3; ++kk) { const float p = (lane + 64 * kk < nk) ? __expf(sc[kk] - m) : 0.f; pl[lane + 64 * kk] = p; l += p; }
        l = wave_sum(l); LDS_WAIT();
        float acc = 0.f; const bf16* vb = Vs + ((size_t)bh * SEQ + first) * 64 + lane;
        for (int j = 0; j < nk; ++j) acc += pl[j] * bf2f(vb[(size_t)j * 64]);
        const size_t orow = ((size_t)g * T + (size_t)b * SEQ + s) * 4 + (h & 3);
        OG[orow * 64 + lane] = (bf16)f2bf(acc / l);
        if (lane == 0) LSE[orow] = m + __logf(l);
        LDS_WAIT();
    }
}
__device__ __forceinline__ void merge_even(Frame& F, bf16* mix) {
    const bf16* OG = (const bf16*)(F.ws + WS_HID + H_OG); const float* LSE = (const float*)(F.ws + WS_HID + H_LSE);
    for (int it = F.blk * NWAVES + F.wave; it < T * 4; it += F.G * NWAVES) {
        const float l0 = LSE[it], l1 = LSE[(size_t)T * 4 + it], l2 = LSE[(size_t)2 * T * 4 + it]; const float m = fmaxf(l0, fmaxf(l1, l2));
        const float w0 = __expf(l0 - m), w1 = __expf(l1 - m), w2 = __expf(l2 - m), inv = 1.0f / (w0 + w1 + w2);
        const float o = (w0 * bf2f(OG[(size_t)it * 64 + F.lane]) + w1 * bf2f(OG[((size_t)T * 4 + it) * 64 + F.lane]) + w2 * bf2f(OG[((size_t)2 * T * 4 + it) * 64 + F.lane])) * inv;
        mix[(size_t)(it >> 2) * EVEN_OUT + 256 + (it & 3) * 64 + F.lane] = (bf16)f2bf(o);
    }
}
__device__ __forceinline__ void gmlp_phase(Frame& F, const float* wsp, const float* bsp, bf16* mix) {
    const bf16* UV = (const bf16*)(F.ws + WS_P + P_UV);
    LAS float* WT = (LAS float*)(F.lds + RING_OFF);
    LAS float* VL = WT + 128 * 128;
    const int tid = F.tid;
    for (int unit = F.blk; unit < (T / 128) * 4; unit += F.G) {
        const int c = unit >> 2, g = unit & 3, row0 = c * 128;
        __syncthreads();
        { const int i = tid & 127; const float* wrow = wsp + ((size_t)g * 128 + i) * 128;
          for (int jq = tid >> 7; jq < 32; jq += 4) { const f32x4 w = *(const f32x4*)(wrow + 4 * jq);
              WT[(4 * jq + 0) * 128 + i] = (4 * jq + 0 <= i) ? w.x : 0.f; WT[(4 * jq + 1) * 128 + i] = (4 * jq + 1 <= i) ? w.y : 0.f;
              WT[(4 * jq + 2) * 128 + i] = (4 * jq + 2 <= i) ? w.z : 0.f; WT[(4 * jq + 3) * 128 + i] = (4 * jq + 3 <= i) ? w.w : 0.f; } }
        for (int e = tid; e < 128 * 64; e += 512) { const int j = e >> 6, d = e & 63; VL[e] = bf2f(UV[(size_t)(row0 + j) * 512 + 256 + g * 64 + d]); }
        __syncthreads();
        const int i0 = 4 * (tid >> 4), d0 = 4 * (tid & 15);
        f32x4 acc[4];
#pragma unroll
        for (int a = 0; a < 4; ++a) acc[a] = (f32x4){0.f, 0.f, 0.f, 0.f};
        const int jmax = i0 + 3;
        for (int j = 0; j <= jmax; ++j) { const f32x4 w = *(const LAS f32x4*)(WT + j * 128 + i0); const f32x4 v = *(const LAS f32x4*)(VL + j * 64 + d0);
            acc[0] += w.x * v; acc[1] += w.y * v; acc[2] += w.z * v; acc[3] += w.w * v; }
#pragma unroll
        for (int a = 0; a < 4; ++a) { const int i = i0 + a; const float bb = bsp[g * 128 + i]; const size_t row = row0 + i;
            const v2u uu = *(const v2u*)(UV + row * 512 + g * 64 + d0);
            v2u o; o.x = pk2(bflo(uu.x) * (acc[a].x + bb), bfhi(uu.x) * (acc[a].y + bb)); o.y = pk2(bflo(uu.y) * (acc[a].z + bb), bfhi(uu.y) * (acc[a].w + bb));
            *(v2u*)(mix + row * EVEN_OUT + g * 64 + d0) = o; }
    }
    __syncthreads();
}
__device__ __forceinline__ void moba_naive(Frame& F, bf16* mix) {
    unsigned char* ws = F.ws; const bf16* Qm = (const bf16*)(ws + WS_P + P_QM); const bf16* Km = (const bf16*)(ws + WS_P + P_KM); const bf16* Vm = (const bf16*)(ws + WS_P + P_VM);
    const float* km = (const float*)(ws + WS_KMEAN);
    LAS float* sc = (LAS float*)(F.lds + RING_OFF) + F.wave * 1024;
    const int lane = F.lane;
    for (int it = F.blk * NWAVES + F.wave; it < 48 * SEQ; it += F.G * NWAVES) {
        const int bh = it >> 12, s = it & 4095, b = bh / 12, h = bh % 12, qb = s >> 8;
        float q[64]; load_row64(Qm + ((size_t)bh * SEQ + s) * 64, q);
        float gate = -INFINITY;
        if (lane < qb) { const f32x4* kp = (const f32x4*)(km + ((size_t)bh * 16 + lane) * 64); float a = 0.f;
#pragma unroll
            for (int i = 0; i < 16; ++i) { const f32x4 w = kp[i]; a += q[4 * i] * w.x + q[4 * i + 1] * w.y + q[4 * i + 2] * w.z + q[4 * i + 3] * w.w; }
            gate = a; }
        unsigned sel = 1u << qb;
        for (int r = 0; r < 3; ++r) { float v = gate; int idx = lane;
#pragma unroll
            for (int o = 1; o < 64; o <<= 1) { const float ov = __shfl_xor(v, o); const int oi = __shfl_xor(idx, o); if (ov > v || (ov == v && oi < idx)) { v = ov; idx = oi; } }
            if (v > -INFINITY) { sel |= 1u << idx; if (lane == idx) gate = -INFINITY; } }
        int cnt = 0; float m = -INFINITY;
        for (int n = 0; n <= qb; ++n) { if (!((sel >> n) & 1u)) continue;
#pragma unroll
            for (int kk = 0; kk < 4; ++kk) { const int key = n * 256 + kk * 64 + lane; float x = -INFINITY;
                if (key <= s) x = 0.125f * dot_row64(Km + ((size_t)bh * SEQ + key) * 64, q);
                sc[cnt * 256 + kk * 64 + lane] = x; m = fmaxf(m, x); }
            ++cnt; }
        m = wave_max(m); float l = 0.f; LDS_WAIT();
        for (int i = lane; i < cnt * 256; i += 64) { const float p = __expf(sc[i] - m); sc[i] = p; l += p; }
        l = wave_sum(l); LDS_WAIT();
        float acc = 0.f; int c2 = 0;
        for (int n = 0; n <= qb; ++n) { if (!((sel >> n) & 1u)) continue;
            const bf16* vb = Vm + ((size_t)bh * SEQ + n * 256) * 64 + lane; const int kend = (n == qb) ? (s & 255) + 1 : 256;
            for (int kk = 0; kk < kend; ++kk) acc += sc[c2 * 256 + kk] * bf2f(vb[(size_t)kk * 64]);
            ++c2; }
        mix[((size_t)b * SEQ + s) * ODD_OUT + h * 64 + lane] = (bf16)f2bf(acc / l);
        LDS_WAIT();
    }
}
__device__ __forceinline__ void conv_phase(Frame& F, const bf16* rawp, const float* cw, bf16* mix) {
    for (int it = F.blk * 512 + F.tid; it < T * 256; it += F.G * 512) {
        const int row = it >> 8, c = it & 255, s = row & 4095;
        const bf16* p = rawp + (size_t)row * ODD_IN;
        const float z0 = bf2f(p[2560 + c]) * bf2f(p[2816 + c]);
        const float z1 = s >= 1 ? bf2f(p[2560 + c - ODD_IN]) * bf2f(p[2816 + c - ODD_IN]) : 0.f;
        const float z2 = s >= 2 ? bf2f(p[2560 + c - 2 * ODD_IN]) * bf2f(p[2816 + c - 2 * ODD_IN]) : 0.f;
        const float y = cw[c] * z2 + cw[256 + c] * z1 + cw[512 + c] * z0;
        mix[(size_t)row * ODD_OUT + 768 + c] = (bf16)f2bf(bf2f(p[2304 + c]) * y);
    }
}

constexpr int PH_PER_PAIR = 19, NPH = 1 + 2 * PH_PER_PAIR + 1;
__global__ void __launch_bounds__(NWAVES * 64, 2) fwd(Args args) {
    extern __shared__ __attribute__((aligned(16))) unsigned char lds[];
#define MKFRAME() Frame F; { int t_ = threadIdx.x; asm volatile("" : "+v"(t_)); int b_ = blockIdx.x; asm volatile("" : "+s"(b_)); \
    F.lds = (LAS unsigned char*)lds; F.MISC = (volatile LAS unsigned*)(F.lds + MISC_OFF); F.tid = t_; F.lane = t_ & 63; F.wave = __builtin_amdgcn_readfirstlane(t_ >> 6); \
    F.G = gridDim.x; F.blk = b_; F.ws = args.ws; F.out = args.out; F.ctl = (gu32*)(args.ws + WS_CTL); }
    for (int u = threadIdx.x; u < (LDS_BYTES - LDSCTL_OFF) / 4; u += NWAVES * 64) ((LAS unsigned*)((LAS unsigned char*)lds + LDSCTL_OFF))[u] = 0u;
    __syncthreads();
    const int lo = args.ph_lo, hi = args.ph_hi;
    XcdBarrier bar; bar.bar = (unsigned*)(args.ws + WS_CTL) + CW_BAR; bar.x = 0; bar.st = nullptr;
    if (hi - lo > 1) bar = xcd_barrier_post((unsigned*)(args.ws + WS_CTL) + CW_BAR, (volatile LAS unsigned*)((LAS unsigned char*)lds + MISC_OFF) + 8);
#ifndef PHMASK
#define PHMASK 0xFFFFFF
#endif
#define PHEN(k) (((PHMASK) >> (k)) & 1)
#define IN(k) (lo <= (k) && (k) < hi)
#define SEAM(k) do { if (IN(k) && IN((k) + 1)) xcd_barrier(bar); } while (0)
#define HN ((bf16*)(args.ws + WS_HN))
#define MIX ((bf16*)(args.ws + WS_MIX))
#define HID ((bf16*)(args.ws + WS_HID))
#define RAWP ((bf16*)(args.ws + WS_HID + H_RAWP))
#define HSORT ((bf16*)(args.ws + WS_P))
#define YB ((bf16*)(args.ws + WS_P))
#define x_in (args.in[0])

    if (PHEN(19) && IN(0)) { MKFRAME(); p0_prologue(F, args); SEAM(0); }

    for (int lp = 0; lp < 2; ++lp) {
        const int pb = 1 + lp * PH_PER_PAIR;
        const int le = 2 * lp, lo_ = 2 * lp + 1;
#define we ((const pg8::bf16_t*)(args.ws + WS_WT_EVEN0 + (size_t)lp * WT_EVEN_BYTES))
#define wo ((const pg8::bf16_t*)(args.ws + WS_WT_ODD0 + (size_t)lp * WT_ODD_BYTES))
        if (PHEN(0) && IN(pb + 0)) { MKFRAME();
            norm_phase(F, lp == 0 ? x_in : F.out, F.out, args.in[1] + (size_t)le * D, HN, lp != 0, false, true, nullptr);
            SEAM(pb + 0); }
        if (PHEN(1) && IN(pb + 1)) { MKFRAME();
            pg8::Gemm g{HN, we + WTE_IN / 2, T, EVEN_IN, D}; pg8::StaticOrder S; S.init(T, EVEN_IN, F.G, F.blk);
            pg8::EpiBf16Plain E{RAWP, EVEN_IN};
            pg8::gemm_phase<pg8::EpiBf16Plain, pg8::StaticOrder>(F.lds + RING_OFF, g, S, E);
            SEAM(pb + 1); }
        if (PHEN(2) && IN(pb + 2)) { MKFRAME(); post_even(F, RAWP, args.in[4] + (size_t)lp * 256, args.in[7] + (size_t)lp * 64, args.in[8] + (size_t)lp * 64); SEAM(pb + 2); }
        if (PHEN(3) && IN(pb + 3)) { MKFRAME(); banded_naive(F); gmlp_phase(F, args.in[5] + (size_t)lp * 4 * 128 * 128, args.in[6] + (size_t)lp * 4 * 128, MIX); SEAM(pb + 3); }
        if (PHEN(4) && IN(pb + 4)) { MKFRAME(); merge_even(F, MIX); SEAM(pb + 4); }
        if (PHEN(5) && IN(pb + 5)) { MKFRAME();
            pg8::Gemm g{MIX, we + WTE_OUT / 2, T, D, EVEN_OUT}; pg8::StaticOrder S; S.init(T, D, F.G, F.blk);
            pg8::EpiF32Res E{lp == 0 ? x_in : F.out, F.out, D};
            pg8::gemm_phase<pg8::EpiF32Res, pg8::StaticOrder>(F.lds + RING_OFF, g, S, E);
            SEAM(pb + 5); }
        if (PHEN(6) && IN(pb + 6)) { MKFRAME(); norm_phase(F, F.out, F.out, args.in[2] + (size_t)le * D, HN, false, false, true, nullptr); SEAM(pb + 6); }
        if (PHEN(7) && IN(pb + 7)) { MKFRAME();
            pg8::Gemm g{HN, we + WTE_GU / 2, T, 2 * DFF, D}; pg8::StaticOrder S; S.init(T, 2 * DFF, F.G, F.blk);
            pg8::EpiSwiGLU E{HID, DFF};
            pg8::gemm_phase<pg8::EpiSwiGLU, pg8::StaticOrder>(F.lds + RING_OFF, g, S, E);
            SEAM(pb + 7); }
        if (PHEN(8) && IN(pb + 8)) { MKFRAME();
            pg8::Gemm g{HID, we + WTE_DN / 2, T, D, DFF}; pg8::StaticOrder S; S.init(T, D, F.G, F.blk);
            pg8::EpiF32Res E{F.out, F.out, D};
            pg8::gemm_phase<pg8::EpiF32Res, pg8::StaticOrder>(F.lds + RING_OFF, g, S, E);
            SEAM(pb + 8); }
        if (PHEN(9) && IN(pb + 9)) { MKFRAME(); norm_phase(F, F.out, F.out, args.in[1] + (size_t)lo_ * D, HN, false, false, true, nullptr); SEAM(pb + 9); }
        if (PHEN(10) && IN(pb + 10)) { MKFRAME();
            pg8::Gemm g{HN, wo + WTO_IN / 2, T, ODD_IN, D}; pg8::StaticOrder S; S.init(T, ODD_IN, F.G, F.blk);
            pg8::EpiBf16Plain E{RAWP, ODD_IN};
            pg8::gemm_phase<pg8::EpiBf16Plain, pg8::StaticOrder>(F.lds + RING_OFF, g, S, E);
            SEAM(pb + 10); }
        if (PHEN(11) && IN(pb + 11)) { MKFRAME(); post_odd(F, RAWP, args.in[14] + (size_t)lp * 64, args.in[15] + (size_t)lp * 64); SEAM(pb + 11); }
        if (PHEN(12) && IN(pb + 12)) { MKFRAME(); kmean_phase(F); SEAM(pb + 12); }
        if (PHEN(13) && IN(pb + 13)) { MKFRAME(); moba_naive(F, MIX); conv_phase(F, RAWP, args.in[16] + (size_t)lp * 3 * 256, MIX); SEAM(pb + 13); }
        if (PHEN(14) && IN(pb + 14)) { MKFRAME();
            pg8::Gemm g{MIX, wo + WTO_OUT / 2, T, D, ODD_OUT}; pg8::StaticOrder S; S.init(T, D, F.G, F.blk);
            pg8::EpiF32Res E{F.out, F.out, D};
            pg8::gemm_phase<pg8::EpiF32Res, pg8::StaticOrder>(F.lds + RING_OFF, g, S, E);
            SEAM(pb + 14); }
        if (PHEN(15) && IN(pb + 15)) { MKFRAME(); norm_phase(F, F.out, F.out, args.in[2] + (size_t)lo_ * D, HN, false, true, true, args.in[18] + (size_t)lp * D * NEXP); SEAM(pb + 15); }
        if (PHEN(16) && IN(pb + 16)) { MKFRAME(); route_phase(F, HN, HSORT); SEAM(pb + 16); }
        if (PHEN(17) && IN(pb + 17)) { MKFRAME();
            const int* tbp = (const int*)(args.ws + WS_MISC + 512 * 1024);
            pg8::MoeOrder S; const int ntiles = tbp[8]; S.init(ntiles * 256, 2 * DFFE, F.G, F.blk);
#pragma unroll
            for (int k = 0; k < 8; ++k) S.tb[k] = tbp[k];
            S.estride = (size_t)2 * DFFE * D * 2;
            pg8::Gemm g{HSORT, wo + WTO_MGU / 2, ntiles * 256, 2 * DFFE, D};
            pg8::EpiSwiGLU E{HID, DFFE};
            pg8::gemm_phase<pg8::EpiSwiGLU, pg8::MoeOrder>(F.lds + RING_OFF, g, S, E);
            SEAM(pb + 17); }
        if (PHEN(18) && IN(pb + 18)) { MKFRAME();
            const int* tbp = (const int*)(args.ws + WS_MISC + 512 * 1024);
            pg8::MoeOrder S; const int ntiles = tbp[8]; S.init(ntiles * 256, D, F.G, F.blk);
#pragma unroll
            for (int k = 0; k < 8; ++k) S.tb[k] = tbp[k];
            S.estride = (size_t)DFFE * D * 2;
            pg8::Gemm g{HID, wo + WTO_MD / 2, ntiles * 256, D, DFFE};
            pg8::EpiBf16Plain E{YB, D};
            pg8::gemm_phase<pg8::EpiBf16Plain, pg8::MoeOrder>(F.lds + RING_OFF, g, S, E);
            SEAM(pb + 18); }
    }
    if (PHEN(20) && IN(NPH - 1)) { MKFRAME(); norm_phase(F, F.out, F.out, args.in[1], HN, true, false, false, nullptr); }
#undef IN
#undef SEAM
#undef HN
#undef MIX
#undef HID
#undef RAWP
#undef HSORT
#undef YB
#undef x_in
#undef we
#undef wo
}

extern "C" void kernel_launch(void* const* d_in, const int* in_sizes, int n_in, void* d_out, int out_size, void* d_ws, size_t ws_size, hipStream_t stream) {
    static int grid = 0;
    if (grid == 0) {
        if (n_in != 22 || out_size != T * D || ws_size < WS_END) { fprintf(stderr, "kernel_launch: unexpected shapes (n_in %d out %d ws %zu)\n", n_in, out_size, ws_size); grid = -1; return; }
        int dev = 0, cus = 0, per_cu = 0;
        if (hipGetDevice(&dev) != hipSuccess || hipDeviceGetAttribute(&cus, hipDeviceAttributeMultiprocessorCount, dev) != hipSuccess) { grid = -1; return; }
        if (hipFuncSetAttribute((const void*)fwd, hipFuncAttributeMaxDynamicSharedMemorySize, LDS_BYTES) != hipSuccess) { fprintf(stderr, "kernel_launch: hipFuncSetAttribute failed\n"); grid = -1; return; }
        if (hipOccupancyMaxActiveBlocksPerMultiprocessor(&per_cu, (const void*)fwd, NWAVES * 64, LDS_BYTES) != hipSuccess || per_cu < 1) fprintf(stderr, "kernel_launch: occupancy query says %d\n", per_cu);
        (void)hipGetLastError();
        grid = cus;
    }
    if (grid < 0) return;
    (void)hipMemsetAsync((char*)d_ws + WS_CTL, 0, CTL_ZERO_BYTES, stream);
    Args a{};
    for (int i = 0; i < 22; ++i) a.in[i] = (const float*)d_in[i];
    a.out = (float*)d_out; a.ws = (unsigned char*)d_ws;
#if MK_PER_PHASE
    for (int p = 0; p < NPH; ++p) { a.ph_lo = p; a.ph_hi = p + 1; hipLaunchKernelGGL(fwd, dim3(grid), dim3(NWAVES * 64), LDS_BYTES, stream, a); }
#else
    a.ph_lo = 0; a.ph_hi = NPH; hipLaunchKernelGGL(fwd, dim3(grid), dim3(NWAVES * 64), LDS_BYTES, stream, a);
#endif
}
```

```cpp
#include <hip/hip_runtime.h>
#include <cstdio>
#include <cstdint>
#include <hip/hip_bf16.h>

#ifndef NAIVE_MOBA
#define NAIVE_MOBA 0
#endif
#ifndef NAIVE_BANDED
#define NAIVE_BANDED 0
#endif
#ifndef MK_PER_PHASE
#define MK_PER_PHASE 0
#endif

namespace pg8 {
#define PG8_LAS __attribute__((address_space(3)))
typedef unsigned short bf16_t;
typedef short bf16x8 __attribute__((ext_vector_type(8)));
typedef float f32x4 __attribute__((ext_vector_type(4)));
typedef float f32x2 __attribute__((ext_vector_type(2)));
typedef unsigned u32x4 __attribute__((ext_vector_type(4)));
constexpr int BM = 256, BK = 64, HALF = 128, HTB = HALF * BK * 2, STAGE_BYTES = 8 * HTB, NXCD = 8, WGM = 8;

__host__ __device__ __forceinline__ int lds_byte(int r, int c) { const int st = (r >> 4) * 2 + (c >> 5), rr = r & 15, cc = c & 31, ob = rr * 64 + cc * 2; return st * 1024 + (ob ^ (((ob >> 9) & 1) << 5)); }
__host__ __device__ __forceinline__ void stage_rc(int b, int& R, int& C) { const int st = b / 1024, sb = b % 1024, swz = sb ^ (((sb >> 9) & 1) << 5); R = (st >> 1) * 16 + swz / 64; C = (st & 1) * 32 + (swz % 64) / 2; }
__host__ __device__ __forceinline__ int perm32(int rho) { const int n = rho >> 4, i = rho & 15; return 8 * (i >> 2) + 4 * n + (i & 3); }

struct Unit { int pm, pn; };
struct Gemm { const bf16_t* A; const bf16_t* Bt; int M, N, K; };

struct StaticOrder {
    int nM, nN, nwg, G, c;
    __device__ void init(int M, int N, int G_, int c_) { nM = M / BM; nN = N / BM; nwg = nM * nN; G = G_; c = c_; }
    __device__ bool next(int i, Unit& u) const {
        const long L = (long)i * G + c; if (L >= nwg) return false;
        int wgid = (int)L; { const int q = nwg / NXCD, r = nwg % NXCD, xcd = wgid % NXCD, off = wgid / NXCD; wgid = (xcd < r ? xcd * (q + 1) : r * (q + 1) + (xcd - r) * q) + off; }
        const int nig = WGM * nN, gid = wgid / nig, fm = gid * WGM, gsz = (nM - fm) < WGM ? (nM - fm) : WGM;
        u.pm = fm + ((wgid % nig) % gsz); u.pn = (wgid % nig) / gsz; return true;
    }
    __device__ __forceinline__ const char* bbase(const Unit&, const bf16_t* Bt) const { return (const char*)Bt; }
};
struct MoeOrder : StaticOrder {
    int tb[8]; size_t estride;
    __device__ __forceinline__ const char* bbase(const Unit& u, const bf16_t* Bt) const {
        int e = 0;
#pragma unroll
        for (int k = 1; k < 8; ++k) e += (u.pm >= tb[k]) ? 1 : 0;
        return (const char*)Bt + (size_t)e * estride;
    }
};

__device__ __forceinline__ unsigned cvt_pk_bf16(float lo, float hi) { unsigned r; asm volatile("v_cvt_pk_bf16_f32 %0, %1, %2" : "=v"(r) : "v"(lo), "v"(hi)); return r; }

struct EpiBf16Plain {
    static constexpr bool PERM = true;
    bf16_t* O; int ldc;
    __device__ __forceinline__ void operator()(const f32x4 (&acc)[2][2][4][2], const Unit& u, int wr, int wc, int fr, int fq) const {
        const int row0 = u.pm * BM + wr * 64 + fr, col0 = u.pn * BM + wc * 32 + 8 * fq;
#pragma unroll
        for (int ai = 0; ai < 2; ++ai)
#pragma unroll
            for (int m = 0; m < 4; ++m) { bf16_t* rowp = O + (size_t)(row0 + ai * HALF + m * 16) * ldc + col0;
#pragma unroll
                for (int bj = 0; bj < 2; ++bj) { const f32x4 v0 = acc[ai][bj][m][0], v1 = acc[ai][bj][m][1];
                    u32x4 w; w.x = cvt_pk_bf16(v0[0], v0[1]); w.y = cvt_pk_bf16(v0[2], v0[3]); w.z = cvt_pk_bf16(v1[0], v1[1]); w.w = cvt_pk_bf16(v1[2], v1[3]);
                    *(u32x4*)(rowp + bj * HALF) = w; } }
    }
};
struct EpiF32Res {
    static constexpr bool PERM = false;
    const float* base; float* out; int ldc;
    __device__ __forceinline__ void operator()(const f32x4 (&acc)[2][2][4][2], const Unit& u, int wr, int wc, int fr, int fq) const {
        const int row0 = u.pm * BM + wr * 64 + fr, col0 = u.pn * BM + wc * 32 + 4 * fq;
#pragma unroll
        for (int ai = 0; ai < 2; ++ai)
#pragma unroll
            for (int m = 0; m < 4; ++m) { const size_t off = (size_t)(row0 + ai * HALF + m * 16) * ldc + col0;
#pragma unroll
                for (int bj = 0; bj < 2; ++bj)
#pragma unroll
                    for (int n = 0; n < 2; ++n) { const f32x4 bs = *(const f32x4*)(base + off + bj * HALF + n * 16); *(f32x4*)(out + off + bj * HALF + n * 16) = bs + acc[ai][bj][m][n]; }
                asm volatile("" ::: "memory"); }
    }
};
__device__ __forceinline__ float silu_mul(float g, float u) { return g * __builtin_amdgcn_rcpf(1.0f + __builtin_amdgcn_exp2f(-1.4426950408889634f * g)) * u; }
struct EpiSwiGLU {
    static constexpr bool PERM = true;
    bf16_t* O; int ldc;
    __device__ __forceinline__ void operator()(const f32x4 (&acc)[2][2][4][2], const Unit& u, int wr, int wc, int fr, int fq) const {
        const int row0 = u.pm * BM + wr * 64 + fr, col0 = u.pn * HALF + wc * 32 + 8 * fq;
#pragma unroll
        for (int ai = 0; ai < 2; ++ai)
#pragma unroll
            for (int m = 0; m < 4; ++m) { bf16_t* rowp = O + (size_t)(row0 + ai * HALF + m * 16) * ldc + col0;
                const f32x4 g0 = acc[ai][0][m][0], g1 = acc[ai][0][m][1], u0 = acc[ai][1][m][0], u1 = acc[ai][1][m][1];
                u32x4 w; w.x = cvt_pk_bf16(silu_mul(g0[0], u0[0]), silu_mul(g0[1], u0[1])); w.y = cvt_pk_bf16(silu_mul(g0[2], u0[2]), silu_mul(g0[3], u0[3]));
                w.z = cvt_pk_bf16(silu_mul(g1[0], u1[0]), silu_mul(g1[1], u1[1])); w.w = cvt_pk_bf16(silu_mul(g1[2], u1[2]), silu_mul(g1[3], u1[3]));
                *(u32x4*)rowp = w; }
    }
};

template <class Epi, class Sched, bool ALIGN_EPI = true, bool SP2 = true>
__device__ __forceinline__ void gemm_phase(PG8_LAS unsigned char* lds, const Gemm g, const Sched& S, const Epi& E) {
    int tid_ = threadIdx.x; asm volatile("" : "+v"(tid_));
    const int tid = tid_, wid = __builtin_amdgcn_readfirstlane(tid >> 6), lane = tid & 63, wr = wid >> 2, wc = wid & 3, fr = lane & 15, fq = lane >> 4;
    const int K = g.K, nt = K / BK;
    unsigned voffA[2], voffB[2];
#pragma unroll
    for (int i = 0; i < 2; ++i) { int R, C; stage_rc(tid * 16 + i * 8192, R, C); const int Rb = Epi::PERM ? ((R & ~31) + perm32(R & 31)) : R;
        voffA[i] = (unsigned)(R * K + C) * 2u; voffB[i] = (unsigned)(Rb * K + C) * 2u; }
    const size_t kstep = (size_t)(BK * 2);
    const size_t hstep = (size_t)HALF * K * 2;
    const size_t tstep = 2 * hstep;
    const unsigned ldsw = (unsigned)wid * 1024u;
    const int aoff = lds_byte(wr * 64 + fr, fq * 8), boff = lds_byte(wc * 32 + fr, fq * 8);
#define PG8_SA(b, h) (((b) * 2 + (h)) * HTB)
#define PG8_SB(b, h) ((4 + (b) * 2 + (h)) * HTB)
#define PG8_STAGE(bufoff, gbase, voff) do { _Pragma("unroll") for (int _i = 0; _i < 2; ++_i) \
        __builtin_amdgcn_global_load_lds((const unsigned*)((const char*)(gbase) + (voff)[_i]), (PG8_LAS unsigned*)(lds + (bufoff) + ldsw + _i * 8192), 16, 0, 0); } while (0)
#define PG8_LDA(dst, b, h) do { _Pragma("unroll") for (int m = 0; m < 4; ++m) _Pragma("unroll") for (int k = 0; k < 2; ++k) dst[m][k] = *(const PG8_LAS bf16x8*)(lds + PG8_SA(b, h) + aoff + m * 2048 + k * 1024); } while (0)
#define PG8_LDB(dst, b, h) do { _Pragma("unroll") for (int n = 0; n < 2; ++n) _Pragma("unroll") for (int k = 0; k < 2; ++k) dst[n][k] = *(const PG8_LAS bf16x8*)(lds + PG8_SB(b, h) + boff + n * 2048 + k * 1024); } while (0)
#define PG8_MMA(ai, bj, At, Bt) do { __builtin_amdgcn_s_setprio(1); _Pragma("unroll") for (int m = 0; m < 4; ++m) _Pragma("unroll") for (int n = 0; n < 2; ++n) _Pragma("unroll") for (int k = 0; k < 2; ++k) \
        acc[ai][bj][m][n] = __builtin_amdgcn_mfma_f32_16x16x32_bf16(Bt[n][k], At[m][k], acc[ai][bj][m][n], 0, 0, 0); __builtin_amdgcn_s_setprio(0); } while (0)
#define PG8_WAIT_V(n) asm volatile("s_waitcnt vmcnt(" #n ")" ::: "memory")
#define PG8_WAIT_L(n) asm volatile("s_waitcnt lgkmcnt(" #n ")" ::: "memory")
#define PG8_BAR __builtin_amdgcn_s_barrier()
#define PG8_SCHED __builtin_amdgcn_sched_barrier(0)
    Unit cur, nxt; int ui = 0;
    if (!S.next(0, cur)) return;
    f32x4 acc[2][2][4][2];
#pragma unroll
    for (int a = 0; a < 2; ++a)
#pragma unroll
        for (int b = 0; b < 2; ++b)
#pragma unroll
            for (int m = 0; m < 4; ++m)
#pragma unroll
                for (int n = 0; n < 2; ++n) acc[a][b][m][n] = (f32x4){0.f, 0.f, 0.f, 0.f};
    bf16x8 At[4][2], B0[2][2], B1[2][2];
    const char* cA = (const char*)g.A + (size_t)cur.pm * tstep; const char* cB = S.bbase(cur, g.Bt) + (size_t)cur.pn * tstep;
    if constexpr (SP2) {
        PG8_STAGE(PG8_SB(0, 0), cB, voffB); PG8_STAGE(PG8_SB(0, 1), cB + hstep, voffB); PG8_STAGE(PG8_SA(0, 0), cA, voffA); PG8_STAGE(PG8_SA(0, 1), cA + hstep, voffA);
        if (wr == 1) PG8_BAR;
        PG8_WAIT_V(2); PG8_BAR;
        PG8_STAGE(PG8_SB(1, 0), cB + kstep, voffB); PG8_STAGE(PG8_SA(1, 0), cA + kstep, voffA); PG8_STAGE(PG8_SB(1, 1), cB + hstep + kstep, voffB);
        PG8_WAIT_V(6); PG8_BAR;
    } else {
        PG8_STAGE(PG8_SB(0, 0), cB, voffB); PG8_STAGE(PG8_SA(0, 0), cA, voffA); PG8_STAGE(PG8_SB(0, 1), cB + hstep, voffB); PG8_STAGE(PG8_SA(0, 1), cA + hstep, voffA);
        if (wr == 1) PG8_BAR;
        PG8_WAIT_V(4); PG8_BAR;
        PG8_STAGE(PG8_SB(1, 0), cB + kstep, voffB); PG8_STAGE(PG8_SA(1, 0), cA + kstep, voffA); PG8_STAGE(PG8_SB(1, 1), cB + hstep + kstep, voffB);
        PG8_WAIT_V(6); PG8_BAR;
    }
    for (;;) {
        const bool has_next = S.next(ui + 1, nxt);
        const char* nA = has_next ? (const char*)g.A + (size_t)nxt.pm * tstep : cA; const char* nB = has_next ? S.bbase(nxt, g.Bt) + (size_t)nxt.pn * tstep : cB;
        for (int t = 0; t < nt; t += 2) {
            const bool last = (t == nt - 2);
            const char* a1 = cA + (size_t)(t + 1) * kstep;
            const char* a2 = last ? nA : cA + (size_t)(t + 2) * kstep; const char* b2 = last ? nB : cB + (size_t)(t + 2) * kstep;
            const char* a3 = a2 + kstep; const char* b3 = b2 + kstep;
            if constexpr (SP2) {
            PG8_LDB(B0, 0, 0); PG8_LDB(B1, 0, 1); PG8_SCHED; PG8_LDA(At, 0, 0); PG8_STAGE(PG8_SA(1, 1), a1 + hstep, voffA);
            PG8_WAIT_V(8); PG8_WAIT_L(0); PG8_BAR; PG8_MMA(0, 0, At, B0); PG8_MMA(0, 1, At, B1); PG8_BAR; PG8_SCHED;
            PG8_LDA(At, 0, 1); PG8_STAGE(PG8_SB(0, 0), b2, voffB); PG8_STAGE(PG8_SB(0, 1), b2 + hstep, voffB); PG8_STAGE(PG8_SA(0, 0), a2, voffA);
            PG8_WAIT_V(8); PG8_WAIT_L(0); PG8_BAR; PG8_MMA(1, 0, At, B0); PG8_MMA(1, 1, At, B1); PG8_BAR; PG8_SCHED;
            PG8_LDB(B0, 1, 0); PG8_LDB(B1, 1, 1); PG8_SCHED; PG8_LDA(At, 1, 0); PG8_STAGE(PG8_SA(0, 1), a2 + hstep, voffA);
            PG8_WAIT_V(8); PG8_WAIT_L(0); PG8_BAR; PG8_MMA(0, 0, At, B0); PG8_MMA(0, 1, At, B1); PG8_BAR; PG8_SCHED;
            PG8_LDA(At, 1, 1); PG8_STAGE(PG8_SB(1, 0), b3, voffB); PG8_STAGE(PG8_SB(1, 1), b3 + hstep, voffB); PG8_STAGE(PG8_SA(1, 0), a3, voffA);
            PG8_WAIT_V(8); PG8_WAIT_L(0); PG8_BAR; PG8_MMA(1, 0, At, B0); PG8_MMA(1, 1, At, B1); PG8_BAR; PG8_SCHED;
            } else {
            PG8_LDB(B0, 0, 0); PG8_SCHED; PG8_LDA(At, 0, 0); PG8_STAGE(PG8_SA(1, 1), a1 + hstep, voffA);
            PG8_WAIT_L(8); PG8_BAR; PG8_WAIT_L(0); PG8_MMA(0, 0, At, B0); PG8_BAR; PG8_SCHED;
            PG8_LDB(B1, 0, 1); PG8_STAGE(PG8_SB(0, 0), b2, voffB);
            PG8_BAR; PG8_WAIT_L(0); PG8_MMA(0, 1, At, B1); PG8_BAR;
            PG8_LDA(At, 0, 1); PG8_STAGE(PG8_SA(0, 0), a2, voffA);
            PG8_BAR; PG8_WAIT_L(0); PG8_MMA(1, 0, At, B0); PG8_BAR; PG8_SCHED;
            PG8_STAGE(PG8_SB(0, 1), b2 + hstep, voffB);
            PG8_WAIT_V(6); PG8_BAR; PG8_MMA(1, 1, At, B1); PG8_BAR;
            PG8_LDB(B0, 1, 0); PG8_SCHED; PG8_LDA(At, 1, 0); PG8_STAGE(PG8_SA(0, 1), a2 + hstep, voffA);
            PG8_WAIT_L(8); PG8_BAR; PG8_WAIT_L(0); PG8_MMA(0, 0, At, B0); PG8_BAR; PG8_SCHED;
            PG8_LDB(B1, 1, 1); PG8_STAGE(PG8_SB(1, 0), b3, voffB);
            PG8_BAR; PG8_WAIT_L(0); PG8_MMA(0, 1, At, B1); PG8_BAR;
            PG8_LDA(At, 1, 1); PG8_STAGE(PG8_SA(1, 0), a3, voffA);
            PG8_BAR; PG8_WAIT_L(0); PG8_MMA(1, 0, At, B0); PG8_BAR; PG8_SCHED;
            PG8_STAGE(PG8_SB(1, 1), b3 + hstep, voffB);
            PG8_WAIT_V(6); PG8_BAR; PG8_MMA(1, 1, At, B1); PG8_BAR;
            }
        }
        if constexpr (ALIGN_EPI) { if (wr == 0) PG8_BAR; }
        E(acc, cur, wr, wc, fr, fq);
        if (!has_next) break;
#pragma unroll
        for (int a = 0; a < 2; ++a)
#pragma unroll
            for (int b = 0; b < 2; ++b)
#pragma unroll
                for (int m = 0; m < 4; ++m)
#pragma unroll
                    for (int n = 0; n < 2; ++n) acc[a][b][m][n] = (f32x4){0.f, 0.f, 0.f, 0.f};
        cur = nxt; cA = nA; cB = nB; ++ui;
        if constexpr (ALIGN_EPI) { if (wr == 1) PG8_BAR; }
    }
    PG8_WAIT_V(0);
    if constexpr (!ALIGN_EPI) { if (wr == 0) PG8_BAR; }
    PG8_BAR;
#undef PG8_SA
#undef PG8_SB
#undef PG8_STAGE
#undef PG8_LDA
#undef PG8_LDB
#undef PG8_MMA
#undef PG8_WAIT_V
#undef PG8_WAIT_L
#undef PG8_BAR
#undef PG8_SCHED
}
}


namespace att {
using bf16x8=__attribute__((ext_vector_type(8)))short;
using s16x4=__attribute__((ext_vector_type(4)))short;
using f32x16=__attribute__((ext_vector_type(16)))float;
using u32x4=__attribute__((ext_vector_type(4)))unsigned;
typedef unsigned short bf16;
constexpr int D=64,DM=64;
constexpr int NW=8,QBLK=32,QB=QBLK*NW,KVBLK=64;
__device__ __forceinline__ int crow(int r,int hi){return (r&3)+8*(r>>2)+4*hi;}
#define SBAR() __builtin_amdgcn_sched_barrier(0)
constexpr int NSLOT=3, SLOTB=8192;
constexpr int LDS_K=0, LDS_V=NSLOT*SLOTB, LDS_WS=2*NSLOT*SLOTB, LDS_OST=LDS_WS+NW*64*4, LDS_KM=LDS_OST+NW*4096, LDS_TK=LDS_KM+4096, LDS_BYTES=LDS_TK+64;
constexpr float C2=0.125f*1.4426950408889634f;
__device__ __forceinline__ void glds16(const void*gsrc,unsigned lds_dst){unsigned keep;
  asm volatile("s_mov_b32 %0, m0\n\ts_mov_b32 m0, %2\n\ts_nop 0\n\tglobal_load_lds_dwordx4 %1, off\n\ts_mov_b32 m0, %0":"=&s"(keep):"v"(gsrc),"s"(lds_dst):"memory");}
__device__ __forceinline__ float max3f(float a,float b,float c){float r;asm("v_max3_f32 %0, %1, %2, %3":"=v"(r):"v"(a),"v"(b),"v"(c));return r;}
__device__ __forceinline__ float max2f(float a,float b){float r;asm("v_max_f32_e32 %0, %1, %2":"=v"(r):"v"(a),"v"(b));return r;}
__device__ __forceinline__ float fadd_s(float a,float b){float r;asm("v_add_f32_e32 %0, %1, %2":"=v"(r):"v"(a),"v"(b));return r;}
__device__ __forceinline__ float fsub_s(float a,float b){float r;asm("v_sub_f32_e32 %0, %1, %2":"=v"(r):"v"(a),"v"(b));return r;}
typedef float f32x2_t __attribute__((ext_vector_type(2))); typedef __bf16 bf16x2_t __attribute__((ext_vector_type(2)));
__device__ __forceinline__ unsigned cvtpk_s(float lo,float hi){f32x2_t v={lo,hi};bf16x2_t b=__builtin_convertvector(v,bf16x2_t);return __builtin_bit_cast(unsigned,b);}
#define WAIT_BAR(N) asm volatile("s_waitcnt vmcnt(" #N ") lgkmcnt(0)\n\ts_barrier":::"memory")
__device__ __forceinline__ void qkt(f32x16&p0,f32x16&p1,const char*Kslot,const bf16x8*qr,int r32,int hi){ const f32x16 zero16=f32x16{};
  const char*kb=Kslot+hi*1024+r32*16;
  #pragma unroll
  for(int d0=0;d0<4;++d0){
    const bf16x8 b0=*reinterpret_cast<const bf16x8*>(kb+d0*2048);
    const bf16x8 b1=*reinterpret_cast<const bf16x8*>(kb+d0*2048+512);
    if(d0==0){p0=__builtin_amdgcn_mfma_f32_32x32x16_bf16(b0,qr[0],zero16,0,0,0);p1=__builtin_amdgcn_mfma_f32_32x32x16_bf16(b1,qr[0],zero16,0,0,0);}
    else{p0=__builtin_amdgcn_mfma_f32_32x32x16_bf16(b0,qr[d0],p0,0,0,0);p1=__builtin_amdgcn_mfma_f32_32x32x16_bf16(b1,qr[d0],p1,0,0,0);}}
}
typedef __attribute__((address_space(3))) const char* lds_cptr;
typedef short v4i16_t __attribute__((ext_vector_type(4)));
__device__ __forceinline__ void kload8(bf16x8*kf,lds_cptr kp){
  kf[0]=*(const __attribute__((address_space(3))) bf16x8*)(kp);      kf[1]=*(const __attribute__((address_space(3))) bf16x8*)(kp+512);
  kf[2]=*(const __attribute__((address_space(3))) bf16x8*)(kp+2048); kf[3]=*(const __attribute__((address_space(3))) bf16x8*)(kp+2560);
  kf[4]=*(const __attribute__((address_space(3))) bf16x8*)(kp+4096); kf[5]=*(const __attribute__((address_space(3))) bf16x8*)(kp+4608);
  kf[6]=*(const __attribute__((address_space(3))) bf16x8*)(kp+6144); kf[7]=*(const __attribute__((address_space(3))) bf16x8*)(kp+6656);
}
__device__ __forceinline__ void kload2(bf16x8*kf,lds_cptr kp,int j){ kf[2*j]=*(const __attribute__((address_space(3))) bf16x8*)(kp+j*2048); kf[2*j+1]=*(const __attribute__((address_space(3))) bf16x8*)(kp+j*2048+512); }
__device__ __forceinline__ s16x4 vtr(lds_cptr p){ return __builtin_bit_cast(s16x4,__builtin_amdgcn_ds_read_tr16_b64_v4i16((__attribute__((address_space(3))) v4i16_t*)p)); }
__device__ __forceinline__ float rowmax(const f32x16&p0,const f32x16&p1){
  float a=max3f(p0[0],p0[1],p1[0]),b=max3f(p0[2],p0[3],p1[1]);a=max3f(a,p1[2],p1[3]);
  #pragma unroll
  for(int r=4;r<16;r+=4){a=max3f(a,p0[r],p0[r+1]);b=max3f(b,p0[r+2],p0[r+3]);a=max3f(a,p1[r],p1[r+1]);b=max3f(b,p1[r+2],p1[r+3]);}
  const float m=max2f(a,b);
  auto rr=__builtin_amdgcn_permlane32_swap(__float_as_uint(m),__float_as_uint(m),false,false);
  return max2f(__uint_as_float(rr[0]),__uint_as_float(rr[1]));
}
__device__ __forceinline__ void pv(f32x16*o,int vb,bf16x8 pa0,bf16x8 pa1,bf16x8 pa2,bf16x8 pa3){
  #pragma unroll
  for(int d0=0;d0<2;++d0){s16x4 lo[4],hi[4];
    #pragma unroll
    for(int ks=0;ks<4;++ks){
      asm volatile("ds_read_b64_tr_b16 %0,%1 offset:%c2":"=&v"(lo[ks]):"v"(vb),"i"(d0*4096+ks*1024):"memory");
      asm volatile("ds_read_b64_tr_b16 %0,%1 offset:%c2":"=&v"(hi[ks]):"v"(vb),"i"(d0*4096+ks*1024+512):"memory");}
    asm volatile("s_waitcnt lgkmcnt(0)":::"memory");SBAR();
    #define PK(k) (bf16x8){lo[k][0],lo[k][1],lo[k][2],lo[k][3],hi[k][0],hi[k][1],hi[k][2],hi[k][3]}
    o[d0]=__builtin_amdgcn_mfma_f32_32x32x16_bf16(pa0,PK(0),o[d0],0,0,0);
    o[d0]=__builtin_amdgcn_mfma_f32_32x32x16_bf16(pa1,PK(1),o[d0],0,0,0);
    o[d0]=__builtin_amdgcn_mfma_f32_32x32x16_bf16(pa2,PK(2),o[d0],0,0,0);
    o[d0]=__builtin_amdgcn_mfma_f32_32x32x16_bf16(pa3,PK(3),o[d0],0,0,0);
    #undef PK
  }
}
template<int MODE> __device__ __forceinline__ void amask(f32x16&p0,f32x16&p1,int a,int nb,unsigned sel,int qabs,int qrel,int hi,float mhat){
  const float NEG=-INFINITY;
  if(MODE==0){
    if(a>=nb){ const int kb=64*(a-nb)+4*hi;
      #pragma unroll
      for(int r=0;r<16;++r){const int kv=kb+(r&3)+8*(r>>2); p0[r]=(kv>qrel)?NEG:p0[r]-mhat; p1[r]=(kv+32>qrel)?NEG:p1[r]-mhat;} }
    else { const float bias=((sel>>(a>>2))&1u)?-mhat:NEG;
      #pragma unroll
      for(int r=0;r<16;++r){ p0[r]+=bias; p1[r]+=bias; } }
  } else {
    const int base=qabs-64*a-4*hi;
    #pragma unroll
    for(int r=0;r<16;++r){const int c=(r&3)+8*(r>>2); p0[r]=((unsigned)(base-c)>128u)?NEG:p0[r]-mhat; p1[r]=((unsigned)(base-c-32)>128u)?NEG:p1[r]-mhat;}
  }
}
#ifndef ATTN_STORE16
#define ATTN_STORE16(p,v) (*(u32x4*)(p)=(v))
#endif
template<int MODE,int THRL,int opitch> __device__ __forceinline__ void attn_unit(const bf16*Qs,int q0,int tile0,int NT,unsigned sel,bf16*O,float*LSE,char*shm){
  const bf16*Ks=Qs+12*1024*1024,*Vs=Qs+24*1024*1024;
  int tid_=threadIdx.x; asm volatile("":"+v"(tid_));
  const int tid=tid_,lane=tid&63,r32=lane&31,hi=lane>>5; const int wid=__builtin_amdgcn_readfirstlane(tid>>6);
  const int nb=NT-4;
  const bf16*Qw=Qs+(long)(q0+wid*QBLK)*DM;
  const lds_cptr shm3=(lds_cptr)shm;
  const unsigned lds0=(unsigned)(uintptr_t)shm3;
  float*wsf=(float*)(shm+LDS_WS)+wid*64;
  const bf16*ksrc=Ks+(long)lane*DM+wid*8;
  const bf16*vsrc=Vs+(long)(16*(wid&3)+(lane>>2))*DM+(wid>>2)*32+(lane&3)*8;
  const unsigned kdst=lds0+LDS_K+wid*1024, vdst=lds0+LDS_V+wid*1024;
  #define TM(t) (MODE==0 ? ((t)==0 ? nb : ((t)<=nb ? (t)-1 : (t))) : tile0+(t))
  #define DMA_K(t,slot) glds16(ksrc+(long)TM(t)*KVBLK*DM,(unsigned)__builtin_amdgcn_readfirstlane(kdst+(slot)))
  #define DMA_V(t,slot) glds16(vsrc+(long)TM(t)*KVBLK*DM,(unsigned)__builtin_amdgcn_readfirstlane(vdst+(slot)))
  const char*Kbase=shm+LDS_K; bf16x8 kf[8];
  const lds_cptr kp0=shm3+LDS_K+hi*1024+r32*16; const lds_cptr vp0=shm3+LDS_V+((lane>>4)&1)*32+(lane&3)*8+(4*hi+((lane&15)>>2))*64;
  DMA_K(0,0);DMA_V(0,0);DMA_K(1,SLOTB);
  bf16x8 qr[4];
  #pragma unroll
  for(int d0=0;d0<4;++d0)qr[d0]=*reinterpret_cast<const bf16x8*>(&Qw[(long)r32*DM+d0*16+hi*8]);
  float mhat=0.f,l_reg=0.f;f32x16 o[2];o[0]=f32x16{};o[1]=f32x16{};const f32x16 zero16=f32x16{};
  const int qrel=wid*QBLK+r32, qabs=q0+qrel;
  #define CMASK(P0,P1,t) amask<MODE>(P0,P1,TM(t),nb,sel,qabs,qrel,hi,mhat)
  bool resc=false;
  #define START(P0,P1) do{ const float rm=rowmax(P0,P1); resc=false; \
    { const float dl=__builtin_fmaxf(rm,0.f); mhat=fadd_s(mhat,dl); \
      _Pragma("unroll") for(int r=0;r<16;++r){P0[r]=fsub_s(P0[r],dl);P1[r]=fsub_s(P1[r],dl);} } \
    _Pragma("unroll") for(int r=0;r<16;++r)P0[r]=__builtin_amdgcn_exp2f(P0[r]); }while(0)
  #define RESC() do{ if(resc){ asm volatile("s_waitcnt lgkmcnt(0)":::"memory"); \
      _Pragma("unroll") for(int d_=0;d_<2;++d_) _Pragma("unroll") for(int r=0;r<16;++r)o[d_][r]*=wsf[crow(r,hi)]; } }while(0)
  f32x16 pA0,pA1,pB0,pB1;
  int sl_prev=0,sl_cur=0,sl_next=SLOTB;
  #define ROT() do{sl_prev=sl_cur;sl_cur=sl_next;sl_next=(sl_next==(NSLOT-1)*SLOTB)?0:sl_next+SLOTB;}while(0)
  DMA_K(2,2*SLOTB);
  WAIT_BAR(3);
  qkt(pA0,pA1,Kbase,qr,r32,hi);asm volatile("s_nop 15\n\ts_nop 7":"+v"(pA0),"+v"(pA1));CMASK(pA0,pA1,0);
  START(pA0,pA1);
  _Pragma("unroll") for(int r=0;r<16;++r)pA1[r]=__builtin_amdgcn_exp2f(pA1[r]);
  WAIT_BAR(0);
  DMA_K(3,0);DMA_V(1,SLOTB);
  ROT();
  kload8(kf,kp0+sl_cur);
  WAIT_BAR(2);
  s16x4 vlo[8],vhi[8]; u32x4 pw0,pw1,pw2,pw3;
  #define PKW(P,B) cvtpk_s(P[B],P[B+1])
  #define PAF(k) __builtin_bit_cast(bf16x8,pw##k)
  #define VFR(i) (bf16x8){vlo[i][0],vlo[i][1],vlo[i][2],vlo[i][3],vhi[i][0],vhi[i][1],vhi[i][2],vhi[i][3]}
  #define PIN(x) asm volatile("":"+v"(x))
  #define MX3(a,b,c) __builtin_fmaxf(__builtin_fmaxf((a),(b)),(c))
  #define GAPA(MF,A0,A1,A2,A3,W0,W1,PW) do{ MF; sacc+=A0; sacc+=A1; sacc+=A2; sacc+=A3; PIN(sacc); W0; W1; PIN(PW); SBAR(); }while(0)
  #define EX(v) __builtin_amdgcn_exp2f(v)
  #define GAPB(MF,X,B) do{ MF; X[B]=EX(X[B]); X[B+1]=EX(X[B+1]); X[B+2]=EX(X[B+2]); X[B+3]=EX(X[B+3]); PIN(X); SBAR(); }while(0)
  #define VRD(i) do{ vlo[i]=vtr(vp_+(((i)>>2)*4096+((i)&3)*1024)); vhi[i]=vtr(vp_+(((i)>>2)*4096+((i)&3)*1024+512)); }while(0)
  #define KRD(G,j) do{ if(G){ kload2(kf,kp0+sl_next,j); SBAR(); } }while(0)
  #define STEP(C0,C1,P0,P1,t,GK,GV,GL) do{ SBAR(); \
    const lds_cptr vp_=vp0+sl_prev; \
    VRD(0); SBAR(); float sacc=(P0[0]+P0[1]); \
    GAPA(C0=__builtin_amdgcn_mfma_f32_32x32x16_bf16(kf[0],qr[0],zero16,0,0,0), P0[2],P0[3],P0[4],P0[5],     pw0[0]=PKW(P0,0), pw0[1]=PKW(P0,2), pw0); \
    VRD(4); SBAR(); GAPA(C1=__builtin_amdgcn_mfma_f32_32x32x16_bf16(kf[1],qr[0],zero16,0,0,0), P0[6],P0[7],P0[8],P0[9],     pw0[2]=PKW(P0,4), pw0[3]=PKW(P0,6), pw0); \
    VRD(1); SBAR(); GAPA(C0=__builtin_amdgcn_mfma_f32_32x32x16_bf16(kf[2],qr[1],C0,0,0,0),   P0[10],P0[11],P0[12],P0[13], pw1[0]=PKW(P0,8), pw1[1]=PKW(P0,10), pw1); \
    VRD(5); SBAR(); GAPA(C1=__builtin_amdgcn_mfma_f32_32x32x16_bf16(kf[3],qr[1],C1,0,0,0),   P0[14],P0[15],P1[0],P1[1],   pw1[2]=PKW(P0,12),pw1[3]=PKW(P0,14), pw1); \
    VRD(2); SBAR(); GAPA(C0=__builtin_amdgcn_mfma_f32_32x32x16_bf16(kf[4],qr[2],C0,0,0,0),   P1[2],P1[3],P1[4],P1[5],     pw2[0]=PKW(P1,0), pw2[1]=PKW(P1,2), pw2); \
    VRD(6); SBAR(); GAPA(C1=__builtin_amdgcn_mfma_f32_32x32x16_bf16(kf[5],qr[2],C1,0,0,0),   P1[6],P1[7],P1[8],P1[9],     pw2[2]=PKW(P1,4), pw2[3]=PKW(P1,6), pw2); \
    VRD(3); SBAR(); GAPA(C0=__builtin_amdgcn_mfma_f32_32x32x16_bf16(kf[6],qr[3],C0,0,0,0),   P1[10],P1[11],P1[12],P1[13], pw3[0]=PKW(P1,8), pw3[1]=PKW(P1,10), pw3); \
    VRD(7); SBAR(); GAPA(C1=__builtin_amdgcn_mfma_f32_32x32x16_bf16(kf[7],qr[3],C1,0,0,0),   P1[14],P1[15],0.f,0.f,       pw3[2]=PKW(P1,12),pw3[3]=PKW(P1,14), pw3); \
    l_reg+=sacc; \
    if(GK){DMA_K((t)+3,sl_cur);} if(GV){DMA_V((t)+1,sl_next);} \
    CMASK(C0,C1,t); \
    { float a=MX3(C0[0],C0[1],C1[0]),b=MX3(C0[2],C0[3],C1[1]); a=MX3(a,C1[2],C1[3]); \
      _Pragma("unroll") for(int r=4;r<16;r+=4){a=MX3(a,C0[r],C0[r+1]);b=MX3(b,C0[r+2],C0[r+3]);a=MX3(a,C1[r],C1[r+1]);b=MX3(b,C1[r+2],C1[r+3]);} \
      float rm=__builtin_fmaxf(a,b); { auto rr=__builtin_amdgcn_permlane32_swap(__float_as_uint(rm),__float_as_uint(rm),false,false); rm=__builtin_fmaxf(__uint_as_float(rr[0]),__uint_as_float(rr[1])); } \
      resc=false; \
      if(__builtin_expect(__any(rm>(float)THRL),0)){ const float dl=__builtin_fmaxf(rm,0.f); mhat+=dl; \
        _Pragma("unroll") for(int r=0;r<16;++r){C0[r]-=dl;C1[r]-=dl;} \
        const float f=__builtin_amdgcn_exp2f(-dl); l_reg*=f; if(hi==0)wsf[r32]=f; resc=true; } } \
    SBAR(); \
    GAPB(o[0]=__builtin_amdgcn_mfma_f32_32x32x16_bf16(PAF(0),VFR(0),o[0],0,0,0), C0,0); \
    GAPB(o[1]=__builtin_amdgcn_mfma_f32_32x32x16_bf16(PAF(0),VFR(4),o[1],0,0,0), C0,4); \
    KRD(GL,0); GAPB(o[0]=__builtin_amdgcn_mfma_f32_32x32x16_bf16(PAF(1),VFR(1),o[0],0,0,0), C0,8); \
    KRD(GL,1); GAPB(o[1]=__builtin_amdgcn_mfma_f32_32x32x16_bf16(PAF(1),VFR(5),o[1],0,0,0), C0,12); \
    KRD(GL,2); GAPB(o[0]=__builtin_amdgcn_mfma_f32_32x32x16_bf16(PAF(2),VFR(2),o[0],0,0,0), C1,0); \
    KRD(GL,3); GAPB(o[1]=__builtin_amdgcn_mfma_f32_32x32x16_bf16(PAF(2),VFR(6),o[1],0,0,0), C1,4); \
    GAPB(o[0]=__builtin_amdgcn_mfma_f32_32x32x16_bf16(PAF(3),VFR(3),o[0],0,0,0), C1,8); \
    GAPB(o[1]=__builtin_amdgcn_mfma_f32_32x32x16_bf16(PAF(3),VFR(7),o[1],0,0,0), C1,12); \
    }while(0)
  #define ENDW(tt) do{ if((tt)+3<NT){WAIT_BAR(2);} else if((tt)+2<NT){WAIT_BAR(1);} else {WAIT_BAR(0);} }while(0)
  int t=1;
  for(;t+1<NT;t+=2){
    STEP(pB0,pB1,pA0,pA1,t,(t+3<NT),(t+1<NT),(t+1<NT));       ENDW(t);   RESC(); ROT();
    STEP(pA0,pA1,pB0,pB1,t+1,(t+4<NT),(t+2<NT),(t+2<NT));     ENDW(t+1); RESC(); ROT();
  }
  STEP(pB0,pB1,pA0,pA1,NT-1,false,false,false); RESC();
  { float sacc=pB0[0]+pB0[1]; _Pragma("unroll") for(int r=2;r<16;++r)sacc+=pB0[r]; _Pragma("unroll") for(int r=0;r<16;++r)sacc+=pB1[r]; l_reg+=sacc;
    pw0=(u32x4){PKW(pB0,0),PKW(pB0,2),PKW(pB0,4),PKW(pB0,6)};pw1=(u32x4){PKW(pB0,8),PKW(pB0,10),PKW(pB0,12),PKW(pB0,14)};pw2=(u32x4){PKW(pB1,0),PKW(pB1,2),PKW(pB1,4),PKW(pB1,6)};pw3=(u32x4){PKW(pB1,8),PKW(pB1,10),PKW(pB1,12),PKW(pB1,14)};
    SBAR(); pv(o,(int)(unsigned)(uintptr_t)vp0+sl_cur,PAF(0),PAF(1),PAF(2),PAF(3)); }
  #undef PKW
  #undef PAF
  #undef VFR
  #undef PIN
  #undef MX3
  #undef GAPA
  #undef GAPB
  #undef EX
  #undef VRD
  #undef KRD
  #undef STEP
  #undef ENDW
  {auto rr=__builtin_amdgcn_permlane32_swap(__float_as_uint(l_reg),__float_as_uint(l_reg),false,false);l_reg=__uint_as_float(rr[0])+__uint_as_float(rr[1]);}
  if(MODE==1 && hi==0) LSE[qrel]=0.6931471805599453f*(mhat+__log2f(l_reg));
  if(hi==0)wsf[32+r32]=l_reg;asm volatile("s_waitcnt lgkmcnt(0)":::"memory");
  float rli[16];
  #pragma unroll
  for(int r=0;r<16;++r)rli[r]=__builtin_amdgcn_rcpf(wsf[32+crow(r,hi)]);
  bf16*Ow=O+(long)(wid*QBLK)*opitch;
  { __hip_bfloat16*stg=(__hip_bfloat16*)(shm+LDS_OST)+wid*2048;
    #pragma unroll
    for(int r=0;r<16;++r){const int orow=crow(r,hi);
      #pragma unroll
      for(int d0=0;d0<2;++d0)stg[orow*64+d0*32+r32]=__float2bfloat16(o[d0][r]*rli[r]);}
    asm volatile("s_waitcnt lgkmcnt(0)":::"memory");
    #pragma unroll
    for(int i=0;i<4;++i){const int row=i*8+(lane>>3),ch=lane&7; const u32x4 v=*(const u32x4*)(stg+row*64+ch*8); ATTN_STORE16(Ow+(long)row*opitch+ch*8,v);} }
  asm volatile("s_waitcnt lgkmcnt(0)\n\ts_barrier":::"memory");
  #undef DMA_K
  #undef DMA_V
  #undef TM
  #undef CMASK
  #undef START
  #undef RESC
  #undef ROT
}
#undef SBAR
#undef WAIT_BAR
}

constexpr int NWAVES = 8;
constexpr int NB = 4, SEQ = 4096, T = NB * SEQ, D = 1024;
constexpr int EVEN_IN = 2816, EVEN_OUT = 512, ODD_IN = 3072, ODD_OUT = 1024, DFF = 2816, NEXP = 8, DFFE = 3584;
constexpr int MOE_ROWS = 2 * T + NEXP * 256;
constexpr float EPS = 1e-6f;
constexpr size_t MiB = 1u << 20;
constexpr size_t WS_CTL = 0, CTL_ZERO_BYTES = 2 * MiB;
constexpr size_t WS_ROPE = 2 * MiB;
constexpr size_t WS_MISC = 3 * MiB;
constexpr size_t WS_KMEAN = 4 * MiB;
constexpr size_t WS_WT = 8 * MiB;
constexpr size_t WT_EVEN_BYTES = 23 * MiB, WT_ODD_BYTES = 176 * MiB;
constexpr size_t WTE_IN = 0, WTE_OUT = 5 * MiB + MiB / 2, WTE_GU = 6 * MiB + MiB / 2, WTE_DN = 17 * MiB + MiB / 2;
constexpr size_t WTO_IN = 0, WTO_OUT = 6 * MiB, WTO_MGU = 8 * MiB, WTO_MD = 120 * MiB;
constexpr size_t WS_WT_EVEN0 = WS_WT, WS_WT_ODD0 = WS_WT + 2 * WT_EVEN_BYTES;
constexpr size_t WS_HN = WS_WT + 2 * WT_EVEN_BYTES + 2 * WT_ODD_BYTES;
constexpr size_t WS_P = WS_HN + 32 * MiB;
constexpr size_t WS_MIX = WS_P + 96 * MiB;
constexpr size_t WS_HID = WS_MIX + 32 * MiB;
constexpr size_t WS_END = WS_HID + 238 * MiB;
static_assert(WS_HN == 406 * MiB && WS_END == 804 * MiB, "ws map");
constexpr size_t P_UV = 0, P_QS = 16 * MiB, P_KS = 40 * MiB, P_VS = 64 * MiB, P_QM = 0, P_KM = 24 * MiB, P_VM = 48 * MiB;
constexpr size_t H_RAWP = 0, H_OG = 96 * MiB, H_LSE = 120 * MiB;
constexpr int CW_TMO = 0, CW_CODE = 1, CW_BAR = 4096;
constexpr int RING_OFF = 0, RING_BYTES = 131072, LDSCTL_OFF = RING_BYTES, MISC_OFF = LDSCTL_OFF + 320, LDS_BYTES = 147456;

#define GAS __attribute__((address_space(1)))
#define LAS __attribute__((address_space(3)))
typedef unsigned short bf16;
typedef unsigned v4u __attribute__((ext_vector_type(4)));
typedef unsigned v2u __attribute__((ext_vector_type(2)));
typedef float f32x4 __attribute__((ext_vector_type(4)));
typedef GAS unsigned gu32;
#define RLX_AGENT __ATOMIC_RELAXED, __HIP_MEMORY_SCOPE_AGENT
#define LDS_WAIT() asm volatile("s_waitcnt lgkmcnt(0)" ::: "memory")
#define VM_WAIT() asm volatile("s_waitcnt vmcnt(0)" ::: "memory")
__device__ __forceinline__ unsigned f2bf(float f) { unsigned u = __builtin_bit_cast(unsigned, f); return (u + 0x7fffu + ((u >> 16) & 1u)) >> 16; }
__device__ __forceinline__ unsigned pk2(float lo, float hi) { return f2bf(lo) | (f2bf(hi) << 16); }
__device__ __forceinline__ float bf2f(unsigned short b) { return __builtin_bit_cast(float, ((unsigned)b) << 16); }
__device__ __forceinline__ float bflo(unsigned w) { return __builtin_bit_cast(float, w << 16); }
__device__ __forceinline__ float bfhi(unsigned w) { return __builtin_bit_cast(float, w & 0xffff0000u); }

#define XB_TMO      128
#define XB_XCNT(j)  (256  + 64 * (j))
#define XB_XSUB(j)  (1280 + 64 * (j))
#define XB_XGEN(j)  (2304 + 64 * (j))
#define XB_TOP      3328
#define XB_TOPGEN   3392
#define XCD_BAR_WORDS 3456
#define XB_SPIN_CAP (1u << 22)
__device__ __forceinline__ unsigned xb_ld(unsigned* p)              { return __hip_atomic_load(p, __ATOMIC_RELAXED, __HIP_MEMORY_SCOPE_AGENT); }
__device__ __forceinline__ unsigned xb_add(unsigned* p, unsigned v) { return __hip_atomic_fetch_add(p, v, __ATOMIC_RELAXED, __HIP_MEMORY_SCOPE_AGENT); }
__device__ __forceinline__ unsigned xb_xcc_id() { return (unsigned)__builtin_amdgcn_s_getreg((3 << 11) | 20) & 0xFu; }
#define XB_SPIN(cond, bar) do { unsigned _sp = 0; while (cond) { __builtin_amdgcn_s_sleep(1); \
    if ((++_sp & 255u) == 0u) { if (xb_ld(&(bar)[XB_TMO])) break; if (_sp > XB_SPIN_CAP) { atomicAdd(&(bar)[XB_TMO], 1u); break; } } } } while (0)
struct XcdBarrier { unsigned* bar; unsigned x; volatile LAS unsigned* st; };
__device__ __forceinline__ XcdBarrier xcd_barrier_post(unsigned* bar, volatile LAS unsigned* st) {
    XcdBarrier b; b.bar = bar; b.x = xb_xcc_id(); b.st = st;
    if (threadIdx.x == 0) (void)xb_add(&bar[XB_XCNT(b.x)], 1u);
    return b;
}
__device__ __forceinline__ void xcd_barrier_complete(unsigned* bar, unsigned x, unsigned& nloc, unsigned& nx) {
    const unsigned G = gridDim.x * gridDim.y * gridDim.z;
    unsigned sum, cnt, mine, sp = 0u;
    for (;;) {
        sum = 0u; cnt = 0u; mine = 0u;
#pragma unroll
        for (unsigned j = 0; j < 16; ++j) { const unsigned c = xb_ld(&bar[XB_XCNT(j)]); sum += c; cnt += (c > 0u) ? 1u : 0u; mine = (j == x) ? c : mine; }
        if (sum == G) break;
        __builtin_amdgcn_s_sleep(1);
        if ((++sp & 255u) == 0u) { if (xb_ld(&bar[XB_TMO])) break; if (sp > XB_SPIN_CAP) { atomicAdd(&bar[XB_TMO], 1u); break; } }
    }
    nloc = mine > 0u ? mine : 1u; nx = cnt > 0u ? cnt : 1u;
}
__device__ __forceinline__ void xcd_barrier(const XcdBarrier& b) {
    asm volatile("s_waitcnt vmcnt(0)" ::: "memory");
    __syncthreads();
    if (threadIdx.x == 0) {
        unsigned* bar = b.bar;
        __builtin_amdgcn_s_waitcnt(0);
        unsigned nloc = b.st[0], nx = b.st[1];
        if (nloc == 0u) { xcd_barrier_complete(bar, b.x, nloc, nx); b.st[0] = nloc; b.st[1] = nx; }
        const unsigned old = xb_add(&bar[XB_XSUB(b.x)], 1u);
        const unsigned gen = old / nloc;
        if (old + 1u == (gen + 1u) * nloc) {
            __builtin_amdgcn_fence(__ATOMIC_RELEASE, "agent");
            asm volatile("s_waitcnt vmcnt(0)" ::: "memory");
            const unsigned og = xb_add(&bar[XB_TOP], 1u);
            const unsigned tg = og / nx;
            if (og + 1u == (tg + 1u) * nx) xb_add(&bar[XB_TOPGEN], 1u);
            else XB_SPIN(xb_ld(&bar[XB_TOPGEN]) == tg, bar);
            __builtin_amdgcn_fence(__ATOMIC_ACQUIRE, "agent");
            xb_add(&bar[XB_XGEN(b.x)], 1u);
            asm volatile("s_waitcnt vmcnt(0)" ::: "memory");
        } else {
            XB_SPIN(xb_ld(&bar[XB_XGEN(b.x)]) == gen, bar);
            __builtin_amdgcn_fence(__ATOMIC_ACQUIRE, "agent");
            asm volatile("s_waitcnt vmcnt(0)" ::: "memory");
        }
    }
    __syncthreads();
}

struct Args { const float* in[22]; float* out; unsigned char* ws; int ph_lo, ph_hi; };
struct Frame {
    LAS unsigned char* lds; volatile LAS unsigned* MISC; gu32* ctl;
    int tid, lane, wave, G, blk;
    unsigned char* ws; float* out;
};
struct Route { int e1, e2; float g1, g2; };

__device__ __forceinline__ float wave_sum(float v) {
#pragma unroll
    for (int o = 1; o < 64; o <<= 1) v += __shfl_xor(v, o);
    return v;
}
__device__ __forceinline__ float wave_max(float v) {
#pragma unroll
    for (int o = 1; o < 64; o <<= 1) v = fmaxf(v, __shfl_xor(v, o));
    return v;
}
__device__ __forceinline__ float gelu_tanh(float x) {
    const float y = 0.7978845608028654f * (x + 0.044715f * x * x * x);
    const float e = __expf(2.0f * y);
    const float th = 1.0f - 2.0f / (e + 1.0f);
    return 0.5f * x * (1.0f + th);
}

__device__ __forceinline__ int rowmap(int mode, int n) { return mode == 0 ? n : (256 * (n >> 7) + (n & 127) + (mode == 2 ? 128 : 0)); }
__device__ __forceinline__ void p0_transpose_item(const float* W, int K, int N, bf16* WT, int mode, LAS float* scr, int item, int lane) {
    const int nblk = N / 32, kb = item / nblk, nb = item % nblk, k0 = 64 * kb, n0 = 32 * nb;
#pragma unroll 8
    for (int i = 0; i < 32; ++i) { const int kk = 2 * i + (lane >> 5); scr[kk * 33 + (lane & 31)] = W[(size_t)(k0 + kk) * N + n0 + (lane & 31)]; }
    LDS_WAIT(); asm volatile("" ::: "memory");
    const int c = lane & 7;
#pragma unroll
    for (int j = 0; j < 4; ++j) { const int n = (lane >> 3) + 8 * j; const LAS float* s = scr + (8 * c) * 33 + n;
        v4u o; o.x = pk2(s[0 * 33], s[1 * 33]); o.y = pk2(s[2 * 33], s[3 * 33]); o.z = pk2(s[4 * 33], s[5 * 33]); o.w = pk2(s[6 * 33], s[7 * 33]);
        *(GAS v4u*)(WT + (size_t)rowmap(mode, n0 + n) * K + k0 + 8 * c) = o; }
    LDS_WAIT(); asm volatile("" ::: "memory");
}
struct WDesc { const float* src; bf16* dst; int K, N, nbatch, mode; size_t dst_bstride; };
__device__ __forceinline__ WDesc get_desc(const Args& a, int d) {
    const int layer = d / 10, k = d % 10; unsigned char* ws = a.ws;
    bf16* we = (bf16*)(ws + WS_WT_EVEN0 + (size_t)layer * WT_EVEN_BYTES); bf16* wo = (bf16*)(ws + WS_WT_ODD0 + (size_t)layer * WT_ODD_BYTES);
    WDesc w; w.nbatch = 1; w.mode = 0; w.dst_bstride = 0;
    switch (k) {
    case 0: w.src = a.in[3] + (size_t)layer * D * EVEN_IN; w.dst = we + WTE_IN / 2; w.K = D; w.N = EVEN_IN; break;
    case 1: w.src = a.in[9] + (size_t)layer * EVEN_OUT * D; w.dst = we + WTE_OUT / 2; w.K = EVEN_OUT; w.N = D; break;
    case 2: w.src = a.in[10] + (size_t)layer * D * DFF; w.dst = we + WTE_GU / 2; w.K = D; w.N = DFF; w.mode = 1; break;
    case 3: w.src = a.in[11] + (size_t)layer * D * DFF; w.dst = we + WTE_GU / 2; w.K = D; w.N = DFF; w.mode = 2; break;
    case 4: w.src = a.in[12] + (size_t)layer * DFF * D; w.dst = we + WTE_DN / 2; w.K = DFF; w.N = D; break;
    case 5: w.src = a.in[13] + (size_t)layer * D * ODD_IN; w.dst = wo + WTO_IN / 2; w.K = D; w.N = ODD_IN; break;
    case 6: w.src = a.in[17] + (size_t)layer * ODD_OUT * D; w.dst = wo + WTO_OUT / 2; w.K = ODD_OUT; w.N = D; break;
    case 7: w.src = a.in[19] + (size_t)layer * NEXP * D * DFFE; w.dst = wo + WTO_MGU / 2; w.K = D; w.N = DFFE; w.mode = 1; w.nbatch = NEXP; w.dst_bstride = (size_t)2 * DFFE * D; break;
    case 8: w.src = a.in[20] + (size_t)layer * NEXP * D * DFFE; w.dst = wo + WTO_MGU / 2; w.K = D; w.N = DFFE; w.mode = 2; w.nbatch = NEXP; w.dst_bstride = (size_t)2 * DFFE * D; break;
    default: w.src = a.in[21] + (size_t)layer * NEXP * DFFE * D; w.dst = wo + WTO_MD / 2; w.K = DFFE; w.N = D; w.nbatch = NEXP; w.dst_bstride = (size_t)DFFE * D; break;
    }
    return w;
}
__device__ __forceinline__ void p0_prologue(Frame& F, const Args& a) {
    LAS float* scr = (LAS float*)(F.lds + RING_OFF + F.wave * 16384);
    const int gw = F.blk * NWAVES + F.wave, NGW = F.G * NWAVES;
    for (int d = 0; d < 20; ++d) {
        const WDesc w = get_desc(a, d);
        const int per = (w.K / 64) * (w.N / 32), nitems = per * w.nbatch;
        for (int it = gw; it < nitems; it += NGW) { const int bt = it / per, r = it % per;
            p0_transpose_item(w.src + (size_t)bt * w.K * w.N, w.K, w.N, w.dst + (size_t)bt * w.dst_bstride, w.mode, scr, r, F.lane); }
    }
    float* cs = (float*)(a.ws + WS_ROPE); float* sn = cs + SEQ * 32;
    for (int i = F.blk * 512 + F.tid; i < SEQ * 32; i += F.G * 512) { const int pos = i >> 5, j = i & 31;
        const float inv = 1.0f / powf(10000.0f, (float)j * (1.0f / 32.0f)); const float ang = (float)pos * inv;
        cs[i] = cosf(ang); sn[i] = sinf(ang); }
}

__device__ __forceinline__ void norm_phase(Frame& F, const float* xsrc, float* xdst, const float* gain, bf16* hn, bool do_combine, bool do_router, bool write_hn, const float* router_w) {
    unsigned char* ws = F.ws;
    const Route* route = (const Route*)(ws + WS_MISC); const int* slots = (const int*)(ws + WS_MISC + 256 * 1024); int* ccnt = (int*)(ws + WS_MISC + 384 * 1024);
    const bf16* Y = (const bf16*)(ws + WS_P);
    LAS float* wr = (LAS float*)(F.lds + RING_OFF);
    LAS int* lcnt = (LAS int*)(F.lds + RING_OFF + 32768);
    if (do_router) { for (int i = F.tid; i < 8192; i += 512) { const int d = i >> 3, e = i & 7; wr[e * 1024 + d] = router_w[i]; } }
    const int lane = F.lane;
    f32x4 gv[4];
#pragma unroll
    for (int j = 0; j < 4; ++j) gv[j] = *((const f32x4*)gain + lane + 64 * j);
    for (int c = F.blk; c < T / 64; c += F.G) {
        if (do_router) { if (F.tid < 8) lcnt[F.tid] = 0; }
        __syncthreads();
        for (int k = 0; k < 8; ++k) {
            const int row = c * 64 + F.wave * 8 + k;
            const f32x4* xr = (const f32x4*)(xsrc + (size_t)row * D) + lane;
            f32x4 v[4];
#pragma unroll
            for (int j = 0; j < 4; ++j) v[j] = xr[64 * j];
            if (do_combine) {
                const Route r = route[row]; const int s1 = slots[2 * row], s2 = slots[2 * row + 1];
                const v2u* y1 = (const v2u*)(Y + (size_t)s1 * D) + lane; const v2u* y2 = (const v2u*)(Y + (size_t)s2 * D) + lane;
#pragma unroll
                for (int j = 0; j < 4; ++j) { const v2u a = y1[64 * j], b = y2[64 * j];
                    v[j].x += r.g1 * bflo(a.x) + r.g2 * bflo(b.x); v[j].y += r.g1 * bfhi(a.x) + r.g2 * bfhi(b.x);
                    v[j].z += r.g1 * bflo(a.y) + r.g2 * bflo(b.y); v[j].w += r.g1 * bfhi(a.y) + r.g2 * bfhi(b.y); }
                f32x4* xo = (f32x4*)(xdst + (size_t)row * D) + lane;
#pragma unroll
                for (int j = 0; j < 4; ++j) xo[64 * j] = v[j];
            }
            if (write_hn) {
                float ss = 0.f;
#pragma unroll
                for (int j = 0; j < 4; ++j) ss += (v[j].x * v[j].x + v[j].y * v[j].y) + (v[j].z * v[j].z + v[j].w * v[j].w);
                ss = wave_sum(ss);
                const float rstd = 1.0f / sqrtf(ss * (1.0f / D) + EPS);
#pragma unroll
                for (int j = 0; j < 4; ++j) v[j] = v[j] * rstd * gv[j];
                v2u* o8 = (v2u*)(hn + (size_t)row * D) + lane;
#pragma unroll
                for (int j = 0; j < 4; ++j) { v2u o; o.x = pk2(v[j].x, v[j].y); o.y = pk2(v[j].z, v[j].w); o8[64 * j] = o; }
                if (do_router) {
                    float lg[8];
#pragma unroll
                    for (int e = 0; e < 8; ++e) { float s = 0.f;
#pragma unroll
                        for (int j = 0; j < 4; ++j) { const f32x4 w = *((const LAS f32x4*)(wr + e * 1024) + lane + 64 * j); s += (v[j].x * w.x + v[j].y * w.y) + (v[j].z * w.z + v[j].w * w.w); }
                        lg[e] = wave_sum(s); }
                    int e1 = 0; float v1 = lg[0];
#pragma unroll
                    for (int e = 1; e < 8; ++e) if (lg[e] > v1) { v1 = lg[e]; e1 = e; }
                    int e2 = -1; float v2 = -INFINITY;
#pragma unroll
                    for (int e = 0; e < 8; ++e) if (e != e1 && lg[e] > v2) { v2 = lg[e]; e2 = e; }
                    const float g2 = 1.0f / (1.0f + __expf(v1 - v2)), g1 = 1.0f - g2;
                    if (lane == 0) { Route r; r.e1 = e1; r.e2 = e2; r.g1 = g1; r.g2 = g2; ((Route*)route)[row] = r; __hip_atomic_fetch_add(&lcnt[e1], 1, __ATOMIC_RELAXED, __HIP_MEMORY_SCOPE_WORKGROUP); __hip_atomic_fetch_add(&lcnt[e2], 1, __ATOMIC_RELAXED, __HIP_MEMORY_SCOPE_WORKGROUP); }
                }
            }
        }
        __syncthreads();
        if (do_router) { if (F.tid < 8) ccnt[c * 8 + F.tid] = lcnt[F.tid]; }
        __syncthreads();
    }
}

__device__ __forceinline__ void route_phase(Frame& F, const bf16* hn, bf16* hsort) {
    unsigned char* ws = F.ws;
    const Route* route = (const Route*)(ws + WS_MISC); int* slots = (int*)(ws + WS_MISC + 256 * 1024); const int* ccnt = (const int*)(ws + WS_MISC + 384 * 1024); int* tile_base = (int*)(ws + WS_MISC + 512 * 1024);
    LAS int* tot = (LAS int*)(F.lds + RING_OFF); LAS int* bef = tot + 8; LAS int* base = tot + 16; LAS int* sl = tot + 32;
    for (int c = F.blk; c < T / 64; c += F.G) {
        { const int e = F.wave; int t = 0, b = 0;
#pragma unroll
            for (int q = 0; q < 4; ++q) { const int ch = F.lane * 4 + q; const int v = ccnt[ch * 8 + e]; t += v; b += (ch < c) ? v : 0; }
#pragma unroll
            for (int o = 1; o < 64; o <<= 1) { t += __shfl_xor(t, o); b += __shfl_xor(b, o); }
            if (F.lane == 0) { tot[e] = t; bef[e] = b; } }
        __syncthreads();
        if (F.tid == 0) { int acc = 0;
            for (int e = 0; e < 8; ++e) { base[e] = acc; if (c == 0) tile_base[e] = acc >> 8; acc += (tot[e] + 255) & ~255; }
            if (c == 0) tile_base[8] = acc >> 8; }
        __syncthreads();
        if (F.wave == 0) {
            const int row = c * 64 + F.lane; const Route r = route[row];
            int run[8];
#pragma unroll
            for (int e = 0; e < 8; ++e) run[e] = base[e] + bef[e];
#pragma unroll
            for (int k = 0; k < 2; ++k) { const int me = k ? r.e2 : r.e1; int myslot = 0;
#pragma unroll
                for (int e = 0; e < 8; ++e) { const unsigned long long m = __ballot(me == e); const int rank = __popcll(m & ((1ull << F.lane) - 1ull));
                    if (me == e) myslot = run[e] + rank; run[e] += __popcll(m); }
                slots[2 * row + k] = myslot; sl[2 * F.lane + k] = myslot; }
        }
        __syncthreads();
        for (int p = F.wave; p < 128; p += NWAVES) { const int row = c * 64 + (p >> 1); const int s = sl[p];
            const v4u* src = (const v4u*)(hn + (size_t)row * D); v4u* dst = (v4u*)(hsort + (size_t)s * D);
            dst[F.lane] = src[F.lane]; dst[F.lane + 64] = src[F.lane + 64]; }
        __syncthreads();
    }
}

__device__ __forceinline__ int srow(int s, int g) { return g == 0 ? s : (g == 1 ? ((s & 3) * 1024 + (s >> 2)) : ((s & 15) * 256 + (s >> 4))); }
__device__ __forceinline__ float rope_apply(float n, int lane, const float* cs, const float* sn, int s) {
    const float partner = __shfl_xor(n, 32); const int j = lane & 31; const float c = cs[s * 32 + j], si = sn[s * 32 + j];
    return lane < 32 ? n * c - partner * si : n * c + partner * si;
}
__device__ __forceinline__ void post_even(Frame& F, const bf16* rawp, const float* vgain, const float* qgain, const float* kgain) {
    unsigned char* ws = F.ws; bf16* UV = (bf16*)(ws + WS_P + P_UV); bf16* Qs = (bf16*)(ws + WS_P + P_QS); bf16* Ks = (bf16*)(ws + WS_P + P_KS); bf16* Vs = (bf16*)(ws + WS_P + P_VS);
    const float* cs = (const float*)(ws + WS_ROPE); const float* sn = cs + SEQ * 32;
    const int lane = F.lane; const float qg = qgain[lane], kg = kgain[lane];
    const long nitems = (long)T * 44;
    for (long it = (long)F.blk * NWAVES + F.wave; it < nitems; it += (long)F.G * NWAVES) {
        const int row = (int)(it / 44), u = (int)(it % 44), b = row >> 12, s = row & 4095;
        const float v = bf2f(rawp[(size_t)row * EVEN_IN + 64 * u + lane]);
        if (u < 4) { UV[(size_t)row * 512 + 64 * u + lane] = (bf16)f2bf(gelu_tanh(v)); }
        else if (u < 8) { const float z = gelu_tanh(v); const float ss = wave_sum(z * z); const float o = z * (1.0f / sqrtf(ss * (1.0f / 64) + EPS)) * vgain[(u - 4) * 64 + lane];
            UV[(size_t)row * 512 + 64 * u + lane] = (bf16)f2bf(o); }
        else if (u < 32) { const bool isq = u < 20; const int h = isq ? u - 8 : u - 20; const float ss = wave_sum(v * v);
            const float n = v * (1.0f / sqrtf(ss * (1.0f / 64) + EPS)) * (isq ? qg : kg); const float o = rope_apply(n, lane, cs, sn, s);
            (isq ? Qs : Ks)[((size_t)(b * 12 + h) * SEQ + srow(s, h >> 2)) * 64 + lane] = (bf16)f2bf(isq ? o * att::C2 : o); }
        else { const int h = u - 32; Vs[((size_t)(b * 12 + h) * SEQ + srow(s, h >> 2)) * 64 + lane] = (bf16)f2bf(v); }
    }
}
__device__ __forceinline__ void post_odd(Frame& F, const bf16* rawp, const float* qgain, const float* kgain) {
    unsigned char* ws = F.ws; bf16* Qm = (bf16*)(ws + WS_P + P_QM); bf16* Km = (bf16*)(ws + WS_P + P_KM); bf16* Vm = (bf16*)(ws + WS_P + P_VM);
    const float* cs = (const float*)(ws + WS_ROPE); const float* sn = cs + SEQ * 32;
    const int lane = F.lane; const float qg = qgain[lane], kg = kgain[lane];
    const long nitems = (long)T * 36;
    for (long it = (long)F.blk * NWAVES + F.wave; it < nitems; it += (long)F.G * NWAVES) {
        const int row = (int)(it / 36), u = (int)(it % 36), b = row >> 12, s = row & 4095;
        const float v = bf2f(rawp[(size_t)row * ODD_IN + 64 * u + lane]);
        if (u < 24) { const bool isq = u < 12; const int h = isq ? u : u - 12; const float ss = wave_sum(v * v);
            const float n = v * (1.0f / sqrtf(ss * (1.0f / 64) + EPS)) * (isq ? qg : kg); const float o = rope_apply(n, lane, cs, sn, s);
            (isq ? Qm : Km)[((size_t)(b * 12 + h) * SEQ + s) * 64 + lane] = (bf16)f2bf(isq ? o * att::C2 : o); }
        else { const int h = u - 24; Vm[((size_t)(b * 12 + h) * SEQ + s) * 64 + lane] = (bf16)f2bf(v); }
    }
}
__device__ __forceinline__ void kmean_phase(Frame& F) {
    const bf16* Km = (const bf16*)(F.ws + WS_P + P_KM); float* km = (float*)(F.ws + WS_KMEAN);
    for (int it = F.blk * NWAVES + F.wave; it < 48 * 16; it += F.G * NWAVES) {
        const bf16* k = Km + (size_t)it * 256 * 64 + F.lane; float s = 0.f;
        for (int r = 0; r < 256; ++r) s += bf2f(k[r * 64]);
        km[it * 64 + F.lane] = s * (1.0f / 256.0f);
    }
}

__device__ __forceinline__ void load_row64(const bf16* p, float (&q)[64]) {
    const v4u* p4 = (const v4u*)p;
#pragma unroll
    for (int i = 0; i < 8; ++i) { const v4u w = p4[i]; q[8 * i + 0] = bflo(w.x); q[8 * i + 1] = bfhi(w.x); q[8 * i + 2] = bflo(w.y); q[8 * i + 3] = bfhi(w.y); q[8 * i + 4] = bflo(w.z); q[8 * i + 5] = bfhi(w.z); q[8 * i + 6] = bflo(w.w); q[8 * i + 7] = bfhi(w.w); }
}
__device__ __forceinline__ float dot_row64(const bf16* p, const float (&q)[64]) {
    const v4u* p4 = (const v4u*)p; float s = 0.f;
#pragma unroll
    for (int i = 0; i < 8; ++i) { const v4u w = p4[i]; s += q[8 * i + 0] * bflo(w.x) + q[8 * i + 1] * bfhi(w.x) + q[8 * i + 2] * bflo(w.y) + q[8 * i + 3] * bfhi(w.y) + q[8 * i + 4] * bflo(w.z) + q[8 * i + 5] * bfhi(w.z) + q[8 * i + 6] * bflo(w.w) + q[8 * i + 7] * bfhi(w.w); }
    return s;
}
__device__ __forceinline__ void banded_naive(Frame& F) {
    unsigned char* ws = F.ws; const bf16* Qs = (const bf16*)(ws + WS_P + P_QS); const bf16* Ks = (const bf16*)(ws + WS_P + P_KS); const bf16* Vs = (const bf16*)(ws + WS_P + P_VS);
    bf16* OG = (bf16*)(ws + WS_HID + H_OG); float* LSE = (float*)(ws + WS_HID + H_LSE);
    LAS float* pl = (LAS float*)(F.lds + RING_OFF) + F.wave * 256;
    const int lane = F.lane;
    for (int it = F.blk * NWAVES + F.wave; it < 48 * SEQ; it += F.G * NWAVES) {
        const int bh = it >> 12, rp = it & 4095, b = bh / 12, h = bh % 12, g = h >> 2, dil = g == 0 ? 1 : (g == 1 ? 4 : 16), L = SEQ / dil;
        const int i = rp % L, r = rp / L, s = i * dil + r, nk = (i < 128 ? i : 128) + 1, first = rp - (nk - 1);
        float q[64]; load_row64(Qs + ((size_t)bh * SEQ + rp) * 64, q);
        float sc[3]; float m = -INFINITY;
#pragma unroll
        for (int kk = 0; kk < 3; ++kk) { const int j = lane + 64 * kk; sc[kk] = -INFINITY; if (j < nk) { sc[kk] = 0.6931471805599453f * dot_row64(Ks + ((size_t)bh * SEQ + first + j) * 64, q); } m = fmaxf(m, sc[kk]); }
        m = wave_max(m); float l = 0.f;
#pragma unroll
        for (int kk = 0; kk < 3; ++kk) { const float p = (lane + 64 * kk < nk) ? __expf(sc[kk] - m) : 0.f; pl[lane + 64 * kk] = p; l += p; }
        l = wave_sum(l); LDS_WAIT();
        float acc = 0.f; const bf16* vb = Vs + ((size_t)bh * SEQ + first) * 64 + lane;
        for (int j = 0; j < nk; ++j) acc += pl[j] * bf2f(vb[(size_t)j * 64]);
        const size_t orow = ((size_t)g * T + (size_t)b * SEQ + s) * 4 + (h & 3);
        OG[orow * 64 + lane] = (bf16)f2bf(acc / l);
        if (lane == 0) LSE[orow] = m + __logf(l);
        LDS_WAIT();
    }
}
__device__ __forceinline__ void merge_even(Frame& F, bf16* mix) {
    const bf16* OG = (const bf16*)(F.ws + WS_HID + H_OG); const float* LSE = (const float*)(F.ws + WS_HID + H_LSE);
    for (int it = F.blk * NWAVES + F.wave; it < T * 4; it += F.G * NWAVES) {
        const int row = it >> 2, hg = it & 3, b = row >> 12, s = row & 4095;
        size_t i0, i1, i2;
#if NAIVE_BANDED
        i0 = it; i1 = (size_t)T * 4 + it; i2 = (size_t)2 * T * 4 + it;
#else
        i0 = ((size_t)0 * 16 + b * 4 + hg) * SEQ + srow(s, 0); i1 = ((size_t)1 * 16 + b * 4 + hg) * SEQ + srow(s, 1); i2 = ((size_t)2 * 16 + b * 4 + hg) * SEQ + srow(s, 2);
#endif
        const float l0 = LSE[i0], l1 = LSE[i1], l2 = LSE[i2]; const float m = fmaxf(l0, fmaxf(l1, l2));
        const float w0 = __expf(l0 - m), w1 = __expf(l1 - m), w2 = __expf(l2 - m), inv = 1.0f / (w0 + w1 + w2);
        const float o = (w0 * bf2f(OG[i0 * 64 + F.lane]) + w1 * bf2f(OG[i1 * 64 + F.lane]) + w2 * bf2f(OG[i2 * 64 + F.lane])) * inv;
        mix[(size_t)row * EVEN_OUT + 256 + hg * 64 + F.lane] = (bf16)f2bf(o);
    }
}
__device__ __forceinline__ void gmlp_phase(Frame& F, const float* wsp, const float* bsp, bf16* mix) {
    const bf16* UV = (const bf16*)(F.ws + WS_P + P_UV);
    LAS float* WT = (LAS float*)(F.lds + RING_OFF);
    LAS float* VL = WT + 128 * 128;
    const int tid = F.tid;
    for (int unit = F.blk; unit < (T / 128) * 4; unit += F.G) {
        const int c = unit >> 2, g = unit & 3, row0 = c * 128;
        __syncthreads();
        { const int i = tid & 127; const float* wrow = wsp + ((size_t)g * 128 + i) * 128;
          for (int jq = tid >> 7; jq < 32; jq += 4) { const f32x4 w = *(const f32x4*)(wrow + 4 * jq);
              WT[(4 * jq + 0) * 128 + i] = (4 * jq + 0 <= i) ? w.x : 0.f; WT[(4 * jq + 1) * 128 + i] = (4 * jq + 1 <= i) ? w.y : 0.f;
              WT[(4 * jq + 2) * 128 + i] = (4 * jq + 2 <= i) ? w.z : 0.f; WT[(4 * jq + 3) * 128 + i] = (4 * jq + 3 <= i) ? w.w : 0.f; } }
        for (int e = tid; e < 128 * 64; e += 512) { const int j = e >> 6, d = e & 63; VL[e] = bf2f(UV[(size_t)(row0 + j) * 512 + 256 + g * 64 + d]); }
        __syncthreads();
        const int i0 = 4 * (tid >> 4), d0 = 4 * (tid & 15);
        f32x4 acc[4];
#pragma unroll
        for (int a = 0; a < 4; ++a) acc[a] = (f32x4){0.f, 0.f, 0.f, 0.f};
        const int jmax = i0 + 3;
        for (int j = 0; j <= jmax; ++j) { const f32x4 w = *(const LAS f32x4*)(WT + j * 128 + i0); const f32x4 v = *(const LAS f32x4*)(VL + j * 64 + d0);
            acc[0] += w.x * v; acc[1] += w.y * v; acc[2] += w.z * v; acc[3] += w.w * v; }
#pragma unroll
        for (int a = 0; a < 4; ++a) { const int i = i0 + a; const float bb = bsp[g * 128 + i]; const size_t row = row0 + i;
            const v2u uu = *(const v2u*)(UV + row * 512 + g * 64 + d0);
            v2u o; o.x = pk2(bflo(uu.x) * (acc[a].x + bb), bfhi(uu.x) * (acc[a].y + bb)); o.y = pk2(bflo(uu.y) * (acc[a].z + bb), bfhi(uu.y) * (acc[a].w + bb));
            *(v2u*)(mix + row * EVEN_OUT + g * 64 + d0) = o; }
    }
    __syncthreads();
}
__device__ __forceinline__ void moba_naive(Frame& F, bf16* mix) {
    unsigned char* ws = F.ws; const bf16* Qm = (const bf16*)(ws + WS_P + P_QM); const bf16* Km = (const bf16*)(ws + WS_P + P_KM); const bf16* Vm = (const bf16*)(ws + WS_P + P_VM);
    const float* km = (const float*)(ws + WS_KMEAN);
    LAS float* sc = (LAS float*)(F.lds + RING_OFF) + F.wave * 1024;
    const int lane = F.lane;
    for (int it = F.blk * NWAVES + F.wave; it < 48 * SEQ; it += F.G * NWAVES) {
        const int bh = it >> 12, s = it & 4095, b = bh / 12, h = bh % 12, qb = s >> 8;
        float q[64]; load_row64(Qm + ((size_t)bh * SEQ + s) * 64, q);
        float gate = -INFINITY;
        if (lane < qb) { const f32x4* kp = (const f32x4*)(km + ((size_t)bh * 16 + lane) * 64); float a = 0.f;
#pragma unroll
            for (int i = 0; i < 16; ++i) { const f32x4 w = kp[i]; a += q[4 * i] * w.x + q[4 * i + 1] * w.y + q[4 * i + 2] * w.z + q[4 * i + 3] * w.w; }
            gate = a; }
        unsigned sel = 1u << qb;
        for (int r = 0; r < 3; ++r) { float v = gate; int idx = lane;
#pragma unroll
            for (int o = 1; o < 64; o <<= 1) { const float ov = __shfl_xor(v, o); const int oi = __shfl_xor(idx, o); if (ov > v || (ov == v && oi < idx)) { v = ov; idx = oi; } }
            if (v > -INFINITY) { sel |= 1u << idx; if (lane == idx) gate = -INFINITY; } }
        int cnt = 0; float m = -INFINITY;
        for (int n = 0; n <= qb; ++n) { if (!((sel >> n) & 1u)) continue;
#pragma unroll
            for (int kk = 0; kk < 4; ++kk) { const int key = n * 256 + kk * 64 + lane; float x = -INFINITY;
                if (key <= s) x = 0.6931471805599453f * dot_row64(Km + ((size_t)bh * SEQ + key) * 64, q);
                sc[cnt * 256 + kk * 64 + lane] = x; m = fmaxf(m, x); }
            ++cnt; }
        m = wave_max(m); float l = 0.f; LDS_WAIT();
        for (int i = lane; i < cnt * 256; i += 64) { const float p = __expf(sc[i] - m); sc[i] = p; l += p; }
        l = wave_sum(l); LDS_WAIT();
        float acc = 0.f; int c2 = 0;
        for (int n = 0; n <= qb; ++n) { if (!((sel >> n) & 1u)) continue;
            const bf16* vb = Vm + ((size_t)bh * SEQ + n * 256) * 64 + lane; const int kend = (n == qb) ? (s & 255) + 1 : 256;
            for (int kk = 0; kk < kend; ++kk) acc += sc[c2 * 256 + kk] * bf2f(vb[(size_t)kk * 64]);
            ++c2; }
        mix[((size_t)b * SEQ + s) * ODD_OUT + h * 64 + lane] = (bf16)f2bf(acc / l);
        LDS_WAIT();
    }
}
__device__ __forceinline__ void conv_phase(Frame& F, const bf16* rawp, const float* cw, bf16* mix) {
    for (int it = F.blk * 512 + F.tid; it < T * 256; it += F.G * 512) {
        const int row = it >> 8, c = it & 255, s = row & 4095;
        const bf16* p = rawp + (size_t)row * ODD_IN;
        const float z0 = bf2f(p[2560 + c]) * bf2f(p[2816 + c]);
        const float z1 = s >= 1 ? bf2f(p[2560 + c - ODD_IN]) * bf2f(p[2816 + c - ODD_IN]) : 0.f;
        const float z2 = s >= 2 ? bf2f(p[2560 + c - 2 * ODD_IN]) * bf2f(p[2816 + c - 2 * ODD_IN]) : 0.f;
        const float y = cw[c] * z2 + cw[256 + c] * z1 + cw[512 + c] * z0;
        mix[(size_t)row * ODD_OUT + 768 + c] = (bf16)f2bf(bf2f(p[2304 + c]) * y);
    }
}


constexpr int CW_QMOBA = 8192;
__device__ __forceinline__ void moba_phase(Frame& F, int lp, bf16* mix) {
    unsigned char* ws = F.ws; const bf16* Qm = (const bf16*)(ws + WS_P + P_QM); const bf16* Km = (const bf16*)(ws + WS_P + P_KM); const bf16* Vm = (const bf16*)(ws + WS_P + P_VM);
    const float* km = (const float*)(ws + WS_KMEAN);
    char* shm = (char*)F.lds + RING_OFF; LAS unsigned char* l3 = F.lds + RING_OFF;
    LAS float* kml = (LAS float*)(l3 + att::LDS_KM); volatile LAS int* tkw = (volatile LAS int*)(l3 + att::LDS_TK);
    unsigned* head = (unsigned*)(F.ctl + CW_QMOBA + 64 * lp);
    const int tid = F.tid, wid = F.wave;
    for (;;) {
        if (tid == 0) tkw[0] = (int)__hip_atomic_fetch_add(head, 1u, __ATOMIC_RELAXED, __HIP_MEMORY_SCOPE_AGENT);
        __syncthreads();
        const int tk = __builtin_amdgcn_readfirstlane(tkw[0]);
        if (tk >= 48 * 16) break;
        const int qb = 15 - tk / 48, bh = tk % 48, b = bh / 12, h = bh % 12;
        int lane_ = F.lane; asm volatile("" : "+v"(lane_)); const int r32 = lane_ & 31, hi = lane_ >> 5;
        ((LAS v2u*)kml)[tid] = ((const v2u*)(km + (size_t)bh * 1024))[tid];
        __syncthreads();
        unsigned sel = 0u;
        { const bf16* qrow = Qm + ((size_t)bh * SEQ + qb * 256 + wid * 32 + r32) * 64 + hi * 8;
          float qf[32];
#pragma unroll
          for (int d0 = 0; d0 < 4; ++d0) { const v4u w = *(const v4u*)(qrow + d0 * 16);
              qf[8 * d0 + 0] = bflo(w.x); qf[8 * d0 + 1] = bfhi(w.x); qf[8 * d0 + 2] = bflo(w.y); qf[8 * d0 + 3] = bfhi(w.y); qf[8 * d0 + 4] = bflo(w.z); qf[8 * d0 + 5] = bfhi(w.z); qf[8 * d0 + 6] = bflo(w.w); qf[8 * d0 + 7] = bfhi(w.w); }
          float v1 = -INFINITY, v2 = -INFINITY, v3 = -INFINITY; int i1 = 0, i2 = 0, i3 = 0;
          for (int n = 0; n < qb; ++n) { float a = 0.f;
#pragma unroll
              for (int d0 = 0; d0 < 4; ++d0) { const f32x4 k0 = *(const LAS f32x4*)(kml + n * 64 + d0 * 16 + hi * 8), k1 = *(const LAS f32x4*)(kml + n * 64 + d0 * 16 + hi * 8 + 4);
                  a += qf[8 * d0 + 0] * k0.x + qf[8 * d0 + 1] * k0.y + qf[8 * d0 + 2] * k0.z + qf[8 * d0 + 3] * k0.w + qf[8 * d0 + 4] * k1.x + qf[8 * d0 + 5] * k1.y + qf[8 * d0 + 6] * k1.z + qf[8 * d0 + 7] * k1.w; }
              a += __shfl_xor(a, 32);
              if (a > v1) { v3 = v2; i3 = i2; v2 = v1; i2 = i1; v1 = a; i1 = n; } else if (a > v2) { v3 = v2; i3 = i2; v2 = a; i2 = n; } else if (a > v3) { v3 = a; i3 = n; } }
          if (v1 > -INFINITY) sel |= 1u << i1; if (v2 > -INFINITY) sel |= 1u << i2; if (v3 > -INFINITY) sel |= 1u << i3; }
        const size_t sb = (size_t)bh * SEQ * 64;
        att::attn_unit<0, 8, ODD_OUT>(Qm + sb, qb * 256, 0, 4 * (qb + 1), sel, mix + ((size_t)b * SEQ + qb * 256) * ODD_OUT + h * 64, nullptr, shm);
    }
    __syncthreads();
}
__device__ __forceinline__ void banded_phase(Frame& F) {
    unsigned char* ws = F.ws; const bf16* Qs = (const bf16*)(ws + WS_P + P_QS); const bf16* Ks = (const bf16*)(ws + WS_P + P_KS); const bf16* Vs = (const bf16*)(ws + WS_P + P_VS);
    bf16* OG = (bf16*)(ws + WS_HID + H_OG); float* LSE = (float*)(ws + WS_HID + H_LSE);
    char* shm = (char*)F.lds + RING_OFF;
    for (int u = F.blk; u < 768; u += F.G) {
        const int g = u >> 8, rem = u & 255, b = rem >> 6, hg = (rem >> 4) & 3, u16 = rem & 15, h = g * 4 + hg, bh = b * 12 + h;
        const int dil = g == 0 ? 1 : (g == 1 ? 4 : 16), L = SEQ / dil, row0 = 256 * u16, r = row0 / L, q0s = row0 % L;
        const int tile0 = (q0s >> 6) >= 2 ? (q0s >> 6) - 2 : 0, NT = (q0s >> 6) + 4 - tile0;
        const size_t sb = ((size_t)bh * SEQ + (size_t)r * L) * 64;
        const size_t orow = ((size_t)g * 16 + b * 4 + hg) * SEQ + row0;
        att::attn_unit<1, 8, 64>(Qs + sb, q0s, tile0, NT, 0u, OG + orow * 64, LSE + orow, shm);
    }
    __syncthreads();
}

constexpr int PH_PER_PAIR = 19, NPH = 1 + 2 * PH_PER_PAIR + 1;
__global__ void __launch_bounds__(NWAVES * 64, 2) fwd(Args args) {
    extern __shared__ __attribute__((aligned(16))) unsigned char lds[];
#define MKFRAME() Frame F; { int t_ = threadIdx.x; asm volatile("" : "+v"(t_)); int b_ = blockIdx.x; asm volatile("" : "+s"(b_)); \
    F.lds = (LAS unsigned char*)lds; F.MISC = (volatile LAS unsigned*)(F.lds + MISC_OFF); F.tid = t_; F.lane = t_ & 63; F.wave = __builtin_amdgcn_readfirstlane(t_ >> 6); \
    F.G = gridDim.x; F.blk = b_; F.ws = args.ws; F.out = args.out; F.ctl = (gu32*)(args.ws + WS_CTL); }
    for (int u = threadIdx.x; u < (LDS_BYTES - LDSCTL_OFF) / 4; u += NWAVES * 64) ((LAS unsigned*)((LAS unsigned char*)lds + LDSCTL_OFF))[u] = 0u;
    __syncthreads();
    const int lo = args.ph_lo, hi = args.ph_hi;
    XcdBarrier bar; bar.bar = (unsigned*)(args.ws + WS_CTL) + CW_BAR; bar.x = 0; bar.st = nullptr;
    if (hi - lo > 1) bar = xcd_barrier_post((unsigned*)(args.ws + WS_CTL) + CW_BAR, (volatile LAS unsigned*)((LAS unsigned char*)lds + MISC_OFF) + 8);
#ifndef PHMASK
#define PHMASK 0xFFFFFF
#endif
#define PHEN(k) (((PHMASK) >> (k)) & 1)
#define IN(k) (lo <= (k) && (k) < hi)
#define SEAM(k) do { if (IN(k) && IN((k) + 1)) xcd_barrier(bar); } while (0)
#define HN ((bf16*)(args.ws + WS_HN))
#define MIX ((bf16*)(args.ws + WS_MIX))
#define HID ((bf16*)(args.ws + WS_HID))
#define RAWP ((bf16*)(args.ws + WS_HID + H_RAWP))
#define HSORT ((bf16*)(args.ws + WS_P))
#define YB ((bf16*)(args.ws + WS_P))
#define x_in (args.in[0])

    if (PHEN(19) && IN(0)) { MKFRAME(); p0_prologue(F, args); SEAM(0); }

    for (int lp = 0; lp < 2; ++lp) {
        const int pb = 1 + lp * PH_PER_PAIR;
        const int le = 2 * lp, lo_ = 2 * lp + 1;
#define we ((const pg8::bf16_t*)(args.ws + WS_WT_EVEN0 + (size_t)lp * WT_EVEN_BYTES))
#define wo ((const pg8::bf16_t*)(args.ws + WS_WT_ODD0 + (size_t)lp * WT_ODD_BYTES))
        if (PHEN(0) && IN(pb + 0)) { MKFRAME();
            norm_phase(F, lp == 0 ? x_in : F.out, F.out, args.in[1] + (size_t)le * D, HN, lp != 0, false, true, nullptr);
            SEAM(pb + 0); }
        if (PHEN(1) && IN(pb + 1)) { MKFRAME();
            pg8::Gemm g{HN, we + WTE_IN / 2, T, EVEN_IN, D}; pg8::StaticOrder S; S.init(T, EVEN_IN, F.G, F.blk);
            pg8::EpiBf16Plain E{RAWP, EVEN_IN};
            pg8::gemm_phase<pg8::EpiBf16Plain, pg8::StaticOrder>(F.lds + RING_OFF, g, S, E);
            SEAM(pb + 1); }
        if (PHEN(2) && IN(pb + 2)) { MKFRAME(); post_even(F, RAWP, args.in[4] + (size_t)lp * 256, args.in[7] + (size_t)lp * 64, args.in[8] + (size_t)lp * 64); SEAM(pb + 2); }
        if (PHEN(3) && IN(pb + 3)) { MKFRAME();
#if NAIVE_BANDED
            banded_naive(F);
#else
            banded_phase(F);
#endif
            gmlp_phase(F, args.in[5] + (size_t)lp * 4 * 128 * 128, args.in[6] + (size_t)lp * 4 * 128, MIX); SEAM(pb + 3); }
        if (PHEN(4) && IN(pb + 4)) { MKFRAME(); merge_even(F, MIX); SEAM(pb + 4); }
        if (PHEN(5) && IN(pb + 5)) { MKFRAME();
            pg8::Gemm g{MIX, we + WTE_OUT / 2, T, D, EVEN_OUT}; pg8::StaticOrder S; S.init(T, D, F.G, F.blk);
            pg8::EpiF32Res E{lp == 0 ? x_in : F.out, F.out, D};
            pg8::gemm_phase<pg8::EpiF32Res, pg8::StaticOrder>(F.lds + RING_OFF, g, S, E);
            SEAM(pb + 5); }
        if (PHEN(6) && IN(pb + 6)) { MKFRAME(); norm_phase(F, F.out, F.out, args.in[2] + (size_t)le * D, HN, false, false, true, nullptr); SEAM(pb + 6); }
        if (PHEN(7) && IN(pb + 7)) { MKFRAME();
            pg8::Gemm g{HN, we + WTE_GU / 2, T, 2 * DFF, D}; pg8::StaticOrder S; S.init(T, 2 * DFF, F.G, F.blk);
            pg8::EpiSwiGLU E{HID, DFF};
            pg8::gemm_phase<pg8::EpiSwiGLU, pg8::StaticOrder>(F.lds + RING_OFF, g, S, E);
            SEAM(pb + 7); }
        if (PHEN(8) && IN(pb + 8)) { MKFRAME();
            pg8::Gemm g{HID, we + WTE_DN / 2, T, D, DFF}; pg8::StaticOrder S; S.init(T, D, F.G, F.blk);
            pg8::EpiF32Res E{F.out, F.out, D};
            pg8::gemm_phase<pg8::EpiF32Res, pg8::StaticOrder>(F.lds + RING_OFF, g, S, E);
            SEAM(pb + 8); }
        if (PHEN(9) && IN(pb + 9)) { MKFRAME(); norm_phase(F, F.out, F.out, args.in[1] + (size_t)lo_ * D, HN, false, false, true, nullptr); SEAM(pb + 9); }
        if (PHEN(10) && IN(pb + 10)) { MKFRAME();
            pg8::Gemm g{HN, wo + WTO_IN / 2, T, ODD_IN, D}; pg8::StaticOrder S; S.init(T, ODD_IN, F.G, F.blk);
            pg8::EpiBf16Plain E{RAWP, ODD_IN};
            pg8::gemm_phase<pg8::EpiBf16Plain, pg8::StaticOrder>(F.lds + RING_OFF, g, S, E);
            SEAM(pb + 10); }
        if (PHEN(11) && IN(pb + 11)) { MKFRAME(); post_odd(F, RAWP, args.in[14] + (size_t)lp * 64, args.in[15] + (size_t)lp * 64); SEAM(pb + 11); }
        if (PHEN(12) && IN(pb + 12)) { MKFRAME(); kmean_phase(F); SEAM(pb + 12); }
        if (PHEN(13) && IN(pb + 13)) { MKFRAME();
#if NAIVE_MOBA
            moba_naive(F, MIX);
#else
            moba_phase(F, lp, MIX);
#endif
            conv_phase(F, RAWP, args.in[16] + (size_t)lp * 3 * 256, MIX); SEAM(pb + 13); }
        if (PHEN(14) && IN(pb + 14)) { MKFRAME();
            pg8::Gemm g{MIX, wo + WTO_OUT / 2, T, D, ODD_OUT}; pg8::StaticOrder S; S.init(T, D, F.G, F.blk);
            pg8::EpiF32Res E{F.out, F.out, D};
            pg8::gemm_phase<pg8::EpiF32Res, pg8::StaticOrder>(F.lds + RING_OFF, g, S, E);
            SEAM(pb + 14); }
        if (PHEN(15) && IN(pb + 15)) { MKFRAME(); norm_phase(F, F.out, F.out, args.in[2] + (size_t)lo_ * D, HN, false, true, true, args.in[18] + (size_t)lp * D * NEXP); SEAM(pb + 15); }
        if (PHEN(16) && IN(pb + 16)) { MKFRAME(); route_phase(F, HN, HSORT); SEAM(pb + 16); }
        if (PHEN(17) && IN(pb + 17)) { MKFRAME();
            const int* tbp = (const int*)(args.ws + WS_MISC + 512 * 1024);
            pg8::MoeOrder S; const int ntiles = tbp[8]; S.init(ntiles * 256, 2 * DFFE, F.G, F.blk);
#pragma unroll
            for (int k = 0; k < 8; ++k) S.tb[k] = tbp[k];
            S.estride = (size_t)2 * DFFE * D * 2;
            pg8::Gemm g{HSORT, wo + WTO_MGU / 2, ntiles * 256, 2 * DFFE, D};
            pg8::EpiSwiGLU E{HID, DFFE};
            pg8::gemm_phase<pg8::EpiSwiGLU, pg8::MoeOrder>(F.lds + RING_OFF, g, S, E);
            SEAM(pb + 17); }
        if (PHEN(18) && IN(pb + 18)) { MKFRAME();
            const int* tbp = (const int*)(args.ws + WS_MISC + 512 * 1024);
            pg8::MoeOrder S; const int ntiles = tbp[8]; S.init(ntiles * 256, D, F.G, F.blk);
#pragma unroll
            for (int k = 0; k < 8; ++k) S.tb[k] = tbp[k];
            S.estride = (size_t)DFFE * D * 2;
            pg8::Gemm g{HID, wo + WTO_MD / 2, ntiles * 256, D, DFFE};
            pg8::EpiBf16Plain E{YB, D};
            pg8::gemm_phase<pg8::EpiBf16Plain, pg8::MoeOrder>(F.lds + RING_OFF, g, S, E);
            SEAM(pb + 18); }
    }
    if (PHEN(20) && IN(NPH - 1)) { MKFRAME(); norm_phase(F, F.out, F.out, args.in[1], HN, true, false, false, nullptr); }
#undef IN
#undef SEAM
#undef HN
#undef MIX
#undef HID
#undef RAWP
#undef HSORT
#undef YB
#undef x_in
#undef we
#undef wo
}

extern "C" void kernel_launch(void* const* d_in, const int* in_sizes, int n_in, void* d_out, int out_size, void* d_ws, size_t ws_size, hipStream_t stream) {
    static int grid = 0;
    if (grid == 0) {
        if (n_in != 22 || out_size != T * D || ws_size < WS_END) { fprintf(stderr, "kernel_launch: unexpected shapes (n_in %d out %d ws %zu)\n", n_in, out_size, ws_size); grid = -1; return; }
        int dev = 0, cus = 0, per_cu = 0;
        if (hipGetDevice(&dev) != hipSuccess || hipDeviceGetAttribute(&cus, hipDeviceAttributeMultiprocessorCount, dev) != hipSuccess) { grid = -1; return; }
        if (hipFuncSetAttribute((const void*)fwd, hipFuncAttributeMaxDynamicSharedMemorySize, LDS_BYTES) != hipSuccess) { fprintf(stderr, "kernel_launch: hipFuncSetAttribute failed\n"); grid = -1; return; }
        if (hipOccupancyMaxActiveBlocksPerMultiprocessor(&per_cu, (const void*)fwd, NWAVES * 64, LDS_BYTES) != hipSuccess || per_cu < 1) fprintf(stderr, "kernel_launch: occupancy query says %d\n", per_cu);
        (void)hipGetLastError();
        grid = cus;
    }
    if (grid < 0) return;
    (void)hipMemsetAsync((char*)d_ws + WS_CTL, 0, CTL_ZERO_BYTES, stream);
    Args a{};
    for (int i = 0; i < 22; ++i) a.in[i] = (const float*)d_in[i];
    a.out = (float*)d_out; a.ws = (unsigned char*)d_ws;
#if MK_PER_PHASE
    for (int p = 0; p < NPH; ++p) { a.ph_lo = p; a.ph_hi = p + 1; hipLaunchKernelGGL(fwd, dim3(grid), dim3(NWAVES * 64), LDS_BYTES, stream, a); }
#else
    a.ph_lo = 0; a.ph_hi = NPH; hipLaunchKernelGGL(fwd, dim3(grid), dim3(NWAVES * 64), LDS_BYTES, stream, a);
#endif
}
```

```cpp
#include <hip/hip_runtime.h>
#include <cstdio>
#include <cstdint>
#include <hip/hip_bf16.h>


template <int X> __device__ __forceinline__ float xswz(float v) { return __builtin_bit_cast(float, __builtin_amdgcn_ds_swizzle(__builtin_bit_cast(int, v), (X << 10) | 0x1F)); }
template <int X> __device__ __forceinline__ int xswzi(int v) { return __builtin_amdgcn_ds_swizzle(v, (X << 10) | 0x1F); }
__device__ __forceinline__ float xsum32(float v) { float a = v, b = v; asm("s_nop 1\n\tv_permlane32_swap_b32_e32 %0, %1" : "+v"(a), "+v"(b)); return a + b; }
__device__ __forceinline__ int xsum32i(int v) { int a = v, b = v; asm("s_nop 1\n\tv_permlane32_swap_b32_e32 %0, %1" : "+v"(a), "+v"(b)); return a + b; }
__device__ __forceinline__ float xmax32(float v) { float a = v, b = v; asm("s_nop 1\n\tv_permlane32_swap_b32_e32 %0, %1" : "+v"(a), "+v"(b)); return fmaxf(a, b); }

#ifndef NAIVE_MOBA
#define NAIVE_MOBA 0
#endif
#ifndef NAIVE_BANDED
#define NAIVE_BANDED 0
#endif
#ifndef MK_PER_PHASE
#define MK_PER_PHASE 0
#endif

namespace pg8 {
#define PG8_LAS __attribute__((address_space(3)))
typedef unsigned short bf16_t;
typedef short bf16x8 __attribute__((ext_vector_type(8)));
typedef float f32x4 __attribute__((ext_vector_type(4)));
typedef float f32x2 __attribute__((ext_vector_type(2)));
typedef unsigned u32x4 __attribute__((ext_vector_type(4)));
constexpr int BM = 256, BK = 64, HALF = 128, HTB = HALF * BK * 2, STAGE_BYTES = 8 * HTB, NXCD = 8, WGM = 8;

__host__ __device__ __forceinline__ int lds_byte(int r, int c) { const int st = (r >> 4) * 2 + (c >> 5), rr = r & 15, cc = c & 31, ob = rr * 64 + cc * 2; return st * 1024 + (ob ^ (((ob >> 9) & 1) << 5)); }
__host__ __device__ __forceinline__ void stage_rc(int b, int& R, int& C) { const int st = b / 1024, sb = b % 1024, swz = sb ^ (((sb >> 9) & 1) << 5); R = (st >> 1) * 16 + swz / 64; C = (st & 1) * 32 + (swz % 64) / 2; }
__host__ __device__ __forceinline__ int perm32(int rho) { const int n = rho >> 4, i = rho & 15; return 8 * (i >> 2) + 4 * n + (i & 3); }

struct Unit { int pm, pn; };
struct Gemm { const bf16_t* A; const bf16_t* Bt; int M, N, K; };

struct StaticOrder {
    int nM, nN, nwg, G, c;
    __device__ void init(int M, int N, int G_, int c_) { nM = M / BM; nN = N / BM; nwg = nM * nN; G = G_; c = c_; }
    __device__ bool next(int i, Unit& u) const {
        const long L = (long)i * G + c; if (L >= nwg) return false;
        int wgid = (int)L; { const int q = nwg / NXCD, r = nwg % NXCD, xcd = wgid % NXCD, off = wgid / NXCD; wgid = (xcd < r ? xcd * (q + 1) : r * (q + 1) + (xcd - r) * q) + off; }
        const int nig = WGM * nN, gid = wgid / nig, fm = gid * WGM, gsz = (nM - fm) < WGM ? (nM - fm) : WGM;
        u.pm = fm + ((wgid % nig) % gsz); u.pn = (wgid % nig) / gsz; return true;
    }
    __device__ __forceinline__ const char* bbase(const Unit&, const bf16_t* Bt) const { return (const char*)Bt; }
};
struct MoeOrder : StaticOrder {
    int tb[8]; size_t estride;
    __device__ __forceinline__ const char* bbase(const Unit& u, const bf16_t* Bt) const {
        int e = 0;
#pragma unroll
        for (int k = 1; k < 8; ++k) e += (u.pm >= tb[k]) ? 1 : 0;
        return (const char*)Bt + (size_t)e * estride;
    }
};

__device__ __forceinline__ unsigned cvt_pk_bf16(float lo, float hi) { unsigned r; asm volatile("v_cvt_pk_bf16_f32 %0, %1, %2" : "=v"(r) : "v"(lo), "v"(hi)); return r; }

struct EpiBf16Plain {
    static constexpr bool PERM = true;
    bf16_t* O; int ldc;
    __device__ __forceinline__ void operator()(const f32x4 (&acc)[2][2][4][2], const Unit& u, int wr, int wc, int fr, int fq) const {
        const int row0 = u.pm * BM + wr * 64 + fr, col0 = u.pn * BM + wc * 32 + 8 * fq;
#pragma unroll
        for (int ai = 0; ai < 2; ++ai)
#pragma unroll
            for (int m = 0; m < 4; ++m) { bf16_t* rowp = O + (size_t)(row0 + ai * HALF + m * 16) * ldc + col0;
#pragma unroll
                for (int bj = 0; bj < 2; ++bj) { const f32x4 v0 = acc[ai][bj][m][0], v1 = acc[ai][bj][m][1];
                    u32x4 w; w.x = cvt_pk_bf16(v0[0], v0[1]); w.y = cvt_pk_bf16(v0[2], v0[3]); w.z = cvt_pk_bf16(v1[0], v1[1]); w.w = cvt_pk_bf16(v1[2], v1[3]);
                    *(u32x4*)(rowp + bj * HALF) = w; } }
    }
};
struct EpiF32Res {
    static constexpr bool PERM = false;
    const float* base; float* out; int ldc;
    __device__ __forceinline__ void operator()(const f32x4 (&acc)[2][2][4][2], const Unit& u, int wr, int wc, int fr, int fq) const {
        const int row0 = u.pm * BM + wr * 64 + fr, col0 = u.pn * BM + wc * 32 + 4 * fq;
#pragma unroll
        for (int ai = 0; ai < 2; ++ai)
#pragma unroll
            for (int m = 0; m < 4; ++m) { const size_t off = (size_t)(row0 + ai * HALF + m * 16) * ldc + col0;
#pragma unroll
                for (int bj = 0; bj < 2; ++bj)
#pragma unroll
                    for (int n = 0; n < 2; ++n) { const f32x4 bs = *(const f32x4*)(base + off + bj * HALF + n * 16); *(f32x4*)(out + off + bj * HALF + n * 16) = bs + acc[ai][bj][m][n]; }
                asm volatile("" ::: "memory"); }
    }
};
__device__ __forceinline__ float silu_mul(float g, float u) { return g * __builtin_amdgcn_rcpf(1.0f + __builtin_amdgcn_exp2f(-1.4426950408889634f * g)) * u; }
struct EpiSwiGLU {
    static constexpr bool PERM = true;
    bf16_t* O; int ldc;
    __device__ __forceinline__ void operator()(const f32x4 (&acc)[2][2][4][2], const Unit& u, int wr, int wc, int fr, int fq) const {
        const int row0 = u.pm * BM + wr * 64 + fr, col0 = u.pn * HALF + wc * 32 + 8 * fq;
#pragma unroll
        for (int ai = 0; ai < 2; ++ai)
#pragma unroll
            for (int m = 0; m < 4; ++m) { bf16_t* rowp = O + (size_t)(row0 + ai * HALF + m * 16) * ldc + col0;
                const f32x4 g0 = acc[ai][0][m][0], g1 = acc[ai][0][m][1], u0 = acc[ai][1][m][0], u1 = acc[ai][1][m][1];
                u32x4 w; w.x = cvt_pk_bf16(silu_mul(g0[0], u0[0]), silu_mul(g0[1], u0[1])); w.y = cvt_pk_bf16(silu_mul(g0[2], u0[2]), silu_mul(g0[3], u0[3]));
                w.z = cvt_pk_bf16(silu_mul(g1[0], u1[0]), silu_mul(g1[1], u1[1])); w.w = cvt_pk_bf16(silu_mul(g1[2], u1[2]), silu_mul(g1[3], u1[3]));
                *(u32x4*)rowp = w; }
    }
};


__device__ __forceinline__ float gelu_t(float x) { const float y2 = 1.5957691216057308f * (x + 0.044715f * x * x * x); return x * __builtin_amdgcn_rcpf(1.0f + __builtin_amdgcn_exp2f(-1.4426950408889634f * y2)); }
__device__ __forceinline__ void st8(bf16_t* p, const float (&v)[8]) { u32x4 w; w.x = cvt_pk_bf16(v[0], v[1]); w.y = cvt_pk_bf16(v[2], v[3]); w.z = cvt_pk_bf16(v[4], v[5]); w.w = cvt_pk_bf16(v[6], v[7]); *(u32x4*)p = w; }
__device__ __forceinline__ int srow_g(int s, int g) { return g == 0 ? s : (g == 1 ? ((s & 3) * 1024 + (s >> 2)) : ((s & 15) * 256 + (s >> 4))); }
#define PG8_GETROW(x0, x1) do { const f32x4 a0 = acc[ai][0][m][0], a1 = acc[ai][0][m][1], b0 = acc[ai][1][m][0], b1 = acc[ai][1][m][1]; \
    x0[0] = a0[0]; x0[1] = a0[1]; x0[2] = a0[2]; x0[3] = a0[3]; x0[4] = a1[0]; x0[5] = a1[1]; x0[6] = a1[2]; x0[7] = a1[3]; \
    x1[0] = b0[0]; x1[1] = b0[1]; x1[2] = b0[2]; x1[3] = b0[3]; x1[4] = b1[0]; x1[5] = b1[1]; x1[6] = b1[2]; x1[7] = b1[3]; } while (0)
__device__ __forceinline__ void head_norm_rope(float (&x0)[8], float (&x1)[8], const float (&g0)[8], const float (&g1)[8], const float* cs, const float* sn, int s, int fq, float scale) {
    float ss = 0.f;
#pragma unroll
    for (int i = 0; i < 8; ++i) ss += x0[i] * x0[i] + x1[i] * x1[i];
    ss += xswz<16>(ss); ss = xsum32(ss);
    const float rstd = scale / sqrtf(ss * (1.0f / 64.0f) + 1e-6f);
    const f32x4 c0 = *(const f32x4*)(cs + s * 32 + 8 * fq), c1 = *(const f32x4*)(cs + s * 32 + 8 * fq + 4), s0 = *(const f32x4*)(sn + s * 32 + 8 * fq), s1 = *(const f32x4*)(sn + s * 32 + 8 * fq + 4);
#pragma unroll
    for (int i = 0; i < 8; ++i) { const float a = x0[i] * rstd * g0[i], b = x1[i] * rstd * g1[i]; const float c = i < 4 ? c0[i & 3] : c1[i & 3], sv = i < 4 ? s0[i & 3] : s1[i & 3];
        x0[i] = a * c - b * sv; x1[i] = b * c + a * sv; }
}
struct EpiHeadsEven {
    static constexpr bool PERM = false;
    bf16_t* UV; bf16_t* Qs; const float* vgain; const float* qgain; const float* kgain; const float* cs; const float* sn;
    __device__ __forceinline__ void operator()(const f32x4 (&acc)[2][2][4][2], const Unit& u, int wr, int wc, int fr, int fq) const {
        const int pn = u.pn, row0 = u.pm * BM + wr * 64 + fr;
        const int kind = pn == 0 ? 0 : (pn == 1 ? 1 : (pn < 8 ? 2 : 3));
        const bool isq = pn < 5; const int h = (pn < 5 ? pn - 2 : (pn < 8 ? pn - 5 : pn - 8)) * 4 + wc, grp = h >> 2;
        float g0[8], g1[8];
        { const float* gp = kind == 1 ? vgain + wc * 64 : (isq ? qgain : kgain);
#pragma unroll
          for (int i = 0; i < 8; ++i) { g0[i] = gp[8 * fq + i]; g1[i] = gp[32 + 8 * fq + i]; } }
        bf16_t* hb = Qs + (kind == 3 ? (size_t)24 * 1024 * 1024 : (isq ? (size_t)0 : (size_t)12 * 1024 * 1024));
#pragma unroll
        for (int ai = 0; ai < 2; ++ai)
#pragma unroll
            for (int m = 0; m < 4; ++m) {
                const int row = row0 + ai * HALF + m * 16, b = row >> 12, s = row & 4095;
                float x0[8], x1[8]; PG8_GETROW(x0, x1);
                if (kind <= 1) {
#pragma unroll
                    for (int i = 0; i < 8; ++i) { x0[i] = gelu_t(x0[i]); x1[i] = gelu_t(x1[i]); }
                    if (kind == 1) { float ss = 0.f;
#pragma unroll
                        for (int i = 0; i < 8; ++i) ss += x0[i] * x0[i] + x1[i] * x1[i];
                        ss += xswz<16>(ss); ss = xsum32(ss);
                        const float rstd = 1.0f / sqrtf(ss * (1.0f / 64.0f) + 1e-6f);
#pragma unroll
                        for (int i = 0; i < 8; ++i) { x0[i] *= rstd * g0[i]; x1[i] *= rstd * g1[i]; } }
                    bf16_t* d = UV + (size_t)row * 512 + pn * 256 + wc * 64 + 8 * fq; st8(d, x0); st8(d + 32, x1);
                } else {
                    if (kind == 2) head_norm_rope(x0, x1, g0, g1, cs, sn, s, fq, isq ? 0.18033688011112042f : 1.0f);
                    bf16_t* d = hb + ((size_t)(b * 12 + h) * 4096 + srow_g(s, grp)) * 64 + 8 * fq; st8(d, x0); st8(d + 32, x1);
                }
            }
    }
};
struct EpiHeadsOdd {
    static constexpr bool PERM = false;
    bf16_t* Qm; bf16_t* CONV; float* kmsum; const float* qgain; const float* kgain; const float* cs; const float* sn;
    __device__ __forceinline__ void operator()(const f32x4 (&acc)[2][2][4][2], const Unit& u, int wr, int wc, int fr, int fq) const {
        const int pn = u.pn, row0 = u.pm * BM + wr * 64 + fr;
        const int kind = pn < 6 ? 2 : (pn < 9 ? 3 : 4);
        const bool isq = pn < 3; const int h = (pn % 3) * 4 + wc;
        float g0[8], g1[8];
        { const float* gp = isq ? qgain : kgain;
#pragma unroll
          for (int i = 0; i < 8; ++i) { g0[i] = gp[8 * fq + i]; g1[i] = gp[32 + 8 * fq + i]; } }
        bf16_t* hb = Qm + (kind == 3 ? (size_t)24 * 1024 * 1024 : (isq ? (size_t)0 : (size_t)12 * 1024 * 1024));
        float cs0[8], cs1[8];
#pragma unroll
        for (int i = 0; i < 8; ++i) { cs0[i] = 0.f; cs1[i] = 0.f; }
#pragma unroll
        for (int ai = 0; ai < 2; ++ai)
#pragma unroll
            for (int m = 0; m < 4; ++m) {
                const int row = row0 + ai * HALF + m * 16, b = row >> 12, s = row & 4095;
                float x0[8], x1[8]; PG8_GETROW(x0, x1);
                if (kind == 4) { bf16_t* d = CONV + (size_t)row * 768 + (pn - 9) * 256 + wc * 64 + 8 * fq; st8(d, x0); st8(d + 32, x1); }
                else {
                    if (kind == 2) { head_norm_rope(x0, x1, g0, g1, cs, sn, s, fq, isq ? 0.18033688011112042f : 1.0f);
                        if (!isq) {
#pragma unroll
                            for (int i = 0; i < 8; ++i) { cs0[i] += x0[i]; cs1[i] += x1[i]; } } }
                    bf16_t* d = hb + ((size_t)(b * 12 + h) * 4096 + s) * 64 + 8 * fq; st8(d, x0); st8(d + 32, x1);
                }
            }
        if (kind == 2 && !isq) {
#pragma unroll
            for (int i = 0; i < 8; ++i) {
                { cs0[i] += xswz<1>(cs0[i]); cs1[i] += xswz<1>(cs1[i]); cs0[i] += xswz<2>(cs0[i]); cs1[i] += xswz<2>(cs1[i]); cs0[i] += xswz<4>(cs0[i]); cs1[i] += xswz<4>(cs1[i]); cs0[i] += xswz<8>(cs0[i]); cs1[i] += xswz<8>(cs1[i]); } }
            if (fr == 0) { const int b = (u.pm * BM) >> 12, blk = u.pm & 15; float* kp = kmsum + ((size_t)(b * 12 + h) * 16 + blk) * 64 + 8 * fq;
#pragma unroll
                for (int i = 0; i < 8; ++i) { atomicAdd(kp + i, cs0[i]); atomicAdd(kp + 32 + i, cs1[i]); } }
        }
    }
};

template <class Epi, class Sched, bool ALIGN_EPI = true, bool SP2 = true>
__device__ __forceinline__ void gemm_phase(PG8_LAS unsigned char* lds, const Gemm g, const Sched& S, const Epi& E) {
    int tid_ = threadIdx.x; asm volatile("" : "+v"(tid_));
    const int tid = tid_, wid = __builtin_amdgcn_readfirstlane(tid >> 6), lane = tid & 63, wr = wid >> 2, wc = wid & 3, fr = lane & 15, fq = lane >> 4;
    const int K = g.K, nt = K / BK;
    unsigned voffA[2], voffB[2];
#pragma unroll
    for (int i = 0; i < 2; ++i) { int R, C; stage_rc(tid * 16 + i * 8192, R, C); const int Rb = Epi::PERM ? ((R & ~31) + perm32(R & 31)) : R;
        voffA[i] = (unsigned)(R * K + C) * 2u; voffB[i] = (unsigned)(Rb * K + C) * 2u; }
    const size_t kstep = (size_t)(BK * 2);
    const size_t hstep = (size_t)HALF * K * 2;
    const size_t tstep = 2 * hstep;
    const unsigned ldsw = (unsigned)wid * 1024u;
    const int aoff = lds_byte(wr * 64 + fr, fq * 8), boff = lds_byte(wc * 32 + fr, fq * 8);
#define PG8_SA(b, h) (((b) * 2 + (h)) * HTB)
#define PG8_SB(b, h) ((4 + (b) * 2 + (h)) * HTB)
#define PG8_STAGE(bufoff, gbase, voff) do { _Pragma("unroll") for (int _i = 0; _i < 2; ++_i) \
        __builtin_amdgcn_global_load_lds((const unsigned*)((const char*)(gbase) + (voff)[_i]), (PG8_LAS unsigned*)(lds + (bufoff) + ldsw + _i * 8192), 16, 0, 0); } while (0)
#define PG8_LDA(dst, b, h) do { _Pragma("unroll") for (int m = 0; m < 4; ++m) _Pragma("unroll") for (int k = 0; k < 2; ++k) dst[m][k] = *(const PG8_LAS bf16x8*)(lds + PG8_SA(b, h) + aoff + m * 2048 + k * 1024); } while (0)
#define PG8_LDB(dst, b, h) do { _Pragma("unroll") for (int n = 0; n < 2; ++n) _Pragma("unroll") for (int k = 0; k < 2; ++k) dst[n][k] = *(const PG8_LAS bf16x8*)(lds + PG8_SB(b, h) + boff + n * 2048 + k * 1024); } while (0)
#define PG8_MMA(ai, bj, At, Bt) do { __builtin_amdgcn_s_setprio(1); _Pragma("unroll") for (int m = 0; m < 4; ++m) _Pragma("unroll") for (int n = 0; n < 2; ++n) _Pragma("unroll") for (int k = 0; k < 2; ++k) \
        acc[ai][bj][m][n] = __builtin_amdgcn_mfma_f32_16x16x32_bf16(Bt[n][k], At[m][k], acc[ai][bj][m][n], 0, 0, 0); __builtin_amdgcn_s_setprio(0); } while (0)
#define PG8_WAIT_V(n) asm volatile("s_waitcnt vmcnt(" #n ")" ::: "memory")
#define PG8_WAIT_L(n) asm volatile("s_waitcnt lgkmcnt(" #n ")" ::: "memory")
#define PG8_BAR __builtin_amdgcn_s_barrier()
#define PG8_SCHED __builtin_amdgcn_sched_barrier(0)
    Unit cur, nxt; int ui = 0;
    if (!S.next(0, cur)) return;
    f32x4 acc[2][2][4][2];
#pragma unroll
    for (int a = 0; a < 2; ++a)
#pragma unroll
        for (int b = 0; b < 2; ++b)
#pragma unroll
            for (int m = 0; m < 4; ++m)
#pragma unroll
                for (int n = 0; n < 2; ++n) acc[a][b][m][n] = (f32x4){0.f, 0.f, 0.f, 0.f};
    bf16x8 At[4][2], B0[2][2], B1[2][2];
    const char* cA = (const char*)g.A + (size_t)cur.pm * tstep; const char* cB = S.bbase(cur, g.Bt) + (size_t)cur.pn * tstep;
    if constexpr (SP2) {
        PG8_STAGE(PG8_SB(0, 0), cB, voffB); PG8_STAGE(PG8_SB(0, 1), cB + hstep, voffB); PG8_STAGE(PG8_SA(0, 0), cA, voffA); PG8_STAGE(PG8_SA(0, 1), cA + hstep, voffA);
        if (wr == 1) PG8_BAR;
        PG8_WAIT_V(2); PG8_BAR;
        PG8_STAGE(PG8_SB(1, 0), cB + kstep, voffB); PG8_STAGE(PG8_SA(1, 0), cA + kstep, voffA); PG8_STAGE(PG8_SB(1, 1), cB + hstep + kstep, voffB);
        PG8_WAIT_V(6); PG8_BAR;
    } else {
        PG8_STAGE(PG8_SB(0, 0), cB, voffB); PG8_STAGE(PG8_SA(0, 0), cA, voffA); PG8_STAGE(PG8_SB(0, 1), cB + hstep, voffB); PG8_STAGE(PG8_SA(0, 1), cA + hstep, voffA);
        if (wr == 1) PG8_BAR;
        PG8_WAIT_V(4); PG8_BAR;
        PG8_STAGE(PG8_SB(1, 0), cB + kstep, voffB); PG8_STAGE(PG8_SA(1, 0), cA + kstep, voffA); PG8_STAGE(PG8_SB(1, 1), cB + hstep + kstep, voffB);
        PG8_WAIT_V(6); PG8_BAR;
    }
    for (;;) {
        const bool has_next = S.next(ui + 1, nxt);
        const char* nA = has_next ? (const char*)g.A + (size_t)nxt.pm * tstep : cA; const char* nB = has_next ? S.bbase(nxt, g.Bt) + (size_t)nxt.pn * tstep : cB;
        for (int t = 0; t < nt; t += 2) {
            const bool last = (t == nt - 2);
            const char* a1 = cA + (size_t)(t + 1) * kstep;
            const char* a2 = last ? nA : cA + (size_t)(t + 2) * kstep; const char* b2 = last ? nB : cB + (size_t)(t + 2) * kstep;
            const char* a3 = a2 + kstep; const char* b3 = b2 + kstep;
            if constexpr (SP2) {
            PG8_LDB(B0, 0, 0); PG8_LDB(B1, 0, 1); PG8_SCHED; PG8_LDA(At, 0, 0); PG8_STAGE(PG8_SA(1, 1), a1 + hstep, voffA);
            PG8_WAIT_V(8); PG8_WAIT_L(0); PG8_BAR; PG8_MMA(0, 0, At, B0); PG8_MMA(0, 1, At, B1); PG8_BAR; PG8_SCHED;
            PG8_LDA(At, 0, 1); PG8_STAGE(PG8_SB(0, 0), b2, voffB); PG8_STAGE(PG8_SB(0, 1), b2 + hstep, voffB); PG8_STAGE(PG8_SA(0, 0), a2, voffA);
            PG8_WAIT_V(8); PG8_WAIT_L(0); PG8_BAR; PG8_MMA(1, 0, At, B0); PG8_MMA(1, 1, At, B1); PG8_BAR; PG8_SCHED;
            PG8_LDB(B0, 1, 0); PG8_LDB(B1, 1, 1); PG8_SCHED; PG8_LDA(At, 1, 0); PG8_STAGE(PG8_SA(0, 1), a2 + hstep, voffA);
            PG8_WAIT_V(8); PG8_WAIT_L(0); PG8_BAR; PG8_MMA(0, 0, At, B0); PG8_MMA(0, 1, At, B1); PG8_BAR; PG8_SCHED;
            PG8_LDA(At, 1, 1); PG8_STAGE(PG8_SB(1, 0), b3, voffB); PG8_STAGE(PG8_SB(1, 1), b3 + hstep, voffB); PG8_STAGE(PG8_SA(1, 0), a3, voffA);
            PG8_WAIT_V(8); PG8_WAIT_L(0); PG8_BAR; PG8_MMA(1, 0, At, B0); PG8_MMA(1, 1, At, B1); PG8_BAR; PG8_SCHED;
            } else {
            PG8_LDB(B0, 0, 0); PG8_SCHED; PG8_LDA(At, 0, 0); PG8_STAGE(PG8_SA(1, 1), a1 + hstep, voffA);
            PG8_WAIT_L(8); PG8_BAR; PG8_WAIT_L(0); PG8_MMA(0, 0, At, B0); PG8_BAR; PG8_SCHED;
            PG8_LDB(B1, 0, 1); PG8_STAGE(PG8_SB(0, 0), b2, voffB);
            PG8_BAR; PG8_WAIT_L(0); PG8_MMA(0, 1, At, B1); PG8_BAR;
            PG8_LDA(At, 0, 1); PG8_STAGE(PG8_SA(0, 0), a2, voffA);
            PG8_BAR; PG8_WAIT_L(0); PG8_MMA(1, 0, At, B0); PG8_BAR; PG8_SCHED;
            PG8_STAGE(PG8_SB(0, 1), b2 + hstep, voffB);
            PG8_WAIT_V(6); PG8_BAR; PG8_MMA(1, 1, At, B1); PG8_BAR;
            PG8_LDB(B0, 1, 0); PG8_SCHED; PG8_LDA(At, 1, 0); PG8_STAGE(PG8_SA(0, 1), a2 + hstep, voffA);
            PG8_WAIT_L(8); PG8_BAR; PG8_WAIT_L(0); PG8_MMA(0, 0, At, B0); PG8_BAR; PG8_SCHED;
            PG8_LDB(B1, 1, 1); PG8_STAGE(PG8_SB(1, 0), b3, voffB);
            PG8_BAR; PG8_WAIT_L(0); PG8_MMA(0, 1, At, B1); PG8_BAR;
            PG8_LDA(At, 1, 1); PG8_STAGE(PG8_SA(1, 0), a3, voffA);
            PG8_BAR; PG8_WAIT_L(0); PG8_MMA(1, 0, At, B0); PG8_BAR; PG8_SCHED;
            PG8_STAGE(PG8_SB(1, 1), b3 + hstep, voffB);
            PG8_WAIT_V(6); PG8_BAR; PG8_MMA(1, 1, At, B1); PG8_BAR;
            }
        }
        if constexpr (ALIGN_EPI) { if (wr == 0) PG8_BAR; }
        E(acc, cur, wr, wc, fr, fq);
        if (!has_next) break;
#pragma unroll
        for (int a = 0; a < 2; ++a)
#pragma unroll
            for (int b = 0; b < 2; ++b)
#pragma unroll
                for (int m = 0; m < 4; ++m)
#pragma unroll
                    for (int n = 0; n < 2; ++n) acc[a][b][m][n] = (f32x4){0.f, 0.f, 0.f, 0.f};
        cur = nxt; cA = nA; cB = nB; ++ui;
        if constexpr (ALIGN_EPI) { if (wr == 1) PG8_BAR; }
    }
    PG8_WAIT_V(0);
    if constexpr (!ALIGN_EPI) { if (wr == 0) PG8_BAR; }
    PG8_BAR;
#undef PG8_SA
#undef PG8_SB
#undef PG8_STAGE
#undef PG8_LDA
#undef PG8_LDB
#undef PG8_MMA
#undef PG8_WAIT_V
#undef PG8_WAIT_L
#undef PG8_BAR
#undef PG8_SCHED
}
}


namespace att {
using bf16x8=__attribute__((ext_vector_type(8)))short;
using s16x4=__attribute__((ext_vector_type(4)))short;
using f32x16=__attribute__((ext_vector_type(16)))float;
using u32x4=__attribute__((ext_vector_type(4)))unsigned;
typedef unsigned short bf16;
constexpr int D=64,DM=64;
constexpr int NW=8,QBLK=32,QB=QBLK*NW,KVBLK=64;
__device__ __forceinline__ int crow(int r,int hi){return (r&3)+8*(r>>2)+4*hi;}
#define SBAR() __builtin_amdgcn_sched_barrier(0)
constexpr int NSLOT=3, SLOTB=8192;
constexpr int LDS_K=0, LDS_V=NSLOT*SLOTB, LDS_WS=2*NSLOT*SLOTB, LDS_OST=LDS_WS+NW*64*4, LDS_KM=LDS_OST+NW*4096, LDS_TK=LDS_KM+4096, LDS_BYTES=LDS_TK+64;
constexpr float C2=0.125f*1.4426950408889634f;
__device__ __forceinline__ void glds16(const void*gsrc,unsigned lds_dst){unsigned keep;
  asm volatile("s_mov_b32 %0, m0\n\ts_mov_b32 m0, %2\n\ts_nop 0\n\tglobal_load_lds_dwordx4 %1, off\n\ts_mov_b32 m0, %0":"=&s"(keep):"v"(gsrc),"s"(lds_dst):"memory");}
__device__ __forceinline__ float max3f(float a,float b,float c){float r;asm("v_max3_f32 %0, %1, %2, %3":"=v"(r):"v"(a),"v"(b),"v"(c));return r;}
__device__ __forceinline__ float max2f(float a,float b){float r;asm("v_max_f32_e32 %0, %1, %2":"=v"(r):"v"(a),"v"(b));return r;}
__device__ __forceinline__ float fadd_s(float a,float b){float r;asm("v_add_f32_e32 %0, %1, %2":"=v"(r):"v"(a),"v"(b));return r;}
__device__ __forceinline__ float fsub_s(float a,float b){float r;asm("v_sub_f32_e32 %0, %1, %2":"=v"(r):"v"(a),"v"(b));return r;}
typedef float f32x2_t __attribute__((ext_vector_type(2))); typedef __bf16 bf16x2_t __attribute__((ext_vector_type(2)));
__device__ __forceinline__ unsigned cvtpk_s(float lo,float hi){f32x2_t v={lo,hi};bf16x2_t b=__builtin_convertvector(v,bf16x2_t);return __builtin_bit_cast(unsigned,b);}
#define WAIT_BAR(N) asm volatile("s_waitcnt vmcnt(" #N ") lgkmcnt(0)\n\ts_barrier":::"memory")
__device__ __forceinline__ void qkt(f32x16&p0,f32x16&p1,const char*Kslot,const bf16x8*qr,int r32,int hi){ const f32x16 zero16=f32x16{};
  const char*kb=Kslot+hi*1024+r32*16;
  #pragma unroll
  for(int d0=0;d0<4;++d0){
    const bf16x8 b0=*reinterpret_cast<const bf16x8*>(kb+d0*2048);
    const bf16x8 b1=*reinterpret_cast<const bf16x8*>(kb+d0*2048+512);
    if(d0==0){p0=__builtin_amdgcn_mfma_f32_32x32x16_bf16(b0,qr[0],zero16,0,0,0);p1=__builtin_amdgcn_mfma_f32_32x32x16_bf16(b1,qr[0],zero16,0,0,0);}
    else{p0=__builtin_amdgcn_mfma_f32_32x32x16_bf16(b0,qr[d0],p0,0,0,0);p1=__builtin_amdgcn_mfma_f32_32x32x16_bf16(b1,qr[d0],p1,0,0,0);}}
}
typedef __attribute__((address_space(3))) const char* lds_cptr;
typedef short v4i16_t __attribute__((ext_vector_type(4)));
__device__ __forceinline__ void kload8(bf16x8*kf,lds_cptr kp){
  kf[0]=*(const __attribute__((address_space(3))) bf16x8*)(kp);      kf[1]=*(const __attribute__((address_space(3))) bf16x8*)(kp+512);
  kf[2]=*(const __attribute__((address_space(3))) bf16x8*)(kp+2048); kf[3]=*(const __attribute__((address_space(3))) bf16x8*)(kp+2560);
  kf[4]=*(const __attribute__((address_space(3))) bf16x8*)(kp+4096); kf[5]=*(const __attribute__((address_space(3))) bf16x8*)(kp+4608);
  kf[6]=*(const __attribute__((address_space(3))) bf16x8*)(kp+6144); kf[7]=*(const __attribute__((address_space(3))) bf16x8*)(kp+6656);
}
__device__ __forceinline__ void kload2(bf16x8*kf,lds_cptr kp,int j){ kf[2*j]=*(const __attribute__((address_space(3))) bf16x8*)(kp+j*2048); kf[2*j+1]=*(const __attribute__((address_space(3))) bf16x8*)(kp+j*2048+512); }
__device__ __forceinline__ s16x4 vtr(lds_cptr p){ return __builtin_bit_cast(s16x4,__builtin_amdgcn_ds_read_tr16_b64_v4i16((__attribute__((address_space(3))) v4i16_t*)p)); }
__device__ __forceinline__ float rowmax(const f32x16&p0,const f32x16&p1){
  float a=max3f(p0[0],p0[1],p1[0]),b=max3f(p0[2],p0[3],p1[1]);a=max3f(a,p1[2],p1[3]);
  #pragma unroll
  for(int r=4;r<16;r+=4){a=max3f(a,p0[r],p0[r+1]);b=max3f(b,p0[r+2],p0[r+3]);a=max3f(a,p1[r],p1[r+1]);b=max3f(b,p1[r+2],p1[r+3]);}
  const float m=max2f(a,b);
  auto rr=__builtin_amdgcn_permlane32_swap(__float_as_uint(m),__float_as_uint(m),false,false);
  return max2f(__uint_as_float(rr[0]),__uint_as_float(rr[1]));
}
__device__ __forceinline__ void pv(f32x16*o,int vb,bf16x8 pa0,bf16x8 pa1,bf16x8 pa2,bf16x8 pa3){
  #pragma unroll
  for(int d0=0;d0<2;++d0){s16x4 lo[4],hi[4];
    #pragma unroll
    for(int ks=0;ks<4;++ks){
      asm volatile("ds_read_b64_tr_b16 %0,%1 offset:%c2":"=&v"(lo[ks]):"v"(vb),"i"(d0*4096+ks*1024):"memory");
      asm volatile("ds_read_b64_tr_b16 %0,%1 offset:%c2":"=&v"(hi[ks]):"v"(vb),"i"(d0*4096+ks*1024+512):"memory");}
    asm volatile("s_waitcnt lgkmcnt(0)":::"memory");SBAR();
    #define PK(k) (bf16x8){lo[k][0],lo[k][1],lo[k][2],lo[k][3],hi[k][0],hi[k][1],hi[k][2],hi[k][3]}
    o[d0]=__builtin_amdgcn_mfma_f32_32x32x16_bf16(pa0,PK(0),o[d0],0,0,0);
    o[d0]=__builtin_amdgcn_mfma_f32_32x32x16_bf16(pa1,PK(1),o[d0],0,0,0);
    o[d0]=__builtin_amdgcn_mfma_f32_32x32x16_bf16(pa2,PK(2),o[d0],0,0,0);
    o[d0]=__builtin_amdgcn_mfma_f32_32x32x16_bf16(pa3,PK(3),o[d0],0,0,0);
    #undef PK
  }
}
template<int MODE> __device__ __forceinline__ void amask(f32x16&p0,f32x16&p1,int a,int nb,unsigned sel,int qabs,int qrel,int hi,float mhat){
  const float NEG=-INFINITY;
  if(MODE==0){
    if(a>=nb){ const int kb=64*(a-nb)+4*hi;
      #pragma unroll
      for(int r=0;r<16;++r){const int kv=kb+(r&3)+8*(r>>2); p0[r]=(kv>qrel)?NEG:p0[r]-mhat; p1[r]=(kv+32>qrel)?NEG:p1[r]-mhat;} }
    else { const float bias=((sel>>(a>>2))&1u)?-mhat:NEG;
      #pragma unroll
      for(int r=0;r<16;++r){ p0[r]+=bias; p1[r]+=bias; } }
  } else {
    const int base=qabs-64*a-4*hi;
    #pragma unroll
    for(int r=0;r<16;++r){const int c=(r&3)+8*(r>>2); p0[r]=((unsigned)(base-c)>128u)?NEG:p0[r]-mhat; p1[r]=((unsigned)(base-c-32)>128u)?NEG:p1[r]-mhat;}
  }
}
#ifndef ATTN_STORE16
#define ATTN_STORE16(p,v) (*(u32x4*)(p)=(v))
#endif
template<int MODE,int THRL,int opitch> __device__ __forceinline__ void attn_unit(const bf16*Qs,int q0,int tile0,int NT,unsigned sel,bf16*O,float*LSE,char*shm){
  const bf16*Ks=Qs+12*1024*1024,*Vs=Qs+24*1024*1024;
  int tid_=threadIdx.x; asm volatile("":"+v"(tid_));
  const int tid=tid_,lane=tid&63,r32=lane&31,hi=lane>>5; const int wid=__builtin_amdgcn_readfirstlane(tid>>6);
  const int nb=NT-4;
  const bf16*Qw=Qs+(long)(q0+wid*QBLK)*DM;
  const lds_cptr shm3=(lds_cptr)shm;
  const unsigned lds0=(unsigned)(uintptr_t)shm3;
  float*wsf=(float*)(shm+LDS_WS)+wid*64;
  const bf16*ksrc=Ks+(long)lane*DM+wid*8;
  const bf16*vsrc=Vs+(long)(16*(wid&3)+(lane>>2))*DM+(wid>>2)*32+(lane&3)*8;
  const unsigned kdst=lds0+LDS_K+wid*1024, vdst=lds0+LDS_V+wid*1024;
  #define TM(t) (MODE==0 ? ((t)==0 ? nb : ((t)<=nb ? (t)-1 : (t))) : tile0+(t))
  #define DMA_K(t,slot) glds16(ksrc+(long)TM(t)*KVBLK*DM,(unsigned)__builtin_amdgcn_readfirstlane(kdst+(slot)))
  #define DMA_V(t,slot) glds16(vsrc+(long)TM(t)*KVBLK*DM,(unsigned)__builtin_amdgcn_readfirstlane(vdst+(slot)))
  const char*Kbase=shm+LDS_K; bf16x8 kf[8];
  const lds_cptr kp0=shm3+LDS_K+hi*1024+r32*16; const lds_cptr vp0=shm3+LDS_V+((lane>>4)&1)*32+(lane&3)*8+(4*hi+((lane&15)>>2))*64;
  DMA_K(0,0);DMA_V(0,0);DMA_K(1,SLOTB);
  bf16x8 qr[4];
  #pragma unroll
  for(int d0=0;d0<4;++d0)qr[d0]=*reinterpret_cast<const bf16x8*>(&Qw[(long)r32*DM+d0*16+hi*8]);
  float mhat=0.f,l_reg=0.f;f32x16 o[2];o[0]=f32x16{};o[1]=f32x16{};const f32x16 zero16=f32x16{};
  const int qrel=wid*QBLK+r32, qabs=q0+qrel;
  #define CMASK(P0,P1,t) amask<MODE>(P0,P1,TM(t),nb,sel,qabs,qrel,hi,mhat)
  bool resc=false;
  #define START(P0,P1) do{ const float rm=rowmax(P0,P1); resc=false; \
    { const float dl=__builtin_fmaxf(rm,0.f); mhat=fadd_s(mhat,dl); \
      _Pragma("unroll") for(int r=0;r<16;++r){P0[r]=fsub_s(P0[r],dl);P1[r]=fsub_s(P1[r],dl);} } \
    _Pragma("unroll") for(int r=0;r<16;++r)P0[r]=__builtin_amdgcn_exp2f(P0[r]); }while(0)
  #define RESC() do{ if(resc){ asm volatile("s_waitcnt lgkmcnt(0)":::"memory"); \
      _Pragma("unroll") for(int d_=0;d_<2;++d_) _Pragma("unroll") for(int r=0;r<16;++r)o[d_][r]*=wsf[crow(r,hi)]; } }while(0)
  f32x16 pA0,pA1,pB0,pB1;
  int sl_prev=0,sl_cur=0,sl_next=SLOTB;
  #define ROT() do{sl_prev=sl_cur;sl_cur=sl_next;sl_next=(sl_next==(NSLOT-1)*SLOTB)?0:sl_next+SLOTB;}while(0)
  DMA_K(2,2*SLOTB);
  WAIT_BAR(3);
  qkt(pA0,pA1,Kbase,qr,r32,hi);asm volatile("s_nop 15\n\ts_nop 7":"+v"(pA0),"+v"(pA1));CMASK(pA0,pA1,0);
  START(pA0,pA1);
  _Pragma("unroll") for(int r=0;r<16;++r)pA1[r]=__builtin_amdgcn_exp2f(pA1[r]);
  WAIT_BAR(0);
  DMA_K(3,0);DMA_V(1,SLOTB);
  ROT();
  kload8(kf,kp0+sl_cur);
  WAIT_BAR(2);
  s16x4 vlo[8],vhi[8]; u32x4 pw0,pw1,pw2,pw3;
  #define PKW(P,B) cvtpk_s(P[B],P[B+1])
  #define PAF(k) __builtin_bit_cast(bf16x8,pw##k)
  #define VFR(i) (bf16x8){vlo[i][0],vlo[i][1],vlo[i][2],vlo[i][3],vhi[i][0],vhi[i][1],vhi[i][2],vhi[i][3]}
  #define PIN(x) asm volatile("":"+v"(x))
  #define MX3(a,b,c) __builtin_fmaxf(__builtin_fmaxf((a),(b)),(c))
  #define GAPA(MF,A0,A1,A2,A3,W0,W1,PW) do{ MF; sacc+=A0; sacc+=A1; sacc+=A2; sacc+=A3; PIN(sacc); W0; W1; PIN(PW); SBAR(); }while(0)
  #define EX(v) __builtin_amdgcn_exp2f(v)
  #define GAPB(MF,X,B) do{ MF; X[B]=EX(X[B]); X[B+1]=EX(X[B+1]); X[B+2]=EX(X[B+2]); X[B+3]=EX(X[B+3]); PIN(X); SBAR(); }while(0)
  #define VRD(i) do{ vlo[i]=vtr(vp_+(((i)>>2)*4096+((i)&3)*1024)); vhi[i]=vtr(vp_+(((i)>>2)*4096+((i)&3)*1024+512)); }while(0)
  #define KRD(G,j) do{ if(G){ kload2(kf,kp0+sl_next,j); SBAR(); } }while(0)
  #define STEP(C0,C1,P0,P1,t,GK,GV,GL) do{ SBAR(); \
    const lds_cptr vp_=vp0+sl_prev; \
    VRD(0); SBAR(); float sacc=(P0[0]+P0[1]); \
    GAPA(C0=__builtin_amdgcn_mfma_f32_32x32x16_bf16(kf[0],qr[0],zero16,0,0,0), P0[2],P0[3],P0[4],P0[5],     pw0[0]=PKW(P0,0), pw0[1]=PKW(P0,2), pw0); \
    VRD(4); SBAR(); GAPA(C1=__builtin_amdgcn_mfma_f32_32x32x16_bf16(kf[1],qr[0],zero16,0,0,0), P0[6],P0[7],P0[8],P0[9],     pw0[2]=PKW(P0,4), pw0[3]=PKW(P0,6), pw0); \
    VRD(1); SBAR(); GAPA(C0=__builtin_amdgcn_mfma_f32_32x32x16_bf16(kf[2],qr[1],C0,0,0,0),   P0[10],P0[11],P0[12],P0[13], pw1[0]=PKW(P0,8), pw1[1]=PKW(P0,10), pw1); \
    VRD(5); SBAR(); GAPA(C1=__builtin_amdgcn_mfma_f32_32x32x16_bf16(kf[3],qr[1],C1,0,0,0),   P0[14],P0[15],P1[0],P1[1],   pw1[2]=PKW(P0,12),pw1[3]=PKW(P0,14), pw1); \
    VRD(2); SBAR(); GAPA(C0=__builtin_amdgcn_mfma_f32_32x32x16_bf16(kf[4],qr[2],C0,0,0,0),   P1[2],P1[3],P1[4],P1[5],     pw2[0]=PKW(P1,0), pw2[1]=PKW(P1,2), pw2); \
    VRD(6); SBAR(); GAPA(C1=__builtin_amdgcn_mfma_f32_32x32x16_bf16(kf[5],qr[2],C1,0,0,0),   P1[6],P1[7],P1[8],P1[9],     pw2[2]=PKW(P1,4), pw2[3]=PKW(P1,6), pw2); \
    VRD(3); SBAR(); GAPA(C0=__builtin_amdgcn_mfma_f32_32x32x16_bf16(kf[6],qr[3],C0,0,0,0),   P1[10],P1[11],P1[12],P1[13], pw3[0]=PKW(P1,8), pw3[1]=PKW(P1,10), pw3); \
    VRD(7); SBAR(); GAPA(C1=__builtin_amdgcn_mfma_f32_32x32x16_bf16(kf[7],qr[3],C1,0,0,0),   P1[14],P1[15],0.f,0.f,       pw3[2]=PKW(P1,12),pw3[3]=PKW(P1,14), pw3); \
    l_reg+=sacc; \
    if(GK){DMA_K((t)+3,sl_cur);} if(GV){DMA_V((t)+1,sl_next);} \
    CMASK(C0,C1,t); \
    { float a=MX3(C0[0],C0[1],C1[0]),b=MX3(C0[2],C0[3],C1[1]); a=MX3(a,C1[2],C1[3]); \
      _Pragma("unroll") for(int r=4;r<16;r+=4){a=MX3(a,C0[r],C0[r+1]);b=MX3(b,C0[r+2],C0[r+3]);a=MX3(a,C1[r],C1[r+1]);b=MX3(b,C1[r+2],C1[r+3]);} \
      float rm=__builtin_fmaxf(a,b); { auto rr=__builtin_amdgcn_permlane32_swap(__float_as_uint(rm),__float_as_uint(rm),false,false); rm=__builtin_fmaxf(__uint_as_float(rr[0]),__uint_as_float(rr[1])); } \
      resc=false; \
      if(__builtin_expect(__any(rm>(float)THRL),0)){ const float dl=__builtin_fmaxf(rm,0.f); mhat+=dl; \
        _Pragma("unroll") for(int r=0;r<16;++r){C0[r]-=dl;C1[r]-=dl;} \
        const float f=__builtin_amdgcn_exp2f(-dl); l_reg*=f; if(hi==0)wsf[r32]=f; resc=true; } } \
    SBAR(); \
    GAPB(o[0]=__builtin_amdgcn_mfma_f32_32x32x16_bf16(PAF(0),VFR(0),o[0],0,0,0), C0,0); \
    GAPB(o[1]=__builtin_amdgcn_mfma_f32_32x32x16_bf16(PAF(0),VFR(4),o[1],0,0,0), C0,4); \
    KRD(GL,0); GAPB(o[0]=__builtin_amdgcn_mfma_f32_32x32x16_bf16(PAF(1),VFR(1),o[0],0,0,0), C0,8); \
    KRD(GL,1); GAPB(o[1]=__builtin_amdgcn_mfma_f32_32x32x16_bf16(PAF(1),VFR(5),o[1],0,0,0), C0,12); \
    KRD(GL,2); GAPB(o[0]=__builtin_amdgcn_mfma_f32_32x32x16_bf16(PAF(2),VFR(2),o[0],0,0,0), C1,0); \
    KRD(GL,3); GAPB(o[1]=__builtin_amdgcn_mfma_f32_32x32x16_bf16(PAF(2),VFR(6),o[1],0,0,0), C1,4); \
    GAPB(o[0]=__builtin_amdgcn_mfma_f32_32x32x16_bf16(PAF(3),VFR(3),o[0],0,0,0), C1,8); \
    GAPB(o[1]=__builtin_amdgcn_mfma_f32_32x32x16_bf16(PAF(3),VFR(7),o[1],0,0,0), C1,12); \
    }while(0)
  #define ENDW(tt) do{ if((tt)+3<NT){WAIT_BAR(2);} else if((tt)+2<NT){WAIT_BAR(1);} else {WAIT_BAR(0);} }while(0)
  int t=1;
  for(;t+1<NT;t+=2){
    STEP(pB0,pB1,pA0,pA1,t,(t+3<NT),(t+1<NT),(t+1<NT));       ENDW(t);   RESC(); ROT();
    STEP(pA0,pA1,pB0,pB1,t+1,(t+4<NT),(t+2<NT),(t+2<NT));     ENDW(t+1); RESC(); ROT();
  }
  STEP(pB0,pB1,pA0,pA1,NT-1,false,false,false); RESC();
  { float sacc=pB0[0]+pB0[1]; _Pragma("unroll") for(int r=2;r<16;++r)sacc+=pB0[r]; _Pragma("unroll") for(int r=0;r<16;++r)sacc+=pB1[r]; l_reg+=sacc;
    pw0=(u32x4){PKW(pB0,0),PKW(pB0,2),PKW(pB0,4),PKW(pB0,6)};pw1=(u32x4){PKW(pB0,8),PKW(pB0,10),PKW(pB0,12),PKW(pB0,14)};pw2=(u32x4){PKW(pB1,0),PKW(pB1,2),PKW(pB1,4),PKW(pB1,6)};pw3=(u32x4){PKW(pB1,8),PKW(pB1,10),PKW(pB1,12),PKW(pB1,14)};
    SBAR(); pv(o,(int)(unsigned)(uintptr_t)vp0+sl_cur,PAF(0),PAF(1),PAF(2),PAF(3)); }
  #undef PKW
  #undef PAF
  #undef VFR
  #undef PIN
  #undef MX3
  #undef GAPA
  #undef GAPB
  #undef EX
  #undef VRD
  #undef KRD
  #undef STEP
  #undef ENDW
  {auto rr=__builtin_amdgcn_permlane32_swap(__float_as_uint(l_reg),__float_as_uint(l_reg),false,false);l_reg=__uint_as_float(rr[0])+__uint_as_float(rr[1]);}
  if(MODE==1 && hi==0) LSE[qrel]=0.6931471805599453f*(mhat+__log2f(l_reg));
  if(hi==0)wsf[32+r32]=l_reg;asm volatile("s_waitcnt lgkmcnt(0)":::"memory");
  float rli[16];
  #pragma unroll
  for(int r=0;r<16;++r)rli[r]=__builtin_amdgcn_rcpf(wsf[32+crow(r,hi)]);
  bf16*Ow=O+(long)(wid*QBLK)*opitch;
  { __hip_bfloat16*stg=(__hip_bfloat16*)(shm+LDS_OST)+wid*2048;
    #pragma unroll
    for(int r=0;r<16;++r){const int orow=crow(r,hi);
      #pragma unroll
      for(int d0=0;d0<2;++d0)stg[orow*64+d0*32+r32]=__float2bfloat16(o[d0][r]*rli[r]);}
    asm volatile("s_waitcnt lgkmcnt(0)":::"memory");
    #pragma unroll
    for(int i=0;i<4;++i){const int row=i*8+(lane>>3),ch=lane&7; const u32x4 v=*(const u32x4*)(stg+row*64+ch*8); ATTN_STORE16(Ow+(long)row*opitch+ch*8,v);} }
  asm volatile("s_waitcnt lgkmcnt(0)\n\ts_barrier":::"memory");
  #undef DMA_K
  #undef DMA_V
  #undef TM
  #undef CMASK
  #undef START
  #undef RESC
  #undef ROT
}
#undef SBAR
#undef WAIT_BAR
}

constexpr int NWAVES = 8;
constexpr int NB = 4, SEQ = 4096, T = NB * SEQ, D = 1024;
constexpr int EVEN_IN = 2816, EVEN_OUT = 512, ODD_IN = 3072, ODD_OUT = 1024, DFF = 2816, NEXP = 8, DFFE = 3584;
constexpr int MOE_ROWS = 2 * T + NEXP * 256;
constexpr float EPS = 1e-6f;
constexpr size_t MiB = 1u << 20;
constexpr size_t WS_CTL = 0, CTL_ZERO_BYTES = 2 * MiB;
constexpr size_t WS_ROPE = 2 * MiB;
constexpr size_t WS_MISC = 3 * MiB;
constexpr size_t WS_KMEAN = 4 * MiB;
constexpr size_t WS_WT = 8 * MiB;
constexpr size_t WT_EVEN_BYTES = 23 * MiB, WT_ODD_BYTES = 176 * MiB;
constexpr size_t WTE_IN = 0, WTE_OUT = 5 * MiB + MiB / 2, WTE_GU = 6 * MiB + MiB / 2, WTE_DN = 17 * MiB + MiB / 2;
constexpr size_t WTO_IN = 0, WTO_OUT = 6 * MiB, WTO_MGU = 8 * MiB, WTO_MD = 120 * MiB;
constexpr size_t WS_WT_EVEN0 = WS_WT, WS_WT_ODD0 = WS_WT + 2 * WT_EVEN_BYTES;
constexpr size_t WS_HN = WS_WT + 2 * WT_EVEN_BYTES + 2 * WT_ODD_BYTES;
constexpr size_t WS_P = WS_HN + 32 * MiB;
constexpr size_t WS_MIX = WS_P + 96 * MiB;
constexpr size_t WS_HID = WS_MIX + 32 * MiB;
constexpr size_t WS_END = WS_HID + 238 * MiB;
static_assert(WS_HN == 406 * MiB && WS_END == 804 * MiB, "ws map");
constexpr size_t P_UV = 0, P_QS = 16 * MiB, P_KS = 40 * MiB, P_VS = 64 * MiB, P_QM = 0, P_KM = 24 * MiB, P_VM = 48 * MiB;
constexpr size_t H_RAWP = 0, H_OG = 96 * MiB, H_LSE = 120 * MiB;
constexpr int CW_TMO = 0, CW_CODE = 1, CW_BAR = 4096;
constexpr size_t CTL_KMSUM = 256 * 1024, KMSUM_BYTES = 256 * 1024;
constexpr size_t P_CONV = 72 * MiB;
constexpr int RING_OFF = 0, RING_BYTES = 131072, LDSCTL_OFF = RING_BYTES, MISC_OFF = LDSCTL_OFF + 320, LDS_BYTES = 147456;

#define GAS __attribute__((address_space(1)))
#define LAS __attribute__((address_space(3)))
typedef unsigned short bf16;
typedef unsigned v4u __attribute__((ext_vector_type(4)));
typedef unsigned v2u __attribute__((ext_vector_type(2)));
typedef float f32x4 __attribute__((ext_vector_type(4)));
typedef GAS unsigned gu32;
#define RLX_AGENT __ATOMIC_RELAXED, __HIP_MEMORY_SCOPE_AGENT
#define LDS_WAIT() asm volatile("s_waitcnt lgkmcnt(0)" ::: "memory")
#define VM_WAIT() asm volatile("s_waitcnt vmcnt(0)" ::: "memory")
__device__ __forceinline__ unsigned f2bf(float f) { unsigned u = __builtin_bit_cast(unsigned, f); return (u + 0x7fffu + ((u >> 16) & 1u)) >> 16; }
__device__ __forceinline__ unsigned pk2(float lo, float hi) { return f2bf(lo) | (f2bf(hi) << 16); }
__device__ __forceinline__ float bf2f(unsigned short b) { return __builtin_bit_cast(float, ((unsigned)b) << 16); }
__device__ __forceinline__ float bflo(unsigned w) { return __builtin_bit_cast(float, w << 16); }
__device__ __forceinline__ float bfhi(unsigned w) { return __builtin_bit_cast(float, w & 0xffff0000u); }

#define XB_TMO      128
#define XB_XCNT(j)  (256  + 64 * (j))
#define XB_XSUB(j)  (1280 + 64 * (j))
#define XB_XGEN(j)  (2304 + 64 * (j))
#define XB_TOP      3328
#define XB_TOPGEN   3392
#define XCD_BAR_WORDS 3456
#define XB_SPIN_CAP (1u << 22)
__device__ __forceinline__ unsigned xb_ld(unsigned* p)              { return __hip_atomic_load(p, __ATOMIC_RELAXED, __HIP_MEMORY_SCOPE_AGENT); }
__device__ __forceinline__ unsigned xb_add(unsigned* p, unsigned v) { return __hip_atomic_fetch_add(p, v, __ATOMIC_RELAXED, __HIP_MEMORY_SCOPE_AGENT); }
__device__ __forceinline__ unsigned xb_xcc_id() { return (unsigned)__builtin_amdgcn_s_getreg((3 << 11) | 20) & 0xFu; }
#define XB_SPIN(cond, bar) do { unsigned _sp = 0; while (cond) { __builtin_amdgcn_s_sleep(1); \
    if ((++_sp & 255u) == 0u) { if (xb_ld(&(bar)[XB_TMO])) break; if (_sp > XB_SPIN_CAP) { atomicAdd(&(bar)[XB_TMO], 1u); break; } } } } while (0)
struct XcdBarrier { unsigned* bar; unsigned x; volatile LAS unsigned* st; };
__device__ __forceinline__ XcdBarrier xcd_barrier_post(unsigned* bar, volatile LAS unsigned* st) {
    XcdBarrier b; b.bar = bar; b.x = xb_xcc_id(); b.st = st;
    if (threadIdx.x == 0) (void)xb_add(&bar[XB_XCNT(b.x)], 1u);
    return b;
}
__device__ __forceinline__ void xcd_barrier_complete(unsigned* bar, unsigned x, unsigned& nloc, unsigned& nx) {
    const unsigned G = gridDim.x * gridDim.y * gridDim.z;
    unsigned sum, cnt, mine, sp = 0u;
    for (;;) {
        sum = 0u; cnt = 0u; mine = 0u;
#pragma unroll
        for (unsigned j = 0; j < 16; ++j) { const unsigned c = xb_ld(&bar[XB_XCNT(j)]); sum += c; cnt += (c > 0u) ? 1u : 0u; mine = (j == x) ? c : mine; }
        if (sum == G) break;
        __builtin_amdgcn_s_sleep(1);
        if ((++sp & 255u) == 0u) { if (xb_ld(&bar[XB_TMO])) break; if (sp > XB_SPIN_CAP) { atomicAdd(&bar[XB_TMO], 1u); break; } }
    }
    nloc = mine > 0u ? mine : 1u; nx = cnt > 0u ? cnt : 1u;
}
__device__ __forceinline__ void xcd_barrier(const XcdBarrier& b) {
    asm volatile("s_waitcnt vmcnt(0)" ::: "memory");
    __syncthreads();
    if (threadIdx.x == 0) {
        unsigned* bar = b.bar;
        __builtin_amdgcn_s_waitcnt(0);
        unsigned nloc = b.st[0], nx = b.st[1];
        if (nloc == 0u) { xcd_barrier_complete(bar, b.x, nloc, nx); b.st[0] = nloc; b.st[1] = nx; }
        const unsigned old = xb_add(&bar[XB_XSUB(b.x)], 1u);
        const unsigned gen = old / nloc;
        if (old + 1u == (gen + 1u) * nloc) {
            __builtin_amdgcn_fence(__ATOMIC_RELEASE, "agent");
            asm volatile("s_waitcnt vmcnt(0)" ::: "memory");
            const unsigned og = xb_add(&bar[XB_TOP], 1u);
            const unsigned tg = og / nx;
            if (og + 1u == (tg + 1u) * nx) xb_add(&bar[XB_TOPGEN], 1u);
            else XB_SPIN(xb_ld(&bar[XB_TOPGEN]) == tg, bar);
            __builtin_amdgcn_fence(__ATOMIC_ACQUIRE, "agent");
            xb_add(&bar[XB_XGEN(b.x)], 1u);
            asm volatile("s_waitcnt vmcnt(0)" ::: "memory");
        } else {
            XB_SPIN(xb_ld(&bar[XB_XGEN(b.x)]) == gen, bar);
            __builtin_amdgcn_fence(__ATOMIC_ACQUIRE, "agent");
            asm volatile("s_waitcnt vmcnt(0)" ::: "memory");
        }
    }
    __syncthreads();
}

struct Args { const float* in[22]; float* out; unsigned char* ws; int ph_lo, ph_hi; };
struct Frame {
    LAS unsigned char* lds; volatile LAS unsigned* MISC; gu32* ctl;
    int tid, lane, wave, G, blk;
    unsigned char* ws; float* out;
};
struct Route { int e1, e2; float g1, g2; };

__device__ __forceinline__ float wave_sum(float v) { v += xswz<1>(v); v += xswz<2>(v); v += xswz<4>(v); v += xswz<8>(v); v += xswz<16>(v); return xsum32(v); }
__device__ __forceinline__ float wave_max(float v) { v = fmaxf(v, xswz<1>(v)); v = fmaxf(v, xswz<2>(v)); v = fmaxf(v, xswz<4>(v)); v = fmaxf(v, xswz<8>(v)); v = fmaxf(v, xswz<16>(v)); return xmax32(v); }
__device__ __forceinline__ int wave_sumi(int v) { v += xswzi<1>(v); v += xswzi<2>(v); v += xswzi<4>(v); v += xswzi<8>(v); v += xswzi<16>(v); return xsum32i(v); }
__device__ __forceinline__ float gelu_tanh(float x) {
    const float y = 0.7978845608028654f * (x + 0.044715f * x * x * x);
    const float e = __expf(2.0f * y);
    const float th = 1.0f - 2.0f / (e + 1.0f);
    return 0.5f * x * (1.0f + th);
}

__device__ __forceinline__ int rowmap(int mode, int n) {
    if (mode == 0) return n;
    if (mode == 3) { const int w = n & 255, wc = w >> 6, dd = w & 63, bj = dd >> 5, e = dd & 31, fq = e >> 3, nn = (e >> 2) & 1, j = e & 3; return (n & ~255) + 128 * bj + 32 * wc + 16 * nn + 4 * fq + j; }
    return 256 * (n >> 7) + (n & 127) + (mode == 2 ? 128 : 0);
}
__device__ __forceinline__ void p0_transpose_item(const float* W, int K, int N, bf16* WT, int mode, LAS float* scr, int item, int lane) {
    const int nblk = N / 32, kb = item / nblk, nb = item % nblk, k0 = 64 * kb, n0 = 32 * nb;
#pragma unroll 8
    for (int i = 0; i < 32; ++i) { const int kk = 2 * i + (lane >> 5); scr[kk * 33 + (lane & 31)] = W[(size_t)(k0 + kk) * N + n0 + (lane & 31)]; }
    LDS_WAIT(); asm volatile("" ::: "memory");
    const int c = lane & 7;
#pragma unroll
    for (int j = 0; j < 4; ++j) { const int n = (lane >> 3) + 8 * j; const LAS float* s = scr + (8 * c) * 33 + n;
        v4u o; o.x = pk2(s[0 * 33], s[1 * 33]); o.y = pk2(s[2 * 33], s[3 * 33]); o.z = pk2(s[4 * 33], s[5 * 33]); o.w = pk2(s[6 * 33], s[7 * 33]);
        *(GAS v4u*)(WT + (size_t)rowmap(mode, n0 + n) * K + k0 + 8 * c) = o; }
    LDS_WAIT(); asm volatile("" ::: "memory");
}
struct WDesc { const float* src; bf16* dst; int K, N, nbatch, mode; size_t dst_bstride; };
__device__ __forceinline__ WDesc get_desc(const Args& a, int d) {
    const int layer = d / 10, k = d % 10; unsigned char* ws = a.ws;
    bf16* we = (bf16*)(ws + WS_WT_EVEN0 + (size_t)layer * WT_EVEN_BYTES); bf16* wo = (bf16*)(ws + WS_WT_ODD0 + (size_t)layer * WT_ODD_BYTES);
    WDesc w; w.nbatch = 1; w.mode = 0; w.dst_bstride = 0;
    switch (k) {
    case 0: w.src = a.in[3] + (size_t)layer * D * EVEN_IN; w.dst = we + WTE_IN / 2; w.K = D; w.N = EVEN_IN; w.mode = 3; break;
    case 1: w.src = a.in[9] + (size_t)layer * EVEN_OUT * D; w.dst = we + WTE_OUT / 2; w.K = EVEN_OUT; w.N = D; break;
    case 2: w.src = a.in[10] + (size_t)layer * D * DFF; w.dst = we + WTE_GU / 2; w.K = D; w.N = DFF; w.mode = 1; break;
    case 3: w.src = a.in[11] + (size_t)layer * D * DFF; w.dst = we + WTE_GU / 2; w.K = D; w.N = DFF; w.mode = 2; break;
    case 4: w.src = a.in[12] + (size_t)layer * DFF * D; w.dst = we + WTE_DN / 2; w.K = DFF; w.N = D; break;
    case 5: w.src = a.in[13] + (size_t)layer * D * ODD_IN; w.dst = wo + WTO_IN / 2; w.K = D; w.N = ODD_IN; w.mode = 3; break;
    case 6: w.src = a.in[17] + (size_t)layer * ODD_OUT * D; w.dst = wo + WTO_OUT / 2; w.K = ODD_OUT; w.N = D; break;
    case 7: w.src = a.in[19] + (size_t)layer * NEXP * D * DFFE; w.dst = wo + WTO_MGU / 2; w.K = D; w.N = DFFE; w.mode = 1; w.nbatch = NEXP; w.dst_bstride = (size_t)2 * DFFE * D; break;
    case 8: w.src = a.in[20] + (size_t)layer * NEXP * D * DFFE; w.dst = wo + WTO_MGU / 2; w.K = D; w.N = DFFE; w.mode = 2; w.nbatch = NEXP; w.dst_bstride = (size_t)2 * DFFE * D; break;
    default: w.src = a.in[21] + (size_t)layer * NEXP * DFFE * D; w.dst = wo + WTO_MD / 2; w.K = DFFE; w.N = D; w.nbatch = NEXP; w.dst_bstride = (size_t)DFFE * D; break;
    }
    return w;
}
__device__ __forceinline__ void p0_prologue(Frame& F, const Args& a) {
    LAS float* scr = (LAS float*)(F.lds + RING_OFF + F.wave * 16384);
    const int gw = F.blk * NWAVES + F.wave, NGW = F.G * NWAVES;
    for (int d = 0; d < 20; ++d) {
        const WDesc w = get_desc(a, d);
        const int per = (w.K / 64) * (w.N / 32), nitems = per * w.nbatch;
        for (int it = gw; it < nitems; it += NGW) { const int bt = it / per, r = it % per;
            p0_transpose_item(w.src + (size_t)bt * w.K * w.N, w.K, w.N, w.dst + (size_t)bt * w.dst_bstride, w.mode, scr, r, F.lane); }
    }
    float* cs = (float*)(a.ws + WS_ROPE); float* sn = cs + SEQ * 32;
    for (int i = F.blk * 512 + F.tid; i < SEQ * 32; i += F.G * 512) { const int pos = i >> 5, j = i & 31;
        const float inv = 1.0f / powf(10000.0f, (float)j * (1.0f / 32.0f)); const float ang = (float)pos * inv;
        cs[i] = cosf(ang); sn[i] = sinf(ang); }
}

__device__ __forceinline__ void norm_phase(Frame& F, const float* xsrc, float* xdst, const float* gain, bf16* hn, bool do_combine, bool do_router, bool write_hn, const float* router_w) {
    unsigned char* ws = F.ws;
    const Route* route = (const Route*)(ws + WS_MISC); const int* slots = (const int*)(ws + WS_MISC + 256 * 1024); int* ccnt = (int*)(ws + WS_MISC + 384 * 1024);
    const bf16* Y = (const bf16*)(ws + WS_P);
    LAS float* wr = (LAS float*)(F.lds + RING_OFF);
    LAS int* lcnt = (LAS int*)(F.lds + RING_OFF + 32768);
    if (do_router) { for (int i = F.tid; i < 8192; i += 512) { const int d = i >> 3, e = i & 7; wr[e * 1024 + d] = router_w[i]; } }
    const int lane = F.lane;
    f32x4 gv[4];
#pragma unroll
    for (int j = 0; j < 4; ++j) gv[j] = *((const f32x4*)gain + lane + 64 * j);
    for (int c = F.blk; c < T / 64; c += F.G) {
        if (do_router) { if (F.tid < 8) lcnt[F.tid] = 0; }
        __syncthreads();
        for (int k = 0; k < 8; ++k) {
            const int row = c * 64 + F.wave * 8 + k;
            const f32x4* xr = (const f32x4*)(xsrc + (size_t)row * D) + lane;
            f32x4 v[4];
#pragma unroll
            for (int j = 0; j < 4; ++j) v[j] = xr[64 * j];
            if (do_combine) {
                const Route r = route[row]; const int s1 = slots[2 * row], s2 = slots[2 * row + 1];
                const v2u* y1 = (const v2u*)(Y + (size_t)s1 * D) + lane; const v2u* y2 = (const v2u*)(Y + (size_t)s2 * D) + lane;
#pragma unroll
                for (int j = 0; j < 4; ++j) { const v2u a = y1[64 * j], b = y2[64 * j];
                    v[j].x += r.g1 * bflo(a.x) + r.g2 * bflo(b.x); v[j].y += r.g1 * bfhi(a.x) + r.g2 * bfhi(b.x);
                    v[j].z += r.g1 * bflo(a.y) + r.g2 * bflo(b.y); v[j].w += r.g1 * bfhi(a.y) + r.g2 * bfhi(b.y); }
                f32x4* xo = (f32x4*)(xdst + (size_t)row * D) + lane;
#pragma unroll
                for (int j = 0; j < 4; ++j) xo[64 * j] = v[j];
            }
            if (write_hn) {
                float ss = 0.f;
#pragma unroll
                for (int j = 0; j < 4; ++j) ss += (v[j].x * v[j].x + v[j].y * v[j].y) + (v[j].z * v[j].z + v[j].w * v[j].w);
                ss = wave_sum(ss);
                const float rstd = 1.0f / sqrtf(ss * (1.0f / D) + EPS);
#pragma unroll
                for (int j = 0; j < 4; ++j) v[j] = v[j] * rstd * gv[j];
                v2u* o8 = (v2u*)(hn + (size_t)row * D) + lane;
#pragma unroll
                for (int j = 0; j < 4; ++j) { v2u o; o.x = pk2(v[j].x, v[j].y); o.y = pk2(v[j].z, v[j].w); o8[64 * j] = o; }
                if (do_router) {
                    float lg[8];
#pragma unroll
                    for (int e = 0; e < 8; ++e) { float s = 0.f;
#pragma unroll
                        for (int j = 0; j < 4; ++j) { const f32x4 w = *((const LAS f32x4*)(wr + e * 1024) + lane + 64 * j); s += (v[j].x * w.x + v[j].y * w.y) + (v[j].z * w.z + v[j].w * w.w); }
                        lg[e] = wave_sum(s); }
                    int e1 = 0; float v1 = lg[0];
#pragma unroll
                    for (int e = 1; e < 8; ++e) if (lg[e] > v1) { v1 = lg[e]; e1 = e; }
                    int e2 = -1; float v2 = -INFINITY;
#pragma unroll
                    for (int e = 0; e < 8; ++e) if (e != e1 && lg[e] > v2) { v2 = lg[e]; e2 = e; }
                    const float g2 = 1.0f / (1.0f + __expf(v1 - v2)), g1 = 1.0f - g2;
                    if (lane == 0) { Route r; r.e1 = e1; r.e2 = e2; r.g1 = g1; r.g2 = g2; ((Route*)route)[row] = r; __hip_atomic_fetch_add(&lcnt[e1], 1, __ATOMIC_RELAXED, __HIP_MEMORY_SCOPE_WORKGROUP); __hip_atomic_fetch_add(&lcnt[e2], 1, __ATOMIC_RELAXED, __HIP_MEMORY_SCOPE_WORKGROUP); }
                }
            }
        }
        __syncthreads();
        if (do_router) { if (F.tid < 8) ccnt[c * 8 + F.tid] = lcnt[F.tid]; }
        __syncthreads();
    }
}

__device__ __forceinline__ void route_phase(Frame& F, const bf16* hn, bf16* hsort) {
    unsigned char* ws = F.ws;
    const Route* route = (const Route*)(ws + WS_MISC); int* slots = (int*)(ws + WS_MISC + 256 * 1024); const int* ccnt = (const int*)(ws + WS_MISC + 384 * 1024); int* tile_base = (int*)(ws + WS_MISC + 512 * 1024);
    LAS int* tot = (LAS int*)(F.lds + RING_OFF); LAS int* bef = tot + 8; LAS int* base = tot + 16; LAS int* sl = tot + 32;
    for (int c = F.blk; c < T / 64; c += F.G) {
        { const int e = F.wave; int t = 0, b = 0;
#pragma unroll
            for (int q = 0; q < 4; ++q) { const int ch = F.lane * 4 + q; const int v = ccnt[ch * 8 + e]; t += v; b += (ch < c) ? v : 0; }
            t = wave_sumi(t); b = wave_sumi(b);
            if (F.lane == 0) { tot[e] = t; bef[e] = b; } }
        __syncthreads();
        if (F.tid == 0) { int acc = 0;
            for (int e = 0; e < 8; ++e) { base[e] = acc; if (c == 0) tile_base[e] = acc >> 8; acc += (tot[e] + 255) & ~255; }
            if (c == 0) tile_base[8] = acc >> 8; }
        __syncthreads();
        if (F.wave == 0) {
            const int row = c * 64 + F.lane; const Route r = route[row];
            int run[8];
#pragma unroll
            for (int e = 0; e < 8; ++e) run[e] = base[e] + bef[e];
#pragma unroll
            for (int k = 0; k < 2; ++k) { const int me = k ? r.e2 : r.e1; int myslot = 0;
#pragma unroll
                for (int e = 0; e < 8; ++e) { const unsigned long long m = __ballot(me == e); const int rank = __popcll(m & ((1ull << F.lane) - 1ull));
                    if (me == e) myslot = run[e] + rank; run[e] += __popcll(m); }
                slots[2 * row + k] = myslot; sl[2 * F.lane + k] = myslot; }
        }
        __syncthreads();
        for (int p = F.wave; p < 128; p += NWAVES) { const int row = c * 64 + (p >> 1); const int s = sl[p];
            const v4u* src = (const v4u*)(hn + (size_t)row * D); v4u* dst = (v4u*)(hsort + (size_t)s * D);
            dst[F.lane] = src[F.lane]; dst[F.lane + 64] = src[F.lane + 64]; }
        __syncthreads();
    }
}

__device__ __forceinline__ int srow(int s, int g) { return g == 0 ? s : (g == 1 ? ((s & 3) * 1024 + (s >> 2)) : ((s & 15) * 256 + (s >> 4))); }
__device__ __forceinline__ float rope_apply(float n, int lane, const float* cs, const float* sn, int s) {
    const float partner = __shfl_xor(n, 32); const int j = lane & 31; const float c = cs[s * 32 + j], si = sn[s * 32 + j];
    return lane < 32 ? n * c - partner * si : n * c + partner * si;
}
__device__ __forceinline__ void post_even(Frame& F, const bf16* rawp, const float* vgain, const float* qgain, const float* kgain) {
    unsigned char* ws = F.ws; bf16* UV = (bf16*)(ws + WS_P + P_UV); bf16* Qs = (bf16*)(ws + WS_P + P_QS); bf16* Ks = (bf16*)(ws + WS_P + P_KS); bf16* Vs = (bf16*)(ws + WS_P + P_VS);
    const float* cs = (const float*)(ws + WS_ROPE); const float* sn = cs + SEQ * 32;
    const int lane = F.lane; const float qg = qgain[lane], kg = kgain[lane];
    const long nitems = (long)T * 44;
    for (long it = (long)F.blk * NWAVES + F.wave; it < nitems; it += (long)F.G * NWAVES) {
        const int row = (int)(it / 44), u = (int)(it % 44), b = row >> 12, s = row & 4095;
        const float v = bf2f(rawp[(size_t)row * EVEN_IN + 64 * u + lane]);
        if (u < 4) { UV[(size_t)row * 512 + 64 * u + lane] = (bf16)f2bf(gelu_tanh(v)); }
        else if (u < 8) { const float z = gelu_tanh(v); const float ss = wave_sum(z * z); const float o = z * (1.0f / sqrtf(ss * (1.0f / 64) + EPS)) * vgain[(u - 4) * 64 + lane];
            UV[(size_t)row * 512 + 64 * u + lane] = (bf16)f2bf(o); }
        else if (u < 32) { const bool isq = u < 20; const int h = isq ? u - 8 : u - 20; const float ss = wave_sum(v * v);
            const float n = v * (1.0f / sqrtf(ss * (1.0f / 64) + EPS)) * (isq ? qg : kg); const float o = rope_apply(n, lane, cs, sn, s);
            (isq ? Qs : Ks)[((size_t)(b * 12 + h) * SEQ + srow(s, h >> 2)) * 64 + lane] = (bf16)f2bf(isq ? o * att::C2 : o); }
        else { const int h = u - 32; Vs[((size_t)(b * 12 + h) * SEQ + srow(s, h >> 2)) * 64 + lane] = (bf16)f2bf(v); }
    }
}
__device__ __forceinline__ void post_odd(Frame& F, const bf16* rawp, const float* qgain, const float* kgain) {
    unsigned char* ws = F.ws; bf16* Qm = (bf16*)(ws + WS_P + P_QM); bf16* Km = (bf16*)(ws + WS_P + P_KM); bf16* Vm = (bf16*)(ws + WS_P + P_VM);
    const float* cs = (const float*)(ws + WS_ROPE); const float* sn = cs + SEQ * 32;
    const int lane = F.lane; const float qg = qgain[lane], kg = kgain[lane];
    const long nitems = (long)T * 36;
    for (long it = (long)F.blk * NWAVES + F.wave; it < nitems; it += (long)F.G * NWAVES) {
        const int row = (int)(it / 36), u = (int)(it % 36), b = row >> 12, s = row & 4095;
        const float v = bf2f(rawp[(size_t)row * ODD_IN + 64 * u + lane]);
        if (u < 24) { const bool isq = u < 12; const int h = isq ? u : u - 12; const float ss = wave_sum(v * v);
            const float n = v * (1.0f / sqrtf(ss * (1.0f / 64) + EPS)) * (isq ? qg : kg); const float o = rope_apply(n, lane, cs, sn, s);
            (isq ? Qm : Km)[((size_t)(b * 12 + h) * SEQ + s) * 64 + lane] = (bf16)f2bf(isq ? o * att::C2 : o); }
        else { const int h = u - 24; Vm[((size_t)(b * 12 + h) * SEQ + s) * 64 + lane] = (bf16)f2bf(v); }
    }
}
__device__ __forceinline__ void kmean_phase(Frame& F) {
    const bf16* Km = (const bf16*)(F.ws + WS_P + P_KM); float* km = (float*)(F.ws + WS_KMEAN);
    for (int it = F.blk * NWAVES + F.wave; it < 48 * 16; it += F.G * NWAVES) {
        const bf16* k = Km + (size_t)it * 256 * 64 + F.lane; float s = 0.f;
        for (int r = 0; r < 256; ++r) s += bf2f(k[r * 64]);
        km[it * 64 + F.lane] = s * (1.0f / 256.0f);
    }
}

__device__ __forceinline__ void load_row64(const bf16* p, float (&q)[64]) {
    const v4u* p4 = (const v4u*)p;
#pragma unroll
    for (int i = 0; i < 8; ++i) { const v4u w = p4[i]; q[8 * i + 0] = bflo(w.x); q[8 * i + 1] = bfhi(w.x); q[8 * i + 2] = bflo(w.y); q[8 * i + 3] = bfhi(w.y); q[8 * i + 4] = bflo(w.z); q[8 * i + 5] = bfhi(w.z); q[8 * i + 6] = bflo(w.w); q[8 * i + 7] = bfhi(w.w); }
}
__device__ __forceinline__ float dot_row64(const bf16* p, const float (&q)[64]) {
    const v4u* p4 = (const v4u*)p; float s = 0.f;
#pragma unroll
    for (int i = 0; i < 8; ++i) { const v4u w = p4[i]; s += q[8 * i + 0] * bflo(w.x) + q[8 * i + 1] * bfhi(w.x) + q[8 * i + 2] * bflo(w.y) + q[8 * i + 3] * bfhi(w.y) + q[8 * i + 4] * bflo(w.z) + q[8 * i + 5] * bfhi(w.z) + q[8 * i + 6] * bflo(w.w) + q[8 * i + 7] * bfhi(w.w); }
    return s;
}
__device__ __forceinline__ void banded_naive(Frame& F) {
    unsigned char* ws = F.ws; const bf16* Qs = (const bf16*)(ws + WS_P + P_QS); const bf16* Ks = (const bf16*)(ws + WS_P + P_KS); const bf16* Vs = (const bf16*)(ws + WS_P + P_VS);
    bf16* OG = (bf16*)(ws + WS_HID + H_OG); float* LSE = (float*)(ws + WS_HID + H_LSE);
    LAS float* pl = (LAS float*)(F.lds + RING_OFF) + F.wave * 256;
    const int lane = F.lane;
    for (int it = F.blk * NWAVES + F.wave; it < 48 * SEQ; it += F.G * NWAVES) {
        const int bh = it >> 12, rp = it & 4095, b = bh / 12, h = bh % 12, g = h >> 2, dil = g == 0 ? 1 : (g == 1 ? 4 : 16), L = SEQ / dil;
        const int i = rp % L, r = rp / L, s = i * dil + r, nk = (i < 128 ? i : 128) + 1, first = rp - (nk - 1);
        float q[64]; load_row64(Qs + ((size_t)bh * SEQ + rp) * 64, q);
        float sc[3]; float m = -INFINITY;
#pragma unroll
        for (int kk = 0; kk < 3; ++kk) { const int j = lane + 64 * kk; sc[kk] = -INFINITY; if (j < nk) { sc[kk] = 0.6931471805599453f * dot_row64(Ks + ((size_t)bh * SEQ + first + j) * 64, q); } m = fmaxf(m, sc[kk]); }
        m = wave_max(m); float l = 0.f;
#pragma unroll
        for (int kk = 0; kk < 3; ++kk) { const float p = (lane + 64 * kk < nk) ? __expf(sc[kk] - m) : 0.f; pl[lane + 64 * kk] = p; l += p; }
        l = wave_sum(l); LDS_WAIT();
        float acc = 0.f; const bf16* vb = Vs + ((size_t)bh * SEQ + first) * 64 + lane;
        for (int j = 0; j < nk; ++j) acc += pl[j] * bf2f(vb[(size_t)j * 64]);
        const size_t orow = ((size_t)g * T + (size_t)b * SEQ + s) * 4 + (h & 3);
        OG[orow * 64 + lane] = (bf16)f2bf(acc / l);
        if (lane == 0) LSE[orow] = m + __logf(l);
        LDS_WAIT();
    }
}
__device__ __forceinline__ void merge_even(Frame& F, bf16* mix) {
    const bf16* OG = (const bf16*)(F.ws + WS_HID + H_OG); const float* LSE = (const float*)(F.ws + WS_HID + H_LSE);
    for (int it = F.blk * NWAVES + F.wave; it < T * 4; it += F.G * NWAVES) {
        const int row = it >> 2, hg = it & 3, b = row >> 12, s = row & 4095;
        size_t i0, i1, i2;
#if NAIVE_BANDED
        i0 = it; i1 = (size_t)T * 4 + it; i2 = (size_t)2 * T * 4 + it;
#else
        i0 = ((size_t)0 * 16 + b * 4 + hg) * SEQ + srow(s, 0); i1 = ((size_t)1 * 16 + b * 4 + hg) * SEQ + srow(s, 1); i2 = ((size_t)2 * 16 + b * 4 + hg) * SEQ + srow(s, 2);
#endif
        const float l0 = LSE[i0], l1 = LSE[i1], l2 = LSE[i2]; const float m = fmaxf(l0, fmaxf(l1, l2));
        const float w0 = __expf(l0 - m), w1 = __expf(l1 - m), w2 = __expf(l2 - m), inv = 1.0f / (w0 + w1 + w2);
        const float o = (w0 * bf2f(OG[i0 * 64 + F.lane]) + w1 * bf2f(OG[i1 * 64 + F.lane]) + w2 * bf2f(OG[i2 * 64 + F.lane])) * inv;
        mix[(size_t)row * EVEN_OUT + 256 + hg * 64 + F.lane] = (bf16)f2bf(o);
    }
}
__device__ __forceinline__ void gmlp_phase(Frame& F, const float* wsp, const float* bsp, bf16* mix) {
    const bf16* UV = (const bf16*)(F.ws + WS_P + P_UV);
    LAS float* WT = (LAS float*)(F.lds + RING_OFF);
    LAS float* VL = WT + 128 * 128;
    const int tid = F.tid;
    for (int unit = F.blk; unit < (T / 128) * 4; unit += F.G) {
        const int c = unit >> 2, g = unit & 3, row0 = c * 128;
        __syncthreads();
        { const int i = tid & 127; const float* wrow = wsp + ((size_t)g * 128 + i) * 128;
          for (int jq = tid >> 7; jq < 32; jq += 4) { const f32x4 w = *(const f32x4*)(wrow + 4 * jq);
              WT[(4 * jq + 0) * 128 + i] = (4 * jq + 0 <= i) ? w.x : 0.f; WT[(4 * jq + 1) * 128 + i] = (4 * jq + 1 <= i) ? w.y : 0.f;
              WT[(4 * jq + 2) * 128 + i] = (4 * jq + 2 <= i) ? w.z : 0.f; WT[(4 * jq + 3) * 128 + i] = (4 * jq + 3 <= i) ? w.w : 0.f; } }
        for (int e = tid; e < 128 * 64; e += 512) { const int j = e >> 6, d = e & 63; VL[e] = bf2f(UV[(size_t)(row0 + j) * 512 + 256 + g * 64 + d]); }
        __syncthreads();
        const int i0 = 4 * (tid >> 4), d0 = 4 * (tid & 15);
        f32x4 acc[4];
#pragma unroll
        for (int a = 0; a < 4; ++a) acc[a] = (f32x4){0.f, 0.f, 0.f, 0.f};
        const int jmax = i0 + 3;
        for (int j = 0; j <= jmax; ++j) { const f32x4 w = *(const LAS f32x4*)(WT + j * 128 + i0); const f32x4 v = *(const LAS f32x4*)(VL + j * 64 + d0);
            acc[0] += w.x * v; acc[1] += w.y * v; acc[2] += w.z * v; acc[3] += w.w * v; }
#pragma unroll
        for (int a = 0; a < 4; ++a) { const int i = i0 + a; const float bb = bsp[g * 128 + i]; const size_t row = row0 + i;
            const v2u uu = *(const v2u*)(UV + row * 512 + g * 64 + d0);
            v2u o; o.x = pk2(bflo(uu.x) * (acc[a].x + bb), bfhi(uu.x) * (acc[a].y + bb)); o.y = pk2(bflo(uu.y) * (acc[a].z + bb), bfhi(uu.y) * (acc[a].w + bb));
            *(v2u*)(mix + row * EVEN_OUT + g * 64 + d0) = o; }
    }
    __syncthreads();
}
__device__ __forceinline__ void moba_naive(Frame& F, bf16* mix) {
    unsigned char* ws = F.ws; const bf16* Qm = (const bf16*)(ws + WS_P + P_QM); const bf16* Km = (const bf16*)(ws + WS_P + P_KM); const bf16* Vm = (const bf16*)(ws + WS_P + P_VM);
    const float* km = (const float*)(ws + WS_KMEAN);
    LAS float* sc = (LAS float*)(F.lds + RING_OFF) + F.wave * 1024;
    const int lane = F.lane;
    for (int it = F.blk * NWAVES + F.wave; it < 48 * SEQ; it += F.G * NWAVES) {
        const int bh = it >> 12, s = it & 4095, b = bh / 12, h = bh % 12, qb = s >> 8;
        float q[64]; load_row64(Qm + ((size_t)bh * SEQ + s) * 64, q);
        float gate = -INFINITY;
        if (lane < qb) { const f32x4* kp = (const f32x4*)(km + ((size_t)bh * 16 + lane) * 64); float a = 0.f;
#pragma unroll
            for (int i = 0; i < 16; ++i) { const f32x4 w = kp[i]; a += q[4 * i] * w.x + q[4 * i + 1] * w.y + q[4 * i + 2] * w.z + q[4 * i + 3] * w.w; }
            gate = a; }
        unsigned sel = 1u << qb;
        for (int r = 0; r < 3; ++r) { float v = gate; int idx = lane;
#pragma unroll
            for (int o = 1; o < 64; o <<= 1) { const float ov = __shfl_xor(v, o); const int oi = __shfl_xor(idx, o); if (ov > v || (ov == v && oi < idx)) { v = ov; idx = oi; } }
            if (v > -INFINITY) { sel |= 1u << idx; if (lane == idx) gate = -INFINITY; } }
        int cnt = 0; float m = -INFINITY;
        for (int n = 0; n <= qb; ++n) { if (!((sel >> n) & 1u)) continue;
#pragma unroll
            for (int kk = 0; kk < 4; ++kk) { const int key = n * 256 + kk * 64 + lane; float x = -INFINITY;
                if (key <= s) x = 0.6931471805599453f * dot_row64(Km + ((size_t)bh * SEQ + key) * 64, q);
                sc[cnt * 256 + kk * 64 + lane] = x; m = fmaxf(m, x); }
            ++cnt; }
        m = wave_max(m); float l = 0.f; LDS_WAIT();
        for (int i = lane; i < cnt * 256; i += 64) { const float p = __expf(sc[i] - m); sc[i] = p; l += p; }
        l = wave_sum(l); LDS_WAIT();
        float acc = 0.f; int c2 = 0;
        for (int n = 0; n <= qb; ++n) { if (!((sel >> n) & 1u)) continue;
            const bf16* vb = Vm + ((size_t)bh * SEQ + n * 256) * 64 + lane; const int kend = (n == qb) ? (s & 255) + 1 : 256;
            for (int kk = 0; kk < kend; ++kk) acc += sc[c2 * 256 + kk] * bf2f(vb[(size_t)kk * 64]);
            ++c2; }
        mix[((size_t)b * SEQ + s) * ODD_OUT + h * 64 + lane] = (bf16)f2bf(acc / l);
        LDS_WAIT();
    }
}
__device__ __forceinline__ void conv_phase(Frame& F, const bf16* cv, const float* cw, bf16* mix) {
    for (int it = F.blk * 512 + F.tid; it < T * 256; it += F.G * 512) {
        const int row = it >> 8, c = it & 255, s = row & 4095;
        const bf16* p = cv + (size_t)row * 768;
        const float z0 = bf2f(p[256 + c]) * bf2f(p[512 + c]);
        const float z1 = s >= 1 ? bf2f(p[256 + c - 768]) * bf2f(p[512 + c - 768]) : 0.f;
        const float z2 = s >= 2 ? bf2f(p[256 + c - 1536]) * bf2f(p[512 + c - 1536]) : 0.f;
        const float y = cw[c] * z2 + cw[256 + c] * z1 + cw[512 + c] * z0;
        mix[(size_t)row * ODD_OUT + 768 + c] = (bf16)f2bf(bf2f(p[c]) * y);
    }
}

constexpr int CW_QMOBA = 8192;
__device__ __forceinline__ void moba_phase(Frame& F, int lp, bf16* mix) {
    unsigned char* ws = F.ws; const bf16* Qm = (const bf16*)(ws + WS_P + P_QM); const bf16* Km = (const bf16*)(ws + WS_P + P_KM); const bf16* Vm = (const bf16*)(ws + WS_P + P_VM);
    const float* km = (const float*)(ws + WS_CTL + CTL_KMSUM + (size_t)lp * KMSUM_BYTES);
    char* shm = (char*)F.lds + RING_OFF; LAS unsigned char* l3 = F.lds + RING_OFF;
    LAS float* kml = (LAS float*)(l3 + att::LDS_KM); volatile LAS int* tkw = (volatile LAS int*)(l3 + att::LDS_TK);
    unsigned* head = (unsigned*)(F.ctl + CW_QMOBA + 64 * lp);
    const int tid = F.tid, wid = F.wave;
    for (;;) {
        if (tid == 0) tkw[0] = (int)__hip_atomic_fetch_add(head, 1u, __ATOMIC_RELAXED, __HIP_MEMORY_SCOPE_AGENT);
        __syncthreads();
        const int tk = __builtin_amdgcn_readfirstlane(tkw[0]);
        if (tk >= 48 * 16) break;
        const int qb = 15 - tk / 48, bh = tk % 48, b = bh / 12, h = bh % 12;
        int lane_ = F.lane; asm volatile("" : "+v"(lane_)); const int r32 = lane_ & 31, hi = lane_ >> 5;
        ((LAS v2u*)kml)[tid] = ((const v2u*)(km + (size_t)bh * 1024))[tid];
        __syncthreads();
        unsigned sel = 0u;
        { const bf16* qrow = Qm + ((size_t)bh * SEQ + qb * 256 + wid * 32 + r32) * 64 + hi * 8;
          float qf[32];
#pragma unroll
          for (int d0 = 0; d0 < 4; ++d0) { const v4u w = *(const v4u*)(qrow + d0 * 16);
              qf[8 * d0 + 0] = bflo(w.x); qf[8 * d0 + 1] = bfhi(w.x); qf[8 * d0 + 2] = bflo(w.y); qf[8 * d0 + 3] = bfhi(w.y); qf[8 * d0 + 4] = bflo(w.z); qf[8 * d0 + 5] = bfhi(w.z); qf[8 * d0 + 6] = bflo(w.w); qf[8 * d0 + 7] = bfhi(w.w); }
          float v1 = -INFINITY, v2 = -INFINITY, v3 = -INFINITY; int i1 = 0, i2 = 0, i3 = 0;
          for (int n = 0; n < qb; ++n) { float a = 0.f;
#pragma unroll
              for (int d0 = 0; d0 < 4; ++d0) { const f32x4 k0 = *(const LAS f32x4*)(kml + n * 64 + d0 * 16 + hi * 8), k1 = *(const LAS f32x4*)(kml + n * 64 + d0 * 16 + hi * 8 + 4);
                  a += qf[8 * d0 + 0] * k0.x + qf[8 * d0 + 1] * k0.y + qf[8 * d0 + 2] * k0.z + qf[8 * d0 + 3] * k0.w + qf[8 * d0 + 4] * k1.x + qf[8 * d0 + 5] * k1.y + qf[8 * d0 + 6] * k1.z + qf[8 * d0 + 7] * k1.w; }
              a = xsum32(a);
              if (a > v1) { v3 = v2; i3 = i2; v2 = v1; i2 = i1; v1 = a; i1 = n; } else if (a > v2) { v3 = v2; i3 = i2; v2 = a; i2 = n; } else if (a > v3) { v3 = a; i3 = n; } }
          if (v1 > -INFINITY) sel |= 1u << i1; if (v2 > -INFINITY) sel |= 1u << i2; if (v3 > -INFINITY) sel |= 1u << i3; }
        const size_t sb = (size_t)bh * SEQ * 64;
        att::attn_unit<0, 8, ODD_OUT>(Qm + sb, qb * 256, 0, 4 * (qb + 1), sel, mix + ((size_t)b * SEQ + qb * 256) * ODD_OUT + h * 64, nullptr, shm);
    }
    __syncthreads();
}
__device__ __forceinline__ void banded_phase(Frame& F) {
    unsigned char* ws = F.ws; const bf16* Qs = (const bf16*)(ws + WS_P + P_QS); const bf16* Ks = (const bf16*)(ws + WS_P + P_KS); const bf16* Vs = (const bf16*)(ws + WS_P + P_VS);
    bf16* OG = (bf16*)(ws + WS_HID + H_OG); float* LSE = (float*)(ws + WS_HID + H_LSE);
    char* shm = (char*)F.lds + RING_OFF;
    for (int u = F.blk; u < 768; u += F.G) {
        const int g = u >> 8, rem = u & 255, b = rem >> 6, hg = (rem >> 4) & 3, u16 = rem & 15, h = g * 4 + hg, bh = b * 12 + h;
        const int dil = g == 0 ? 1 : (g == 1 ? 4 : 16), L = SEQ / dil, row0 = 256 * u16, r = row0 / L, q0s = row0 % L;
        const int tile0 = (q0s >> 6) >= 2 ? (q0s >> 6) - 2 : 0, NT = (q0s >> 6) + 4 - tile0;
        const size_t sb = ((size_t)bh * SEQ + (size_t)r * L) * 64;
        const size_t orow = ((size_t)g * 16 + b * 4 + hg) * SEQ + row0;
        att::attn_unit<1, 8, 64>(Qs + sb, q0s, tile0, NT, 0u, OG + orow * 64, LSE + orow, shm);
    }
    __syncthreads();
}

constexpr int PH_PER_PAIR = 16, NPH = 1 + 2 * PH_PER_PAIR + 1;
__global__ void __launch_bounds__(NWAVES * 64, 2) fwd(Args args) {
    extern __shared__ __attribute__((aligned(16))) unsigned char lds[];
#define MKFRAME() Frame F; { int t_ = threadIdx.x; asm volatile("" : "+v"(t_)); int b_ = blockIdx.x; asm volatile("" : "+s"(b_)); \
    F.lds = (LAS unsigned char*)lds; F.MISC = (volatile LAS unsigned*)(F.lds + MISC_OFF); F.tid = t_; F.lane = t_ & 63; F.wave = __builtin_amdgcn_readfirstlane(t_ >> 6); \
    unsigned char* w_ = args.ws; asm volatile("" : "+s"(w_)); F.G = gridDim.x; F.blk = b_; F.ws = w_; F.out = args.out; F.ctl = (gu32*)(w_ + WS_CTL); }
    for (int u = threadIdx.x; u < (LDS_BYTES - LDSCTL_OFF) / 4; u += NWAVES * 64) ((LAS unsigned*)((LAS unsigned char*)lds + LDSCTL_OFF))[u] = 0u;
    __syncthreads();
    const int lo = args.ph_lo, hi = args.ph_hi;
    XcdBarrier bar; bar.bar = (unsigned*)(args.ws + WS_CTL) + CW_BAR; bar.x = 0; bar.st = nullptr;
    if (hi - lo > 1) bar = xcd_barrier_post((unsigned*)(args.ws + WS_CTL) + CW_BAR, (volatile LAS unsigned*)((LAS unsigned char*)lds + MISC_OFF) + 8);
#ifndef PHMASK
#define PHMASK 0xFFFFFF
#endif
#define PHEN(k) (((PHMASK) >> (k)) & 1)
#define IN(k) (lo <= (k) && (k) < hi)
#define SEAM(k) do { if (IN(k) && IN((k) + 1)) xcd_barrier(bar); } while (0)
#define HN ((bf16*)(F.ws + WS_HN))
#define MIX ((bf16*)(F.ws + WS_MIX))
#define HID ((bf16*)(F.ws + WS_HID))
#define RAWP ((bf16*)(F.ws + WS_HID + H_RAWP))
#define HSORT ((bf16*)(F.ws + WS_P))
#define YB ((bf16*)(F.ws + WS_P))
#define x_in (args.in[0])

    if (PHEN(19) && IN(0)) { MKFRAME(); p0_prologue(F, args); SEAM(0); }

    for (int lp = 0; lp < 2; ++lp) {
        const int pb = 1 + lp * PH_PER_PAIR;
        const int le = 2 * lp, lo_ = 2 * lp + 1;
#define we ((const pg8::bf16_t*)(F.ws + WS_WT_EVEN0 + (size_t)lp * WT_EVEN_BYTES))
#define wo ((const pg8::bf16_t*)(F.ws + WS_WT_ODD0 + (size_t)lp * WT_ODD_BYTES))
        if (PHEN(0) && IN(pb + 0)) { MKFRAME();
            norm_phase(F, lp == 0 ? x_in : F.out, F.out, args.in[1] + (size_t)le * D, HN, lp != 0, false, true, nullptr);
            SEAM(pb + 0); }
        if (PHEN(1) && IN(pb + 1)) { MKFRAME();
            pg8::Gemm g{HN, we + WTE_IN / 2, T, EVEN_IN, D}; pg8::StaticOrder S; S.init(T, EVEN_IN, F.G, F.blk);
            pg8::EpiHeadsEven E{(bf16*)(F.ws + WS_P + P_UV), (bf16*)(F.ws + WS_P + P_QS), args.in[4] + (size_t)lp * 256, args.in[7] + (size_t)lp * 64, args.in[8] + (size_t)lp * 64,
                                (const float*)(F.ws + WS_ROPE), (const float*)(F.ws + WS_ROPE) + SEQ * 32};
            pg8::gemm_phase<pg8::EpiHeadsEven, pg8::StaticOrder>(F.lds + RING_OFF, g, S, E);
            SEAM(pb + 1); }
        if (PHEN(2) && IN(pb + 2)) { MKFRAME(); banded_phase(F); gmlp_phase(F, args.in[5] + (size_t)lp * 4 * 128 * 128, args.in[6] + (size_t)lp * 4 * 128, MIX); SEAM(pb + 2); }
        if (PHEN(3) && IN(pb + 3)) { MKFRAME(); merge_even(F, MIX); SEAM(pb + 3); }
        if (PHEN(4) && IN(pb + 4)) { MKFRAME();
            pg8::Gemm g{MIX, we + WTE_OUT / 2, T, D, EVEN_OUT}; pg8::StaticOrder S; S.init(T, D, F.G, F.blk);
            pg8::EpiF32Res E{lp == 0 ? x_in : F.out, F.out, D};
            pg8::gemm_phase<pg8::EpiF32Res, pg8::StaticOrder>(F.lds + RING_OFF, g, S, E);
            SEAM(pb + 4); }
        if (PHEN(5) && IN(pb + 5)) { MKFRAME(); norm_phase(F, F.out, F.out, args.in[2] + (size_t)le * D, HN, false, false, true, nullptr); SEAM(pb + 5); }
        if (PHEN(6) && IN(pb + 6)) { MKFRAME();
            pg8::Gemm g{HN, we + WTE_GU / 2, T, 2 * DFF, D}; pg8::StaticOrder S; S.init(T, 2 * DFF, F.G, F.blk);
            pg8::EpiSwiGLU E{HID, DFF};
            pg8::gemm_phase<pg8::EpiSwiGLU, pg8::StaticOrder>(F.lds + RING_OFF, g, S, E);
            SEAM(pb + 6); }
        if (PHEN(7) && IN(pb + 7)) { MKFRAME();
            pg8::Gemm g{HID, we + WTE_DN / 2, T, D, DFF}; pg8::StaticOrder S; S.init(T, D, F.G, F.blk);
            pg8::EpiF32Res E{F.out, F.out, D};
            pg8::gemm_phase<pg8::EpiF32Res, pg8::StaticOrder>(F.lds + RING_OFF, g, S, E);
            SEAM(pb + 7); }
        if (PHEN(8) && IN(pb + 8)) { MKFRAME(); norm_phase(F, F.out, F.out, args.in[1] + (size_t)lo_ * D, HN, false, false, true, nullptr); SEAM(pb + 8); }
        if (PHEN(9) && IN(pb + 9)) { MKFRAME();
            pg8::Gemm g{HN, wo + WTO_IN / 2, T, ODD_IN, D}; pg8::StaticOrder S; S.init(T, ODD_IN, F.G, F.blk);
            pg8::EpiHeadsOdd E{(bf16*)(F.ws + WS_P + P_QM), (bf16*)(F.ws + WS_P + P_CONV), (float*)(F.ws + WS_CTL + CTL_KMSUM + (size_t)lp * KMSUM_BYTES),
                               args.in[14] + (size_t)lp * 64, args.in[15] + (size_t)lp * 64, (const float*)(F.ws + WS_ROPE), (const float*)(F.ws + WS_ROPE) + SEQ * 32};
            pg8::gemm_phase<pg8::EpiHeadsOdd, pg8::StaticOrder>(F.lds + RING_OFF, g, S, E);
            SEAM(pb + 9); }
        if (PHEN(10) && IN(pb + 10)) { MKFRAME(); moba_phase(F, lp, MIX); conv_phase(F, (const bf16*)(F.ws + WS_P + P_CONV), args.in[16] + (size_t)lp * 3 * 256, MIX); SEAM(pb + 10); }
        if (PHEN(11) && IN(pb + 11)) { MKFRAME();
            pg8::Gemm g{MIX, wo + WTO_OUT / 2, T, D, ODD_OUT}; pg8::StaticOrder S; S.init(T, D, F.G, F.blk);
            pg8::EpiF32Res E{F.out, F.out, D};
            pg8::gemm_phase<pg8::EpiF32Res, pg8::StaticOrder>(F.lds + RING_OFF, g, S, E);
            SEAM(pb + 11); }
        if (PHEN(12) && IN(pb + 12)) { MKFRAME(); norm_phase(F, F.out, F.out, args.in[2] + (size_t)lo_ * D, HN, false, true, true, args.in[18] + (size_t)lp * D * NEXP); SEAM(pb + 12); }
        if (PHEN(13) && IN(pb + 13)) { MKFRAME(); route_phase(F, HN, HSORT); SEAM(pb + 13); }
        if (PHEN(14) && IN(pb + 14)) { MKFRAME();
            const int* tbp = (const int*)(F.ws + WS_MISC + 512 * 1024);
            pg8::MoeOrder S; const int ntiles = __builtin_amdgcn_readfirstlane(tbp[8]); S.init(ntiles * 256, 2 * DFFE, F.G, F.blk);
#pragma unroll
            for (int k = 0; k < 8; ++k) S.tb[k] = __builtin_amdgcn_readfirstlane(tbp[k]);
            S.estride = (size_t)2 * DFFE * D * 2;
            pg8::Gemm g{HSORT, wo + WTO_MGU / 2, ntiles * 256, 2 * DFFE, D};
            pg8::EpiSwiGLU E{HID, DFFE};
            pg8::gemm_phase<pg8::EpiSwiGLU, pg8::MoeOrder>(F.lds + RING_OFF, g, S, E);
            SEAM(pb + 14); }
        if (PHEN(15) && IN(pb + 15)) { MKFRAME();
            const int* tbp = (const int*)(F.ws + WS_MISC + 512 * 1024);
            pg8::MoeOrder S; const int ntiles = __builtin_amdgcn_readfirstlane(tbp[8]); S.init(ntiles * 256, D, F.G, F.blk);
#pragma unroll
            for (int k = 0; k < 8; ++k) S.tb[k] = __builtin_amdgcn_readfirstlane(tbp[k]);
            S.estride = (size_t)DFFE * D * 2;
            pg8::Gemm g{HID, wo + WTO_MD / 2, ntiles * 256, D, DFFE};
            pg8::EpiBf16Plain E{YB, D};
            pg8::gemm_phase<pg8::EpiBf16Plain, pg8::MoeOrder>(F.lds + RING_OFF, g, S, E);
            SEAM(pb + 15); }
    }
    if (PHEN(20) && IN(NPH - 1)) { MKFRAME(); norm_phase(F, F.out, F.out, args.in[1], HN, true, false, false, nullptr); }
#undef IN
#undef SEAM
#undef HN
#undef MIX
#undef HID
#undef RAWP
#undef HSORT
#undef YB
#undef x_in
#undef we
#undef wo
}

extern "C" void kernel_launch(void* const* d_in, const int* in_sizes, int n_in, void* d_out, int out_size, void* d_ws, size_t ws_size, hipStream_t stream) {
    static int grid = 0;
    if (grid == 0) {
        if (n_in != 22 || out_size != T * D || ws_size < WS_END) { fprintf(stderr, "kernel_launch: unexpected shapes (n_in %d out %d ws %zu)\n", n_in, out_size, ws_size); grid = -1; return; }
        int dev = 0, cus = 0, per_cu = 0;
        if (hipGetDevice(&dev) != hipSuccess || hipDeviceGetAttribute(&cus, hipDeviceAttributeMultiprocessorCount, dev) != hipSuccess) { grid = -1; return; }
        if (hipFuncSetAttribute((const void*)fwd, hipFuncAttributeMaxDynamicSharedMemorySize, LDS_BYTES) != hipSuccess) { fprintf(stderr, "kernel_launch: hipFuncSetAttribute failed\n"); grid = -1; return; }
        if (hipOccupancyMaxActiveBlocksPerMultiprocessor(&per_cu, (const void*)fwd, NWAVES * 64, LDS_BYTES) != hipSuccess || per_cu < 1) fprintf(stderr, "kernel_launch: occupancy query says %d\n", per_cu);
        (void)hipGetLastError();
        grid = cus;
    }
    if (grid < 0) return;
    (void)hipMemsetAsync((char*)d_ws + WS_CTL, 0, CTL_ZERO_BYTES, stream);
    Args a{};
    for (int i = 0; i < 22; ++i) a.in[i] = (const float*)d_in[i];
    a.out = (float*)d_out; a.ws = (unsigned char*)d_ws;
#if MK_PER_PHASE
    for (int p = 0; p < NPH; ++p) { a.ph_lo = p; a.ph_hi = p + 1; hipLaunchKernelGGL(fwd, dim3(grid), dim3(NWAVES * 64), LDS_BYTES, stream, a); }
#else
    a.ph_lo = 0; a.ph_hi = NPH; hipLaunchKernelGGL(fwd, dim3(grid), dim3(NWAVES * 64), LDS_BYTES, stream, a);
#endif
}
```

```cpp
#include <hip/hip_runtime.h>
#include <cstdio>
#include <cstdint>
#include <hip/hip_bf16.h>


template <int X> __device__ __forceinline__ float xswz(float v) { return __builtin_bit_cast(float, __builtin_amdgcn_ds_swizzle(__builtin_bit_cast(int, v), (X << 10) | 0x1F)); }
template <int X> __device__ __forceinline__ int xswzi(int v) { return __builtin_amdgcn_ds_swizzle(v, (X << 10) | 0x1F); }
__device__ __forceinline__ float xsum32(float v) { float a = v, b = v; asm("s_nop 1\n\tv_permlane32_swap_b32_e32 %0, %1" : "+v"(a), "+v"(b)); return a + b; }
__device__ __forceinline__ int xsum32i(int v) { int a = v, b = v; asm("s_nop 1\n\tv_permlane32_swap_b32_e32 %0, %1" : "+v"(a), "+v"(b)); return a + b; }
__device__ __forceinline__ float xmax32(float v) { float a = v, b = v; asm("s_nop 1\n\tv_permlane32_swap_b32_e32 %0, %1" : "+v"(a), "+v"(b)); return fmaxf(a, b); }


__device__ __forceinline__ int lane_hw() { int l; asm volatile("v_mbcnt_lo_u32_b32 %0, -1, 0\n\tv_mbcnt_hi_u32_b32 %0, -1, %0" : "=v"(l)); return l; }
#define TID_NOW(wv) ((wv) * 64 + lane_hw())

#ifndef NAIVE_MOBA
#define NAIVE_MOBA 0
#endif
#ifndef NAIVE_BANDED
#define NAIVE_BANDED 0
#endif
#ifndef MK_PER_PHASE
#define MK_PER_PHASE 0
#endif

namespace pg8 {
#define PG8_LAS __attribute__((address_space(3)))
typedef unsigned short bf16_t;
typedef short bf16x8 __attribute__((ext_vector_type(8)));
typedef float f32x4 __attribute__((ext_vector_type(4)));
typedef float f32x2 __attribute__((ext_vector_type(2)));
typedef unsigned u32x4 __attribute__((ext_vector_type(4)));
constexpr int BM = 256, BK = 64, HALF = 128, HTB = HALF * BK * 2, STAGE_BYTES = 8 * HTB, NXCD = 8, WGM = 8;

__host__ __device__ __forceinline__ int lds_byte(int r, int c) { const int st = (r >> 4) * 2 + (c >> 5), rr = r & 15, cc = c & 31, ob = rr * 64 + cc * 2; return st * 1024 + (ob ^ (((ob >> 9) & 1) << 5)); }
__host__ __device__ __forceinline__ void stage_rc(int b, int& R, int& C) { const int st = b / 1024, sb = b % 1024, swz = sb ^ (((sb >> 9) & 1) << 5); R = (st >> 1) * 16 + swz / 64; C = (st & 1) * 32 + (swz % 64) / 2; }
__host__ __device__ __forceinline__ int perm32(int rho) { const int n = rho >> 4, i = rho & 15; return 8 * (i >> 2) + 4 * n + (i & 3); }

struct Unit { int pm, pn; };
struct Gemm { const bf16_t* A; const bf16_t* Bt; int M, N, K; };

struct StaticOrder {
    int nM, nN, nwg, G, c;
    __device__ void init(int M, int N, int G_, int c_) { nM = M / BM; nN = N / BM; nwg = nM * nN; G = G_; c = c_; }
    __device__ bool next(int i, Unit& u) const {
        const long L = (long)i * G + c; if (L >= nwg) return false;
        int wgid = (int)L; { const int q = nwg / NXCD, r = nwg % NXCD, xcd = wgid % NXCD, off = wgid / NXCD; wgid = (xcd < r ? xcd * (q + 1) : r * (q + 1) + (xcd - r) * q) + off; }
        const int nig = WGM * nN, gid = wgid / nig, fm = gid * WGM, gsz = (nM - fm) < WGM ? (nM - fm) : WGM;
        u.pm = fm + ((wgid % nig) % gsz); u.pn = (wgid % nig) / gsz; return true;
    }
    __device__ __forceinline__ const char* bbase(const Unit&, const bf16_t* Bt) const { return (const char*)Bt; }
};
struct MoeOrder : StaticOrder {
    int tb[8]; size_t estride;
    __device__ __forceinline__ const char* bbase(const Unit& u, const bf16_t* Bt) const {
        int e = 0;
#pragma unroll
        for (int k = 1; k < 8; ++k) e += (u.pm >= tb[k]) ? 1 : 0;
        return (const char*)Bt + (size_t)e * estride;
    }
};

__device__ __forceinline__ unsigned cvt_pk_bf16(float lo, float hi) { unsigned r; asm volatile("v_cvt_pk_bf16_f32 %0, %1, %2" : "=v"(r) : "v"(lo), "v"(hi)); return r; }

struct EpiBf16Plain {
    static constexpr bool PERM = true;
    bf16_t* O; int ldc;
    __device__ __forceinline__ void operator()(const f32x4 (&acc)[2][2][4][2], const Unit& u, int wr, int wc, int fr, int fq) const {
        const int row0 = u.pm * BM + wr * 64 + fr, col0 = u.pn * BM + wc * 32 + 8 * fq;
#pragma unroll
        for (int ai = 0; ai < 2; ++ai)
#pragma unroll
            for (int m = 0; m < 4; ++m) { bf16_t* rowp = O + (size_t)(row0 + ai * HALF + m * 16) * ldc + col0;
#pragma unroll
                for (int bj = 0; bj < 2; ++bj) { const f32x4 v0 = acc[ai][bj][m][0], v1 = acc[ai][bj][m][1];
                    u32x4 w; w.x = cvt_pk_bf16(v0[0], v0[1]); w.y = cvt_pk_bf16(v0[2], v0[3]); w.z = cvt_pk_bf16(v1[0], v1[1]); w.w = cvt_pk_bf16(v1[2], v1[3]);
                    *(u32x4*)(rowp + bj * HALF) = w; } }
    }
};
struct EpiF32Res {
    static constexpr bool PERM = false;
    const float* base; float* out; int ldc;
    __device__ __forceinline__ void operator()(const f32x4 (&acc)[2][2][4][2], const Unit& u, int wr, int wc, int fr, int fq) const {
        const int row0 = u.pm * BM + wr * 64 + fr, col0 = u.pn * BM + wc * 32 + 4 * fq;
#pragma unroll
        for (int ai = 0; ai < 2; ++ai)
#pragma unroll
            for (int m = 0; m < 4; ++m) { const size_t off = (size_t)(row0 + ai * HALF + m * 16) * ldc + col0;
#pragma unroll
                for (int bj = 0; bj < 2; ++bj)
#pragma unroll
                    for (int n = 0; n < 2; ++n) { const f32x4 bs = *(const f32x4*)(base + off + bj * HALF + n * 16); *(f32x4*)(out + off + bj * HALF + n * 16) = bs + acc[ai][bj][m][n]; }
                asm volatile("" ::: "memory"); }
    }
};
__device__ __forceinline__ float silu_mul(float g, float u) { return g * __builtin_amdgcn_rcpf(1.0f + __builtin_amdgcn_exp2f(-1.4426950408889634f * g)) * u; }
struct EpiSwiGLU {
    static constexpr bool PERM = true;
    bf16_t* O; int ldc; float sc;
    __device__ __forceinline__ void operator()(const f32x4 (&acc)[2][2][4][2], const Unit& u, int wr, int wc, int fr, int fq) const {
        const int row0 = u.pm * BM + wr * 64 + fr, col0 = u.pn * HALF + wc * 32 + 8 * fq;
#pragma unroll
        for (int ai = 0; ai < 2; ++ai)
#pragma unroll
            for (int m = 0; m < 4; ++m) { bf16_t* rowp = O + (size_t)(row0 + ai * HALF + m * 16) * ldc + col0;
                const f32x4 g0 = acc[ai][0][m][0] * sc, g1 = acc[ai][0][m][1] * sc, u0 = acc[ai][1][m][0] * sc, u1 = acc[ai][1][m][1] * sc;
                u32x4 w; w.x = cvt_pk_bf16(silu_mul(g0[0], u0[0]), silu_mul(g0[1], u0[1])); w.y = cvt_pk_bf16(silu_mul(g0[2], u0[2]), silu_mul(g0[3], u0[3]));
                w.z = cvt_pk_bf16(silu_mul(g1[0], u1[0]), silu_mul(g1[1], u1[1])); w.w = cvt_pk_bf16(silu_mul(g1[2], u1[2]), silu_mul(g1[3], u1[3]));
                *(u32x4*)rowp = w; }
    }
};


__device__ __forceinline__ float gelu_t(float x) { const float y2 = 1.5957691216057308f * (x + 0.044715f * x * x * x); return x * __builtin_amdgcn_rcpf(1.0f + __builtin_amdgcn_exp2f(-1.4426950408889634f * y2)); }
__device__ __forceinline__ void st8(bf16_t* p, const float (&v)[8]) { u32x4 w; w.x = cvt_pk_bf16(v[0], v[1]); w.y = cvt_pk_bf16(v[2], v[3]); w.z = cvt_pk_bf16(v[4], v[5]); w.w = cvt_pk_bf16(v[6], v[7]); *(u32x4*)p = w; }
__device__ __forceinline__ int srow_g(int s, int g) { return g == 0 ? s : (g == 1 ? ((s & 3) * 1024 + (s >> 2)) : ((s & 15) * 256 + (s >> 4))); }
#define PG8_GETROW(x0, x1) do { const f32x4 a0 = acc[ai][0][m][0], a1 = acc[ai][0][m][1], b0 = acc[ai][1][m][0], b1 = acc[ai][1][m][1]; \
    x0[0] = a0[0]; x0[1] = a0[1]; x0[2] = a0[2]; x0[3] = a0[3]; x0[4] = a1[0]; x0[5] = a1[1]; x0[6] = a1[2]; x0[7] = a1[3]; \
    x1[0] = b0[0]; x1[1] = b0[1]; x1[2] = b0[2]; x1[3] = b0[3]; x1[4] = b1[0]; x1[5] = b1[1]; x1[6] = b1[2]; x1[7] = b1[3]; } while (0)
__device__ __forceinline__ void head_norm_rope(float (&x0)[8], float (&x1)[8], const float (&g0)[8], const float (&g1)[8], const float* cs, const float* sn, int s, int fq, float scale) {
    float ss = 0.f;
#pragma unroll
    for (int i = 0; i < 8; ++i) ss += x0[i] * x0[i] + x1[i] * x1[i];
    ss += xswz<16>(ss); ss = xsum32(ss);
    const float rstd = scale / sqrtf(ss * (1.0f / 64.0f) + 1e-6f);
    const f32x4 c0 = *(const f32x4*)(cs + s * 32 + 8 * fq), c1 = *(const f32x4*)(cs + s * 32 + 8 * fq + 4), s0 = *(const f32x4*)(sn + s * 32 + 8 * fq), s1 = *(const f32x4*)(sn + s * 32 + 8 * fq + 4);
#pragma unroll
    for (int i = 0; i < 8; ++i) { const float a = x0[i] * rstd * g0[i], b = x1[i] * rstd * g1[i]; const float c = i < 4 ? c0[i & 3] : c1[i & 3], sv = i < 4 ? s0[i & 3] : s1[i & 3];
        x0[i] = a * c - b * sv; x1[i] = b * c + a * sv; }
}
struct EpiHeadsEven {
    static constexpr bool PERM = false;
    bf16_t* UV; bf16_t* Qs; const float* vgain; const float* qgain; const float* kgain; const float* cs; const float* sn;
    __device__ __forceinline__ void operator()(const f32x4 (&acc)[2][2][4][2], const Unit& u, int wr, int wc, int fr, int fq) const {
        const int pn = u.pn, row0 = u.pm * BM + wr * 64 + fr;
        const int kind = pn == 0 ? 0 : (pn == 1 ? 1 : (pn < 8 ? 2 : 3));
        const bool isq = pn < 5; const int h = (pn < 5 ? pn - 2 : (pn < 8 ? pn - 5 : pn - 8)) * 4 + wc, grp = h >> 2;
        float g0[8], g1[8];
        { const float* gp = kind == 1 ? vgain + wc * 64 : (isq ? qgain : kgain);
#pragma unroll
          for (int i = 0; i < 8; ++i) { g0[i] = gp[8 * fq + i]; g1[i] = gp[32 + 8 * fq + i]; } }
        bf16_t* hb = Qs + (kind == 3 ? (size_t)24 * 1024 * 1024 : (isq ? (size_t)0 : (size_t)12 * 1024 * 1024));
#pragma unroll
        for (int ai = 0; ai < 2; ++ai)
#pragma unroll
            for (int m = 0; m < 4; ++m) {
                const int row = row0 + ai * HALF + m * 16, b = row >> 12, s = row & 4095;
                float x0[8], x1[8]; PG8_GETROW(x0, x1);
                if (kind <= 1) {
#pragma unroll
                    for (int i = 0; i < 8; ++i) { x0[i] = gelu_t(x0[i]); x1[i] = gelu_t(x1[i]); }
                    if (kind == 1) { float ss = 0.f;
#pragma unroll
                        for (int i = 0; i < 8; ++i) ss += x0[i] * x0[i] + x1[i] * x1[i];
                        ss += xswz<16>(ss); ss = xsum32(ss);
                        const float rstd = 1.0f / sqrtf(ss * (1.0f / 64.0f) + 1e-6f);
#pragma unroll
                        for (int i = 0; i < 8; ++i) { x0[i] *= rstd * g0[i]; x1[i] *= rstd * g1[i]; } }
                    bf16_t* d = UV + (size_t)row * 512 + pn * 256 + wc * 64 + 8 * fq; st8(d, x0); st8(d + 32, x1);
                } else {
                    if (kind == 2) head_norm_rope(x0, x1, g0, g1, cs, sn, s, fq, isq ? 0.18033688011112042f : 1.0f);
                    bf16_t* d = hb + ((size_t)(b * 12 + h) * 4096 + srow_g(s, grp)) * 64 + 8 * fq; st8(d, x0); st8(d + 32, x1);
                }
            }
    }
};
struct EpiHeadsOdd {
    static constexpr bool PERM = false;
    bf16_t* Qm; bf16_t* CONV; float* kmsum; const float* qgain; const float* kgain; const float* cs; const float* sn;
    __device__ __forceinline__ void operator()(const f32x4 (&acc)[2][2][4][2], const Unit& u, int wr, int wc, int fr, int fq) const {
        const int pn = u.pn, row0 = u.pm * BM + wr * 64 + fr;
        const int kind = pn < 6 ? 2 : (pn < 9 ? 3 : 4);
        const bool isq = pn < 3; const int h = (pn % 3) * 4 + wc;
        float g0[8], g1[8];
        { const float* gp = isq ? qgain : kgain;
#pragma unroll
          for (int i = 0; i < 8; ++i) { g0[i] = gp[8 * fq + i]; g1[i] = gp[32 + 8 * fq + i]; } }
        bf16_t* hb = Qm + (kind == 3 ? (size_t)24 * 1024 * 1024 : (isq ? (size_t)0 : (size_t)12 * 1024 * 1024));
        float cs0[8], cs1[8];
#pragma unroll
        for (int i = 0; i < 8; ++i) { cs0[i] = 0.f; cs1[i] = 0.f; }
#pragma unroll
        for (int ai = 0; ai < 2; ++ai)
#pragma unroll
            for (int m = 0; m < 4; ++m) {
                const int row = row0 + ai * HALF + m * 16, b = row >> 12, s = row & 4095;
                float x0[8], x1[8]; PG8_GETROW(x0, x1);
                if (kind == 4) { bf16_t* d = CONV + (size_t)row * 768 + (pn - 9) * 256 + wc * 64 + 8 * fq; st8(d, x0); st8(d + 32, x1); }
                else {
                    if (kind == 2) { head_norm_rope(x0, x1, g0, g1, cs, sn, s, fq, isq ? 0.18033688011112042f : 1.0f);
                        if (!isq) {
#pragma unroll
                            for (int i = 0; i < 8; ++i) { cs0[i] += x0[i]; cs1[i] += x1[i]; } } }
                    bf16_t* d = hb + ((size_t)(b * 12 + h) * 4096 + s) * 64 + 8 * fq; st8(d, x0); st8(d + 32, x1);
                }
            }
        if (kind == 2 && !isq) {
#pragma unroll
            for (int i = 0; i < 8; ++i) {
                { cs0[i] += xswz<1>(cs0[i]); cs1[i] += xswz<1>(cs1[i]); cs0[i] += xswz<2>(cs0[i]); cs1[i] += xswz<2>(cs1[i]); cs0[i] += xswz<4>(cs0[i]); cs1[i] += xswz<4>(cs1[i]); cs0[i] += xswz<8>(cs0[i]); cs1[i] += xswz<8>(cs1[i]); } }
            if (fr == 0) { const int b = (u.pm * BM) >> 12, blk = u.pm & 15; float* kp = kmsum + ((size_t)(b * 12 + h) * 16 + blk) * 64 + 8 * fq;
#pragma unroll
                for (int i = 0; i < 8; ++i) { atomicAdd(kp + i, cs0[i]); atomicAdd(kp + 32 + i, cs1[i]); } }
        }
    }
};

__device__ __forceinline__ const char* uptr(const char* p) { const unsigned long long b_ = (unsigned long long)p; return (const char*)(((unsigned long long)(unsigned)__builtin_amdgcn_readfirstlane((int)(unsigned)(b_ >> 32)) << 32) | (unsigned)__builtin_amdgcn_readfirstlane((int)(unsigned)b_)); }
__device__ __forceinline__ void glds16s(const void* sbase, unsigned voff, unsigned lds_dst) { unsigned keep;
    asm volatile("s_mov_b32 %0, m0\n\ts_mov_b32 m0, %3\n\ts_nop 0\n\tglobal_load_lds_dwordx4 %1, %2\n\ts_mov_b32 m0, %0" : "=&s"(keep) : "v"(voff), "s"(sbase), "s"(lds_dst) : "memory"); }
typedef int i32x4 __attribute__((ext_vector_type(4)));
typedef int i32x8 __attribute__((ext_vector_type(8)));
template <class Epi, class Sched, bool ALIGN_EPI = true, bool SP2 = true, bool FP8 = false>
__device__ __forceinline__ void gemm_phase(PG8_LAS unsigned char* lds, const Gemm g, const Sched& S, const Epi& E, int tid_in) {
    int tid_ = tid_in; asm volatile("" : "+v"(tid_));
    const int tid = tid_, wid = __builtin_amdgcn_readfirstlane(tid >> 6), lane = tid & 63, wr = wid >> 2, wc = wid & 3, fr = lane & 15, fq = lane >> 4;
    const int Kb = FP8 ? g.K : 2 * g.K, nt = Kb / 128;
    unsigned voffA[2], voffB[2];
#pragma unroll
    for (int i = 0; i < 2; ++i) { int R, C; stage_rc(tid * 16 + i * 8192, R, C); const int Rb = Epi::PERM ? ((R & ~31) + perm32(R & 31)) : R;
        voffA[i] = (unsigned)(R * Kb + 2 * C); voffB[i] = (unsigned)(Rb * Kb + 2 * C); }
    const size_t kstep = (size_t)128;
    const size_t hstep = (size_t)HALF * Kb;
    const size_t tstep = 2 * hstep;
    const unsigned ldsw = (unsigned)wid * 1024u;
    const unsigned lds0 = (unsigned)(uintptr_t)lds;
    const int fcol = FP8 ? (32 * (fq >> 1) + 16 * (fq & 1)) : fq * 8;
    const int aoff = lds_byte(wr * 64 + fr, fcol), boff = lds_byte(wc * 32 + fr, fcol);
#define PG8_SA(b, h) (((b) * 2 + (h)) * HTB)
#define PG8_SB(b, h) ((4 + (b) * 2 + (h)) * HTB)
#define PG8_STAGE(bufoff, gbase, voff) do { _Pragma("unroll") for (int _i = 0; _i < 2; ++_i) \
        glds16s((const void*)(gbase), (voff)[_i], (unsigned)__builtin_amdgcn_readfirstlane((int)(lds0 + (bufoff) + ldsw + _i * 8192))); } while (0)
#define PG8_RD16(p) (*(const PG8_LAS i32x4*)(p))
#define PG8_CAT8(lo, hi) __builtin_shufflevector((lo), (hi), 0, 1, 2, 3, 4, 5, 6, 7)
#define PG8_LDA(dst, b, h) do { if constexpr (FP8) { _Pragma("unroll") for (int m = 0; m < 4; ++m) dst##8[m] = PG8_CAT8(PG8_RD16(lds + PG8_SA(b, h) + aoff + m * 2048), PG8_RD16(lds + PG8_SA(b, h) + aoff + m * 2048 + 16)); } \
        else { _Pragma("unroll") for (int m = 0; m < 4; ++m) _Pragma("unroll") for (int k = 0; k < 2; ++k) dst[m][k] = *(const PG8_LAS bf16x8*)(lds + PG8_SA(b, h) + aoff + m * 2048 + k * 1024); } } while (0)
#define PG8_LDB(dst, b, h) do { if constexpr (FP8) { _Pragma("unroll") for (int n = 0; n < 2; ++n) dst##8[n] = PG8_CAT8(PG8_RD16(lds + PG8_SB(b, h) + boff + n * 2048), PG8_RD16(lds + PG8_SB(b, h) + boff + n * 2048 + 16)); } \
        else { _Pragma("unroll") for (int n = 0; n < 2; ++n) _Pragma("unroll") for (int k = 0; k < 2; ++k) dst[n][k] = *(const PG8_LAS bf16x8*)(lds + PG8_SB(b, h) + boff + n * 2048 + k * 1024); } } while (0)
#define PG8_MMA(ai, bj, At, Bt) do { __builtin_amdgcn_s_setprio(1); \
        if constexpr (FP8) { _Pragma("unroll") for (int m = 0; m < 4; ++m) _Pragma("unroll") for (int n = 0; n < 2; ++n) \
            acc[ai][bj][m][n] = __builtin_amdgcn_mfma_scale_f32_16x16x128_f8f6f4(Bt##8[n], At##8[m], acc[ai][bj][m][n], 0, 0, 0, 0, 0, 0); } \
        else { _Pragma("unroll") for (int m = 0; m < 4; ++m) _Pragma("unroll") for (int n = 0; n < 2; ++n) _Pragma("unroll") for (int k = 0; k < 2; ++k) \
            acc[ai][bj][m][n] = __builtin_amdgcn_mfma_f32_16x16x32_bf16(Bt[n][k], At[m][k], acc[ai][bj][m][n], 0, 0, 0); } \
        __builtin_amdgcn_s_setprio(0); } while (0)
#define PG8_WAIT_V(n) asm volatile("s_waitcnt vmcnt(" #n ")" ::: "memory")
#define PG8_WAIT_L(n) asm volatile("s_waitcnt lgkmcnt(" #n ")" ::: "memory")
#define PG8_BAR __builtin_amdgcn_s_barrier()
#define PG8_SCHED __builtin_amdgcn_sched_barrier(0)
    Unit cur, nxt; int ui = 0;
    if (!S.next(0, cur)) return;
    f32x4 acc[2][2][4][2];
#pragma unroll
    for (int a = 0; a < 2; ++a)
#pragma unroll
        for (int b = 0; b < 2; ++b)
#pragma unroll
            for (int m = 0; m < 4; ++m)
#pragma unroll
                for (int n = 0; n < 2; ++n) acc[a][b][m][n] = (f32x4){0.f, 0.f, 0.f, 0.f};
    bf16x8 At[4][2], B0[2][2], B1[2][2]; i32x8 At8[4], B08[2], B18[2];
    const char* cA = uptr((const char*)g.A + (size_t)cur.pm * tstep); const char* cB = uptr(S.bbase(cur, g.Bt) + (size_t)cur.pn * tstep);
    if constexpr (SP2) {
        PG8_STAGE(PG8_SB(0, 0), cB, voffB); PG8_STAGE(PG8_SB(0, 1), cB + hstep, voffB); PG8_STAGE(PG8_SA(0, 0), cA, voffA); PG8_STAGE(PG8_SA(0, 1), cA + hstep, voffA);
        if (wr == 1) PG8_BAR;
        PG8_WAIT_V(2); PG8_BAR;
        PG8_STAGE(PG8_SB(1, 0), cB + kstep, voffB); PG8_STAGE(PG8_SA(1, 0), cA + kstep, voffA); PG8_STAGE(PG8_SB(1, 1), cB + hstep + kstep, voffB);
        PG8_WAIT_V(6); PG8_BAR;
    } else {
        PG8_STAGE(PG8_SB(0, 0), cB, voffB); PG8_STAGE(PG8_SA(0, 0), cA, voffA); PG8_STAGE(PG8_SB(0, 1), cB + hstep, voffB); PG8_STAGE(PG8_SA(0, 1), cA + hstep, voffA);
        if (wr == 1) PG8_BAR;
        PG8_WAIT_V(4); PG8_BAR;
        PG8_STAGE(PG8_SB(1, 0), cB + kstep, voffB); PG8_STAGE(PG8_SA(1, 0), cA + kstep, voffA); PG8_STAGE(PG8_SB(1, 1), cB + hstep + kstep, voffB);
        PG8_WAIT_V(6); PG8_BAR;
    }
    for (;;) {
        const bool has_next = S.next(ui + 1, nxt);
        const char* nA = uptr(has_next ? (const char*)g.A + (size_t)nxt.pm * tstep : cA); const char* nB = uptr(has_next ? S.bbase(nxt, g.Bt) + (size_t)nxt.pn * tstep : cB);
        for (int t = 0; t < nt; t += 2) {
            const bool last = (t == nt - 2);
            const char* a1 = cA + (size_t)(t + 1) * kstep;
            const char* a2 = last ? nA : cA + (size_t)(t + 2) * kstep; const char* b2 = last ? nB : cB + (size_t)(t + 2) * kstep;
            const char* a3 = a2 + kstep; const char* b3 = b2 + kstep;
            if constexpr (SP2) {
            PG8_LDB(B0, 0, 0); PG8_LDB(B1, 0, 1); PG8_SCHED; PG8_LDA(At, 0, 0); PG8_STAGE(PG8_SA(1, 1), a1 + hstep, voffA);
            PG8_WAIT_V(8); PG8_WAIT_L(0); PG8_BAR; PG8_MMA(0, 0, At, B0); PG8_MMA(0, 1, At, B1); PG8_BAR; PG8_SCHED;
            PG8_LDA(At, 0, 1); PG8_STAGE(PG8_SB(0, 0), b2, voffB); PG8_STAGE(PG8_SB(0, 1), b2 + hstep, voffB); PG8_STAGE(PG8_SA(0, 0), a2, voffA);
            PG8_WAIT_V(8); PG8_WAIT_L(0); PG8_BAR; PG8_MMA(1, 0, At, B0); PG8_MMA(1, 1, At, B1); PG8_BAR; PG8_SCHED;
            PG8_LDB(B0, 1, 0); PG8_LDB(B1, 1, 1); PG8_SCHED; PG8_LDA(At, 1, 0); PG8_STAGE(PG8_SA(0, 1), a2 + hstep, voffA);
            PG8_WAIT_V(8); PG8_WAIT_L(0); PG8_BAR; PG8_MMA(0, 0, At, B0); PG8_MMA(0, 1, At, B1); PG8_BAR; PG8_SCHED;
            PG8_LDA(At, 1, 1); PG8_STAGE(PG8_SB(1, 0), b3, voffB); PG8_STAGE(PG8_SB(1, 1), b3 + hstep, voffB); PG8_STAGE(PG8_SA(1, 0), a3, voffA);
            PG8_WAIT_V(8); PG8_WAIT_L(0); PG8_BAR; PG8_MMA(1, 0, At, B0); PG8_MMA(1, 1, At, B1); PG8_BAR; PG8_SCHED;
            } else {
            PG8_LDB(B0, 0, 0); PG8_SCHED; PG8_LDA(At, 0, 0); PG8_STAGE(PG8_SA(1, 1), a1 + hstep, voffA);
            PG8_WAIT_L(8); PG8_BAR; PG8_WAIT_L(0); PG8_MMA(0, 0, At, B0); PG8_BAR; PG8_SCHED;
            PG8_LDB(B1, 0, 1); PG8_STAGE(PG8_SB(0, 0), b2, voffB);
            PG8_BAR; PG8_WAIT_L(0); PG8_MMA(0, 1, At, B1); PG8_BAR;
            PG8_LDA(At, 0, 1); PG8_STAGE(PG8_SA(0, 0), a2, voffA);
            PG8_BAR; PG8_WAIT_L(0); PG8_MMA(1, 0, At, B0); PG8_BAR; PG8_SCHED;
            PG8_STAGE(PG8_SB(0, 1), b2 + hstep, voffB);
            PG8_WAIT_V(6); PG8_BAR; PG8_MMA(1, 1, At, B1); PG8_BAR;
            PG8_LDB(B0, 1, 0); PG8_SCHED; PG8_LDA(At, 1, 0); PG8_STAGE(PG8_SA(0, 1), a2 + hstep, voffA);
            PG8_WAIT_L(8); PG8_BAR; PG8_WAIT_L(0); PG8_MMA(0, 0, At, B0); PG8_BAR; PG8_SCHED;
            PG8_LDB(B1, 1, 1); PG8_STAGE(PG8_SB(1, 0), b3, voffB);
            PG8_BAR; PG8_WAIT_L(0); PG8_MMA(0, 1, At, B1); PG8_BAR;
            PG8_LDA(At, 1, 1); PG8_STAGE(PG8_SA(1, 0), a3, voffA);
            PG8_BAR; PG8_WAIT_L(0); PG8_MMA(1, 0, At, B0); PG8_BAR; PG8_SCHED;
            PG8_STAGE(PG8_SB(1, 1), b3 + hstep, voffB);
            PG8_WAIT_V(6); PG8_BAR; PG8_MMA(1, 1, At, B1); PG8_BAR;
            }
        }
        if constexpr (ALIGN_EPI) { if (wr == 0) PG8_BAR; }
        { int l_; asm volatile("v_mbcnt_lo_u32_b32 %0, -1, 0\n\tv_mbcnt_hi_u32_b32 %0, -1, %0" : "=v"(l_));
          E(acc, cur, wr, wc, l_ & 15, l_ >> 4); }
        if (!has_next) break;
#pragma unroll
        for (int a = 0; a < 2; ++a)
#pragma unroll
            for (int b = 0; b < 2; ++b)
#pragma unroll
                for (int m = 0; m < 4; ++m)
#pragma unroll
                    for (int n = 0; n < 2; ++n) acc[a][b][m][n] = (f32x4){0.f, 0.f, 0.f, 0.f};
        cur = nxt; cA = nA; cB = nB; ++ui;
        if constexpr (ALIGN_EPI) { if (wr == 1) PG8_BAR; }
    }
    PG8_WAIT_V(0);
    if constexpr (!ALIGN_EPI) { if (wr == 0) PG8_BAR; }
    PG8_BAR;
#undef PG8_SA
#undef PG8_SB
#undef PG8_STAGE
#undef PG8_LDA
#undef PG8_RD16
#undef PG8_CAT8
#undef PG8_LDB
#undef PG8_MMA
#undef PG8_WAIT_V
#undef PG8_WAIT_L
#undef PG8_BAR
#undef PG8_SCHED
}
}


namespace att {
using bf16x8=__attribute__((ext_vector_type(8)))short;
using s16x4=__attribute__((ext_vector_type(4)))short;
using f32x16=__attribute__((ext_vector_type(16)))float;
using u32x4=__attribute__((ext_vector_type(4)))unsigned;
typedef unsigned short bf16;
constexpr int D=64,DM=64;
constexpr int NW=8,QBLK=32,QB=QBLK*NW,KVBLK=64;
__device__ __forceinline__ int crow(int r,int hi){return (r&3)+8*(r>>2)+4*hi;}
#define SBAR() __builtin_amdgcn_sched_barrier(0)
constexpr int NSLOT=3, SLOTB=8192;
constexpr int LDS_K=0, LDS_V=NSLOT*SLOTB, LDS_WS=2*NSLOT*SLOTB, LDS_OST=LDS_WS+NW*64*4, LDS_KM=LDS_OST+NW*4096, LDS_TK=LDS_KM+4096, LDS_BYTES=LDS_TK+64;
constexpr float C2=0.125f*1.4426950408889634f;
__device__ __forceinline__ void glds16(const void*gsrc,unsigned lds_dst){unsigned keep;
  asm volatile("s_mov_b32 %0, m0\n\ts_mov_b32 m0, %2\n\ts_nop 0\n\tglobal_load_lds_dwordx4 %1, off\n\ts_mov_b32 m0, %0":"=&s"(keep):"v"(gsrc),"s"(lds_dst):"memory");}
__device__ __forceinline__ float max3f(float a,float b,float c){float r;asm("v_max3_f32 %0, %1, %2, %3":"=v"(r):"v"(a),"v"(b),"v"(c));return r;}
__device__ __forceinline__ float max2f(float a,float b){float r;asm("v_max_f32_e32 %0, %1, %2":"=v"(r):"v"(a),"v"(b));return r;}
__device__ __forceinline__ float fadd_s(float a,float b){float r;asm("v_add_f32_e32 %0, %1, %2":"=v"(r):"v"(a),"v"(b));return r;}
__device__ __forceinline__ float fsub_s(float a,float b){float r;asm("v_sub_f32_e32 %0, %1, %2":"=v"(r):"v"(a),"v"(b));return r;}
typedef float f32x2_t __attribute__((ext_vector_type(2))); typedef __bf16 bf16x2_t __attribute__((ext_vector_type(2)));
__device__ __forceinline__ unsigned cvtpk_s(float lo,float hi){f32x2_t v={lo,hi};bf16x2_t b=__builtin_convertvector(v,bf16x2_t);return __builtin_bit_cast(unsigned,b);}
#define WAIT_BAR(N) asm volatile("s_waitcnt vmcnt(" #N ") lgkmcnt(0)\n\ts_barrier":::"memory")
__device__ __forceinline__ void qkt(f32x16&p0,f32x16&p1,const char*Kslot,const bf16x8*qr,int r32,int hi){ const f32x16 zero16=f32x16{};
  const char*kb=Kslot+hi*1024+r32*16;
  #pragma unroll
  for(int d0=0;d0<4;++d0){
    const bf16x8 b0=*reinterpret_cast<const bf16x8*>(kb+d0*2048);
    const bf16x8 b1=*reinterpret_cast<const bf16x8*>(kb+d0*2048+512);
    if(d0==0){p0=__builtin_amdgcn_mfma_f32_32x32x16_bf16(b0,qr[0],zero16,0,0,0);p1=__builtin_amdgcn_mfma_f32_32x32x16_bf16(b1,qr[0],zero16,0,0,0);}
    else{p0=__builtin_amdgcn_mfma_f32_32x32x16_bf16(b0,qr[d0],p0,0,0,0);p1=__builtin_amdgcn_mfma_f32_32x32x16_bf16(b1,qr[d0],p1,0,0,0);}}
}
typedef __attribute__((address_space(3))) const char* lds_cptr;
typedef short v4i16_t __attribute__((ext_vector_type(4)));
__device__ __forceinline__ void kload8(bf16x8*kf,lds_cptr kp){
  kf[0]=*(const __attribute__((address_space(3))) bf16x8*)(kp);      kf[1]=*(const __attribute__((address_space(3))) bf16x8*)(kp+512);
  kf[2]=*(const __attribute__((address_space(3))) bf16x8*)(kp+2048); kf[3]=*(const __attribute__((address_space(3))) bf16x8*)(kp+2560);
  kf[4]=*(const __attribute__((address_space(3))) bf16x8*)(kp+4096); kf[5]=*(const __attribute__((address_space(3))) bf16x8*)(kp+4608);
  kf[6]=*(const __attribute__((address_space(3))) bf16x8*)(kp+6144); kf[7]=*(const __attribute__((address_space(3))) bf16x8*)(kp+6656);
}
__device__ __forceinline__ void kload2(bf16x8*kf,lds_cptr kp,int j){ kf[2*j]=*(const __attribute__((address_space(3))) bf16x8*)(kp+j*2048); kf[2*j+1]=*(const __attribute__((address_space(3))) bf16x8*)(kp+j*2048+512); }
__device__ __forceinline__ s16x4 vtr(lds_cptr p){ return __builtin_bit_cast(s16x4,__builtin_amdgcn_ds_read_tr16_b64_v4i16((__attribute__((address_space(3))) v4i16_t*)p)); }
__device__ __forceinline__ float rowmax(const f32x16&p0,const f32x16&p1){
  float a=max3f(p0[0],p0[1],p1[0]),b=max3f(p0[2],p0[3],p1[1]);a=max3f(a,p1[2],p1[3]);
  #pragma unroll
  for(int r=4;r<16;r+=4){a=max3f(a,p0[r],p0[r+1]);b=max3f(b,p0[r+2],p0[r+3]);a=max3f(a,p1[r],p1[r+1]);b=max3f(b,p1[r+2],p1[r+3]);}
  const float m=max2f(a,b);
  auto rr=__builtin_amdgcn_permlane32_swap(__float_as_uint(m),__float_as_uint(m),false,false);
  return max2f(__uint_as_float(rr[0]),__uint_as_float(rr[1]));
}
__device__ __forceinline__ void pv(f32x16*o,int vb,bf16x8 pa0,bf16x8 pa1,bf16x8 pa2,bf16x8 pa3){
  #pragma unroll
  for(int d0=0;d0<2;++d0){s16x4 lo[4],hi[4];
    #pragma unroll
    for(int ks=0;ks<4;++ks){
      asm volatile("ds_read_b64_tr_b16 %0,%1 offset:%c2":"=&v"(lo[ks]):"v"(vb),"i"(d0*4096+ks*1024):"memory");
      asm volatile("ds_read_b64_tr_b16 %0,%1 offset:%c2":"=&v"(hi[ks]):"v"(vb),"i"(d0*4096+ks*1024+512):"memory");}
    asm volatile("s_waitcnt lgkmcnt(0)":::"memory");SBAR();
    #define PK(k) (bf16x8){lo[k][0],lo[k][1],lo[k][2],lo[k][3],hi[k][0],hi[k][1],hi[k][2],hi[k][3]}
    o[d0]=__builtin_amdgcn_mfma_f32_32x32x16_bf16(pa0,PK(0),o[d0],0,0,0);
    o[d0]=__builtin_amdgcn_mfma_f32_32x32x16_bf16(pa1,PK(1),o[d0],0,0,0);
    o[d0]=__builtin_amdgcn_mfma_f32_32x32x16_bf16(pa2,PK(2),o[d0],0,0,0);
    o[d0]=__builtin_amdgcn_mfma_f32_32x32x16_bf16(pa3,PK(3),o[d0],0,0,0);
    #undef PK
  }
}
template<int MODE> __device__ __forceinline__ void amask(f32x16&p0,f32x16&p1,int a,int nb,unsigned sel,int qabs,int qrel,int hi,float mhat){
  const float NEG=-INFINITY;
  if(MODE==0){
    if(a>=nb){ const int kb=64*(a-nb)+4*hi;
      #pragma unroll
      for(int r=0;r<16;++r){const int kv=kb+(r&3)+8*(r>>2); p0[r]=(kv>qrel)?NEG:p0[r]-mhat; p1[r]=(kv+32>qrel)?NEG:p1[r]-mhat;} }
    else { const float bias=((sel>>(a>>2))&1u)?-mhat:NEG;
      #pragma unroll
      for(int r=0;r<16;++r){ p0[r]+=bias; p1[r]+=bias; } }
  } else {
    const int base=qabs-64*a-4*hi;
    #pragma unroll
    for(int r=0;r<16;++r){const int c=(r&3)+8*(r>>2); p0[r]=((unsigned)(base-c)>128u)?NEG:p0[r]-mhat; p1[r]=((unsigned)(base-c-32)>128u)?NEG:p1[r]-mhat;}
  }
}
#ifndef ATTN_STORE16
#define ATTN_STORE16(p,v) (*(u32x4*)(p)=(v))
#endif
template<int MODE,int THRL,int opitch> __device__ __forceinline__ void attn_unit(const bf16*Qs,int q0,int tile0,int NT,unsigned sel,bf16*O,float*LSE,char*shm,int tid_in){
  const bf16*Ks=Qs+12*1024*1024,*Vs=Qs+24*1024*1024;
  int tid_=tid_in; asm volatile("":"+v"(tid_));
  const int tid=tid_,lane=tid&63,r32=lane&31,hi=lane>>5; const int wid=__builtin_amdgcn_readfirstlane(tid>>6);
  const int nb=NT-4;
  const bf16*Qw=Qs+(long)(q0+wid*QBLK)*DM;
  const lds_cptr shm3=(lds_cptr)shm;
  const unsigned lds0=(unsigned)(uintptr_t)shm3;
  float*wsf=(float*)(shm+LDS_WS)+wid*64;
  const bf16*ksrc=Ks+(long)lane*DM+wid*8;
  const bf16*vsrc=Vs+(long)(16*(wid&3)+(lane>>2))*DM+(wid>>2)*32+(lane&3)*8;
  const unsigned kdst=lds0+LDS_K+wid*1024, vdst=lds0+LDS_V+wid*1024;
  #define TM(t) (MODE==0 ? ((t)==0 ? nb : ((t)<=nb ? (t)-1 : (t))) : tile0+(t))
  #define DMA_K(t,slot) glds16(ksrc+(long)TM(t)*KVBLK*DM,(unsigned)__builtin_amdgcn_readfirstlane(kdst+(slot)))
  #define DMA_V(t,slot) glds16(vsrc+(long)TM(t)*KVBLK*DM,(unsigned)__builtin_amdgcn_readfirstlane(vdst+(slot)))
  const char*Kbase=shm+LDS_K; bf16x8 kf[8];
  const lds_cptr kp0=shm3+LDS_K+hi*1024+r32*16; const lds_cptr vp0=shm3+LDS_V+((lane>>4)&1)*32+(lane&3)*8+(4*hi+((lane&15)>>2))*64;
  DMA_K(0,0);DMA_V(0,0);DMA_K(1,SLOTB);
  bf16x8 qr[4];
  #pragma unroll
  for(int d0=0;d0<4;++d0)qr[d0]=*reinterpret_cast<const bf16x8*>(&Qw[(long)r32*DM+d0*16+hi*8]);
  float mhat=0.f,l_reg=0.f;f32x16 o[2];o[0]=f32x16{};o[1]=f32x16{};const f32x16 zero16=f32x16{};
  const int qrel=wid*QBLK+r32, qabs=q0+qrel;
  #define CMASK(P0,P1,t) amask<MODE>(P0,P1,TM(t),nb,sel,qabs,qrel,hi,mhat)
  bool resc=false;
  #define START(P0,P1) do{ const float rm=rowmax(P0,P1); resc=false; \
    { const float dl=__builtin_fmaxf(rm,0.f); mhat=fadd_s(mhat,dl); \
      _Pragma("unroll") for(int r=0;r<16;++r){P0[r]=fsub_s(P0[r],dl);P1[r]=fsub_s(P1[r],dl);} } \
    _Pragma("unroll") for(int r=0;r<16;++r)P0[r]=__builtin_amdgcn_exp2f(P0[r]); }while(0)
  #define RESC() do{ if(resc){ asm volatile("s_waitcnt lgkmcnt(0)":::"memory"); \
      _Pragma("unroll") for(int d_=0;d_<2;++d_) _Pragma("unroll") for(int r=0;r<16;++r)o[d_][r]*=wsf[crow(r,hi)]; } }while(0)
  f32x16 pA0,pA1,pB0,pB1;
  int sl_prev=0,sl_cur=0,sl_next=SLOTB;
  #define ROT() do{sl_prev=sl_cur;sl_cur=sl_next;sl_next=(sl_next==(NSLOT-1)*SLOTB)?0:sl_next+SLOTB;}while(0)
  DMA_K(2,2*SLOTB);
  WAIT_BAR(3);
  qkt(pA0,pA1,Kbase,qr,r32,hi);asm volatile("s_nop 15\n\ts_nop 7":"+v"(pA0),"+v"(pA1));CMASK(pA0,pA1,0);
  START(pA0,pA1);
  _Pragma("unroll") for(int r=0;r<16;++r)pA1[r]=__builtin_amdgcn_exp2f(pA1[r]);
  WAIT_BAR(0);
  DMA_K(3,0);DMA_V(1,SLOTB);
  ROT();
  kload8(kf,kp0+sl_cur);
  WAIT_BAR(2);
  s16x4 vlo[8],vhi[8]; u32x4 pw0,pw1,pw2,pw3;
  #define PKW(P,B) cvtpk_s(P[B],P[B+1])
  #define PAF(k) __builtin_bit_cast(bf16x8,pw##k)
  #define VFR(i) (bf16x8){vlo[i][0],vlo[i][1],vlo[i][2],vlo[i][3],vhi[i][0],vhi[i][1],vhi[i][2],vhi[i][3]}
  #define PIN(x) asm volatile("":"+v"(x))
  #define MX3(a,b,c) __builtin_fmaxf(__builtin_fmaxf((a),(b)),(c))
  #define GAPA(MF,A0,A1,A2,A3,W0,W1,PW) do{ MF; sacc+=A0; sacc+=A1; sacc+=A2; sacc+=A3; PIN(sacc); W0; W1; PIN(PW); SBAR(); }while(0)
  #define EX(v) __builtin_amdgcn_exp2f(v)
  #define GAPB(MF,X,B) do{ MF; X[B]=EX(X[B]); X[B+1]=EX(X[B+1]); X[B+2]=EX(X[B+2]); X[B+3]=EX(X[B+3]); PIN(X); SBAR(); }while(0)
  #define VRD(i) do{ vlo[i]=vtr(vp_+(((i)>>2)*4096+((i)&3)*1024)); vhi[i]=vtr(vp_+(((i)>>2)*4096+((i)&3)*1024+512)); }while(0)
  #define KRD(G,j) do{ if(G){ kload2(kf,kp0+sl_next,j); SBAR(); } }while(0)
  #define STEP(C0,C1,P0,P1,t,GK,GV,GL) do{ SBAR(); \
    const lds_cptr vp_=vp0+sl_prev; \
    VRD(0); SBAR(); float sacc=(P0[0]+P0[1]); \
    GAPA(C0=__builtin_amdgcn_mfma_f32_32x32x16_bf16(kf[0],qr[0],zero16,0,0,0), P0[2],P0[3],P0[4],P0[5],     pw0[0]=PKW(P0,0), pw0[1]=PKW(P0,2), pw0); \
    VRD(4); SBAR(); GAPA(C1=__builtin_amdgcn_mfma_f32_32x32x16_bf16(kf[1],qr[0],zero16,0,0,0), P0[6],P0[7],P0[8],P0[9],     pw0[2]=PKW(P0,4), pw0[3]=PKW(P0,6), pw0); \
    VRD(1); SBAR(); GAPA(C0=__builtin_amdgcn_mfma_f32_32x32x16_bf16(kf[2],qr[1],C0,0,0,0),   P0[10],P0[11],P0[12],P0[13], pw1[0]=PKW(P0,8), pw1[1]=PKW(P0,10), pw1); \
    VRD(5); SBAR(); GAPA(C1=__builtin_amdgcn_mfma_f32_32x32x16_bf16(kf[3],qr[1],C1,0,0,0),   P0[14],P0[15],P1[0],P1[1],   pw1[2]=PKW(P0,12),pw1[3]=PKW(P0,14), pw1); \
    VRD(2); SBAR(); GAPA(C0=__builtin_amdgcn_mfma_f32_32x32x16_bf16(kf[4],qr[2],C0,0,0,0),   P1[2],P1[3],P1[4],P1[5],     pw2[0]=PKW(P1,0), pw2[1]=PKW(P1,2), pw2); \
    VRD(6); SBAR(); GAPA(C1=__builtin_amdgcn_mfma_f32_32x32x16_bf16(kf[5],qr[2],C1,0,0,0),   P1[6],P1[7],P1[8],P1[9],     pw2[2]=PKW(P1,4), pw2[3]=PKW(P1,6), pw2); \
    VRD(3); SBAR(); GAPA(C0=__builtin_amdgcn_mfma_f32_32x32x16_bf16(kf[6],qr[3],C0,0,0,0),   P1[10],P1[11],P1[12],P1[13], pw3[0]=PKW(P1,8), pw3[1]=PKW(P1,10), pw3); \
    VRD(7); SBAR(); GAPA(C1=__builtin_amdgcn_mfma_f32_32x32x16_bf16(kf[7],qr[3],C1,0,0,0),   P1[14],P1[15],0.f,0.f,       pw3[2]=PKW(P1,12),pw3[3]=PKW(P1,14), pw3); \
    l_reg+=sacc; \
    if(GK){DMA_K((t)+3,sl_cur);} if(GV){DMA_V((t)+1,sl_next);} \
    CMASK(C0,C1,t); \
    { float a=MX3(C0[0],C0[1],C1[0]),b=MX3(C0[2],C0[3],C1[1]); a=MX3(a,C1[2],C1[3]); \
      _Pragma("unroll") for(int r=4;r<16;r+=4){a=MX3(a,C0[r],C0[r+1]);b=MX3(b,C0[r+2],C0[r+3]);a=MX3(a,C1[r],C1[r+1]);b=MX3(b,C1[r+2],C1[r+3]);} \
      float rm=__builtin_fmaxf(a,b); { auto rr=__builtin_amdgcn_permlane32_swap(__float_as_uint(rm),__float_as_uint(rm),false,false); rm=__builtin_fmaxf(__uint_as_float(rr[0]),__uint_as_float(rr[1])); } \
      resc=false; \
      if(__builtin_expect(__any(rm>(float)THRL),0)){ const float dl=__builtin_fmaxf(rm,0.f); mhat+=dl; \
        _Pragma("unroll") for(int r=0;r<16;++r){C0[r]-=dl;C1[r]-=dl;} \
        const float f=__builtin_amdgcn_exp2f(-dl); l_reg*=f; if(hi==0)wsf[r32]=f; resc=true; } } \
    SBAR(); \
    GAPB(o[0]=__builtin_amdgcn_mfma_f32_32x32x16_bf16(PAF(0),VFR(0),o[0],0,0,0), C0,0); \
    GAPB(o[1]=__builtin_amdgcn_mfma_f32_32x32x16_bf16(PAF(0),VFR(4),o[1],0,0,0), C0,4); \
    KRD(GL,0); GAPB(o[0]=__builtin_amdgcn_mfma_f32_32x32x16_bf16(PAF(1),VFR(1),o[0],0,0,0), C0,8); \
    KRD(GL,1); GAPB(o[1]=__builtin_amdgcn_mfma_f32_32x32x16_bf16(PAF(1),VFR(5),o[1],0,0,0), C0,12); \
    KRD(GL,2); GAPB(o[0]=__builtin_amdgcn_mfma_f32_32x32x16_bf16(PAF(2),VFR(2),o[0],0,0,0), C1,0); \
    KRD(GL,3); GAPB(o[1]=__builtin_amdgcn_mfma_f32_32x32x16_bf16(PAF(2),VFR(6),o[1],0,0,0), C1,4); \
    GAPB(o[0]=__builtin_amdgcn_mfma_f32_32x32x16_bf16(PAF(3),VFR(3),o[0],0,0,0), C1,8); \
    GAPB(o[1]=__builtin_amdgcn_mfma_f32_32x32x16_bf16(PAF(3),VFR(7),o[1],0,0,0), C1,12); \
    }while(0)
  #define ENDW(tt) do{ if((tt)+3<NT){WAIT_BAR(2);} else if((tt)+2<NT){WAIT_BAR(1);} else {WAIT_BAR(0);} }while(0)
  int t=1;
  for(;t+1<NT;t+=2){
    STEP(pB0,pB1,pA0,pA1,t,(t+3<NT),(t+1<NT),(t+1<NT));       ENDW(t);   RESC(); ROT();
    STEP(pA0,pA1,pB0,pB1,t+1,(t+4<NT),(t+2<NT),(t+2<NT));     ENDW(t+1); RESC(); ROT();
  }
  STEP(pB0,pB1,pA0,pA1,NT-1,false,false,false); RESC();
  { float sacc=pB0[0]+pB0[1]; _Pragma("unroll") for(int r=2;r<16;++r)sacc+=pB0[r]; _Pragma("unroll") for(int r=0;r<16;++r)sacc+=pB1[r]; l_reg+=sacc;
    pw0=(u32x4){PKW(pB0,0),PKW(pB0,2),PKW(pB0,4),PKW(pB0,6)};pw1=(u32x4){PKW(pB0,8),PKW(pB0,10),PKW(pB0,12),PKW(pB0,14)};pw2=(u32x4){PKW(pB1,0),PKW(pB1,2),PKW(pB1,4),PKW(pB1,6)};pw3=(u32x4){PKW(pB1,8),PKW(pB1,10),PKW(pB1,12),PKW(pB1,14)};
    SBAR(); pv(o,(int)(unsigned)(uintptr_t)vp0+sl_cur,PAF(0),PAF(1),PAF(2),PAF(3)); }
  #undef PKW
  #undef PAF
  #undef VFR
  #undef PIN
  #undef MX3
  #undef GAPA
  #undef GAPB
  #undef EX
  #undef VRD
  #undef KRD
  #undef STEP
  #undef ENDW
  {auto rr=__builtin_amdgcn_permlane32_swap(__float_as_uint(l_reg),__float_as_uint(l_reg),false,false);l_reg=__uint_as_float(rr[0])+__uint_as_float(rr[1]);}
  if(MODE==1 && hi==0) LSE[qrel]=0.6931471805599453f*(mhat+__log2f(l_reg));
  if(hi==0)wsf[32+r32]=l_reg;asm volatile("s_waitcnt lgkmcnt(0)":::"memory");
  float rli[16];
  #pragma unroll
  for(int r=0;r<16;++r)rli[r]=__builtin_amdgcn_rcpf(wsf[32+crow(r,hi)]);
  bf16*Ow=O+(long)(wid*QBLK)*opitch;
  { __hip_bfloat16*stg=(__hip_bfloat16*)(shm+LDS_OST)+wid*2048;
    #pragma unroll
    for(int r=0;r<16;++r){const int orow=crow(r,hi);
      #pragma unroll
      for(int d0=0;d0<2;++d0)stg[orow*64+d0*32+r32]=__float2bfloat16(o[d0][r]*rli[r]);}
    asm volatile("s_waitcnt lgkmcnt(0)":::"memory");
    #pragma unroll
    for(int i=0;i<4;++i){const int row=i*8+(lane>>3),ch=lane&7; const u32x4 v=*(const u32x4*)(stg+row*64+ch*8); ATTN_STORE16(Ow+(long)row*opitch+ch*8,v);} }
  asm volatile("s_waitcnt lgkmcnt(0)\n\ts_barrier":::"memory");
  #undef DMA_K
  #undef DMA_V
  #undef TM
  #undef CMASK
  #undef START
  #undef RESC
  #undef ROT
}
#undef SBAR
#undef WAIT_BAR
}

constexpr int NWAVES = 8;
constexpr int NB = 4, SEQ = 4096, T = NB * SEQ, D = 1024;
constexpr int EVEN_IN = 2816, EVEN_OUT = 512, ODD_IN = 3072, ODD_OUT = 1024, DFF = 2816, NEXP = 8, DFFE = 3584;
constexpr int MOE_ROWS = 2 * T + NEXP * 256;
constexpr float EPS = 1e-6f;
constexpr size_t MiB = 1u << 20;
constexpr size_t WS_CTL = 0, CTL_ZERO_BYTES = 2 * MiB;
constexpr size_t WS_ROPE = 2 * MiB;
constexpr size_t WS_MISC = 3 * MiB;
constexpr size_t WS_KMEAN = 4 * MiB;
constexpr size_t WS_WT = 8 * MiB;
constexpr size_t WT_EVEN_BYTES = 23 * MiB, WT_ODD_BYTES = 176 * MiB;
constexpr size_t WTE_IN = 0, WTE_OUT = 5 * MiB + MiB / 2, WTE_GU = 6 * MiB + MiB / 2, WTE_DN = 17 * MiB + MiB / 2;
constexpr size_t WTO_IN = 0, WTO_OUT = 6 * MiB, WTO_MGU = 8 * MiB, WTO_MD = 120 * MiB;
constexpr size_t WS_WT_EVEN0 = WS_WT, WS_WT_ODD0 = WS_WT + 2 * WT_EVEN_BYTES;
constexpr size_t WS_HN = WS_WT + 2 * WT_EVEN_BYTES + 2 * WT_ODD_BYTES;
constexpr size_t WS_P = WS_HN + 32 * MiB;
constexpr size_t WS_MIX = WS_P + 96 * MiB;
constexpr size_t WS_HID = WS_MIX + 32 * MiB;
constexpr size_t WS_END = WS_HID + 238 * MiB;
static_assert(WS_HN == 406 * MiB && WS_END == 804 * MiB, "ws map");
constexpr size_t P_UV = 0, P_QS = 16 * MiB, P_KS = 40 * MiB, P_VS = 64 * MiB, P_QM = 0, P_KM = 24 * MiB, P_VM = 48 * MiB;
constexpr size_t H_RAWP = 0, H_OG = 96 * MiB, H_LSE = 120 * MiB;
constexpr int CW_TMO = 0, CW_CODE = 1, CW_BAR = 4096;
constexpr size_t CTL_KMSUM = 256 * 1024, KMSUM_BYTES = 256 * 1024;
constexpr size_t P_CONV = 72 * MiB;
constexpr int RING_OFF = 0, RING_BYTES = 131072, LDSCTL_OFF = RING_BYTES, MISC_OFF = LDSCTL_OFF + 320, LDS_BYTES = 147456;

#define GAS __attribute__((address_space(1)))
#define LAS __attribute__((address_space(3)))
typedef unsigned short bf16;
typedef unsigned v4u __attribute__((ext_vector_type(4)));
typedef unsigned v2u __attribute__((ext_vector_type(2)));
typedef float f32x4 __attribute__((ext_vector_type(4)));
typedef GAS unsigned gu32;
#define RLX_AGENT __ATOMIC_RELAXED, __HIP_MEMORY_SCOPE_AGENT
#define LDS_WAIT() asm volatile("s_waitcnt lgkmcnt(0)" ::: "memory")
#define VM_WAIT() asm volatile("s_waitcnt vmcnt(0)" ::: "memory")
__device__ __forceinline__ unsigned f2bf(float f) { unsigned u = __builtin_bit_cast(unsigned, f); return (u + 0x7fffu + ((u >> 16) & 1u)) >> 16; }
__device__ __forceinline__ unsigned pk2(float lo, float hi) { return f2bf(lo) | (f2bf(hi) << 16); }
__device__ __forceinline__ float bf2f(unsigned short b) { return __builtin_bit_cast(float, ((unsigned)b) << 16); }
__device__ __forceinline__ float bflo(unsigned w) { return __builtin_bit_cast(float, w << 16); }
__device__ __forceinline__ float bfhi(unsigned w) { return __builtin_bit_cast(float, w & 0xffff0000u); }

#define XB_TMO      128
#define XB_XCNT(j)  (256  + 64 * (j))
#define XB_XSUB(j)  (1280 + 64 * (j))
#define XB_XGEN(j)  (2304 + 64 * (j))
#define XB_TOP      3328
#define XB_TOPGEN   3392
#define XCD_BAR_WORDS 3456
#define XB_SPIN_CAP (1u << 22)
__device__ __forceinline__ unsigned xb_ld(unsigned* p)              { return __hip_atomic_load(p, __ATOMIC_RELAXED, __HIP_MEMORY_SCOPE_AGENT); }
__device__ __forceinline__ unsigned xb_add(unsigned* p, unsigned v) { return __hip_atomic_fetch_add(p, v, __ATOMIC_RELAXED, __HIP_MEMORY_SCOPE_AGENT); }
__device__ __forceinline__ unsigned xb_xcc_id() { return (unsigned)__builtin_amdgcn_s_getreg((3 << 11) | 20) & 0xFu; }
#define XB_SPIN(cond, bar) do { unsigned _sp = 0; while (cond) { __builtin_amdgcn_s_sleep(1); \
    if ((++_sp & 255u) == 0u) { if (xb_ld(&(bar)[XB_TMO])) break; if (_sp > XB_SPIN_CAP) { atomicAdd(&(bar)[XB_TMO], 1u); break; } } } } while (0)
struct XcdBarrier { unsigned* bar; unsigned x; volatile LAS unsigned* st; };
__device__ __forceinline__ XcdBarrier xcd_barrier_post(unsigned* bar, volatile LAS unsigned* st, int tid) {
    XcdBarrier b; b.bar = bar; b.x = xb_xcc_id(); b.st = st;
    if (tid == 0) (void)xb_add(&bar[XB_XCNT(b.x)], 1u);
    return b;
}
__device__ __forceinline__ void xcd_barrier_complete(unsigned* bar, unsigned x, unsigned& nloc, unsigned& nx) {
    const unsigned G = gridDim.x * gridDim.y * gridDim.z;
    unsigned sum, cnt, mine, sp = 0u;
    for (;;) {
        sum = 0u; cnt = 0u; mine = 0u;
#pragma unroll
        for (unsigned j = 0; j < 16; ++j) { const unsigned c = xb_ld(&bar[XB_XCNT(j)]); sum += c; cnt += (c > 0u) ? 1u : 0u; mine = (j == x) ? c : mine; }
        if (sum == G) break;
        __builtin_amdgcn_s_sleep(1);
        if ((++sp & 255u) == 0u) { if (xb_ld(&bar[XB_TMO])) break; if (sp > XB_SPIN_CAP) { atomicAdd(&bar[XB_TMO], 1u); break; } }
    }
    nloc = mine > 0u ? mine : 1u; nx = cnt > 0u ? cnt : 1u;
}
__device__ __forceinline__ void xcd_barrier(const XcdBarrier& b, int tid) {
    asm volatile("s_waitcnt vmcnt(0)" ::: "memory");
    __syncthreads();
    if (tid == 0) {
        unsigned* bar = b.bar;
        __builtin_amdgcn_s_waitcnt(0);
        unsigned nloc = b.st[0], nx = b.st[1];
        if (nloc == 0u) { xcd_barrier_complete(bar, b.x, nloc, nx); b.st[0] = nloc; b.st[1] = nx; }
        const unsigned old = xb_add(&bar[XB_XSUB(b.x)], 1u);
        const unsigned gen = old / nloc;
        if (old + 1u == (gen + 1u) * nloc) {
            __builtin_amdgcn_fence(__ATOMIC_RELEASE, "agent");
            asm volatile("s_waitcnt vmcnt(0)" ::: "memory");
            const unsigned og = xb_add(&bar[XB_TOP], 1u);
            const unsigned tg = og / nx;
            if (og + 1u == (tg + 1u) * nx) xb_add(&bar[XB_TOPGEN], 1u);
            else XB_SPIN(xb_ld(&bar[XB_TOPGEN]) == tg, bar);
            __builtin_amdgcn_fence(__ATOMIC_ACQUIRE, "agent");
            xb_add(&bar[XB_XGEN(b.x)], 1u);
            asm volatile("s_waitcnt vmcnt(0)" ::: "memory");
        } else {
            XB_SPIN(xb_ld(&bar[XB_XGEN(b.x)]) == gen, bar);
            __builtin_amdgcn_fence(__ATOMIC_ACQUIRE, "agent");
            asm volatile("s_waitcnt vmcnt(0)" ::: "memory");
        }
    }
    __syncthreads();
}

struct Args { const float* in[22]; float* out; unsigned char* ws; int ph_lo, ph_hi; };
struct Frame {
    LAS unsigned char* lds; volatile LAS unsigned* MISC; gu32* ctl;
    int tid, lane, wave, G, blk;
    unsigned char* ws; float* out;
};
struct Route { int e1, e2; float g1, g2; };

__device__ __forceinline__ float wave_sum(float v) { v += xswz<1>(v); v += xswz<2>(v); v += xswz<4>(v); v += xswz<8>(v); v += xswz<16>(v); return xsum32(v); }
__device__ __forceinline__ float wave_max(float v) { v = fmaxf(v, xswz<1>(v)); v = fmaxf(v, xswz<2>(v)); v = fmaxf(v, xswz<4>(v)); v = fmaxf(v, xswz<8>(v)); v = fmaxf(v, xswz<16>(v)); return xmax32(v); }
__device__ __forceinline__ int wave_sumi(int v) { v += xswzi<1>(v); v += xswzi<2>(v); v += xswzi<4>(v); v += xswzi<8>(v); v += xswzi<16>(v); return xsum32i(v); }
__device__ __forceinline__ float gelu_tanh(float x) {
    const float y = 0.7978845608028654f * (x + 0.044715f * x * x * x);
    const float e = __expf(2.0f * y);
    const float th = 1.0f - 2.0f / (e + 1.0f);
    return 0.5f * x * (1.0f + th);
}

__device__ __forceinline__ int rowmap(int mode, int n) {
    if (mode == 0) return n;
    if (mode == 3) { const int w = n & 255, wc = w >> 6, dd = w & 63, bj = dd >> 5, e = dd & 31, fq = e >> 3, nn = (e >> 2) & 1, j = e & 3; return (n & ~255) + 128 * bj + 32 * wc + 16 * nn + 4 * fq + j; }
    return 256 * (n >> 7) + (n & 127) + (mode == 2 ? 128 : 0);
}
constexpr float W8_SCALE = 64.0f;
__device__ __forceinline__ unsigned pk4_fp8(float a, float b, float c, float d) { int w = __builtin_amdgcn_cvt_pk_fp8_f32(a, b, 0, false); w = __builtin_amdgcn_cvt_pk_fp8_f32(c, d, w, true); return (unsigned)w; }
__device__ __forceinline__ void p0_transpose_item(const float* W, int K, int N, bf16* WT, int mode, int fp8, LAS float* scr, int item, int lane) {
    const int nblk = N / 64, kb = item / nblk, nb = item % nblk, k0 = 32 * kb, n0 = 64 * nb;
    const float* src = W + (size_t)(k0 + (lane >> 4)) * N + n0 + (lane & 15) * 4;
    f32x4 v[8];
#pragma unroll
    for (int i = 0; i < 8; ++i) v[i] = *(const f32x4*)(src + (size_t)(4 * i) * N);
#pragma unroll
    for (int i = 0; i < 8; ++i) *(LAS f32x4*)(scr + (4 * i + (lane >> 4)) * 68 + (lane & 15) * 4) = v[i];
    LDS_WAIT(); asm volatile("" ::: "memory");
    if (fp8) { unsigned char* d8 = (unsigned char*)WT + (size_t)rowmap(mode, n0 + lane) * K + k0;
#pragma unroll
        for (int q = 0; q < 2; ++q) { v4u o;
            o.x = pk4_fp8(scr[(16 * q + 0) * 68 + lane] * W8_SCALE, scr[(16 * q + 1) * 68 + lane] * W8_SCALE, scr[(16 * q + 2) * 68 + lane] * W8_SCALE, scr[(16 * q + 3) * 68 + lane] * W8_SCALE);
            o.y = pk4_fp8(scr[(16 * q + 4) * 68 + lane] * W8_SCALE, scr[(16 * q + 5) * 68 + lane] * W8_SCALE, scr[(16 * q + 6) * 68 + lane] * W8_SCALE, scr[(16 * q + 7) * 68 + lane] * W8_SCALE);
            o.z = pk4_fp8(scr[(16 * q + 8) * 68 + lane] * W8_SCALE, scr[(16 * q + 9) * 68 + lane] * W8_SCALE, scr[(16 * q + 10) * 68 + lane] * W8_SCALE, scr[(16 * q + 11) * 68 + lane] * W8_SCALE);
            o.w = pk4_fp8(scr[(16 * q + 12) * 68 + lane] * W8_SCALE, scr[(16 * q + 13) * 68 + lane] * W8_SCALE, scr[(16 * q + 14) * 68 + lane] * W8_SCALE, scr[(16 * q + 15) * 68 + lane] * W8_SCALE);
            *(GAS v4u*)(d8 + 16 * q) = o; }
        LDS_WAIT(); asm volatile("" ::: "memory"); return; }
    bf16* dst = WT + (size_t)rowmap(mode, n0 + lane) * K + k0;
#pragma unroll
    for (int q = 0; q < 4; ++q) { v4u o;
        o.x = pk2(scr[(8 * q + 0) * 68 + lane], scr[(8 * q + 1) * 68 + lane]); o.y = pk2(scr[(8 * q + 2) * 68 + lane], scr[(8 * q + 3) * 68 + lane]);
        o.z = pk2(scr[(8 * q + 4) * 68 + lane], scr[(8 * q + 5) * 68 + lane]); o.w = pk2(scr[(8 * q + 6) * 68 + lane], scr[(8 * q + 7) * 68 + lane]);
        *(GAS v4u*)(dst + 8 * q) = o; }
    LDS_WAIT(); asm volatile("" ::: "memory");
}
struct WDesc { const float* src; bf16* dst; int K, N, nbatch, mode, fp8; size_t dst_bstride; };
__device__ __forceinline__ WDesc get_desc(const Args& a, int d) {
    const int layer = d / 10, k = d % 10; unsigned char* ws = a.ws;
    bf16* we = (bf16*)(ws + WS_WT_EVEN0 + (size_t)layer * WT_EVEN_BYTES); bf16* wo = (bf16*)(ws + WS_WT_ODD0 + (size_t)layer * WT_ODD_BYTES);
    WDesc w; w.nbatch = 1; w.mode = 0; w.dst_bstride = 0; w.fp8 = 0;
    switch (k) {
    case 0: w.src = a.in[3] + (size_t)layer * D * EVEN_IN; w.dst = we + WTE_IN / 2; w.K = D; w.N = EVEN_IN; w.mode = 3; break;
    case 1: w.src = a.in[9] + (size_t)layer * EVEN_OUT * D; w.dst = we + WTE_OUT / 2; w.K = EVEN_OUT; w.N = D; break;
    case 2: w.src = a.in[10] + (size_t)layer * D * DFF; w.dst = we + WTE_GU / 2; w.K = D; w.N = DFF; w.mode = 1; break;
    case 3: w.src = a.in[11] + (size_t)layer * D * DFF; w.dst = we + WTE_GU / 2; w.K = D; w.N = DFF; w.mode = 2; break;
    case 4: w.src = a.in[12] + (size_t)layer * DFF * D; w.dst = we + WTE_DN / 2; w.K = DFF; w.N = D; break;
    case 5: w.src = a.in[13] + (size_t)layer * D * ODD_IN; w.dst = wo + WTO_IN / 2; w.K = D; w.N = ODD_IN; w.mode = 3; break;
    case 6: w.src = a.in[17] + (size_t)layer * ODD_OUT * D; w.dst = wo + WTO_OUT / 2; w.K = ODD_OUT; w.N = D; break;
    case 7: w.src = a.in[19] + (size_t)layer * NEXP * D * DFFE; w.dst = wo + WTO_MGU / 2; w.K = D; w.N = DFFE; w.mode = 1; w.nbatch = NEXP; w.dst_bstride = (size_t)DFFE * D; w.fp8 = 1; break;
    case 8: w.src = a.in[20] + (size_t)layer * NEXP * D * DFFE; w.dst = wo + WTO_MGU / 2; w.K = D; w.N = DFFE; w.mode = 2; w.nbatch = NEXP; w.dst_bstride = (size_t)DFFE * D; w.fp8 = 1; break;
    default: w.src = a.in[21] + (size_t)layer * NEXP * DFFE * D; w.dst = wo + WTO_MD / 2; w.K = DFFE; w.N = D; w.nbatch = NEXP; w.dst_bstride = (size_t)DFFE * D; break;
    }
    return w;
}
__device__ __forceinline__ void p0_prologue(Frame& F, const Args& a) {
    LAS float* scr = (LAS float*)(F.lds + RING_OFF + F.wave * 16384);
    const int gw = F.blk * NWAVES + F.wave, NGW = F.G * NWAVES;
    for (int d = 0; d < 20; ++d) {
        const WDesc w = get_desc(a, d);
        const int per = (w.K / 32) * (w.N / 64), nitems = per * w.nbatch;
        for (int it = gw; it < nitems; it += NGW) { const int bt = it / per, r = it % per;
            p0_transpose_item(w.src + (size_t)bt * w.K * w.N, w.K, w.N, w.dst + (size_t)bt * w.dst_bstride, w.mode, w.fp8, scr, r, F.lane); }
    }
    { float* wtg = (float*)(a.ws + WS_KMEAN); const float* wsp = a.in[5];
      for (int i = F.blk * 512 + F.tid; i < 2 * 4 * 128 * 128; i += F.G * 512) { const int lg = i >> 14, j = (i >> 7) & 127, ii = i & 127; wtg[i] = (j <= ii) ? wsp[(size_t)lg * 16384 + ii * 128 + j] : 0.f; } }
    float* cs = (float*)(a.ws + WS_ROPE); float* sn = cs + SEQ * 32;
    for (int i = F.blk * 512 + F.tid; i < SEQ * 32; i += F.G * 512) { const int pos = i >> 5, j = i & 31;
        const float inv = 1.0f / powf(10000.0f, (float)j * (1.0f / 32.0f)); const float ang = (float)pos * inv;
        cs[i] = cosf(ang); sn[i] = sinf(ang); }
}

__device__ __forceinline__ void norm_phase(Frame& F, const float* xsrc, float* xdst, const float* gain, bf16* hn, bool do_combine, bool do_router, bool write_hn, const float* router_w) {
    unsigned char* ws = F.ws;
    const Route* route = (const Route*)(ws + WS_MISC); const int* slots = (const int*)(ws + WS_MISC + 256 * 1024); int* ccnt = (int*)(ws + WS_MISC + 384 * 1024);
    const bf16* Y = (const bf16*)(ws + WS_P);
    LAS float* wr = (LAS float*)(F.lds + RING_OFF);
    LAS int* lcnt = (LAS int*)(F.lds + RING_OFF + 32768);
    if (do_router) { for (int i = F.tid; i < 8192; i += 512) { const int d = i >> 3, e = i & 7; wr[e * 1024 + d] = router_w[i]; } }
    const int lane = F.lane;
    f32x4 gv[4];
#pragma unroll
    for (int j = 0; j < 4; ++j) gv[j] = *((const f32x4*)gain + lane + 64 * j);
    for (int c = F.blk; c < T / 64; c += F.G) {
        if (do_router) { if (F.tid < 8) lcnt[F.tid] = 0; }
        __syncthreads();
        for (int k = 0; k < 8; ++k) {
            const int row = c * 64 + F.wave * 8 + k;
            const f32x4* xr = (const f32x4*)(xsrc + (size_t)row * D) + lane;
            f32x4 v[4];
#pragma unroll
            for (int j = 0; j < 4; ++j) v[j] = xr[64 * j];
            if (do_combine) {
                const Route r = route[row]; const int s1 = slots[2 * row], s2 = slots[2 * row + 1];
                const v2u* y1 = (const v2u*)(Y + (size_t)s1 * D) + lane; const v2u* y2 = (const v2u*)(Y + (size_t)s2 * D) + lane;
#pragma unroll
                for (int j = 0; j < 4; ++j) { const v2u a = y1[64 * j], b = y2[64 * j];
                    v[j].x += r.g1 * bflo(a.x) + r.g2 * bflo(b.x); v[j].y += r.g1 * bfhi(a.x) + r.g2 * bfhi(b.x);
                    v[j].z += r.g1 * bflo(a.y) + r.g2 * bflo(b.y); v[j].w += r.g1 * bfhi(a.y) + r.g2 * bfhi(b.y); }
                f32x4* xo = (f32x4*)(xdst + (size_t)row * D) + lane;
#pragma unroll
                for (int j = 0; j < 4; ++j) xo[64 * j] = v[j];
            }
            if (write_hn) {
                float ss = 0.f;
#pragma unroll
                for (int j = 0; j < 4; ++j) ss += (v[j].x * v[j].x + v[j].y * v[j].y) + (v[j].z * v[j].z + v[j].w * v[j].w);
                ss = wave_sum(ss);
                const float rstd = 1.0f / sqrtf(ss * (1.0f / D) + EPS);
#pragma unroll
                for (int j = 0; j < 4; ++j) v[j] = v[j] * rstd * gv[j];
                v2u* o8 = (v2u*)(hn + (size_t)row * D) + lane;
#pragma unroll
                for (int j = 0; j < 4; ++j) { v2u o; o.x = pk2(v[j].x, v[j].y); o.y = pk2(v[j].z, v[j].w); o8[64 * j] = o; }
                if (do_router) {
                    float lg[8];
#pragma unroll
                    for (int e = 0; e < 8; ++e) { float s = 0.f;
#pragma unroll
                        for (int j = 0; j < 4; ++j) { const f32x4 w = *((const LAS f32x4*)(wr + e * 1024) + lane + 64 * j); s += (v[j].x * w.x + v[j].y * w.y) + (v[j].z * w.z + v[j].w * w.w); }
                        lg[e] = wave_sum(s); }
                    int e1 = 0; float v1 = lg[0];
#pragma unroll
                    for (int e = 1; e < 8; ++e) if (lg[e] > v1) { v1 = lg[e]; e1 = e; }
                    int e2 = -1; float v2 = -INFINITY;
#pragma unroll
                    for (int e = 0; e < 8; ++e) if (e != e1 && lg[e] > v2) { v2 = lg[e]; e2 = e; }
                    const float g2 = 1.0f / (1.0f + __expf(v1 - v2)), g1 = 1.0f - g2;
                    if (lane == 0) { Route r; r.e1 = e1; r.e2 = e2; r.g1 = g1; r.g2 = g2; ((Route*)route)[row] = r; __hip_atomic_fetch_add(&lcnt[e1], 1, __ATOMIC_RELAXED, __HIP_MEMORY_SCOPE_WORKGROUP); __hip_atomic_fetch_add(&lcnt[e2], 1, __ATOMIC_RELAXED, __HIP_MEMORY_SCOPE_WORKGROUP); }
                }
            }
        }
        __syncthreads();
        if (do_router) { if (F.tid < 8) ccnt[c * 8 + F.tid] = lcnt[F.tid]; }
        __syncthreads();
    }
}

__device__ __forceinline__ void route_phase(Frame& F, const bf16* hn, bf16* hsort) {
    unsigned char* ws = F.ws;
    const Route* route = (const Route*)(ws + WS_MISC); int* slots = (int*)(ws + WS_MISC + 256 * 1024); const int* ccnt = (const int*)(ws + WS_MISC + 384 * 1024); int* tile_base = (int*)(ws + WS_MISC + 512 * 1024);
    LAS int* tot = (LAS int*)(F.lds + RING_OFF); LAS int* bef = tot + 8; LAS int* base = tot + 16; LAS int* sl = tot + 32;
    for (int c = F.blk; c < T / 64; c += F.G) {
        { const int e = F.wave; int t = 0, b = 0;
#pragma unroll
            for (int q = 0; q < 4; ++q) { const int ch = F.lane * 4 + q; const int v = ccnt[ch * 8 + e]; t += v; b += (ch < c) ? v : 0; }
            t = wave_sumi(t); b = wave_sumi(b);
            if (F.lane == 0) { tot[e] = t; bef[e] = b; } }
        __syncthreads();
        if (F.tid == 0) { int acc = 0;
            for (int e = 0; e < 8; ++e) { base[e] = acc; if (c == 0) tile_base[e] = acc >> 8; acc += (tot[e] + 255) & ~255; }
            if (c == 0) tile_base[8] = acc >> 8; }
        __syncthreads();
        if (F.wave == 0) {
            const int row = c * 64 + F.lane; const Route r = route[row];
            int run[8];
#pragma unroll
            for (int e = 0; e < 8; ++e) run[e] = base[e] + bef[e];
#pragma unroll
            for (int k = 0; k < 2; ++k) { const int me = k ? r.e2 : r.e1; int myslot = 0;
#pragma unroll
                for (int e = 0; e < 8; ++e) { const unsigned long long m = __ballot(me == e); const int rank = __popcll(m & ((1ull << F.lane) - 1ull));
                    if (me == e) myslot = run[e] + rank; run[e] += __popcll(m); }
                slots[2 * row + k] = myslot; sl[2 * F.lane + k] = myslot; }
        }
        __syncthreads();
        for (int p = F.wave; p < 128; p += NWAVES) { const int row = c * 64 + (p >> 1); const int s = sl[p];
            const v4u* src = (const v4u*)(hn + (size_t)row * D) + 2 * F.lane; const v4u a = src[0], b = src[1];
            v4u o; o.x = pk4_fp8(bflo(a.x), bfhi(a.x), bflo(a.y), bfhi(a.y)); o.y = pk4_fp8(bflo(a.z), bfhi(a.z), bflo(a.w), bfhi(a.w));
            o.z = pk4_fp8(bflo(b.x), bfhi(b.x), bflo(b.y), bfhi(b.y)); o.w = pk4_fp8(bflo(b.z), bfhi(b.z), bflo(b.w), bfhi(b.w));
            *((v4u*)((unsigned char*)hsort + (size_t)s * D) + F.lane) = o; }
        __syncthreads();
    }
}

__device__ __forceinline__ int srow(int s, int g) { return g == 0 ? s : (g == 1 ? ((s & 3) * 1024 + (s >> 2)) : ((s & 15) * 256 + (s >> 4))); }
__device__ __forceinline__ float rope_apply(float n, int lane, const float* cs, const float* sn, int s) {
    const float partner = __shfl_xor(n, 32); const int j = lane & 31; const float c = cs[s * 32 + j], si = sn[s * 32 + j];
    return lane < 32 ? n * c - partner * si : n * c + partner * si;
}
__device__ __forceinline__ void post_even(Frame& F, const bf16* rawp, const float* vgain, const float* qgain, const float* kgain) {
    unsigned char* ws = F.ws; bf16* UV = (bf16*)(ws + WS_P + P_UV); bf16* Qs = (bf16*)(ws + WS_P + P_QS); bf16* Ks = (bf16*)(ws + WS_P + P_KS); bf16* Vs = (bf16*)(ws + WS_P + P_VS);
    const float* cs = (const float*)(ws + WS_ROPE); const float* sn = cs + SEQ * 32;
    const int lane = F.lane; const float qg = qgain[lane], kg = kgain[lane];
    const long nitems = (long)T * 44;
    for (long it = (long)F.blk * NWAVES + F.wave; it < nitems; it += (long)F.G * NWAVES) {
        const int row = (int)(it / 44), u = (int)(it % 44), b = row >> 12, s = row & 4095;
        const float v = bf2f(rawp[(size_t)row * EVEN_IN + 64 * u + lane]);
        if (u < 4) { UV[(size_t)row * 512 + 64 * u + lane] = (bf16)f2bf(gelu_tanh(v)); }
        else if (u < 8) { const float z = gelu_tanh(v); const float ss = wave_sum(z * z); const float o = z * (1.0f / sqrtf(ss * (1.0f / 64) + EPS)) * vgain[(u - 4) * 64 + lane];
            UV[(size_t)row * 512 + 64 * u + lane] = (bf16)f2bf(o); }
        else if (u < 32) { const bool isq = u < 20; const int h = isq ? u - 8 : u - 20; const float ss = wave_sum(v * v);
            const float n = v * (1.0f / sqrtf(ss * (1.0f / 64) + EPS)) * (isq ? qg : kg); const float o = rope_apply(n, lane, cs, sn, s);
            (isq ? Qs : Ks)[((size_t)(b * 12 + h) * SEQ + srow(s, h >> 2)) * 64 + lane] = (bf16)f2bf(isq ? o * att::C2 : o); }
        else { const int h = u - 32; Vs[((size_t)(b * 12 + h) * SEQ + srow(s, h >> 2)) * 64 + lane] = (bf16)f2bf(v); }
    }
}
__device__ __forceinline__ void post_odd(Frame& F, const bf16* rawp, const float* qgain, const float* kgain) {
    unsigned char* ws = F.ws; bf16* Qm = (bf16*)(ws + WS_P + P_QM); bf16* Km = (bf16*)(ws + WS_P + P_KM); bf16* Vm = (bf16*)(ws + WS_P + P_VM);
    const float* cs = (const float*)(ws + WS_ROPE); const float* sn = cs + SEQ * 32;
    const int lane = F.lane; const float qg = qgain[lane], kg = kgain[lane];
    const long nitems = (long)T * 36;
    for (long it = (long)F.blk * NWAVES + F.wave; it < nitems; it += (long)F.G * NWAVES) {
        const int row = (int)(it / 36), u = (int)(it % 36), b = row >> 12, s = row & 4095;
        const float v = bf2f(rawp[(size_t)row * ODD_IN + 64 * u + lane]);
        if (u < 24) { const bool isq = u < 12; const int h = isq ? u : u - 12; const float ss = wave_sum(v * v);
            const float n = v * (1.0f / sqrtf(ss * (1.0f / 64) + EPS)) * (isq ? qg : kg); const float o = rope_apply(n, lane, cs, sn, s);
            (isq ? Qm : Km)[((size_t)(b * 12 + h) * SEQ + s) * 64 + lane] = (bf16)f2bf(isq ? o * att::C2 : o); }
        else { const int h = u - 24; Vm[((size_t)(b * 12 + h) * SEQ + s) * 64 + lane] = (bf16)f2bf(v); }
    }
}
__device__ __forceinline__ void kmean_phase(Frame& F) {
    const bf16* Km = (const bf16*)(F.ws + WS_P + P_KM); float* km = (float*)(F.ws + WS_KMEAN);
    for (int it = F.blk * NWAVES + F.wave; it < 48 * 16; it += F.G * NWAVES) {
        const bf16* k = Km + (size_t)it * 256 * 64 + F.lane; float s = 0.f;
        for (int r = 0; r < 256; ++r) s += bf2f(k[r * 64]);
        km[it * 64 + F.lane] = s * (1.0f / 256.0f);
    }
}

__device__ __forceinline__ void load_row64(const bf16* p, float (&q)[64]) {
    const v4u* p4 = (const v4u*)p;
#pragma unroll
    for (int i = 0; i < 8; ++i) { const v4u w = p4[i]; q[8 * i + 0] = bflo(w.x); q[8 * i + 1] = bfhi(w.x); q[8 * i + 2] = bflo(w.y); q[8 * i + 3] = bfhi(w.y); q[8 * i + 4] = bflo(w.z); q[8 * i + 5] = bfhi(w.z); q[8 * i + 6] = bflo(w.w); q[8 * i + 7] = bfhi(w.w); }
}
__device__ __forceinline__ float dot_row64(const bf16* p, const float (&q)[64]) {
    const v4u* p4 = (const v4u*)p; float s = 0.f;
#pragma unroll
    for (int i = 0; i < 8; ++i) { const v4u w = p4[i]; s += q[8 * i + 0] * bflo(w.x) + q[8 * i + 1] * bfhi(w.x) + q[8 * i + 2] * bflo(w.y) + q[8 * i + 3] * bfhi(w.y) + q[8 * i + 4] * bflo(w.z) + q[8 * i + 5] * bfhi(w.z) + q[8 * i + 6] * bflo(w.w) + q[8 * i + 7] * bfhi(w.w); }
    return s;
}
__device__ __forceinline__ void banded_naive(Frame& F) {
    unsigned char* ws = F.ws; const bf16* Qs = (const bf16*)(ws + WS_P + P_QS); const bf16* Ks = (const bf16*)(ws + WS_P + P_KS); const bf16* Vs = (const bf16*)(ws + WS_P + P_VS);
    bf16* OG = (bf16*)(ws + WS_HID + H_OG); float* LSE = (float*)(ws + WS_HID + H_LSE);
    LAS float* pl = (LAS float*)(F.lds + RING_OFF) + F.wave * 256;
    const int lane = F.lane;
    for (int it = F.blk * NWAVES + F.wave; it < 48 * SEQ; it += F.G * NWAVES) {
        const int bh = it >> 12, rp = it & 4095, b = bh / 12, h = bh % 12, g = h >> 2, dil = g == 0 ? 1 : (g == 1 ? 4 : 16), L = SEQ / dil;
        const int i = rp % L, r = rp / L, s = i * dil + r, nk = (i < 128 ? i : 128) + 1, first = rp - (nk - 1);
        float q[64]; load_row64(Qs + ((size_t)bh * SEQ + rp) * 64, q);
        float sc[3]; float m = -INFINITY;
#pragma unroll
        for (int kk = 0; kk < 3; ++kk) { const int j = lane + 64 * kk; sc[kk] = -INFINITY; if (j < nk) { sc[kk] = 0.6931471805599453f * dot_row64(Ks + ((size_t)bh * SEQ + first + j) * 64, q); } m = fmaxf(m, sc[kk]); }
        m = wave_max(m); float l = 0.f;
#pragma unroll
        for (int kk = 0; kk < 3; ++kk) { const float p = (lane + 64 * kk < nk) ? __expf(sc[kk] - m) : 0.f; pl[lane + 64 * kk] = p; l += p; }
        l = wave_sum(l); LDS_WAIT();
        float acc = 0.f; const bf16* vb = Vs + ((size_t)bh * SEQ + first) * 64 + lane;
        for (int j = 0; j < nk; ++j) acc += pl[j] * bf2f(vb[(size_t)j * 64]);
        const size_t orow = ((size_t)g * T + (size_t)b * SEQ + s) * 4 + (h & 3);
        OG[orow * 64 + lane] = (bf16)f2bf(acc / l);
        if (lane == 0) LSE[orow] = m + __logf(l);
        LDS_WAIT();
    }
}
__device__ __forceinline__ void merge_even(Frame& F, bf16* mix) {
    const bf16* OG = (const bf16*)(F.ws + WS_HID + H_OG); const float* LSE = (const float*)(F.ws + WS_HID + H_LSE);
    for (int t = F.blk * 512 + F.tid; t < T * 4 * 8; t += F.G * 512) {
        const int it = t >> 3, part = t & 7, row = it >> 2, hg = it & 3, b = row >> 12, s = row & 4095;
        const size_t i0 = ((size_t)0 * 16 + b * 4 + hg) * SEQ + srow(s, 0), i1 = ((size_t)1 * 16 + b * 4 + hg) * SEQ + srow(s, 1), i2 = ((size_t)2 * 16 + b * 4 + hg) * SEQ + srow(s, 2);
        const float l0 = LSE[i0], l1 = LSE[i1], l2 = LSE[i2]; const float m = fmaxf(l0, fmaxf(l1, l2));
        float w0 = __expf(l0 - m), w1 = __expf(l1 - m), w2 = __expf(l2 - m); const float inv = 1.0f / (w0 + w1 + w2); w0 *= inv; w1 *= inv; w2 *= inv;
        const v4u a = *(const v4u*)(OG + i0 * 64 + part * 8), bb = *(const v4u*)(OG + i1 * 64 + part * 8), c = *(const v4u*)(OG + i2 * 64 + part * 8);
        v4u o;
        o.x = pk2(w0 * bflo(a.x) + w1 * bflo(bb.x) + w2 * bflo(c.x), w0 * bfhi(a.x) + w1 * bfhi(bb.x) + w2 * bfhi(c.x));
        o.y = pk2(w0 * bflo(a.y) + w1 * bflo(bb.y) + w2 * bflo(c.y), w0 * bfhi(a.y) + w1 * bfhi(bb.y) + w2 * bfhi(c.y));
        o.z = pk2(w0 * bflo(a.z) + w1 * bflo(bb.z) + w2 * bflo(c.z), w0 * bfhi(a.z) + w1 * bfhi(bb.z) + w2 * bfhi(c.z));
        o.w = pk2(w0 * bflo(a.w) + w1 * bflo(bb.w) + w2 * bflo(c.w), w0 * bfhi(a.w) + w1 * bfhi(bb.w) + w2 * bfhi(c.w));
        *(v4u*)(mix + (size_t)row * EVEN_OUT + 256 + hg * 64 + part * 8) = o;
    }
}
__device__ __forceinline__ void gmlp_phase(Frame& F, int lp, const float* bsp, bf16* mix) {
    const bf16* UV = (const bf16*)(F.ws + WS_P + P_UV); const float* wtg = (const float*)(F.ws + WS_KMEAN) + (size_t)lp * 4 * 16384;
    LAS float* WT = (LAS float*)(F.lds + RING_OFF);
    LAS float* VL = WT + 128 * 128;
    const int tid = F.tid; int gl = -1;
    for (int unit = F.blk; unit < (T / 128) * 4; unit += F.G) {
        const int c = unit >> 2, g = unit & 3, row0 = c * 128;
        __syncthreads();
        if (g != gl) { gl = g; const f32x4* src = (const f32x4*)(wtg + (size_t)g * 16384);
#pragma unroll
            for (int q = 0; q < 8; ++q) *((LAS f32x4*)WT + tid + 512 * q) = src[tid + 512 * q]; }
        { const int j = tid >> 2, d8 = (tid & 3) * 16;
          const v4u a = *(const v4u*)(UV + (size_t)(row0 + j) * 512 + 256 + g * 64 + d8), b = *(const v4u*)(UV + (size_t)(row0 + j) * 512 + 256 + g * 64 + d8 + 8);
          LAS f32x4* vd = (LAS f32x4*)(VL + j * 64 + d8);
          vd[0] = (f32x4){bflo(a.x), bfhi(a.x), bflo(a.y), bfhi(a.y)}; vd[1] = (f32x4){bflo(a.z), bfhi(a.z), bflo(a.w), bfhi(a.w)};
          vd[2] = (f32x4){bflo(b.x), bfhi(b.x), bflo(b.y), bfhi(b.y)}; vd[3] = (f32x4){bflo(b.z), bfhi(b.z), bflo(b.w), bfhi(b.w)}; }
        __syncthreads();
        const int i0 = 4 * (tid >> 4), d0 = 4 * (tid & 15);
        f32x4 acc[4];
#pragma unroll
        for (int a = 0; a < 4; ++a) acc[a] = (f32x4){0.f, 0.f, 0.f, 0.f};
        const int jmax = i0 + 3;
        for (int j = 0; j <= jmax; ++j) { const f32x4 w = *(const LAS f32x4*)(WT + j * 128 + i0); const f32x4 v = *(const LAS f32x4*)(VL + j * 64 + d0);
            acc[0] += w.x * v; acc[1] += w.y * v; acc[2] += w.z * v; acc[3] += w.w * v; }
#pragma unroll
        for (int a = 0; a < 4; ++a) { const int i = i0 + a; const float bb = bsp[g * 128 + i]; const size_t row = row0 + i;
            const v2u uu = *(const v2u*)(UV + row * 512 + g * 64 + d0);
            v2u o; o.x = pk2(bflo(uu.x) * (acc[a].x + bb), bfhi(uu.x) * (acc[a].y + bb)); o.y = pk2(bflo(uu.y) * (acc[a].z + bb), bfhi(uu.y) * (acc[a].w + bb));
            *(v2u*)(mix + row * EVEN_OUT + g * 64 + d0) = o; }
    }
    __syncthreads();
}
__device__ __forceinline__ void moba_naive(Frame& F, bf16* mix) {
    unsigned char* ws = F.ws; const bf16* Qm = (const bf16*)(ws + WS_P + P_QM); const bf16* Km = (const bf16*)(ws + WS_P + P_KM); const bf16* Vm = (const bf16*)(ws + WS_P + P_VM);
    const float* km = (const float*)(ws + WS_KMEAN);
    LAS float* sc = (LAS float*)(F.lds + RING_OFF) + F.wave * 1024;
    const int lane = F.lane;
    for (int it = F.blk * NWAVES + F.wave; it < 48 * SEQ; it += F.G * NWAVES) {
        const int bh = it >> 12, s = it & 4095, b = bh / 12, h = bh % 12, qb = s >> 8;
        float q[64]; load_row64(Qm + ((size_t)bh * SEQ + s) * 64, q);
        float gate = -INFINITY;
        if (lane < qb) { const f32x4* kp = (const f32x4*)(km + ((size_t)bh * 16 + lane) * 64); float a = 0.f;
#pragma unroll
            for (int i = 0; i < 16; ++i) { const f32x4 w = kp[i]; a += q[4 * i] * w.x + q[4 * i + 1] * w.y + q[4 * i + 2] * w.z + q[4 * i + 3] * w.w; }
            gate = a; }
        unsigned sel = 1u << qb;
        for (int r = 0; r < 3; ++r) { float v = gate; int idx = lane;
#pragma unroll
            for (int o = 1; o < 64; o <<= 1) { const float ov = __shfl_xor(v, o); const int oi = __shfl_xor(idx, o); if (ov > v || (ov == v && oi < idx)) { v = ov; idx = oi; } }
            if (v > -INFINITY) { sel |= 1u << idx; if (lane == idx) gate = -INFINITY; } }
        int cnt = 0; float m = -INFINITY;
        for (int n = 0; n <= qb; ++n) { if (!((sel >> n) & 1u)) continue;
#pragma unroll
            for (int kk = 0; kk < 4; ++kk) { const int key = n * 256 + kk * 64 + lane; float x = -INFINITY;
                if (key <= s) x = 0.6931471805599453f * dot_row64(Km + ((size_t)bh * SEQ + key) * 64, q);
                sc[cnt * 256 + kk * 64 + lane] = x; m = fmaxf(m, x); }
            ++cnt; }
        m = wave_max(m); float l = 0.f; LDS_WAIT();
        for (int i = lane; i < cnt * 256; i += 64) { const float p = __expf(sc[i] - m); sc[i] = p; l += p; }
        l = wave_sum(l); LDS_WAIT();
        float acc = 0.f; int c2 = 0;
        for (int n = 0; n <= qb; ++n) { if (!((sel >> n) & 1u)) continue;
            const bf16* vb = Vm + ((size_t)bh * SEQ + n * 256) * 64 + lane; const int kend = (n == qb) ? (s & 255) + 1 : 256;
            for (int kk = 0; kk < kend; ++kk) acc += sc[c2 * 256 + kk] * bf2f(vb[(size_t)kk * 64]);
            ++c2; }
        mix[((size_t)b * SEQ + s) * ODD_OUT + h * 64 + lane] = (bf16)f2bf(acc / l);
        LDS_WAIT();
    }
}
__device__ __forceinline__ void conv_phase(Frame& F, const bf16* cv, const float* cw, bf16* mix) {
    for (int it = F.blk * 512 + F.tid; it < T * 32; it += F.G * 512) {
        const int row = it >> 5, c = (it & 31) * 8, s = row & 4095;
        const bf16* p = cv + (size_t)row * 768 + c;
        const v4u bg = *(const v4u*)p, c0 = *(const v4u*)(p + 256), x0 = *(const v4u*)(p + 512);
        v4u c1 = (v4u){0u, 0u, 0u, 0u}, x1 = c1, c2 = c1, x2 = c1;
        if (s >= 1) { c1 = *(const v4u*)(p + 256 - 768); x1 = *(const v4u*)(p + 512 - 768); }
        if (s >= 2) { c2 = *(const v4u*)(p + 256 - 1536); x2 = *(const v4u*)(p + 512 - 1536); }
        const f32x4 wa0 = *(const f32x4*)(cw + c), wa1 = *(const f32x4*)(cw + c + 4), wb0 = *(const f32x4*)(cw + 256 + c), wb1 = *(const f32x4*)(cw + 256 + c + 4), wc0 = *(const f32x4*)(cw + 512 + c), wc1 = *(const f32x4*)(cw + 512 + c + 4);
        const unsigned bgw[4] = {bg.x, bg.y, bg.z, bg.w}, c0w[4] = {c0.x, c0.y, c0.z, c0.w}, x0w[4] = {x0.x, x0.y, x0.z, x0.w}, c1w[4] = {c1.x, c1.y, c1.z, c1.w}, x1w[4] = {x1.x, x1.y, x1.z, x1.w}, c2w[4] = {c2.x, c2.y, c2.z, c2.w}, x2w[4] = {x2.x, x2.y, x2.z, x2.w};
        const float w0[8] = {wa0.x, wa0.y, wa0.z, wa0.w, wa1.x, wa1.y, wa1.z, wa1.w}, w1[8] = {wb0.x, wb0.y, wb0.z, wb0.w, wb1.x, wb1.y, wb1.z, wb1.w}, w2[8] = {wc0.x, wc0.y, wc0.z, wc0.w, wc1.x, wc1.y, wc1.z, wc1.w};
        unsigned ow[4];
#pragma unroll
        for (int k = 0; k < 4; ++k) {
            const float ylo = w0[2 * k] * (bflo(c2w[k]) * bflo(x2w[k])) + w1[2 * k] * (bflo(c1w[k]) * bflo(x1w[k])) + w2[2 * k] * (bflo(c0w[k]) * bflo(x0w[k]));
            const float yhi = w0[2 * k + 1] * (bfhi(c2w[k]) * bfhi(x2w[k])) + w1[2 * k + 1] * (bfhi(c1w[k]) * bfhi(x1w[k])) + w2[2 * k + 1] * (bfhi(c0w[k]) * bfhi(x0w[k]));
            ow[k] = pk2(bflo(bgw[k]) * ylo, bfhi(bgw[k]) * yhi); }
        *(v4u*)(mix + (size_t)row * ODD_OUT + 768 + c) = (v4u){ow[0], ow[1], ow[2], ow[3]};
    }
}

constexpr int CW_QMOBA = 8192;
__device__ __forceinline__ void moba_phase(Frame& F, int lp, bf16* mix) {
    unsigned char* ws = F.ws; const bf16* Qm = (const bf16*)(ws + WS_P + P_QM); const bf16* Km = (const bf16*)(ws + WS_P + P_KM); const bf16* Vm = (const bf16*)(ws + WS_P + P_VM);
    const float* km = (const float*)(ws + WS_CTL + CTL_KMSUM + (size_t)(lp & 1) * KMSUM_BYTES);
    char* shm = (char*)F.lds + RING_OFF; LAS unsigned char* l3 = F.lds + RING_OFF;
    LAS float* kml = (LAS float*)(l3 + att::LDS_KM); volatile LAS int* tkw = (volatile LAS int*)(l3 + att::LDS_TK);
    unsigned* head = (unsigned*)(F.ctl + CW_QMOBA + 64 * lp);
    const int tid = F.tid, wid = F.wave;
    for (;;) {
        if (tid == 0) tkw[0] = (int)__hip_atomic_fetch_add(head, 1u, __ATOMIC_RELAXED, __HIP_MEMORY_SCOPE_AGENT);
        __syncthreads();
        const int tk = __builtin_amdgcn_readfirstlane(tkw[0]);
        if (tk >= 48 * 16) break;
        const int qb = 15 - tk / 48, bh = tk % 48, b = bh / 12, h = bh % 12;
        int lane_ = F.lane; asm volatile("" : "+v"(lane_)); const int r32 = lane_ & 31, hi = lane_ >> 5;
        ((LAS v2u*)kml)[tid] = ((const v2u*)(km + (size_t)bh * 1024))[tid];
        __syncthreads();
        unsigned sel = 0u;
        { const bf16* qrow = Qm + ((size_t)bh * SEQ + qb * 256 + wid * 32 + r32) * 64 + hi * 8;
          float qf[32];
#pragma unroll
          for (int d0 = 0; d0 < 4; ++d0) { const v4u w = *(const v4u*)(qrow + d0 * 16);
              qf[8 * d0 + 0] = bflo(w.x); qf[8 * d0 + 1] = bfhi(w.x); qf[8 * d0 + 2] = bflo(w.y); qf[8 * d0 + 3] = bfhi(w.y); qf[8 * d0 + 4] = bflo(w.z); qf[8 * d0 + 5] = bfhi(w.z); qf[8 * d0 + 6] = bflo(w.w); qf[8 * d0 + 7] = bfhi(w.w); }
          float v1 = -INFINITY, v2 = -INFINITY, v3 = -INFINITY; int i1 = 0, i2 = 0, i3 = 0;
          for (int n = 0; n < qb; ++n) { float a = 0.f;
#pragma unroll
              for (int d0 = 0; d0 < 4; ++d0) { const f32x4 k0 = *(const LAS f32x4*)(kml + n * 64 + d0 * 16 + hi * 8), k1 = *(const LAS f32x4*)(kml + n * 64 + d0 * 16 + hi * 8 + 4);
                  a += qf[8 * d0 + 0] * k0.x + qf[8 * d0 + 1] * k0.y + qf[8 * d0 + 2] * k0.z + qf[8 * d0 + 3] * k0.w + qf[8 * d0 + 4] * k1.x + qf[8 * d0 + 5] * k1.y + qf[8 * d0 + 6] * k1.z + qf[8 * d0 + 7] * k1.w; }
              a = xsum32(a);
              if (a > v1) { v3 = v2; i3 = i2; v2 = v1; i2 = i1; v1 = a; i1 = n; } else if (a > v2) { v3 = v2; i3 = i2; v2 = a; i2 = n; } else if (a > v3) { v3 = a; i3 = n; } }
          if (v1 > -INFINITY) sel |= 1u << i1; if (v2 > -INFINITY) sel |= 1u << i2; if (v3 > -INFINITY) sel |= 1u << i3; }
        const size_t sb = (size_t)bh * SEQ * 64;
        att::attn_unit<0, 8, ODD_OUT>(Qm + sb, qb * 256, 0, 4 * (qb + 1), sel, mix + ((size_t)b * SEQ + qb * 256) * ODD_OUT + h * 64, nullptr, shm, tid);
    }
    __syncthreads();
}
__device__ __forceinline__ void banded_phase(Frame& F) {
    unsigned char* ws = F.ws; const bf16* Qs = (const bf16*)(ws + WS_P + P_QS); const bf16* Ks = (const bf16*)(ws + WS_P + P_KS); const bf16* Vs = (const bf16*)(ws + WS_P + P_VS);
    bf16* OG = (bf16*)(ws + WS_HID + H_OG); float* LSE = (float*)(ws + WS_HID + H_LSE);
    char* shm = (char*)F.lds + RING_OFF;
    for (int u = F.blk; u < 768; u += F.G) {
        const int g = u >> 8, rem = u & 255, b = rem >> 6, hg = (rem >> 4) & 3, u16 = rem & 15, h = g * 4 + hg, bh = b * 12 + h;
        const int dil = g == 0 ? 1 : (g == 1 ? 4 : 16), L = SEQ / dil, row0 = 256 * u16, r = row0 / L, q0s = row0 % L;
        const int tile0 = (q0s >> 6) >= 2 ? (q0s >> 6) - 2 : 0, NT = (q0s >> 6) + 4 - tile0;
        const size_t sb = ((size_t)bh * SEQ + (size_t)r * L) * 64;
        const size_t orow = ((size_t)g * 16 + b * 4 + hg) * SEQ + row0;
        att::attn_unit<1, 8, 64>(Qs + sb, q0s, tile0, NT, 0u, OG + orow * 64, LSE + orow, shm, F.tid);
    }
    __syncthreads();
}

constexpr int PH_PER_PAIR = 16, NPH = 1 + 2 * PH_PER_PAIR + 1;
__global__ void __launch_bounds__(NWAVES * 64, 2) fwd(Args args) {
    extern __shared__ __attribute__((aligned(16))) unsigned char lds[];
    const int wv0 = __builtin_amdgcn_readfirstlane((int)threadIdx.x >> 6);
#define MKFRAME() Frame F; { int t_ = TID_NOW(wv0); asm volatile("" : "+v"(t_)); int b_ = blockIdx.x; asm volatile("" : "+s"(b_)); \
    F.lds = (LAS unsigned char*)lds; F.MISC = (volatile LAS unsigned*)(F.lds + MISC_OFF); F.tid = t_; F.lane = t_ & 63; F.wave = __builtin_amdgcn_readfirstlane(t_ >> 6); \
    unsigned char* w_ = args.ws; asm volatile("" : "+s"(w_)); F.G = gridDim.x; F.blk = b_; F.ws = w_; F.out = args.out; F.ctl = (gu32*)(w_ + WS_CTL); }
    for (int u = TID_NOW(wv0); u < (LDS_BYTES - LDSCTL_OFF) / 4; u += NWAVES * 64) ((LAS unsigned*)((LAS unsigned char*)lds + LDSCTL_OFF))[u] = 0u;
    __syncthreads();
    const int lo = args.ph_lo, hi = args.ph_hi;
    XcdBarrier bar; bar.bar = (unsigned*)(args.ws + WS_CTL) + CW_BAR; bar.x = 0; bar.st = nullptr;
    if (hi - lo > 1) bar = xcd_barrier_post((unsigned*)(args.ws + WS_CTL) + CW_BAR, (volatile LAS unsigned*)((LAS unsigned char*)lds + MISC_OFF) + 8, TID_NOW(wv0));
#ifndef PHMASK
#define PHMASK 0xFFFFFF
#endif
#define PHEN(k) (((PHMASK) >> (k)) & 1)
#ifndef PROBE_REP
#define PROBE_REP 0
#endif
#define NREP(k) ((((PROBE_REP) >> (k)) & 1) + 1)
#define IN(k) (lo <= (k) && (k) < hi)
#define SEAM(k) do { if (IN(k) && IN((k) + 1)) xcd_barrier(bar, TID_NOW(wv0)); } while (0)
#define HN ((bf16*)(F.ws + WS_HN))
#define MIX ((bf16*)(F.ws + WS_MIX))
#define HID ((bf16*)(F.ws + WS_HID))
#define RAWP ((bf16*)(F.ws + WS_HID + H_RAWP))
#define HSORT ((bf16*)(F.ws + WS_P))
#define YB ((bf16*)(F.ws + WS_P))
#define x_in (args.in[0])

    if (PHEN(19) && IN(0)) { for (int rep_ = 0; rep_ < NREP(19); ++rep_) { MKFRAME(); p0_prologue(F, args); } SEAM(0); }

    for (int lp = 0; lp < 2; ++lp) {
        const int pb = 1 + lp * PH_PER_PAIR;
        const int le = 2 * lp, lo_ = 2 * lp + 1;
#define we ((const pg8::bf16_t*)(F.ws + WS_WT_EVEN0 + (size_t)lp * WT_EVEN_BYTES))
#define wo ((const pg8::bf16_t*)(F.ws + WS_WT_ODD0 + (size_t)lp * WT_ODD_BYTES))
        if (PHEN(0) && IN(pb + 0)) { for (int rep_ = 0; rep_ < NREP(0); ++rep_) { MKFRAME();
            norm_phase(F, lp == 0 ? x_in : F.out, F.out, args.in[1] + (size_t)le * D, HN, lp != 0, false, true, nullptr);
            } SEAM(pb + 0); }
        if (PHEN(1) && IN(pb + 1)) { for (int rep_ = 0; rep_ < NREP(1); ++rep_) { MKFRAME();
            pg8::Gemm g{HN, we + WTE_IN / 2, T, EVEN_IN, D}; pg8::StaticOrder S; S.init(T, EVEN_IN, F.G, F.blk);
            pg8::EpiHeadsEven E{(bf16*)(F.ws + WS_P + P_UV), (bf16*)(F.ws + WS_P + P_QS), args.in[4] + (size_t)lp * 256, args.in[7] + (size_t)lp * 64, args.in[8] + (size_t)lp * 64,
                                (const float*)(F.ws + WS_ROPE), (const float*)(F.ws + WS_ROPE) + SEQ * 32};
            pg8::gemm_phase<pg8::EpiHeadsEven, pg8::StaticOrder>(F.lds + RING_OFF, g, S, E, F.tid);
            } SEAM(pb + 1); }
        if (PHEN(2) && IN(pb + 2)) { for (int rep_ = 0; rep_ < NREP(2); ++rep_) { MKFRAME(); banded_phase(F); gmlp_phase(F, lp, args.in[6] + (size_t)lp * 4 * 128, MIX); } SEAM(pb + 2); }
        if (PHEN(3) && IN(pb + 3)) { for (int rep_ = 0; rep_ < NREP(3); ++rep_) { MKFRAME(); merge_even(F, MIX); } SEAM(pb + 3); }
        if (PHEN(4) && IN(pb + 4)) { for (int rep_ = 0; rep_ < NREP(4); ++rep_) { MKFRAME();
            pg8::Gemm g{MIX, we + WTE_OUT / 2, T, D, EVEN_OUT}; pg8::StaticOrder S; S.init(T, D, F.G, F.blk);
            pg8::EpiF32Res E{lp == 0 ? x_in : F.out, F.out, D};
            pg8::gemm_phase<pg8::EpiF32Res, pg8::StaticOrder>(F.lds + RING_OFF, g, S, E, F.tid);
            } SEAM(pb + 4); }
        if (PHEN(5) && IN(pb + 5)) { for (int rep_ = 0; rep_ < NREP(5); ++rep_) { MKFRAME(); norm_phase(F, F.out, F.out, args.in[2] + (size_t)le * D, HN, false, false, true, nullptr); } SEAM(pb + 5); }
        if (PHEN(6) && IN(pb + 6)) { for (int rep_ = 0; rep_ < NREP(6); ++rep_) { MKFRAME();
            pg8::Gemm g{HN, we + WTE_GU / 2, T, 2 * DFF, D}; pg8::StaticOrder S; S.init(T, 2 * DFF, F.G, F.blk);
            pg8::EpiSwiGLU E{HID, DFF, 1.0f};
            pg8::gemm_phase<pg8::EpiSwiGLU, pg8::StaticOrder>(F.lds + RING_OFF, g, S, E, F.tid);
            } SEAM(pb + 6); }
        if (PHEN(7) && IN(pb + 7)) { for (int rep_ = 0; rep_ < NREP(7); ++rep_) { MKFRAME();
            pg8::Gemm g{HID, we + WTE_DN / 2, T, D, DFF}; pg8::StaticOrder S; S.init(T, D, F.G, F.blk);
            pg8::EpiF32Res E{F.out, F.out, D};
            pg8::gemm_phase<pg8::EpiF32Res, pg8::StaticOrder>(F.lds + RING_OFF, g, S, E, F.tid);
            } SEAM(pb + 7); }
        if (PHEN(8) && IN(pb + 8)) { for (int rep_ = 0; rep_ < NREP(8); ++rep_) { MKFRAME(); norm_phase(F, F.out, F.out, args.in[1] + (size_t)lo_ * D, HN, false, false, true, nullptr); } SEAM(pb + 8); }
        if (PHEN(9) && IN(pb + 9)) { for (int rep_ = 0; rep_ < NREP(9); ++rep_) { MKFRAME();
            pg8::Gemm g{HN, wo + WTO_IN / 2, T, ODD_IN, D}; pg8::StaticOrder S; S.init(T, ODD_IN, F.G, F.blk);
            pg8::EpiHeadsOdd E{(bf16*)(F.ws + WS_P + P_QM), (bf16*)(F.ws + WS_P + P_CONV), (float*)(F.ws + WS_CTL + CTL_KMSUM + (size_t)lp * KMSUM_BYTES),
                               args.in[14] + (size_t)lp * 64, args.in[15] + (size_t)lp * 64, (const float*)(F.ws + WS_ROPE), (const float*)(F.ws + WS_ROPE) + SEQ * 32};
            pg8::gemm_phase<pg8::EpiHeadsOdd, pg8::StaticOrder>(F.lds + RING_OFF, g, S, E, F.tid);
            } SEAM(pb + 9); }
        if (PHEN(10) && IN(pb + 10)) { for (int rep_ = 0; rep_ < NREP(10); ++rep_) { MKFRAME(); moba_phase(F, lp + 2 * rep_, MIX); conv_phase(F, (const bf16*)(F.ws + WS_P + P_CONV), args.in[16] + (size_t)lp * 3 * 256, MIX); } SEAM(pb + 10); }
        if (PHEN(11) && IN(pb + 11)) { for (int rep_ = 0; rep_ < NREP(11); ++rep_) { MKFRAME();
            pg8::Gemm g{MIX, wo + WTO_OUT / 2, T, D, ODD_OUT}; pg8::StaticOrder S; S.init(T, D, F.G, F.blk);
            pg8::EpiF32Res E{F.out, F.out, D};
            pg8::gemm_phase<pg8::EpiF32Res, pg8::StaticOrder>(F.lds + RING_OFF, g, S, E, F.tid);
            } SEAM(pb + 11); }
        if (PHEN(12) && IN(pb + 12)) { for (int rep_ = 0; rep_ < NREP(12); ++rep_) { MKFRAME(); norm_phase(F, F.out, F.out, args.in[2] + (size_t)lo_ * D, HN, false, true, true, args.in[18] + (size_t)lp * D * NEXP); } SEAM(pb + 12); }
        if (PHEN(13) && IN(pb + 13)) { for (int rep_ = 0; rep_ < NREP(13); ++rep_) { MKFRAME(); route_phase(F, HN, HSORT); } SEAM(pb + 13); }
        if (PHEN(14) && IN(pb + 14)) { for (int rep_ = 0; rep_ < NREP(14); ++rep_) { MKFRAME();
            const int* tbp = (const int*)(F.ws + WS_MISC + 512 * 1024);
            pg8::MoeOrder S; const int ntiles = __builtin_amdgcn_readfirstlane(tbp[8]); S.init(ntiles * 256, 2 * DFFE, F.G, F.blk);
#pragma unroll
            for (int k = 0; k < 8; ++k) S.tb[k] = __builtin_amdgcn_readfirstlane(tbp[k]);
            S.estride = (size_t)2 * DFFE * D;
            pg8::Gemm g{HSORT, wo + WTO_MGU / 2, ntiles * 256, 2 * DFFE, D};
            pg8::EpiSwiGLU E{HID, DFFE, 1.0f / W8_SCALE};
            pg8::gemm_phase<pg8::EpiSwiGLU, pg8::MoeOrder, false, true, true>(F.lds + RING_OFF, g, S, E, F.tid);
            } SEAM(pb + 14); }
        if (PHEN(15) && IN(pb + 15)) { for (int rep_ = 0; rep_ < NREP(15); ++rep_) { MKFRAME();
            const int* tbp = (const int*)(F.ws + WS_MISC + 512 * 1024);
            pg8::MoeOrder S; const int ntiles = __builtin_amdgcn_readfirstlane(tbp[8]); S.init(ntiles * 256, D, F.G, F.blk);
#pragma unroll
            for (int k = 0; k < 8; ++k) S.tb[k] = __builtin_amdgcn_readfirstlane(tbp[k]);
            S.estride = (size_t)DFFE * D * 2;
            pg8::Gemm g{HID, wo + WTO_MD / 2, ntiles * 256, D, DFFE};
            pg8::EpiBf16Plain E{YB, D};
            pg8::gemm_phase<pg8::EpiBf16Plain, pg8::MoeOrder>(F.lds + RING_OFF, g, S, E, F.tid);
            } SEAM(pb + 15); }
    }
    if (PHEN(20) && IN(NPH - 1)) { MKFRAME(); norm_phase(F, F.out, F.out, args.in[1], HN, true, false, false, nullptr); }
#undef IN
#undef SEAM
#undef HN
#undef MIX
#undef HID
#undef RAWP
#undef HSORT
#undef YB
#undef x_in
#undef we
#undef wo
}

extern "C" void kernel_launch(void* const* d_in, const int* in_sizes, int n_in, void* d_out, int out_size, void* d_ws, size_t ws_size, hipStream_t stream) {
    static int grid = 0;
    if (grid == 0) {
        if (n_in != 22 || out_size != T * D || ws_size < WS_END) { fprintf(stderr, "kernel_launch: unexpected shapes (n_in %d out %d ws %zu)\n", n_in, out_size, ws_size); grid = -1; return; }
        int dev = 0, cus = 0, per_cu = 0;
        if (hipGetDevice(&dev) != hipSuccess || hipDeviceGetAttribute(&cus, hipDeviceAttributeMultiprocessorCount, dev) != hipSuccess) { grid = -1; return; }
        if (hipFuncSetAttribute((const void*)fwd, hipFuncAttributeMaxDynamicSharedMemorySize, LDS_BYTES) != hipSuccess) { fprintf(stderr, "kernel_launch: hipFuncSetAttribute failed\n"); grid = -1; return; }
        if (hipOccupancyMaxActiveBlocksPerMultiprocessor(&per_cu, (const void*)fwd, NWAVES * 64, LDS_BYTES) != hipSuccess || per_cu < 1) fprintf(stderr, "kernel_launch: occupancy query says %d\n", per_cu);
        (void)hipGetLastError();
        grid = cus;
    }
    if (grid < 0) return;
    (void)hipMemsetAsync((char*)d_ws + WS_CTL, 0, CTL_ZERO_BYTES, stream);
    Args a{};
    for (int i = 0; i < 22; ++i) a.in[i] = (const float*)d_in[i];
    a.out = (float*)d_out; a.ws = (unsigned char*)d_ws;
#if MK_PER_PHASE
    for (int p = 0; p < NPH; ++p) { a.ph_lo = p; a.ph_hi = p + 1; hipLaunchKernelGGL(fwd, dim3(grid), dim3(NWAVES * 64), LDS_BYTES, stream, a); }
#else
    a.ph_lo = 0; a.ph_hi = NPH; hipLaunchKernelGGL(fwd, dim3(grid), dim3(NWAVES * 64), LDS_BYTES, stream, a);
#endif
}
```

```cpp
#include <hip/hip_runtime.h>
#include <cstdio>
#include <cstdint>
#include <hip/hip_bf16.h>


template <int X> __device__ __forceinline__ float xswz(float v) { return __builtin_bit_cast(float, __builtin_amdgcn_ds_swizzle(__builtin_bit_cast(int, v), (X << 10) | 0x1F)); }
template <int X> __device__ __forceinline__ int xswzi(int v) { return __builtin_amdgcn_ds_swizzle(v, (X << 10) | 0x1F); }
__device__ __forceinline__ float xsum32(float v) { float a = v, b = v; asm("s_nop 1\n\tv_permlane32_swap_b32_e32 %0, %1" : "+v"(a), "+v"(b)); return a + b; }
__device__ __forceinline__ int xsum32i(int v) { int a = v, b = v; asm("s_nop 1\n\tv_permlane32_swap_b32_e32 %0, %1" : "+v"(a), "+v"(b)); return a + b; }
__device__ __forceinline__ float xmax32(float v) { float a = v, b = v; asm("s_nop 1\n\tv_permlane32_swap_b32_e32 %0, %1" : "+v"(a), "+v"(b)); return fmaxf(a, b); }


__device__ __forceinline__ int lane_hw() { int l; asm volatile("v_mbcnt_lo_u32_b32 %0, -1, 0\n\tv_mbcnt_hi_u32_b32 %0, -1, %0" : "=v"(l)); return l; }
#define TID_NOW(wv) ((wv) * 64 + lane_hw())

#ifndef NAIVE_MOBA
#define NAIVE_MOBA 0
#endif
#ifndef NAIVE_BANDED
#define NAIVE_BANDED 0
#endif
#ifndef MK_PER_PHASE
#define MK_PER_PHASE 0
#endif

namespace pg8 {
#define PG8_LAS __attribute__((address_space(3)))
typedef unsigned short bf16_t;
typedef short bf16x8 __attribute__((ext_vector_type(8)));
typedef float f32x4 __attribute__((ext_vector_type(4)));
typedef float f32x2 __attribute__((ext_vector_type(2)));
typedef unsigned u32x4 __attribute__((ext_vector_type(4)));
constexpr int BM = 256, BK = 64, HALF = 128, HTB = HALF * BK * 2, STAGE_BYTES = 8 * HTB, NXCD = 8, WGM = 8;

__host__ __device__ __forceinline__ int lds_byte(int r, int c) { const int st = (r >> 4) * 2 + (c >> 5), rr = r & 15, cc = c & 31, ob = rr * 64 + cc * 2; return st * 1024 + (ob ^ (((ob >> 9) & 1) << 5)); }
__host__ __device__ __forceinline__ void stage_rc(int b, int& R, int& C) { const int st = b / 1024, sb = b % 1024, swz = sb ^ (((sb >> 9) & 1) << 5); R = (st >> 1) * 16 + swz / 64; C = (st & 1) * 32 + (swz % 64) / 2; }
__host__ __device__ __forceinline__ int perm32(int rho) { const int n = rho >> 4, i = rho & 15; return 8 * (i >> 2) + 4 * n + (i & 3); }

struct Unit { int pm, pn; };
struct Gemm { const bf16_t* A; const bf16_t* Bt; int M, N, K; };

struct StaticOrder {
    int nM, nN, nwg, G, c;
    __device__ void init(int M, int N, int G_, int c_) { nM = M / BM; nN = N / BM; nwg = nM * nN; G = G_; c = c_; }
    __device__ bool next(int i, Unit& u) const {
        const long L = (long)i * G + c; if (L >= nwg) return false;
        int wgid = (int)L; { const int q = nwg / NXCD, r = nwg % NXCD, xcd = wgid % NXCD, off = wgid / NXCD; wgid = (xcd < r ? xcd * (q + 1) : r * (q + 1) + (xcd - r) * q) + off; }
        const int nig = WGM * nN, gid = wgid / nig, fm = gid * WGM, gsz = (nM - fm) < WGM ? (nM - fm) : WGM;
        u.pm = fm + ((wgid % nig) % gsz); u.pn = (wgid % nig) / gsz; return true;
    }
    __device__ __forceinline__ const char* bbase(const Unit&, const bf16_t* Bt) const { return (const char*)Bt; }
};
struct MoeOrder : StaticOrder {
    int tb[8]; size_t estride;
    __device__ __forceinline__ const char* bbase(const Unit& u, const bf16_t* Bt) const {
        unsigned e = 0;
#pragma unroll
        for (int k = 1; k < 8; ++k) e += ((unsigned)(tb[k] - 1 - u.pm)) >> 31;
        return (const char*)Bt + (size_t)e * estride;
    }
};

__device__ __forceinline__ unsigned cvt_pk_bf16(float lo, float hi) { unsigned r; asm volatile("v_cvt_pk_bf16_f32 %0, %1, %2" : "=v"(r) : "v"(lo), "v"(hi)); return r; }

struct EpiBf16Plain {
    static constexpr bool PERM = true;
    bf16_t* O; int ldc; float sc;
    __device__ __forceinline__ void operator()(const f32x4 (&acc)[2][2][4][2], const Unit& u, int wr, int wc, int fr, int fq) const {
        const int row0 = u.pm * BM + wr * 64 + fr, col0 = u.pn * BM + wc * 32 + 8 * fq;
#pragma unroll
        for (int ai = 0; ai < 2; ++ai)
#pragma unroll
            for (int m = 0; m < 4; ++m) { bf16_t* rowp = O + (size_t)(row0 + ai * HALF + m * 16) * ldc + col0;
#pragma unroll
                for (int bj = 0; bj < 2; ++bj) { const f32x4 v0 = acc[ai][bj][m][0] * sc, v1 = acc[ai][bj][m][1] * sc;
                    u32x4 w; w.x = cvt_pk_bf16(v0[0], v0[1]); w.y = cvt_pk_bf16(v0[2], v0[3]); w.z = cvt_pk_bf16(v1[0], v1[1]); w.w = cvt_pk_bf16(v1[2], v1[3]);
                    *(u32x4*)(rowp + bj * HALF) = w; } }
    }
};
struct EpiF32Res {
    static constexpr bool PERM = false;
    const float* base; float* out; int ldc;
    __device__ __forceinline__ void operator()(const f32x4 (&acc)[2][2][4][2], const Unit& u, int wr, int wc, int fr, int fq) const {
        const int row0 = u.pm * BM + wr * 64 + fr, col0 = u.pn * BM + wc * 32 + 4 * fq;
#pragma unroll
        for (int ai = 0; ai < 2; ++ai)
#pragma unroll
            for (int m = 0; m < 4; ++m) { const size_t off = (size_t)(row0 + ai * HALF + m * 16) * ldc + col0;
#pragma unroll
                for (int bj = 0; bj < 2; ++bj)
#pragma unroll
                    for (int n = 0; n < 2; ++n) { const f32x4 bs = *(const f32x4*)(base + off + bj * HALF + n * 16); *(f32x4*)(out + off + bj * HALF + n * 16) = bs + acc[ai][bj][m][n]; }
                asm volatile("" ::: "memory"); }
    }
};
__device__ __forceinline__ float silu_mul(float g, float u) { return g * __builtin_amdgcn_rcpf(1.0f + __builtin_amdgcn_exp2f(-1.4426950408889634f * g)) * u; }
struct EpiSwiGLU {
    static constexpr bool PERM = true;
    bf16_t* O; int ldc; float sc;
    __device__ __forceinline__ void operator()(const f32x4 (&acc)[2][2][4][2], const Unit& u, int wr, int wc, int fr, int fq) const {
        const int row0 = u.pm * BM + wr * 64 + fr, col0 = u.pn * HALF + wc * 32 + 8 * fq;
#pragma unroll
        for (int ai = 0; ai < 2; ++ai)
#pragma unroll
            for (int m = 0; m < 4; ++m) { bf16_t* rowp = O + (size_t)(row0 + ai * HALF + m * 16) * ldc + col0;
                const f32x4 g0 = acc[ai][0][m][0] * sc, g1 = acc[ai][0][m][1] * sc, u0 = acc[ai][1][m][0] * sc, u1 = acc[ai][1][m][1] * sc;
                u32x4 w; w.x = cvt_pk_bf16(silu_mul(g0[0], u0[0]), silu_mul(g0[1], u0[1])); w.y = cvt_pk_bf16(silu_mul(g0[2], u0[2]), silu_mul(g0[3], u0[3]));
                w.z = cvt_pk_bf16(silu_mul(g1[0], u1[0]), silu_mul(g1[1], u1[1])); w.w = cvt_pk_bf16(silu_mul(g1[2], u1[2]), silu_mul(g1[3], u1[3]));
                *(u32x4*)rowp = w; }
    }
};


__device__ __forceinline__ float gelu_t(float x) { const float y2 = 1.5957691216057308f * (x + 0.044715f * x * x * x); return x * __builtin_amdgcn_rcpf(1.0f + __builtin_amdgcn_exp2f(-1.4426950408889634f * y2)); }
__device__ __forceinline__ void st8(bf16_t* p, const float (&v)[8]) { u32x4 w; w.x = cvt_pk_bf16(v[0], v[1]); w.y = cvt_pk_bf16(v[2], v[3]); w.z = cvt_pk_bf16(v[4], v[5]); w.w = cvt_pk_bf16(v[6], v[7]); *(u32x4*)p = w; }
__device__ __forceinline__ int srow_g(int s, int g) { return g == 0 ? s : (g == 1 ? ((s & 3) * 1024 + (s >> 2)) : ((s & 15) * 256 + (s >> 4))); }
#define PG8_GETROW(x0, x1) do { const f32x4 a0 = acc[ai][0][m][0], a1 = acc[ai][0][m][1], b0 = acc[ai][1][m][0], b1 = acc[ai][1][m][1]; \
    x0[0] = a0[0]; x0[1] = a0[1]; x0[2] = a0[2]; x0[3] = a0[3]; x0[4] = a1[0]; x0[5] = a1[1]; x0[6] = a1[2]; x0[7] = a1[3]; \
    x1[0] = b0[0]; x1[1] = b0[1]; x1[2] = b0[2]; x1[3] = b0[3]; x1[4] = b1[0]; x1[5] = b1[1]; x1[6] = b1[2]; x1[7] = b1[3]; } while (0)
__device__ __forceinline__ void head_norm_rope(float (&x0)[8], float (&x1)[8], const float (&g0)[8], const float (&g1)[8], const float* cs, const float* sn, int s, int fq, float scale) {
    float ss = 0.f;
#pragma unroll
    for (int i = 0; i < 8; ++i) ss += x0[i] * x0[i] + x1[i] * x1[i];
    ss += xswz<16>(ss); ss = xsum32(ss);
    const float rstd = scale / sqrtf(ss * (1.0f / 64.0f) + 1e-6f);
    const f32x4 c0 = *(const f32x4*)(cs + s * 32 + 8 * fq), c1 = *(const f32x4*)(cs + s * 32 + 8 * fq + 4), s0 = *(const f32x4*)(sn + s * 32 + 8 * fq), s1 = *(const f32x4*)(sn + s * 32 + 8 * fq + 4);
#pragma unroll
    for (int i = 0; i < 8; ++i) { const float a = x0[i] * rstd * g0[i], b = x1[i] * rstd * g1[i]; const float c = i < 4 ? c0[i & 3] : c1[i & 3], sv = i < 4 ? s0[i & 3] : s1[i & 3];
        x0[i] = a * c - b * sv; x1[i] = b * c + a * sv; }
}
struct EpiHeadsEven {
    static constexpr bool PERM = false;
    bf16_t* UV; bf16_t* Qs; const float* vgain; const float* qgain; const float* kgain; const float* cs; const float* sn;
    __device__ __forceinline__ void operator()(const f32x4 (&acc)[2][2][4][2], const Unit& u, int wr, int wc, int fr, int fq) const {
        const int pn = u.pn, row0 = u.pm * BM + wr * 64 + fr;
        const int kind = pn == 0 ? 0 : (pn == 1 ? 1 : (pn < 8 ? 2 : 3));
        const bool isq = pn < 5; const int h = (pn < 5 ? pn - 2 : (pn < 8 ? pn - 5 : pn - 8)) * 4 + wc, grp = h >> 2;
        float g0[8], g1[8];
        { const float* gp = kind == 1 ? vgain + wc * 64 : (isq ? qgain : kgain);
#pragma unroll
          for (int i = 0; i < 8; ++i) { g0[i] = gp[8 * fq + i]; g1[i] = gp[32 + 8 * fq + i]; } }
        bf16_t* hb = Qs + (kind == 3 ? (size_t)24 * 1024 * 1024 : (isq ? (size_t)0 : (size_t)12 * 1024 * 1024));
#pragma unroll
        for (int ai = 0; ai < 2; ++ai)
#pragma unroll
            for (int m = 0; m < 4; ++m) {
                const int row = row0 + ai * HALF + m * 16, b = row >> 12, s = row & 4095;
                float x0[8], x1[8]; PG8_GETROW(x0, x1);
                if (kind <= 1) {
#pragma unroll
                    for (int i = 0; i < 8; ++i) { x0[i] = gelu_t(x0[i]); x1[i] = gelu_t(x1[i]); }
                    if (kind == 1) { float ss = 0.f;
#pragma unroll
                        for (int i = 0; i < 8; ++i) ss += x0[i] * x0[i] + x1[i] * x1[i];
                        ss += xswz<16>(ss); ss = xsum32(ss);
                        const float rstd = 1.0f / sqrtf(ss * (1.0f / 64.0f) + 1e-6f);
#pragma unroll
                        for (int i = 0; i < 8; ++i) { x0[i] *= rstd * g0[i]; x1[i] *= rstd * g1[i]; } }
                    bf16_t* d = UV + (size_t)row * 512 + pn * 256 + wc * 64 + 8 * fq; st8(d, x0); st8(d + 32, x1);
                } else {
                    if (kind == 2) head_norm_rope(x0, x1, g0, g1, cs, sn, s, fq, isq ? 0.18033688011112042f : 1.0f);
                    bf16_t* d = hb + ((size_t)(b * 12 + h) * 4096 + srow_g(s, grp)) * 64 + 8 * fq; st8(d, x0); st8(d + 32, x1);
                }
            }
    }
};
struct EpiHeadsOdd {
    static constexpr bool PERM = false;
    bf16_t* Qm; bf16_t* CONV; float* kmsum; const float* qgain; const float* kgain; const float* cs; const float* sn;
    __device__ __forceinline__ void operator()(const f32x4 (&acc)[2][2][4][2], const Unit& u, int wr, int wc, int fr, int fq) const {
        const int pn = u.pn, row0 = u.pm * BM + wr * 64 + fr;
        const int kind = pn < 6 ? 2 : (pn < 9 ? 3 : 4);
        const bool isq = pn < 3; const int h = (pn % 3) * 4 + wc;
        float g0[8], g1[8];
        { const float* gp = isq ? qgain : kgain;
#pragma unroll
          for (int i = 0; i < 8; ++i) { g0[i] = gp[8 * fq + i]; g1[i] = gp[32 + 8 * fq + i]; } }
        bf16_t* hb = Qm + (kind == 3 ? (size_t)24 * 1024 * 1024 : (isq ? (size_t)0 : (size_t)12 * 1024 * 1024));
        float cs0[8], cs1[8];
#pragma unroll
        for (int i = 0; i < 8; ++i) { cs0[i] = 0.f; cs1[i] = 0.f; }
#pragma unroll
        for (int ai = 0; ai < 2; ++ai)
#pragma unroll
            for (int m = 0; m < 4; ++m) {
                const int row = row0 + ai * HALF + m * 16, b = row >> 12, s = row & 4095;
                float x0[8], x1[8]; PG8_GETROW(x0, x1);
                if (kind == 4) { bf16_t* d = CONV + (size_t)row * 768 + (pn - 9) * 256 + wc * 64 + 8 * fq; st8(d, x0); st8(d + 32, x1); }
                else {
                    if (kind == 2) { head_norm_rope(x0, x1, g0, g1, cs, sn, s, fq, isq ? 0.18033688011112042f : 1.0f);
                        if (!isq) {
#pragma unroll
                            for (int i = 0; i < 8; ++i) { cs0[i] += x0[i]; cs1[i] += x1[i]; } } }
                    bf16_t* d = hb + ((size_t)(b * 12 + h) * 4096 + s) * 64 + 8 * fq; st8(d, x0); st8(d + 32, x1);
                }
            }
        if (kind == 2 && !isq) {
#pragma unroll
            for (int i = 0; i < 8; ++i) {
                { cs0[i] += xswz<1>(cs0[i]); cs1[i] += xswz<1>(cs1[i]); cs0[i] += xswz<2>(cs0[i]); cs1[i] += xswz<2>(cs1[i]); cs0[i] += xswz<4>(cs0[i]); cs1[i] += xswz<4>(cs1[i]); cs0[i] += xswz<8>(cs0[i]); cs1[i] += xswz<8>(cs1[i]); } }
            if (fr == 0) { const int b = (u.pm * BM) >> 12, blk = u.pm & 15; float* kp = kmsum + ((size_t)(b * 12 + h) * 16 + blk) * 64 + 8 * fq;
#pragma unroll
                for (int i = 0; i < 8; ++i) { atomicAdd(kp + i, cs0[i]); atomicAdd(kp + 32 + i, cs1[i]); } }
        }
    }
};

__device__ __forceinline__ const char* uptr(const char* p) { const unsigned long long b_ = (unsigned long long)p; return (const char*)(((unsigned long long)(unsigned)__builtin_amdgcn_readfirstlane((int)(unsigned)(b_ >> 32)) << 32) | (unsigned)__builtin_amdgcn_readfirstlane((int)(unsigned)b_)); }
__device__ __forceinline__ void glds16s(const void* sbase, unsigned voff, unsigned lds_dst) { unsigned keep;
    asm volatile("s_mov_b32 %0, m0\n\ts_mov_b32 m0, %3\n\ts_nop 0\n\tglobal_load_lds_dwordx4 %1, %2\n\ts_mov_b32 m0, %0" : "=&s"(keep) : "v"(voff), "s"(sbase), "s"(lds_dst) : "memory"); }
typedef int i32x4 __attribute__((ext_vector_type(4)));
typedef int i32x8 __attribute__((ext_vector_type(8)));
__device__ __forceinline__ unsigned pk4_e4m3(float a, float b, float c, float d) {
    a = __builtin_amdgcn_fmed3f(a, -448.f, 448.f); b = __builtin_amdgcn_fmed3f(b, -448.f, 448.f); c = __builtin_amdgcn_fmed3f(c, -448.f, 448.f); d = __builtin_amdgcn_fmed3f(d, -448.f, 448.f);
    int w = __builtin_amdgcn_cvt_pk_fp8_f32(a, b, 0, false); w = __builtin_amdgcn_cvt_pk_fp8_f32(c, d, w, true); return (unsigned)w; }
struct EpiSwiGLU8 {
    static constexpr bool PERM = true;
    unsigned char* O; int ldc; float sc, so;
    __device__ __forceinline__ void operator()(const f32x4 (&acc)[2][2][4][2], const Unit& u, int wr, int wc, int fr, int fq) const {
        const int row0 = u.pm * BM + wr * 64 + fr, col0 = u.pn * HALF + wc * 32 + 8 * fq;
#pragma unroll
        for (int ai = 0; ai < 2; ++ai)
#pragma unroll
            for (int m = 0; m < 4; ++m) { unsigned char* rowp = O + (size_t)(row0 + ai * HALF + m * 16) * ldc + col0;
                const f32x4 g0 = acc[ai][0][m][0] * sc, g1 = acc[ai][0][m][1] * sc, u0 = acc[ai][1][m][0] * (sc * so), u1 = acc[ai][1][m][1] * (sc * so);
                typedef unsigned u32x2 __attribute__((ext_vector_type(2)));
                u32x2 w; w.x = pk4_e4m3(silu_mul(g0[0], u0[0]), silu_mul(g0[1], u0[1]), silu_mul(g0[2], u0[2]), silu_mul(g0[3], u0[3]));
                w.y = pk4_e4m3(silu_mul(g1[0], u1[0]), silu_mul(g1[1], u1[1]), silu_mul(g1[2], u1[2]), silu_mul(g1[3], u1[3]));
                *(u32x2*)rowp = w; }
    }
};
template <class Epi, class Sched, bool ALIGN_EPI = true, bool SP2 = true, bool FP8 = false>
__device__ __forceinline__ void gemm_phase(PG8_LAS unsigned char* lds, const Gemm g, const Sched& S, const Epi& E, int tid_in) {
    int tid_ = tid_in; asm volatile("" : "+v"(tid_));
    const int tid = tid_, wid = __builtin_amdgcn_readfirstlane(tid >> 6), lane = tid & 63, wr = wid >> 2, wc = wid & 3, fr = lane & 15, fq = lane >> 4;
    const int Kb = FP8 ? g.K : 2 * g.K, nt = Kb / 128;
    unsigned voffA[2], voffB[2];
#pragma unroll
    for (int i = 0; i < 2; ++i) { int R, C; stage_rc(tid * 16 + i * 8192, R, C); const int Rb = Epi::PERM ? ((R & ~31) + perm32(R & 31)) : R;
        voffA[i] = (unsigned)(R * Kb + 2 * C); voffB[i] = (unsigned)(Rb * Kb + 2 * C); }
    const size_t kstep = (size_t)128;
    const size_t hstep = (size_t)HALF * Kb;
    const size_t tstep = 2 * hstep;
    const unsigned ldsw = (unsigned)wid * 1024u;
    const unsigned lds0 = (unsigned)(uintptr_t)lds;
    const int fcol = FP8 ? (32 * (fq >> 1) + 16 * (fq & 1)) : fq * 8;
    const int aoff = lds_byte(wr * 64 + fr, fcol), boff = lds_byte(wc * 32 + fr, fcol);
#define PG8_SA(b, h) (((b) * 2 + (h)) * HTB)
#define PG8_SB(b, h) ((4 + (b) * 2 + (h)) * HTB)
#define PG8_STAGE(bufoff, gbase, voff) do { _Pragma("unroll") for (int _i = 0; _i < 2; ++_i) \
        glds16s((const void*)(gbase), (voff)[_i], (unsigned)__builtin_amdgcn_readfirstlane((int)(lds0 + (bufoff) + ldsw + _i * 8192))); } while (0)
#define PG8_RD16(p) (*(const PG8_LAS i32x4*)(p))
#define PG8_CAT8(lo, hi) __builtin_shufflevector((lo), (hi), 0, 1, 2, 3, 4, 5, 6, 7)
#define PG8_LDA(dst, b, h) do { if constexpr (FP8) { _Pragma("unroll") for (int m = 0; m < 4; ++m) dst##8[m] = PG8_CAT8(PG8_RD16(lds + PG8_SA(b, h) + aoff + m * 2048), PG8_RD16(lds + PG8_SA(b, h) + aoff + m * 2048 + 16)); } \
        else { _Pragma("unroll") for (int m = 0; m < 4; ++m) _Pragma("unroll") for (int k = 0; k < 2; ++k) dst[m][k] = *(const PG8_LAS bf16x8*)(lds + PG8_SA(b, h) + aoff + m * 2048 + k * 1024); } } while (0)
#define PG8_LDB(dst, b, h) do { if constexpr (FP8) { _Pragma("unroll") for (int n = 0; n < 2; ++n) dst##8[n] = PG8_CAT8(PG8_RD16(lds + PG8_SB(b, h) + boff + n * 2048), PG8_RD16(lds + PG8_SB(b, h) + boff + n * 2048 + 16)); } \
        else { _Pragma("unroll") for (int n = 0; n < 2; ++n) _Pragma("unroll") for (int k = 0; k < 2; ++k) dst[n][k] = *(const PG8_LAS bf16x8*)(lds + PG8_SB(b, h) + boff + n * 2048 + k * 1024); } } while (0)
#define PG8_MMA(ai, bj, At, Bt) do { __builtin_amdgcn_s_setprio(1); \
        if constexpr (FP8) { _Pragma("unroll") for (int m = 0; m < 4; ++m) _Pragma("unroll") for (int n = 0; n < 2; ++n) \
            acc[ai][bj][m][n] = __builtin_amdgcn_mfma_scale_f32_16x16x128_f8f6f4(Bt##8[n], At##8[m], acc[ai][bj][m][n], 0, 0, 0, 0, 0, 0); } \
        else { _Pragma("unroll") for (int m = 0; m < 4; ++m) _Pragma("unroll") for (int n = 0; n < 2; ++n) _Pragma("unroll") for (int k = 0; k < 2; ++k) \
            acc[ai][bj][m][n] = __builtin_amdgcn_mfma_f32_16x16x32_bf16(Bt[n][k], At[m][k], acc[ai][bj][m][n], 0, 0, 0); } \
        __builtin_amdgcn_s_setprio(0); } while (0)
#define PG8_WAIT_V(n) asm volatile("s_waitcnt vmcnt(" #n ")" ::: "memory")
#define PG8_WAIT_L(n) asm volatile("s_waitcnt lgkmcnt(" #n ")" ::: "memory")
#define PG8_BAR __builtin_amdgcn_s_barrier()
#define PG8_SCHED __builtin_amdgcn_sched_barrier(0)
    Unit cur, nxt; int ui = 0;
    if (!S.next(0, cur)) return;
    f32x4 acc[2][2][4][2];
#pragma unroll
    for (int a = 0; a < 2; ++a)
#pragma unroll
        for (int b = 0; b < 2; ++b)
#pragma unroll
            for (int m = 0; m < 4; ++m)
#pragma unroll
                for (int n = 0; n < 2; ++n) acc[a][b][m][n] = (f32x4){0.f, 0.f, 0.f, 0.f};
    bf16x8 At[4][2], B0[2][2], B1[2][2]; i32x8 At8[4], B08[2], B18[2];
    const char* cA = uptr((const char*)g.A + (size_t)cur.pm * tstep); const char* cB = uptr(S.bbase(cur, g.Bt) + (size_t)cur.pn * tstep);
    if constexpr (SP2) {
        PG8_STAGE(PG8_SB(0, 0), cB, voffB); PG8_STAGE(PG8_SB(0, 1), cB + hstep, voffB); PG8_STAGE(PG8_SA(0, 0), cA, voffA); PG8_STAGE(PG8_SA(0, 1), cA + hstep, voffA);
        if (wr == 1) PG8_BAR;
        PG8_WAIT_V(2); PG8_BAR;
        PG8_STAGE(PG8_SB(1, 0), cB + kstep, voffB); PG8_STAGE(PG8_SA(1, 0), cA + kstep, voffA); PG8_STAGE(PG8_SB(1, 1), cB + hstep + kstep, voffB);
        PG8_WAIT_V(6); PG8_BAR;
    } else {
        PG8_STAGE(PG8_SB(0, 0), cB, voffB); PG8_STAGE(PG8_SA(0, 0), cA, voffA); PG8_STAGE(PG8_SB(0, 1), cB + hstep, voffB); PG8_STAGE(PG8_SA(0, 1), cA + hstep, voffA);
        if (wr == 1) PG8_BAR;
        PG8_WAIT_V(4); PG8_BAR;
        PG8_STAGE(PG8_SB(1, 0), cB + kstep, voffB); PG8_STAGE(PG8_SA(1, 0), cA + kstep, voffA); PG8_STAGE(PG8_SB(1, 1), cB + hstep + kstep, voffB);
        PG8_WAIT_V(6); PG8_BAR;
    }
    for (;;) {
        const bool has_next = S.next(ui + 1, nxt);
        const char* nA = uptr(has_next ? (const char*)g.A + (size_t)nxt.pm * tstep : cA); const char* nB = uptr(has_next ? S.bbase(nxt, g.Bt) + (size_t)nxt.pn * tstep : cB);
        for (int t = 0; t < nt; t += 2) {
            const bool last = (t == nt - 2);
            const char* a1 = cA + (size_t)(t + 1) * kstep;
            const char* a2 = last ? nA : cA + (size_t)(t + 2) * kstep; const char* b2 = last ? nB : cB + (size_t)(t + 2) * kstep;
            const char* a3 = a2 + kstep; const char* b3 = b2 + kstep;
            if constexpr (SP2) {
            PG8_LDB(B0, 0, 0); PG8_LDB(B1, 0, 1); PG8_SCHED; PG8_LDA(At, 0, 0); PG8_STAGE(PG8_SA(1, 1), a1 + hstep, voffA);
            PG8_WAIT_V(8); PG8_WAIT_L(0); PG8_BAR; PG8_MMA(0, 0, At, B0); PG8_MMA(0, 1, At, B1); PG8_BAR; PG8_SCHED;
            PG8_LDA(At, 0, 1); PG8_STAGE(PG8_SB(0, 0), b2, voffB); PG8_STAGE(PG8_SB(0, 1), b2 + hstep, voffB); PG8_STAGE(PG8_SA(0, 0), a2, voffA);
            PG8_WAIT_V(8); PG8_WAIT_L(0); PG8_BAR; PG8_MMA(1, 0, At, B0); PG8_MMA(1, 1, At, B1); PG8_BAR; PG8_SCHED;
            PG8_LDB(B0, 1, 0); PG8_LDB(B1, 1, 1); PG8_SCHED; PG8_LDA(At, 1, 0); PG8_STAGE(PG8_SA(0, 1), a2 + hstep, voffA);
            PG8_WAIT_V(8); PG8_WAIT_L(0); PG8_BAR; PG8_MMA(0, 0, At, B0); PG8_MMA(0, 1, At, B1); PG8_BAR; PG8_SCHED;
            PG8_LDA(At, 1, 1); PG8_STAGE(PG8_SB(1, 0), b3, voffB); PG8_STAGE(PG8_SB(1, 1), b3 + hstep, voffB); PG8_STAGE(PG8_SA(1, 0), a3, voffA);
            PG8_WAIT_V(8); PG8_WAIT_L(0); PG8_BAR; PG8_MMA(1, 0, At, B0); PG8_MMA(1, 1, At, B1); PG8_BAR; PG8_SCHED;
            } else {
            PG8_LDB(B0, 0, 0); PG8_SCHED; PG8_LDA(At, 0, 0); PG8_STAGE(PG8_SA(1, 1), a1 + hstep, voffA);
            PG8_WAIT_L(8); PG8_BAR; PG8_WAIT_L(0); PG8_MMA(0, 0, At, B0); PG8_BAR; PG8_SCHED;
            PG8_LDB(B1, 0, 1); PG8_STAGE(PG8_SB(0, 0), b2, voffB);
            PG8_BAR; PG8_WAIT_L(0); PG8_MMA(0, 1, At, B1); PG8_BAR;
            PG8_LDA(At, 0, 1); PG8_STAGE(PG8_SA(0, 0), a2, voffA);
            PG8_BAR; PG8_WAIT_L(0); PG8_MMA(1, 0, At, B0); PG8_BAR; PG8_SCHED;
            PG8_STAGE(PG8_SB(0, 1), b2 + hstep, voffB);
            PG8_WAIT_V(6); PG8_BAR; PG8_MMA(1, 1, At, B1); PG8_BAR;
            PG8_LDB(B0, 1, 0); PG8_SCHED; PG8_LDA(At, 1, 0); PG8_STAGE(PG8_SA(0, 1), a2 + hstep, voffA);
            PG8_WAIT_L(8); PG8_BAR; PG8_WAIT_L(0); PG8_MMA(0, 0, At, B0); PG8_BAR; PG8_SCHED;
            PG8_LDB(B1, 1, 1); PG8_STAGE(PG8_SB(1, 0), b3, voffB);
            PG8_BAR; PG8_WAIT_L(0); PG8_MMA(0, 1, At, B1); PG8_BAR;
            PG8_LDA(At, 1, 1); PG8_STAGE(PG8_SA(1, 0), a3, voffA);
            PG8_BAR; PG8_WAIT_L(0); PG8_MMA(1, 0, At, B0); PG8_BAR; PG8_SCHED;
            PG8_STAGE(PG8_SB(1, 1), b3 + hstep, voffB);
            PG8_WAIT_V(6); PG8_BAR; PG8_MMA(1, 1, At, B1); PG8_BAR;
            }
        }
        if constexpr (ALIGN_EPI) { if (wr == 0) PG8_BAR; }
        { int l_; asm volatile("v_mbcnt_lo_u32_b32 %0, -1, 0\n\tv_mbcnt_hi_u32_b32 %0, -1, %0" : "=v"(l_));
          E(acc, cur, wr, wc, l_ & 15, l_ >> 4); }
        if (!has_next) break;
#pragma unroll
        for (int a = 0; a < 2; ++a)
#pragma unroll
            for (int b = 0; b < 2; ++b)
#pragma unroll
                for (int m = 0; m < 4; ++m)
#pragma unroll
                    for (int n = 0; n < 2; ++n) acc[a][b][m][n] = (f32x4){0.f, 0.f, 0.f, 0.f};
        cur = nxt; cA = nA; cB = nB; ++ui;
        if constexpr (ALIGN_EPI) { if (wr == 1) PG8_BAR; }
    }
    PG8_WAIT_V(0);
    if constexpr (!ALIGN_EPI) { if (wr == 0) PG8_BAR; }
    PG8_BAR;
#undef PG8_SA
#undef PG8_SB
#undef PG8_STAGE
#undef PG8_LDA
#undef PG8_RD16
#undef PG8_CAT8
#undef PG8_LDB
#undef PG8_MMA
#undef PG8_WAIT_V
#undef PG8_WAIT_L
#undef PG8_BAR
#undef PG8_SCHED
}
}


namespace att {
using bf16x8=__attribute__((ext_vector_type(8)))short;
using s16x4=__attribute__((ext_vector_type(4)))short;
using f32x16=__attribute__((ext_vector_type(16)))float;
using u32x4=__attribute__((ext_vector_type(4)))unsigned;
typedef unsigned short bf16;
constexpr int D=64,DM=64;
constexpr int NW=8,QBLK=32,QB=QBLK*NW,KVBLK=64;
__device__ __forceinline__ int crow(int r,int hi){return (r&3)+8*(r>>2)+4*hi;}
#define SBAR() __builtin_amdgcn_sched_barrier(0)
constexpr int NSLOT=3, SLOTB=8192;
constexpr int LDS_K=0, LDS_V=NSLOT*SLOTB, LDS_WS=2*NSLOT*SLOTB, LDS_OST=LDS_WS+NW*64*4, LDS_KM=LDS_OST+NW*4096, LDS_TK=LDS_KM+4096, LDS_BYTES=LDS_TK+64;
constexpr float C2=0.125f*1.4426950408889634f;
__device__ __forceinline__ void glds16(const void*gsrc,unsigned lds_dst){unsigned keep;
  asm volatile("s_mov_b32 %0, m0\n\ts_mov_b32 m0, %2\n\ts_nop 0\n\tglobal_load_lds_dwordx4 %1, off\n\ts_mov_b32 m0, %0":"=&s"(keep):"v"(gsrc),"s"(lds_dst):"memory");}
__device__ __forceinline__ float max3f(float a,float b,float c){float r;asm("v_max3_f32 %0, %1, %2, %3":"=v"(r):"v"(a),"v"(b),"v"(c));return r;}
__device__ __forceinline__ float max2f(float a,float b){float r;asm("v_max_f32_e32 %0, %1, %2":"=v"(r):"v"(a),"v"(b));return r;}
__device__ __forceinline__ float fadd_s(float a,float b){float r;asm("v_add_f32_e32 %0, %1, %2":"=v"(r):"v"(a),"v"(b));return r;}
__device__ __forceinline__ float fsub_s(float a,float b){float r;asm("v_sub_f32_e32 %0, %1, %2":"=v"(r):"v"(a),"v"(b));return r;}
typedef float f32x2_t __attribute__((ext_vector_type(2))); typedef __bf16 bf16x2_t __attribute__((ext_vector_type(2)));
__device__ __forceinline__ unsigned cvtpk_s(float lo,float hi){f32x2_t v={lo,hi};bf16x2_t b=__builtin_convertvector(v,bf16x2_t);return __builtin_bit_cast(unsigned,b);}
#define WAIT_BAR(N) asm volatile("s_waitcnt vmcnt(" #N ") lgkmcnt(0)\n\ts_barrier":::"memory")
__device__ __forceinline__ void qkt(f32x16&p0,f32x16&p1,const char*Kslot,const bf16x8*qr,int r32,int hi){ const f32x16 zero16=f32x16{};
  const char*kb=Kslot+hi*1024+r32*16;
  #pragma unroll
  for(int d0=0;d0<4;++d0){
    const bf16x8 b0=*reinterpret_cast<const bf16x8*>(kb+d0*2048);
    const bf16x8 b1=*reinterpret_cast<const bf16x8*>(kb+d0*2048+512);
    if(d0==0){p0=__builtin_amdgcn_mfma_f32_32x32x16_bf16(b0,qr[0],zero16,0,0,0);p1=__builtin_amdgcn_mfma_f32_32x32x16_bf16(b1,qr[0],zero16,0,0,0);}
    else{p0=__builtin_amdgcn_mfma_f32_32x32x16_bf16(b0,qr[d0],p0,0,0,0);p1=__builtin_amdgcn_mfma_f32_32x32x16_bf16(b1,qr[d0],p1,0,0,0);}}
}
typedef __attribute__((address_space(3))) const char* lds_cptr;
typedef short v4i16_t __attribute__((ext_vector_type(4)));
__device__ __forceinline__ void kload8(bf16x8*kf,lds_cptr kp){
  kf[0]=*(const __attribute__((address_space(3))) bf16x8*)(kp);      kf[1]=*(const __attribute__((address_space(3))) bf16x8*)(kp+512);
  kf[2]=*(const __attribute__((address_space(3))) bf16x8*)(kp+2048); kf[3]=*(const __attribute__((address_space(3))) bf16x8*)(kp+2560);
  kf[4]=*(const __attribute__((address_space(3))) bf16x8*)(kp+4096); kf[5]=*(const __attribute__((address_space(3))) bf16x8*)(kp+4608);
  kf[6]=*(const __attribute__((address_space(3))) bf16x8*)(kp+6144); kf[7]=*(const __attribute__((address_space(3))) bf16x8*)(kp+6656);
}
__device__ __forceinline__ void kload2(bf16x8*kf,lds_cptr kp,int j){ kf[2*j]=*(const __attribute__((address_space(3))) bf16x8*)(kp+j*2048); kf[2*j+1]=*(const __attribute__((address_space(3))) bf16x8*)(kp+j*2048+512); }
__device__ __forceinline__ s16x4 vtr(lds_cptr p){ return __builtin_bit_cast(s16x4,__builtin_amdgcn_ds_read_tr16_b64_v4i16((__attribute__((address_space(3))) v4i16_t*)p)); }
__device__ __forceinline__ float rowmax(const f32x16&p0,const f32x16&p1){
  float a=max3f(p0[0],p0[1],p1[0]),b=max3f(p0[2],p0[3],p1[1]);a=max3f(a,p1[2],p1[3]);
  #pragma unroll
  for(int r=4;r<16;r+=4){a=max3f(a,p0[r],p0[r+1]);b=max3f(b,p0[r+2],p0[r+3]);a=max3f(a,p1[r],p1[r+1]);b=max3f(b,p1[r+2],p1[r+3]);}
  const float m=max2f(a,b);
  auto rr=__builtin_amdgcn_permlane32_swap(__float_as_uint(m),__float_as_uint(m),false,false);
  return max2f(__uint_as_float(rr[0]),__uint_as_float(rr[1]));
}
__device__ __forceinline__ void pv(f32x16*o,int vb,bf16x8 pa0,bf16x8 pa1,bf16x8 pa2,bf16x8 pa3){
  #pragma unroll
  for(int d0=0;d0<2;++d0){s16x4 lo[4],hi[4];
    #pragma unroll
    for(int ks=0;ks<4;++ks){
      asm volatile("ds_read_b64_tr_b16 %0,%1 offset:%c2":"=&v"(lo[ks]):"v"(vb),"i"(d0*4096+ks*1024):"memory");
      asm volatile("ds_read_b64_tr_b16 %0,%1 offset:%c2":"=&v"(hi[ks]):"v"(vb),"i"(d0*4096+ks*1024+512):"memory");}
    asm volatile("s_waitcnt lgkmcnt(0)":::"memory");SBAR();
    #define PK(k) (bf16x8){lo[k][0],lo[k][1],lo[k][2],lo[k][3],hi[k][0],hi[k][1],hi[k][2],hi[k][3]}
    o[d0]=__builtin_amdgcn_mfma_f32_32x32x16_bf16(pa0,PK(0),o[d0],0,0,0);
    o[d0]=__builtin_amdgcn_mfma_f32_32x32x16_bf16(pa1,PK(1),o[d0],0,0,0);
    o[d0]=__builtin_amdgcn_mfma_f32_32x32x16_bf16(pa2,PK(2),o[d0],0,0,0);
    o[d0]=__builtin_amdgcn_mfma_f32_32x32x16_bf16(pa3,PK(3),o[d0],0,0,0);
    #undef PK
  }
}
template<int MODE> __device__ __forceinline__ void amask(f32x16&p0,f32x16&p1,int a,int nb,unsigned sel,int qabs,int qrel,int hi,float mhat){
  const float NEG=-INFINITY;
  if(MODE==0){
    if(a>=nb){ const int kb=64*(a-nb)+4*hi;
      #pragma unroll
      for(int r=0;r<16;++r){const int kv=kb+(r&3)+8*(r>>2); p0[r]=(kv>qrel)?NEG:p0[r]-mhat; p1[r]=(kv+32>qrel)?NEG:p1[r]-mhat;} }
    else { const float bias=((sel>>(a>>2))&1u)?-mhat:NEG;
      #pragma unroll
      for(int r=0;r<16;++r){ p0[r]+=bias; p1[r]+=bias; } }
  } else {
    const int base=qabs-64*a-4*hi;
    #pragma unroll
    for(int r=0;r<16;++r){const int c=(r&3)+8*(r>>2); p0[r]=((unsigned)(base-c)>128u)?NEG:p0[r]-mhat; p1[r]=((unsigned)(base-c-32)>128u)?NEG:p1[r]-mhat;}
  }
}
#ifndef ATTN_STORE16
#define ATTN_STORE16(p,v) (*(u32x4*)(p)=(v))
#endif
template<int MODE,int THRL,int opitch> __device__ __forceinline__ void attn_unit(const bf16*Qs,int q0,int tile0,int NT,unsigned sel,bf16*O,float*LSE,char*shm,int tid_in){
  const bf16*Ks=Qs+12*1024*1024,*Vs=Qs+24*1024*1024;
  int tid_=tid_in; asm volatile("":"+v"(tid_));
  const int tid=tid_,lane=tid&63,r32=lane&31,hi=lane>>5; const int wid=__builtin_amdgcn_readfirstlane(tid>>6);
  const int nb=NT-4;
  const bf16*Qw=Qs+(long)(q0+wid*QBLK)*DM;
  const lds_cptr shm3=(lds_cptr)shm;
  const unsigned lds0=(unsigned)(uintptr_t)shm3;
  float*wsf=(float*)(shm+LDS_WS)+wid*64;
  const bf16*ksrc=Ks+(long)lane*DM+wid*8;
  const bf16*vsrc=Vs+(long)(16*(wid&3)+(lane>>2))*DM+(wid>>2)*32+(lane&3)*8;
  const unsigned kdst=lds0+LDS_K+wid*1024, vdst=lds0+LDS_V+wid*1024;
  #define TM(t) (MODE==0 ? ((t)==0 ? nb : ((t)<=nb ? (t)-1 : (t))) : tile0+(t))
  #define DMA_K(t,slot) glds16(ksrc+(long)TM(t)*KVBLK*DM,(unsigned)__builtin_amdgcn_readfirstlane(kdst+(slot)))
  #define DMA_V(t,slot) glds16(vsrc+(long)TM(t)*KVBLK*DM,(unsigned)__builtin_amdgcn_readfirstlane(vdst+(slot)))
  const char*Kbase=shm+LDS_K; bf16x8 kf[8];
  const lds_cptr kp0=shm3+LDS_K+hi*1024+r32*16; const lds_cptr vp0=shm3+LDS_V+((lane>>4)&1)*32+(lane&3)*8+(4*hi+((lane&15)>>2))*64;
  DMA_K(0,0);DMA_V(0,0);DMA_K(1,SLOTB);
  bf16x8 qr[4];
  #pragma unroll
  for(int d0=0;d0<4;++d0)qr[d0]=*reinterpret_cast<const bf16x8*>(&Qw[(long)r32*DM+d0*16+hi*8]);
  float mhat=0.f,l_reg=0.f;f32x16 o[2];o[0]=f32x16{};o[1]=f32x16{};const f32x16 zero16=f32x16{};
  const int qrel=wid*QBLK+r32, qabs=q0+qrel;
  #define CMASK(P0,P1,t) amask<MODE>(P0,P1,TM(t),nb,sel,qabs,qrel,hi,mhat)
  bool resc=false;
  #define START(P0,P1) do{ const float rm=rowmax(P0,P1); resc=false; \
    { const float dl=__builtin_fmaxf(rm,0.f); mhat=fadd_s(mhat,dl); \
      _Pragma("unroll") for(int r=0;r<16;++r){P0[r]=fsub_s(P0[r],dl);P1[r]=fsub_s(P1[r],dl);} } \
    _Pragma("unroll") for(int r=0;r<16;++r)P0[r]=__builtin_amdgcn_exp2f(P0[r]); }while(0)
  #define RESC() do{ if(resc){ asm volatile("s_waitcnt lgkmcnt(0)":::"memory"); \
      _Pragma("unroll") for(int d_=0;d_<2;++d_) _Pragma("unroll") for(int r=0;r<16;++r)o[d_][r]*=wsf[crow(r,hi)]; } }while(0)
  f32x16 pA0,pA1,pB0,pB1;
  int sl_prev=0,sl_cur=0,sl_next=SLOTB;
  #define ROT() do{sl_prev=sl_cur;sl_cur=sl_next;sl_next=(sl_next==(NSLOT-1)*SLOTB)?0:sl_next+SLOTB;}while(0)
  DMA_K(2,2*SLOTB);
  WAIT_BAR(3);
  qkt(pA0,pA1,Kbase,qr,r32,hi);asm volatile("s_nop 15\n\ts_nop 7":"+v"(pA0),"+v"(pA1));CMASK(pA0,pA1,0);
  START(pA0,pA1);
  _Pragma("unroll") for(int r=0;r<16;++r)pA1[r]=__builtin_amdgcn_exp2f(pA1[r]);
  WAIT_BAR(0);
  DMA_K(3,0);DMA_V(1,SLOTB);
  ROT();
  kload8(kf,kp0+sl_cur);
  WAIT_BAR(2);
  s16x4 vlo[8],vhi[8]; u32x4 pw0,pw1,pw2,pw3;
  #define PKW(P,B) cvtpk_s(P[B],P[B+1])
  #define PAF(k) __builtin_bit_cast(bf16x8,pw##k)
  #define VFR(i) (bf16x8){vlo[i][0],vlo[i][1],vlo[i][2],vlo[i][3],vhi[i][0],vhi[i][1],vhi[i][2],vhi[i][3]}
  #define PIN(x) asm volatile("":"+v"(x))
  #define MX3(a,b,c) __builtin_fmaxf(__builtin_fmaxf((a),(b)),(c))
  #define GAPA(MF,A0,A1,A2,A3,W0,W1,PW) do{ MF; sacc+=A0; sacc+=A1; sacc+=A2; sacc+=A3; PIN(sacc); W0; W1; PIN(PW); SBAR(); }while(0)
  #define EX(v) __builtin_amdgcn_exp2f(v)
  #define GAPB(MF,X,B) do{ MF; X[B]=EX(X[B]); X[B+1]=EX(X[B+1]); X[B+2]=EX(X[B+2]); X[B+3]=EX(X[B+3]); PIN(X); SBAR(); }while(0)
  #define VRD(i) do{ vlo[i]=vtr(vp_+(((i)>>2)*4096+((i)&3)*1024)); vhi[i]=vtr(vp_+(((i)>>2)*4096+((i)&3)*1024+512)); }while(0)
  #define KRD(G,j) do{ if(G){ kload2(kf,kp0+sl_next,j); SBAR(); } }while(0)
  #define STEP(C0,C1,P0,P1,t,GK,GV,GL) do{ SBAR(); \
    const lds_cptr vp_=vp0+sl_prev; \
    VRD(0); SBAR(); float sacc=(P0[0]+P0[1]); \
    GAPA(C0=__builtin_amdgcn_mfma_f32_32x32x16_bf16(kf[0],qr[0],zero16,0,0,0), P0[2],P0[3],P0[4],P0[5],     pw0[0]=PKW(P0,0), pw0[1]=PKW(P0,2), pw0); \
    VRD(4); SBAR(); GAPA(C1=__builtin_amdgcn_mfma_f32_32x32x16_bf16(kf[1],qr[0],zero16,0,0,0), P0[6],P0[7],P0[8],P0[9],     pw0[2]=PKW(P0,4), pw0[3]=PKW(P0,6), pw0); \
    VRD(1); SBAR(); GAPA(C0=__builtin_amdgcn_mfma_f32_32x32x16_bf16(kf[2],qr[1],C0,0,0,0),   P0[10],P0[11],P0[12],P0[13], pw1[0]=PKW(P0,8), pw1[1]=PKW(P0,10), pw1); \
    VRD(5); SBAR(); GAPA(C1=__builtin_amdgcn_mfma_f32_32x32x16_bf16(kf[3],qr[1],C1,0,0,0),   P0[14],P0[15],P1[0],P1[1],   pw1[2]=PKW(P0,12),pw1[3]=PKW(P0,14), pw1); \
    VRD(2); SBAR(); GAPA(C0=__builtin_amdgcn_mfma_f32_32x32x16_bf16(kf[4],qr[2],C0,0,0,0),   P1[2],P1[3],P1[4],P1[5],     pw2[0]=PKW(P1,0), pw2[1]=PKW(P1,2), pw2); \
    VRD(6); SBAR(); GAPA(C1=__builtin_amdgcn_mfma_f32_32x32x16_bf16(kf[5],qr[2],C1,0,0,0),   P1[6],P1[7],P1[8],P1[9],     pw2[2]=PKW(P1,4), pw2[3]=PKW(P1,6), pw2); \
    VRD(3); SBAR(); GAPA(C0=__builtin_amdgcn_mfma_f32_32x32x16_bf16(kf[6],qr[3],C0,0,0,0),   P1[10],P1[11],P1[12],P1[13], pw3[0]=PKW(P1,8), pw3[1]=PKW(P1,10), pw3); \
    VRD(7); SBAR(); GAPA(C1=__builtin_amdgcn_mfma_f32_32x32x16_bf16(kf[7],qr[3],C1,0,0,0),   P1[14],P1[15],0.f,0.f,       pw3[2]=PKW(P1,12),pw3[3]=PKW(P1,14), pw3); \
    l_reg+=sacc; \
    if(GK){DMA_K((t)+3,sl_cur);} if(GV){DMA_V((t)+1,sl_next);} \
    CMASK(C0,C1,t); \
    { float a=MX3(C0[0],C0[1],C1[0]),b=MX3(C0[2],C0[3],C1[1]); a=MX3(a,C1[2],C1[3]); \
      _Pragma("unroll") for(int r=4;r<16;r+=4){a=MX3(a,C0[r],C0[r+1]);b=MX3(b,C0[r+2],C0[r+3]);a=MX3(a,C1[r],C1[r+1]);b=MX3(b,C1[r+2],C1[r+3]);} \
      float rm=__builtin_fmaxf(a,b); { auto rr=__builtin_amdgcn_permlane32_swap(__float_as_uint(rm),__float_as_uint(rm),false,false); rm=__builtin_fmaxf(__uint_as_float(rr[0]),__uint_as_float(rr[1])); } \
      resc=false; \
      if(__builtin_expect(__any(rm>(float)THRL),0)){ const float dl=__builtin_fmaxf(rm,0.f); mhat+=dl; \
        _Pragma("unroll") for(int r=0;r<16;++r){C0[r]-=dl;C1[r]-=dl;} \
        const float f=__builtin_amdgcn_exp2f(-dl); l_reg*=f; if(hi==0)wsf[r32]=f; resc=true; } } \
    SBAR(); \
    GAPB(o[0]=__builtin_amdgcn_mfma_f32_32x32x16_bf16(PAF(0),VFR(0),o[0],0,0,0), C0,0); \
    GAPB(o[1]=__builtin_amdgcn_mfma_f32_32x32x16_bf16(PAF(0),VFR(4),o[1],0,0,0), C0,4); \
    KRD(GL,0); GAPB(o[0]=__builtin_amdgcn_mfma_f32_32x32x16_bf16(PAF(1),VFR(1),o[0],0,0,0), C0,8); \
    KRD(GL,1); GAPB(o[1]=__builtin_amdgcn_mfma_f32_32x32x16_bf16(PAF(1),VFR(5),o[1],0,0,0), C0,12); \
    KRD(GL,2); GAPB(o[0]=__builtin_amdgcn_mfma_f32_32x32x16_bf16(PAF(2),VFR(2),o[0],0,0,0), C1,0); \
    KRD(GL,3); GAPB(o[1]=__builtin_amdgcn_mfma_f32_32x32x16_bf16(PAF(2),VFR(6),o[1],0,0,0), C1,4); \
    GAPB(o[0]=__builtin_amdgcn_mfma_f32_32x32x16_bf16(PAF(3),VFR(3),o[0],0,0,0), C1,8); \
    GAPB(o[1]=__builtin_amdgcn_mfma_f32_32x32x16_bf16(PAF(3),VFR(7),o[1],0,0,0), C1,12); \
    }while(0)
  #define ENDW(tt) do{ if((tt)+3<NT){WAIT_BAR(2);} else if((tt)+2<NT){WAIT_BAR(1);} else {WAIT_BAR(0);} }while(0)
  int t=1;
  for(;t+1<NT;t+=2){
    STEP(pB0,pB1,pA0,pA1,t,(t+3<NT),(t+1<NT),(t+1<NT));       ENDW(t);   RESC(); ROT();
    STEP(pA0,pA1,pB0,pB1,t+1,(t+4<NT),(t+2<NT),(t+2<NT));     ENDW(t+1); RESC(); ROT();
  }
  STEP(pB0,pB1,pA0,pA1,NT-1,false,false,false); RESC();
  { float sacc=pB0[0]+pB0[1]; _Pragma("unroll") for(int r=2;r<16;++r)sacc+=pB0[r]; _Pragma("unroll") for(int r=0;r<16;++r)sacc+=pB1[r]; l_reg+=sacc;
    pw0=(u32x4){PKW(pB0,0),PKW(pB0,2),PKW(pB0,4),PKW(pB0,6)};pw1=(u32x4){PKW(pB0,8),PKW(pB0,10),PKW(pB0,12),PKW(pB0,14)};pw2=(u32x4){PKW(pB1,0),PKW(pB1,2),PKW(pB1,4),PKW(pB1,6)};pw3=(u32x4){PKW(pB1,8),PKW(pB1,10),PKW(pB1,12),PKW(pB1,14)};
    SBAR(); pv(o,(int)(unsigned)(uintptr_t)vp0+sl_cur,PAF(0),PAF(1),PAF(2),PAF(3)); }
  #undef PKW
  #undef PAF
  #undef VFR
  #undef PIN
  #undef MX3
  #undef GAPA
  #undef GAPB
  #undef EX
  #undef VRD
  #undef KRD
  #undef STEP
  #undef ENDW
  {auto rr=__builtin_amdgcn_permlane32_swap(__float_as_uint(l_reg),__float_as_uint(l_reg),false,false);l_reg=__uint_as_float(rr[0])+__uint_as_float(rr[1]);}
  if(MODE==1 && hi==0) LSE[qrel]=0.6931471805599453f*(mhat+__log2f(l_reg));
  if(hi==0)wsf[32+r32]=l_reg;asm volatile("s_waitcnt lgkmcnt(0)":::"memory");
  float rli[16];
  #pragma unroll
  for(int r=0;r<16;++r)rli[r]=__builtin_amdgcn_rcpf(wsf[32+crow(r,hi)]);
  bf16*Ow=O+(long)(wid*QBLK)*opitch;
  { __hip_bfloat16*stg=(__hip_bfloat16*)(shm+LDS_OST)+wid*2048;
    #pragma unroll
    for(int r=0;r<16;++r){const int orow=crow(r,hi);
      #pragma unroll
      for(int d0=0;d0<2;++d0)stg[orow*64+d0*32+r32]=__float2bfloat16(o[d0][r]*rli[r]);}
    asm volatile("s_waitcnt lgkmcnt(0)":::"memory");
    #pragma unroll
    for(int i=0;i<4;++i){const int row=i*8+(lane>>3),ch=lane&7; const u32x4 v=*(const u32x4*)(stg+row*64+ch*8); ATTN_STORE16(Ow+(long)row*opitch+ch*8,v);} }
  asm volatile("s_waitcnt lgkmcnt(0)\n\ts_barrier":::"memory");
  #undef DMA_K
  #undef DMA_V
  #undef TM
  #undef CMASK
  #undef START
  #undef RESC
  #undef ROT
}
#undef SBAR
#undef WAIT_BAR
}

constexpr int NWAVES = 8;
constexpr int NB = 4, SEQ = 4096, T = NB * SEQ, D = 1024;
constexpr int EVEN_IN = 2816, EVEN_OUT = 512, ODD_IN = 3072, ODD_OUT = 1024, DFF = 2816, NEXP = 8, DFFE = 3584;
constexpr int MOE_ROWS = 2 * T + NEXP * 256;
constexpr float EPS = 1e-6f;
constexpr size_t MiB = 1u << 20;
constexpr size_t WS_CTL = 0, CTL_ZERO_BYTES = 2 * MiB;
constexpr size_t WS_ROPE = 2 * MiB;
constexpr size_t WS_MISC = 3 * MiB;
constexpr size_t WS_KMEAN = 4 * MiB;
constexpr size_t WS_WT = 8 * MiB;
constexpr size_t WT_EVEN_BYTES = 23 * MiB, WT_ODD_BYTES = 176 * MiB;
constexpr size_t WTE_IN = 0, WTE_OUT = 5 * MiB + MiB / 2, WTE_GU = 6 * MiB + MiB / 2, WTE_DN = 17 * MiB + MiB / 2;
constexpr size_t WTO_IN = 0, WTO_OUT = 6 * MiB, WTO_MGU = 8 * MiB, WTO_MD = 120 * MiB;
constexpr size_t WS_WT_EVEN0 = WS_WT, WS_WT_ODD0 = WS_WT + 2 * WT_EVEN_BYTES;
constexpr size_t WS_HN = WS_WT + 2 * WT_EVEN_BYTES + 2 * WT_ODD_BYTES;
constexpr size_t WS_P = WS_HN + 32 * MiB;
constexpr size_t WS_MIX = WS_P + 96 * MiB;
constexpr size_t WS_HID = WS_MIX + 32 * MiB;
constexpr size_t WS_END = WS_HID + 238 * MiB;
static_assert(WS_HN == 406 * MiB && WS_END == 804 * MiB, "ws map");
constexpr size_t P_UV = 0, P_QS = 16 * MiB, P_KS = 40 * MiB, P_VS = 64 * MiB, P_QM = 0, P_KM = 24 * MiB, P_VM = 48 * MiB;
constexpr size_t H_RAWP = 0, H_OG = 96 * MiB, H_LSE = 120 * MiB;
constexpr int CW_TMO = 0, CW_CODE = 1, CW_BAR = 4096;
constexpr size_t CTL_KMSUM = 256 * 1024, KMSUM_BYTES = 256 * 1024;
constexpr size_t P_CONV = 72 * MiB;
constexpr int RING_OFF = 0, RING_BYTES = 131072, LDSCTL_OFF = RING_BYTES, MISC_OFF = LDSCTL_OFF + 320, LDS_BYTES = 147456;

#define GAS __attribute__((address_space(1)))
#define LAS __attribute__((address_space(3)))
typedef unsigned short bf16;
typedef unsigned v4u __attribute__((ext_vector_type(4)));
typedef unsigned v2u __attribute__((ext_vector_type(2)));
typedef float f32x4 __attribute__((ext_vector_type(4)));
typedef GAS unsigned gu32;
#define RLX_AGENT __ATOMIC_RELAXED, __HIP_MEMORY_SCOPE_AGENT
#define LDS_WAIT() asm volatile("s_waitcnt lgkmcnt(0)" ::: "memory")
#define VM_WAIT() asm volatile("s_waitcnt vmcnt(0)" ::: "memory")
__device__ __forceinline__ unsigned f2bf(float f) { unsigned u = __builtin_bit_cast(unsigned, f); return (u + 0x7fffu + ((u >> 16) & 1u)) >> 16; }
__device__ __forceinline__ unsigned pk2(float lo, float hi) { return f2bf(lo) | (f2bf(hi) << 16); }
__device__ __forceinline__ float bf2f(unsigned short b) { return __builtin_bit_cast(float, ((unsigned)b) << 16); }
__device__ __forceinline__ float bflo(unsigned w) { return __builtin_bit_cast(float, w << 16); }
__device__ __forceinline__ float bfhi(unsigned w) { return __builtin_bit_cast(float, w & 0xffff0000u); }

#define XB_TMO      128
#define XB_XCNT(j)  (256  + 64 * (j))
#define XB_XSUB(j)  (1280 + 64 * (j))
#define XB_XGEN(j)  (2304 + 64 * (j))
#define XB_TOP      3328
#define XB_TOPGEN   3392
#define XCD_BAR_WORDS 3456
#define XB_SPIN_CAP (1u << 22)
__device__ __forceinline__ unsigned xb_ld(unsigned* p)              { return __hip_atomic_load(p, __ATOMIC_RELAXED, __HIP_MEMORY_SCOPE_AGENT); }
__device__ __forceinline__ unsigned xb_add(unsigned* p, unsigned v) { return __hip_atomic_fetch_add(p, v, __ATOMIC_RELAXED, __HIP_MEMORY_SCOPE_AGENT); }
__device__ __forceinline__ unsigned xb_xcc_id() { return (unsigned)__builtin_amdgcn_s_getreg((3 << 11) | 20) & 0xFu; }
#define XB_SPIN(cond, bar) do { unsigned _sp = 0; while (cond) { __builtin_amdgcn_s_sleep(1); \
    if ((++_sp & 255u) == 0u) { if (xb_ld(&(bar)[XB_TMO])) break; if (_sp > XB_SPIN_CAP) { atomicAdd(&(bar)[XB_TMO], 1u); break; } } } } while (0)
struct XcdBarrier { unsigned* bar; unsigned x; volatile LAS unsigned* st; };
__device__ __forceinline__ XcdBarrier xcd_barrier_post(unsigned* bar, volatile LAS unsigned* st, int tid) {
    XcdBarrier b; b.bar = bar; b.x = xb_xcc_id(); b.st = st;
    if (tid == 0) { unsigned* bp = bar; asm volatile("" : "+v"(bp)); (void)xb_add(&bp[XB_XCNT(b.x)], 1u); }
    return b;
}
__device__ __forceinline__ void xcd_barrier_complete(unsigned* bar, unsigned x, unsigned& nloc, unsigned& nx) {
    const unsigned G = gridDim.x * gridDim.y * gridDim.z;
    unsigned sum, cnt, mine, sp = 0u;
    for (;;) {
        sum = 0u; cnt = 0u; mine = 0u;
#pragma unroll
        for (unsigned j = 0; j < 16; ++j) { const unsigned c = xb_ld(&bar[XB_XCNT(j)]); sum += c; cnt += (c > 0u) ? 1u : 0u; mine = (j == x) ? c : mine; }
        if (sum == G) break;
        __builtin_amdgcn_s_sleep(1);
        if ((++sp & 255u) == 0u) { if (xb_ld(&bar[XB_TMO])) break; if (sp > XB_SPIN_CAP) { atomicAdd(&bar[XB_TMO], 1u); break; } }
    }
    nloc = mine > 0u ? mine : 1u; nx = cnt > 0u ? cnt : 1u;
}
__device__ __forceinline__ void xcd_barrier(const XcdBarrier& b, int tid) {
    asm volatile("s_waitcnt vmcnt(0)" ::: "memory");
    __syncthreads();
    if (tid == 0) {
        unsigned* bar = b.bar; asm volatile("" : "+v"(bar));
        __builtin_amdgcn_s_waitcnt(0);
        unsigned nloc = b.st[0], nx = b.st[1];
        if (nloc == 0u) { xcd_barrier_complete(bar, b.x, nloc, nx); b.st[0] = nloc; b.st[1] = nx; }
        const unsigned old = xb_add(&bar[XB_XSUB(b.x)], 1u);
        const unsigned gen = old / nloc;
        if (old + 1u == (gen + 1u) * nloc) {
            __builtin_amdgcn_fence(__ATOMIC_RELEASE, "agent");
            asm volatile("s_waitcnt vmcnt(0)" ::: "memory");
            const unsigned og = xb_add(&bar[XB_TOP], 1u);
            const unsigned tg = og / nx;
            if (og + 1u == (tg + 1u) * nx) xb_add(&bar[XB_TOPGEN], 1u);
            else XB_SPIN(xb_ld(&bar[XB_TOPGEN]) == tg, bar);
            __builtin_amdgcn_fence(__ATOMIC_ACQUIRE, "agent");
            xb_add(&bar[XB_XGEN(b.x)], 1u);
            asm volatile("s_waitcnt vmcnt(0)" ::: "memory");
        } else {
            XB_SPIN(xb_ld(&bar[XB_XGEN(b.x)]) == gen, bar);
            __builtin_amdgcn_fence(__ATOMIC_ACQUIRE, "agent");
            asm volatile("s_waitcnt vmcnt(0)" ::: "memory");
        }
    }
    __syncthreads();
}

struct Args { const float* in[22]; float* out; unsigned char* ws; int ph_lo, ph_hi; };
struct Frame {
    LAS unsigned char* lds; volatile LAS unsigned* MISC; gu32* ctl;
    int tid, lane, wave, G, blk;
    unsigned char* ws; float* out;
};
struct Route { int e1, e2; float g1, g2; };

__device__ __forceinline__ float wave_sum(float v) { v += xswz<1>(v); v += xswz<2>(v); v += xswz<4>(v); v += xswz<8>(v); v += xswz<16>(v); return xsum32(v); }
__device__ __forceinline__ float wave_max(float v) { v = fmaxf(v, xswz<1>(v)); v = fmaxf(v, xswz<2>(v)); v = fmaxf(v, xswz<4>(v)); v = fmaxf(v, xswz<8>(v)); v = fmaxf(v, xswz<16>(v)); return xmax32(v); }
__device__ __forceinline__ int wave_sumi(int v) { v += xswzi<1>(v); v += xswzi<2>(v); v += xswzi<4>(v); v += xswzi<8>(v); v += xswzi<16>(v); return xsum32i(v); }
__device__ __forceinline__ float gelu_tanh(float x) {
    const float y = 0.7978845608028654f * (x + 0.044715f * x * x * x);
    const float e = __expf(2.0f * y);
    const float th = 1.0f - 2.0f / (e + 1.0f);
    return 0.5f * x * (1.0f + th);
}

__device__ __forceinline__ int rowmap(int mode, int n) {
    if (mode == 0) return n;
    if (mode == 3) { const int w = n & 255, wc = w >> 6, dd = w & 63, bj = dd >> 5, e = dd & 31, fq = e >> 3, nn = (e >> 2) & 1, j = e & 3; return (n & ~255) + 128 * bj + 32 * wc + 16 * nn + 4 * fq + j; }
    return 256 * (n >> 7) + (n & 127) + (mode == 2 ? 128 : 0);
}
constexpr float H8_SCALE = 8.0f;
constexpr float W8_SCALE = 64.0f;
__device__ __forceinline__ unsigned pk4_fp8(float a, float b, float c, float d) { int w = __builtin_amdgcn_cvt_pk_fp8_f32(a, b, 0, false); w = __builtin_amdgcn_cvt_pk_fp8_f32(c, d, w, true); return (unsigned)w; }
__device__ __forceinline__ void p0_transpose_item(const float* W, int K, int N, bf16* WT, int mode, int fp8, LAS float* scr, int item, int lane) {
    const int nblk = N / 64, kb = item / nblk, nb = item % nblk, k0 = 32 * kb, n0 = 64 * nb;
    const float* src = W + (size_t)(k0 + (lane >> 4)) * N + n0 + (lane & 15) * 4;
    f32x4 v[8];
#pragma unroll
    for (int i = 0; i < 8; ++i) v[i] = *(const f32x4*)(src + (size_t)(4 * i) * N);
#pragma unroll
    for (int i = 0; i < 8; ++i) *(LAS f32x4*)(scr + (4 * i + (lane >> 4)) * 68 + (lane & 15) * 4) = v[i];
    LDS_WAIT(); asm volatile("" ::: "memory");
    if (fp8) { unsigned char* d8 = (unsigned char*)WT + (size_t)rowmap(mode, n0 + lane) * K + k0;
#pragma unroll
        for (int q = 0; q < 2; ++q) { v4u o;
            o.x = pk4_fp8(scr[(16 * q + 0) * 68 + lane] * W8_SCALE, scr[(16 * q + 1) * 68 + lane] * W8_SCALE, scr[(16 * q + 2) * 68 + lane] * W8_SCALE, scr[(16 * q + 3) * 68 + lane] * W8_SCALE);
            o.y = pk4_fp8(scr[(16 * q + 4) * 68 + lane] * W8_SCALE, scr[(16 * q + 5) * 68 + lane] * W8_SCALE, scr[(16 * q + 6) * 68 + lane] * W8_SCALE, scr[(16 * q + 7) * 68 + lane] * W8_SCALE);
            o.z = pk4_fp8(scr[(16 * q + 8) * 68 + lane] * W8_SCALE, scr[(16 * q + 9) * 68 + lane] * W8_SCALE, scr[(16 * q + 10) * 68 + lane] * W8_SCALE, scr[(16 * q + 11) * 68 + lane] * W8_SCALE);
            o.w = pk4_fp8(scr[(16 * q + 12) * 68 + lane] * W8_SCALE, scr[(16 * q + 13) * 68 + lane] * W8_SCALE, scr[(16 * q + 14) * 68 + lane] * W8_SCALE, scr[(16 * q + 15) * 68 + lane] * W8_SCALE);
            *(GAS v4u*)(d8 + 16 * q) = o; }
        LDS_WAIT(); asm volatile("" ::: "memory"); return; }
    bf16* dst = WT + (size_t)rowmap(mode, n0 + lane) * K + k0;
#pragma unroll
    for (int q = 0; q < 4; ++q) { v4u o;
        o.x = pk2(scr[(8 * q + 0) * 68 + lane], scr[(8 * q + 1) * 68 + lane]); o.y = pk2(scr[(8 * q + 2) * 68 + lane], scr[(8 * q + 3) * 68 + lane]);
        o.z = pk2(scr[(8 * q + 4) * 68 + lane], scr[(8 * q + 5) * 68 + lane]); o.w = pk2(scr[(8 * q + 6) * 68 + lane], scr[(8 * q + 7) * 68 + lane]);
        *(GAS v4u*)(dst + 8 * q) = o; }
    LDS_WAIT(); asm volatile("" ::: "memory");
}
struct WDesc { const float* src; bf16* dst; int K, N, nbatch, mode, fp8; size_t dst_bstride; };
__device__ __forceinline__ WDesc get_desc(const Args& a, int d) {
    const int layer = d / 10, k = d % 10; unsigned char* ws = a.ws;
    bf16* we = (bf16*)(ws + WS_WT_EVEN0 + (size_t)layer * WT_EVEN_BYTES); bf16* wo = (bf16*)(ws + WS_WT_ODD0 + (size_t)layer * WT_ODD_BYTES);
    WDesc w; w.nbatch = 1; w.mode = 0; w.dst_bstride = 0; w.fp8 = 0;
    switch (k) {
    case 0: w.src = a.in[3] + (size_t)layer * D * EVEN_IN; w.dst = we + WTE_IN / 2; w.K = D; w.N = EVEN_IN; w.mode = 3; break;
    case 1: w.src = a.in[9] + (size_t)layer * EVEN_OUT * D; w.dst = we + WTE_OUT / 2; w.K = EVEN_OUT; w.N = D; break;
    case 2: w.src = a.in[10] + (size_t)layer * D * DFF; w.dst = we + WTE_GU / 2; w.K = D; w.N = DFF; w.mode = 1; break;
    case 3: w.src = a.in[11] + (size_t)layer * D * DFF; w.dst = we + WTE_GU / 2; w.K = D; w.N = DFF; w.mode = 2; break;
    case 4: w.src = a.in[12] + (size_t)layer * DFF * D; w.dst = we + WTE_DN / 2; w.K = DFF; w.N = D; break;
    case 5: w.src = a.in[13] + (size_t)layer * D * ODD_IN; w.dst = wo + WTO_IN / 2; w.K = D; w.N = ODD_IN; w.mode = 3; break;
    case 6: w.src = a.in[17] + (size_t)layer * ODD_OUT * D; w.dst = wo + WTO_OUT / 2; w.K = ODD_OUT; w.N = D; break;
    case 7: w.src = a.in[19] + (size_t)layer * NEXP * D * DFFE; w.dst = wo + WTO_MGU / 2; w.K = D; w.N = DFFE; w.mode = 1; w.nbatch = NEXP; w.dst_bstride = (size_t)DFFE * D; w.fp8 = 1; break;
    case 8: w.src = a.in[20] + (size_t)layer * NEXP * D * DFFE; w.dst = wo + WTO_MGU / 2; w.K = D; w.N = DFFE; w.mode = 2; w.nbatch = NEXP; w.dst_bstride = (size_t)DFFE * D; w.fp8 = 1; break;
    default: w.src = a.in[21] + (size_t)layer * NEXP * DFFE * D; w.dst = wo + WTO_MD / 2; w.K = DFFE; w.N = D; w.nbatch = NEXP; w.dst_bstride = (size_t)DFFE * D / 2; w.fp8 = 1; break;
    }
    return w;
}
__device__ __forceinline__ void p0_prologue(Frame& F, const Args& a) {
    LAS float* scr = (LAS float*)(F.lds + RING_OFF + F.wave * 16384);
    const int gw = F.blk * NWAVES + F.wave, NGW = F.G * NWAVES;
    for (int d = 0; d < 20; ++d) {
        const WDesc w = get_desc(a, d);
        const int per = (w.K / 32) * (w.N / 64), nitems = per * w.nbatch;
        for (int it = gw; it < nitems; it += NGW) { const int bt = it / per, r = it % per;
            p0_transpose_item(w.src + (size_t)bt * w.K * w.N, w.K, w.N, w.dst + (size_t)bt * w.dst_bstride, w.mode, w.fp8, scr, r, F.lane); }
    }
    { float* wtg = (float*)(a.ws + WS_KMEAN); const float* wsp = a.in[5];
      for (int i = F.blk * 512 + F.tid; i < 2 * 4 * 128 * 128; i += F.G * 512) { const int lg = i >> 14, j = (i >> 7) & 127, ii = i & 127; wtg[i] = (j <= ii) ? wsp[(size_t)lg * 16384 + ii * 128 + j] : 0.f; } }
    float* cs = (float*)(a.ws + WS_ROPE); float* sn = cs + SEQ * 32;
    for (int i = F.blk * 512 + F.tid; i < SEQ * 32; i += F.G * 512) { const int pos = i >> 5, j = i & 31;
        const float inv = 1.0f / powf(10000.0f, (float)j * (1.0f / 32.0f)); const float ang = (float)pos * inv;
        cs[i] = cosf(ang); sn[i] = sinf(ang); }
}

__device__ __forceinline__ void norm_phase(Frame& F, const float* xsrc, float* xdst, const float* gain, bf16* hn, bool do_combine, bool do_router, bool write_hn, const float* router_w) {
    unsigned char* ws = F.ws;
    const Route* route = (const Route*)(ws + WS_MISC); const int* slots = (const int*)(ws + WS_MISC + 256 * 1024); int* ccnt = (int*)(ws + WS_MISC + 384 * 1024);
    const bf16* Y = (const bf16*)(ws + WS_P);
    LAS float* wr = (LAS float*)(F.lds + RING_OFF);
    LAS int* lcnt = (LAS int*)(F.lds + RING_OFF + 32768);
    if (do_router) { for (int i = F.tid; i < 8192; i += 512) { const int d = i >> 3, e = i & 7; wr[e * 1024 + d] = router_w[i]; } }
    const int lane = F.lane;
    f32x4 gv[4];
#pragma unroll
    for (int j = 0; j < 4; ++j) gv[j] = *((const f32x4*)gain + lane + 64 * j);
    for (int c = F.blk; c < T / 64; c += F.G) {
        if (do_router) { if (F.tid < 8) lcnt[F.tid] = 0; }
        __syncthreads();
        for (int k = 0; k < 8; ++k) {
            const int row = c * 64 + F.wave * 8 + k;
            const f32x4* xr = (const f32x4*)(xsrc + (size_t)row * D) + lane;
            f32x4 v[4];
#pragma unroll
            for (int j = 0; j < 4; ++j) v[j] = xr[64 * j];
            if (do_combine) {
                const Route r = route[row]; const int s1 = slots[2 * row], s2 = slots[2 * row + 1];
                const v2u* y1 = (const v2u*)(Y + (size_t)s1 * D) + lane; const v2u* y2 = (const v2u*)(Y + (size_t)s2 * D) + lane;
#pragma unroll
                for (int j = 0; j < 4; ++j) { const v2u a = y1[64 * j], b = y2[64 * j];
                    v[j].x += r.g1 * bflo(a.x) + r.g2 * bflo(b.x); v[j].y += r.g1 * bfhi(a.x) + r.g2 * bfhi(b.x);
                    v[j].z += r.g1 * bflo(a.y) + r.g2 * bflo(b.y); v[j].w += r.g1 * bfhi(a.y) + r.g2 * bfhi(b.y); }
                f32x4* xo = (f32x4*)(xdst + (size_t)row * D) + lane;
#pragma unroll
                for (int j = 0; j < 4; ++j) xo[64 * j] = v[j];
            }
            if (write_hn) {
                float ss = 0.f;
#pragma unroll
                for (int j = 0; j < 4; ++j) ss += (v[j].x * v[j].x + v[j].y * v[j].y) + (v[j].z * v[j].z + v[j].w * v[j].w);
                ss = wave_sum(ss);
                const float rstd = 1.0f / sqrtf(ss * (1.0f / D) + EPS);
#pragma unroll
                for (int j = 0; j < 4; ++j) v[j] = v[j] * rstd * gv[j];
                v2u* o8 = (v2u*)(hn + (size_t)row * D) + lane;
#pragma unroll
                for (int j = 0; j < 4; ++j) { v2u o; o.x = pk2(v[j].x, v[j].y); o.y = pk2(v[j].z, v[j].w); o8[64 * j] = o; }
                if (do_router) {
                    float lg[8];
#pragma unroll
                    for (int e = 0; e < 8; ++e) { float s = 0.f;
#pragma unroll
                        for (int j = 0; j < 4; ++j) { const f32x4 w = *((const LAS f32x4*)(wr + e * 1024) + lane + 64 * j); s += (v[j].x * w.x + v[j].y * w.y) + (v[j].z * w.z + v[j].w * w.w); }
                        lg[e] = wave_sum(s); }
                    int e1 = 0; float v1 = lg[0];
#pragma unroll
                    for (int e = 1; e < 8; ++e) if (lg[e] > v1) { v1 = lg[e]; e1 = e; }
                    int e2 = -1; float v2 = -INFINITY;
#pragma unroll
                    for (int e = 0; e < 8; ++e) if (e != e1 && lg[e] > v2) { v2 = lg[e]; e2 = e; }
                    const float g2 = 1.0f / (1.0f + __expf(v1 - v2)), g1 = 1.0f - g2;
                    if (lane == 0) { Route r; r.e1 = e1; r.e2 = e2; r.g1 = g1; r.g2 = g2; ((Route*)route)[row] = r; __hip_atomic_fetch_add(&lcnt[e1], 1, __ATOMIC_RELAXED, __HIP_MEMORY_SCOPE_WORKGROUP); __hip_atomic_fetch_add(&lcnt[e2], 1, __ATOMIC_RELAXED, __HIP_MEMORY_SCOPE_WORKGROUP); }
                }
            }
        }
        __syncthreads();
        if (do_router) { if (F.tid < 8) ccnt[c * 8 + F.tid] = lcnt[F.tid]; }
        __syncthreads();
    }
}

__device__ __forceinline__ void route_phase(Frame& F, const bf16* hn, bf16* hsort) {
    unsigned char* ws = F.ws;
    const Route* route = (const Route*)(ws + WS_MISC); int* slots = (int*)(ws + WS_MISC + 256 * 1024); const int* ccnt = (const int*)(ws + WS_MISC + 384 * 1024); int* tile_base = (int*)(ws + WS_MISC + 512 * 1024);
    LAS int* tot = (LAS int*)(F.lds + RING_OFF); LAS int* bef = tot + 8; LAS int* base = tot + 16; LAS int* sl = tot + 32;
    for (int c = F.blk; c < T / 64; c += F.G) {
        { const int e = F.wave; int t = 0, b = 0;
#pragma unroll
            for (int q = 0; q < 4; ++q) { const int ch = F.lane * 4 + q; const int v = ccnt[ch * 8 + e]; t += v; b += (ch < c) ? v : 0; }
            t = wave_sumi(t); b = wave_sumi(b);
            if (F.lane == 0) { tot[e] = t; bef[e] = b; } }
        __syncthreads();
        if (F.tid == 0) { int acc = 0;
            for (int e = 0; e < 8; ++e) { base[e] = acc; if (c == 0) tile_base[e] = acc >> 8; acc += (tot[e] + 255) & ~255; }
            if (c == 0) tile_base[8] = acc >> 8; }
        __syncthreads();
        if (F.wave == 0) {
            const int row = c * 64 + F.lane; const Route r = route[row];
            int run[8];
#pragma unroll
            for (int e = 0; e < 8; ++e) run[e] = base[e] + bef[e];
#pragma unroll
            for (int k = 0; k < 2; ++k) { const int me = k ? r.e2 : r.e1; int myslot = 0;
#pragma unroll
                for (int e = 0; e < 8; ++e) { const unsigned long long m = __ballot(me == e); const int rank = __popcll(m & ((1ull << F.lane) - 1ull));
                    if (me == e) myslot = run[e] + rank; run[e] += __popcll(m); }
                slots[2 * row + k] = myslot; sl[2 * F.lane + k] = myslot; }
        }
        __syncthreads();
        for (int p = F.wave; p < 128; p += NWAVES) { const int row = c * 64 + (p >> 1); const int s = sl[p];
            const v4u* src = (const v4u*)(hn + (size_t)row * D) + 2 * F.lane; const v4u a = src[0], b = src[1];
            v4u o; o.x = pk4_fp8(bflo(a.x), bfhi(a.x), bflo(a.y), bfhi(a.y)); o.y = pk4_fp8(bflo(a.z), bfhi(a.z), bflo(a.w), bfhi(a.w));
            o.z = pk4_fp8(bflo(b.x), bfhi(b.x), bflo(b.y), bfhi(b.y)); o.w = pk4_fp8(bflo(b.z), bfhi(b.z), bflo(b.w), bfhi(b.w));
            *((v4u*)((unsigned char*)hsort + (size_t)s * D) + F.lane) = o; }
        __syncthreads();
    }
}

__device__ __forceinline__ int srow(int s, int g) { return g == 0 ? s : (g == 1 ? ((s & 3) * 1024 + (s >> 2)) : ((s & 15) * 256 + (s >> 4))); }
__device__ __forceinline__ float rope_apply(float n, int lane, const float* cs, const float* sn, int s) {
    const float partner = __shfl_xor(n, 32); const int j = lane & 31; const float c = cs[s * 32 + j], si = sn[s * 32 + j];
    return lane < 32 ? n * c - partner * si : n * c + partner * si;
}
__device__ __forceinline__ void post_even(Frame& F, const bf16* rawp, const float* vgain, const float* qgain, const float* kgain) {
    unsigned char* ws = F.ws; bf16* UV = (bf16*)(ws + WS_P + P_UV); bf16* Qs = (bf16*)(ws + WS_P + P_QS); bf16* Ks = (bf16*)(ws + WS_P + P_KS); bf16* Vs = (bf16*)(ws + WS_P + P_VS);
    const float* cs = (const float*)(ws + WS_ROPE); const float* sn = cs + SEQ * 32;
    const int lane = F.lane; const float qg = qgain[lane], kg = kgain[lane];
    const long nitems = (long)T * 44;
    for (long it = (long)F.blk * NWAVES + F.wave; it < nitems; it += (long)F.G * NWAVES) {
        const int row = (int)(it / 44), u = (int)(it % 44), b = row >> 12, s = row & 4095;
        const float v = bf2f(rawp[(size_t)row * EVEN_IN + 64 * u + lane]);
        if (u < 4) { UV[(size_t)row * 512 + 64 * u + lane] = (bf16)f2bf(gelu_tanh(v)); }
        else if (u < 8) { const float z = gelu_tanh(v); const float ss = wave_sum(z * z); const float o = z * (1.0f / sqrtf(ss * (1.0f / 64) + EPS)) * vgain[(u - 4) * 64 + lane];
            UV[(size_t)row * 512 + 64 * u + lane] = (bf16)f2bf(o); }
        else if (u < 32) { const bool isq = u < 20; const int h = isq ? u - 8 : u - 20; const float ss = wave_sum(v * v);
            const float n = v * (1.0f / sqrtf(ss * (1.0f / 64) + EPS)) * (isq ? qg : kg); const float o = rope_apply(n, lane, cs, sn, s);
            (isq ? Qs : Ks)[((size_t)(b * 12 + h) * SEQ + srow(s, h >> 2)) * 64 + lane] = (bf16)f2bf(isq ? o * att::C2 : o); }
        else { const int h = u - 32; Vs[((size_t)(b * 12 + h) * SEQ + srow(s, h >> 2)) * 64 + lane] = (bf16)f2bf(v); }
    }
}
__device__ __forceinline__ void post_odd(Frame& F, const bf16* rawp, const float* qgain, const float* kgain) {
    unsigned char* ws = F.ws; bf16* Qm = (bf16*)(ws + WS_P + P_QM); bf16* Km = (bf16*)(ws + WS_P + P_KM); bf16* Vm = (bf16*)(ws + WS_P + P_VM);
    const float* cs = (const float*)(ws + WS_ROPE); const float* sn = cs + SEQ * 32;
    const int lane = F.lane; const float qg = qgain[lane], kg = kgain[lane];
    const long nitems = (long)T * 36;
    for (long it = (long)F.blk * NWAVES + F.wave; it < nitems; it += (long)F.G * NWAVES) {
        const int row = (int)(it / 36), u = (int)(it % 36), b = row >> 12, s = row & 4095;
        const float v = bf2f(rawp[(size_t)row * ODD_IN + 64 * u + lane]);
        if (u < 24) { const bool isq = u < 12; const int h = isq ? u : u - 12; const float ss = wave_sum(v * v);
            const float n = v * (1.0f / sqrtf(ss * (1.0f / 64) + EPS)) * (isq ? qg : kg); const float o = rope_apply(n, lane, cs, sn, s);
            (isq ? Qm : Km)[((size_t)(b * 12 + h) * SEQ + s) * 64 + lane] = (bf16)f2bf(isq ? o * att::C2 : o); }
        else { const int h = u - 24; Vm[((size_t)(b * 12 + h) * SEQ + s) * 64 + lane] = (bf16)f2bf(v); }
    }
}
__device__ __forceinline__ void kmean_phase(Frame& F) {
    const bf16* Km = (const bf16*)(F.ws + WS_P + P_KM); float* km = (float*)(F.ws + WS_KMEAN);
    for (int it = F.blk * NWAVES + F.wave; it < 48 * 16; it += F.G * NWAVES) {
        const bf16* k = Km + (size_t)it * 256 * 64 + F.lane; float s = 0.f;
        for (int r = 0; r < 256; ++r) s += bf2f(k[r * 64]);
        km[it * 64 + F.lane] = s * (1.0f / 256.0f);
    }
}

__device__ __forceinline__ void load_row64(const bf16* p, float (&q)[64]) {
    const v4u* p4 = (const v4u*)p;
#pragma unroll
    for (int i = 0; i < 8; ++i) { const v4u w = p4[i]; q[8 * i + 0] = bflo(w.x); q[8 * i + 1] = bfhi(w.x); q[8 * i + 2] = bflo(w.y); q[8 * i + 3] = bfhi(w.y); q[8 * i + 4] = bflo(w.z); q[8 * i + 5] = bfhi(w.z); q[8 * i + 6] = bflo(w.w); q[8 * i + 7] = bfhi(w.w); }
}
__device__ __forceinline__ float dot_row64(const bf16* p, const float (&q)[64]) {
    const v4u* p4 = (const v4u*)p; float s = 0.f;
#pragma unroll
    for (int i = 0; i < 8; ++i) { const v4u w = p4[i]; s += q[8 * i + 0] * bflo(w.x) + q[8 * i + 1] * bfhi(w.x) + q[8 * i + 2] * bflo(w.y) + q[8 * i + 3] * bfhi(w.y) + q[8 * i + 4] * bflo(w.z) + q[8 * i + 5] * bfhi(w.z) + q[8 * i + 6] * bflo(w.w) + q[8 * i + 7] * bfhi(w.w); }
    return s;
}
__device__ __forceinline__ void banded_naive(Frame& F) {
    unsigned char* ws = F.ws; const bf16* Qs = (const bf16*)(ws + WS_P + P_QS); const bf16* Ks = (const bf16*)(ws + WS_P + P_KS); const bf16* Vs = (const bf16*)(ws + WS_P + P_VS);
    bf16* OG = (bf16*)(ws + WS_HID + H_OG); float* LSE = (float*)(ws + WS_HID + H_LSE);
    LAS float* pl = (LAS float*)(F.lds + RING_OFF) + F.wave * 256;
    const int lane = F.lane;
    for (int it = F.blk * NWAVES + F.wave; it < 48 * SEQ; it += F.G * NWAVES) {
        const int bh = it >> 12, rp = it & 4095, b = bh / 12, h = bh % 12, g = h >> 2, dil = g == 0 ? 1 : (g == 1 ? 4 : 16), L = SEQ / dil;
        const int i = rp % L, r = rp / L, s = i * dil + r, nk = (i < 128 ? i : 128) + 1, first = rp - (nk - 1);
        float q[64]; load_row64(Qs + ((size_t)bh * SEQ + rp) * 64, q);
        float sc[3]; float m = -INFINITY;
#pragma unroll
        for (int kk = 0; kk < 3; ++kk) { const int j = lane + 64 * kk; sc[kk] = -INFINITY; if (j < nk) { sc[kk] = 0.6931471805599453f * dot_row64(Ks + ((size_t)bh * SEQ + first + j) * 64, q); } m = fmaxf(m, sc[kk]); }
        m = wave_max(m); float l = 0.f;
#pragma unroll
        for (int kk = 0; kk < 3; ++kk) { const float p = (lane + 64 * kk < nk) ? __expf(sc[kk] - m) : 0.f; pl[lane + 64 * kk] = p; l += p; }
        l = wave_sum(l); LDS_WAIT();
        float acc = 0.f; const bf16* vb = Vs + ((size_t)bh * SEQ + first) * 64 + lane;
        for (int j = 0; j < nk; ++j) acc += pl[j] * bf2f(vb[(size_t)j * 64]);
        const size_t orow = ((size_t)g * T + (size_t)b * SEQ + s) * 4 + (h & 3);
        OG[orow * 64 + lane] = (bf16)f2bf(acc / l);
        if (lane == 0) LSE[orow] = m + __logf(l);
        LDS_WAIT();
    }
}
__device__ __forceinline__ void merge_even(Frame& F, bf16* mix) {
    const bf16* OG = (const bf16*)(F.ws + WS_HID + H_OG); const float* LSE = (const float*)(F.ws + WS_HID + H_LSE);
    for (int t = F.blk * 512 + F.tid; t < T * 4 * 8; t += F.G * 512) {
        const int it = t >> 3, part = t & 7, row = it >> 2, hg = it & 3, b = row >> 12, s = row & 4095;
        const size_t i0 = ((size_t)0 * 16 + b * 4 + hg) * SEQ + srow(s, 0), i1 = ((size_t)1 * 16 + b * 4 + hg) * SEQ + srow(s, 1), i2 = ((size_t)2 * 16 + b * 4 + hg) * SEQ + srow(s, 2);
        const float l0 = LSE[i0], l1 = LSE[i1], l2 = LSE[i2]; const float m = fmaxf(l0, fmaxf(l1, l2));
        float w0 = __expf(l0 - m), w1 = __expf(l1 - m), w2 = __expf(l2 - m); const float inv = 1.0f / (w0 + w1 + w2); w0 *= inv; w1 *= inv; w2 *= inv;
        const v4u a = *(const v4u*)(OG + i0 * 64 + part * 8), bb = *(const v4u*)(OG + i1 * 64 + part * 8), c = *(const v4u*)(OG + i2 * 64 + part * 8);
        v4u o;
        o.x = pk2(w0 * bflo(a.x) + w1 * bflo(bb.x) + w2 * bflo(c.x), w0 * bfhi(a.x) + w1 * bfhi(bb.x) + w2 * bfhi(c.x));
        o.y = pk2(w0 * bflo(a.y) + w1 * bflo(bb.y) + w2 * bflo(c.y), w0 * bfhi(a.y) + w1 * bfhi(bb.y) + w2 * bfhi(c.y));
        o.z = pk2(w0 * bflo(a.z) + w1 * bflo(bb.z) + w2 * bflo(c.z), w0 * bfhi(a.z) + w1 * bfhi(bb.z) + w2 * bfhi(c.z));
        o.w = pk2(w0 * bflo(a.w) + w1 * bflo(bb.w) + w2 * bflo(c.w), w0 * bfhi(a.w) + w1 * bfhi(bb.w) + w2 * bfhi(c.w));
        *(v4u*)(mix + (size_t)row * EVEN_OUT + 256 + hg * 64 + part * 8) = o;
    }
}
__device__ __forceinline__ void gmlp_phase(Frame& F, int lp, const float* bsp, bf16* mix) {
    const bf16* UV = (const bf16*)(F.ws + WS_P + P_UV); const float* wtg = (const float*)(F.ws + WS_KMEAN) + (size_t)lp * 4 * 16384;
    LAS float* WT = (LAS float*)(F.lds + RING_OFF);
    LAS float* VL = WT + 128 * 128;
    const int tid = F.tid; int gl = -1;
    for (int unit = F.blk; unit < (T / 128) * 4; unit += F.G) {
        const int c = unit >> 2, g = unit & 3, row0 = c * 128;
        __syncthreads();
        if (g != gl) { gl = g; const f32x4* src = (const f32x4*)(wtg + (size_t)g * 16384);
#pragma unroll
            for (int q = 0; q < 8; ++q) *((LAS f32x4*)WT + tid + 512 * q) = src[tid + 512 * q]; }
        { const int j = tid >> 2, d8 = (tid & 3) * 16;
          const v4u a = *(const v4u*)(UV + (size_t)(row0 + j) * 512 + 256 + g * 64 + d8), b = *(const v4u*)(UV + (size_t)(row0 + j) * 512 + 256 + g * 64 + d8 + 8);
          LAS f32x4* vd = (LAS f32x4*)(VL + j * 64 + d8);
          vd[0] = (f32x4){bflo(a.x), bfhi(a.x), bflo(a.y), bfhi(a.y)}; vd[1] = (f32x4){bflo(a.z), bfhi(a.z), bflo(a.w), bfhi(a.w)};
          vd[2] = (f32x4){bflo(b.x), bfhi(b.x), bflo(b.y), bfhi(b.y)}; vd[3] = (f32x4){bflo(b.z), bfhi(b.z), bflo(b.w), bfhi(b.w)}; }
        __syncthreads();
        const int i0 = 4 * (tid >> 4), d0 = 4 * (tid & 15);
        f32x4 acc[4];
#pragma unroll
        for (int a = 0; a < 4; ++a) acc[a] = (f32x4){0.f, 0.f, 0.f, 0.f};
        const int jmax = i0 + 3;
        for (int j = 0; j <= jmax; ++j) { const f32x4 w = *(const LAS f32x4*)(WT + j * 128 + i0); const f32x4 v = *(const LAS f32x4*)(VL + j * 64 + d0);
            acc[0] += w.x * v; acc[1] += w.y * v; acc[2] += w.z * v; acc[3] += w.w * v; }
#pragma unroll
        for (int a = 0; a < 4; ++a) { const int i = i0 + a; const float bb = bsp[g * 128 + i]; const size_t row = row0 + i;
            const v2u uu = *(const v2u*)(UV + row * 512 + g * 64 + d0);
            v2u o; o.x = pk2(bflo(uu.x) * (acc[a].x + bb), bfhi(uu.x) * (acc[a].y + bb)); o.y = pk2(bflo(uu.y) * (acc[a].z + bb), bfhi(uu.y) * (acc[a].w + bb));
            *(v2u*)(mix + row * EVEN_OUT + g * 64 + d0) = o; }
    }
    __syncthreads();
}
__device__ __forceinline__ void moba_naive(Frame& F, bf16* mix) {
    unsigned char* ws = F.ws; const bf16* Qm = (const bf16*)(ws + WS_P + P_QM); const bf16* Km = (const bf16*)(ws + WS_P + P_KM); const bf16* Vm = (const bf16*)(ws + WS_P + P_VM);
    const float* km = (const float*)(ws + WS_KMEAN);
    LAS float* sc = (LAS float*)(F.lds + RING_OFF) + F.wave * 1024;
    const int lane = F.lane;
    for (int it = F.blk * NWAVES + F.wave; it < 48 * SEQ; it += F.G * NWAVES) {
        const int bh = it >> 12, s = it & 4095, b = bh / 12, h = bh % 12, qb = s >> 8;
        float q[64]; load_row64(Qm + ((size_t)bh * SEQ + s) * 64, q);
        float gate = -INFINITY;
        if (lane < qb) { const f32x4* kp = (const f32x4*)(km + ((size_t)bh * 16 + lane) * 64); float a = 0.f;
#pragma unroll
            for (int i = 0; i < 16; ++i) { const f32x4 w = kp[i]; a += q[4 * i] * w.x + q[4 * i + 1] * w.y + q[4 * i + 2] * w.z + q[4 * i + 3] * w.w; }
            gate = a; }
        unsigned sel = 1u << qb;
        for (int r = 0; r < 3; ++r) { float v = gate; int idx = lane;
#pragma unroll
            for (int o = 1; o < 64; o <<= 1) { const float ov = __shfl_xor(v, o); const int oi = __shfl_xor(idx, o); if (ov > v || (ov == v && oi < idx)) { v = ov; idx = oi; } }
            if (v > -INFINITY) { sel |= 1u << idx; if (lane == idx) gate = -INFINITY; } }
        int cnt = 0; float m = -INFINITY;
        for (int n = 0; n <= qb; ++n) { if (!((sel >> n) & 1u)) continue;
#pragma unroll
            for (int kk = 0; kk < 4; ++kk) { const int key = n * 256 + kk * 64 + lane; float x = -INFINITY;
                if (key <= s) x = 0.6931471805599453f * dot_row64(Km + ((size_t)bh * SEQ + key) * 64, q);
                sc[cnt * 256 + kk * 64 + lane] = x; m = fmaxf(m, x); }
            ++cnt; }
        m = wave_max(m); float l = 0.f; LDS_WAIT();
        for (int i = lane; i < cnt * 256; i += 64) { const float p = __expf(sc[i] - m); sc[i] = p; l += p; }
        l = wave_sum(l); LDS_WAIT();
        float acc = 0.f; int c2 = 0;
        for (int n = 0; n <= qb; ++n) { if (!((sel >> n) & 1u)) continue;
            const bf16* vb = Vm + ((size_t)bh * SEQ + n * 256) * 64 + lane; const int kend = (n == qb) ? (s & 255) + 1 : 256;
            for (int kk = 0; kk < kend; ++kk) acc += sc[c2 * 256 + kk] * bf2f(vb[(size_t)kk * 64]);
            ++c2; }
        mix[((size_t)b * SEQ + s) * ODD_OUT + h * 64 + lane] = (bf16)f2bf(acc / l);
        LDS_WAIT();
    }
}
__device__ __forceinline__ void conv_phase(Frame& F, const bf16* cv, const float* cw, bf16* mix) {
    for (int it = F.blk * 512 + F.tid; it < T * 32; it += F.G * 512) {
        const int row = it >> 5, c = (it & 31) * 8, s = row & 4095;
        const bf16* p = cv + (size_t)row * 768 + c;
        const v4u bg = *(const v4u*)p, c0 = *(const v4u*)(p + 256), x0 = *(const v4u*)(p + 512);
        v4u c1 = (v4u){0u, 0u, 0u, 0u}, x1 = c1, c2 = c1, x2 = c1;
        if (s >= 1) { c1 = *(const v4u*)(p + 256 - 768); x1 = *(const v4u*)(p + 512 - 768); }
        if (s >= 2) { c2 = *(const v4u*)(p + 256 - 1536); x2 = *(const v4u*)(p + 512 - 1536); }
        const f32x4 wa0 = *(const f32x4*)(cw + c), wa1 = *(const f32x4*)(cw + c + 4), wb0 = *(const f32x4*)(cw + 256 + c), wb1 = *(const f32x4*)(cw + 256 + c + 4), wc0 = *(const f32x4*)(cw + 512 + c), wc1 = *(const f32x4*)(cw + 512 + c + 4);
        const unsigned bgw[4] = {bg.x, bg.y, bg.z, bg.w}, c0w[4] = {c0.x, c0.y, c0.z, c0.w}, x0w[4] = {x0.x, x0.y, x0.z, x0.w}, c1w[4] = {c1.x, c1.y, c1.z, c1.w}, x1w[4] = {x1.x, x1.y, x1.z, x1.w}, c2w[4] = {c2.x, c2.y, c2.z, c2.w}, x2w[4] = {x2.x, x2.y, x2.z, x2.w};
        const float w0[8] = {wa0.x, wa0.y, wa0.z, wa0.w, wa1.x, wa1.y, wa1.z, wa1.w}, w1[8] = {wb0.x, wb0.y, wb0.z, wb0.w, wb1.x, wb1.y, wb1.z, wb1.w}, w2[8] = {wc0.x, wc0.y, wc0.z, wc0.w, wc1.x, wc1.y, wc1.z, wc1.w};
        unsigned ow[4];
#pragma unroll
        for (int k = 0; k < 4; ++k) {
            const float ylo = w0[2 * k] * (bflo(c2w[k]) * bflo(x2w[k])) + w1[2 * k] * (bflo(c1w[k]) * bflo(x1w[k])) + w2[2 * k] * (bflo(c0w[k]) * bflo(x0w[k]));
            const float yhi = w0[2 * k + 1] * (bfhi(c2w[k]) * bfhi(x2w[k])) + w1[2 * k + 1] * (bfhi(c1w[k]) * bfhi(x1w[k])) + w2[2 * k + 1] * (bfhi(c0w[k]) * bfhi(x0w[k]));
            ow[k] = pk2(bflo(bgw[k]) * ylo, bfhi(bgw[k]) * yhi); }
        *(v4u*)(mix + (size_t)row * ODD_OUT + 768 + c) = (v4u){ow[0], ow[1], ow[2], ow[3]};
    }
}

constexpr int CW_QMOBA = 8192;
__device__ __forceinline__ void moba_phase(Frame& F, int lp, bf16* mix) {
    unsigned char* ws = F.ws; const bf16* Qm = (const bf16*)(ws + WS_P + P_QM); const bf16* Km = (const bf16*)(ws + WS_P + P_KM); const bf16* Vm = (const bf16*)(ws + WS_P + P_VM);
    const float* km = (const float*)(ws + WS_CTL + CTL_KMSUM + (size_t)(lp & 1) * KMSUM_BYTES);
    char* shm = (char*)F.lds + RING_OFF; LAS unsigned char* l3 = F.lds + RING_OFF;
    LAS float* kml = (LAS float*)(l3 + att::LDS_KM); volatile LAS int* tkw = (volatile LAS int*)(l3 + att::LDS_TK);
    unsigned* head = (unsigned*)(F.ctl + CW_QMOBA + 64 * lp);
    const int tid = F.tid, wid = F.wave;
    for (;;) {
        if (tid == 0) { unsigned* hp = head; asm volatile("" : "+v"(hp)); tkw[0] = (int)__hip_atomic_fetch_add(hp, 1u, __ATOMIC_RELAXED, __HIP_MEMORY_SCOPE_AGENT); }
        __syncthreads();
        const int tk = __builtin_amdgcn_readfirstlane(tkw[0]);
        if (tk >= 48 * 16) break;
        const int qb = 15 - tk / 48, bh = tk % 48, b = bh / 12, h = bh % 12;
        int lane_ = F.lane; asm volatile("" : "+v"(lane_)); const int r32 = lane_ & 31, hi = lane_ >> 5;
        ((LAS v2u*)kml)[tid] = ((const v2u*)(km + (size_t)bh * 1024))[tid];
        __syncthreads();
        unsigned sel = 0u;
        { const bf16* qrow = Qm + ((size_t)bh * SEQ + qb * 256 + wid * 32 + r32) * 64 + hi * 8;
          float qf[32];
#pragma unroll
          for (int d0 = 0; d0 < 4; ++d0) { const v4u w = *(const v4u*)(qrow + d0 * 16);
              qf[8 * d0 + 0] = bflo(w.x); qf[8 * d0 + 1] = bfhi(w.x); qf[8 * d0 + 2] = bflo(w.y); qf[8 * d0 + 3] = bfhi(w.y); qf[8 * d0 + 4] = bflo(w.z); qf[8 * d0 + 5] = bfhi(w.z); qf[8 * d0 + 6] = bflo(w.w); qf[8 * d0 + 7] = bfhi(w.w); }
          float v1 = -INFINITY, v2 = -INFINITY, v3 = -INFINITY; int i1 = 0, i2 = 0, i3 = 0;
          for (int n = 0; n < qb; ++n) { float a = 0.f;
#pragma unroll
              for (int d0 = 0; d0 < 4; ++d0) { const f32x4 k0 = *(const LAS f32x4*)(kml + n * 64 + d0 * 16 + hi * 8), k1 = *(const LAS f32x4*)(kml + n * 64 + d0 * 16 + hi * 8 + 4);
                  a += qf[8 * d0 + 0] * k0.x + qf[8 * d0 + 1] * k0.y + qf[8 * d0 + 2] * k0.z + qf[8 * d0 + 3] * k0.w + qf[8 * d0 + 4] * k1.x + qf[8 * d0 + 5] * k1.y + qf[8 * d0 + 6] * k1.z + qf[8 * d0 + 7] * k1.w; }
              a = xsum32(a);
              if (a > v1) { v3 = v2; i3 = i2; v2 = v1; i2 = i1; v1 = a; i1 = n; } else if (a > v2) { v3 = v2; i3 = i2; v2 = a; i2 = n; } else if (a > v3) { v3 = a; i3 = n; } }
          if (v1 > -INFINITY) sel |= 1u << i1; if (v2 > -INFINITY) sel |= 1u << i2; if (v3 > -INFINITY) sel |= 1u << i3; }
        const size_t sb = (size_t)bh * SEQ * 64;
        att::attn_unit<0, 8, ODD_OUT>(Qm + sb, qb * 256, 0, 4 * (qb + 1), sel, mix + ((size_t)b * SEQ + qb * 256) * ODD_OUT + h * 64, nullptr, shm, tid);
    }
    __syncthreads();
}
__device__ __forceinline__ void banded_phase(Frame& F) {
    unsigned char* ws = F.ws; const bf16* Qs = (const bf16*)(ws + WS_P + P_QS); const bf16* Ks = (const bf16*)(ws + WS_P + P_KS); const bf16* Vs = (const bf16*)(ws + WS_P + P_VS);
    bf16* OG = (bf16*)(ws + WS_HID + H_OG); float* LSE = (float*)(ws + WS_HID + H_LSE);
    char* shm = (char*)F.lds + RING_OFF;
    for (int u = F.blk; u < 768; u += F.G) {
        const int g = u >> 8, rem = u & 255, b = rem >> 6, hg = (rem >> 4) & 3, u16 = rem & 15, h = g * 4 + hg, bh = b * 12 + h;
        const int dil = g == 0 ? 1 : (g == 1 ? 4 : 16), L = SEQ / dil, row0 = 256 * u16, r = row0 / L, q0s = row0 % L;
        const int tile0 = (q0s >> 6) >= 2 ? (q0s >> 6) - 2 : 0, NT = (q0s >> 6) + 4 - tile0;
        const size_t sb = ((size_t)bh * SEQ + (size_t)r * L) * 64;
        const size_t orow = ((size_t)g * 16 + b * 4 + hg) * SEQ + row0;
        att::attn_unit<1, 8, 64>(Qs + sb, q0s, tile0, NT, 0u, OG + orow * 64, LSE + orow, shm, F.tid);
    }
    __syncthreads();
}

constexpr int PH_PER_PAIR = 16, NPH = 1 + 2 * PH_PER_PAIR + 1;
__global__ void __launch_bounds__(NWAVES * 64, 2) fwd(Args args) {
    extern __shared__ __attribute__((aligned(16))) unsigned char lds[];
    const int wv0 = __builtin_amdgcn_readfirstlane((int)threadIdx.x >> 6);
#define MKFRAME() Frame F; { int t_ = TID_NOW(wv0); asm volatile("" : "+v"(t_)); int b_ = blockIdx.x; asm volatile("" : "+s"(b_)); \
    F.lds = (LAS unsigned char*)lds; F.MISC = (volatile LAS unsigned*)(F.lds + MISC_OFF); F.tid = t_; F.lane = t_ & 63; F.wave = __builtin_amdgcn_readfirstlane(t_ >> 6); \
    unsigned char* w_ = args.ws; asm volatile("" : "+s"(w_)); F.G = gridDim.x; F.blk = b_; F.ws = w_; F.out = args.out; F.ctl = (gu32*)(w_ + WS_CTL); }
    for (int u = TID_NOW(wv0); u < (LDS_BYTES - LDSCTL_OFF) / 4; u += NWAVES * 64) ((LAS unsigned*)((LAS unsigned char*)lds + LDSCTL_OFF))[u] = 0u;
    __syncthreads();
    const int lo = args.ph_lo, hi = args.ph_hi;
    XcdBarrier bar; bar.bar = (unsigned*)(args.ws + WS_CTL) + CW_BAR; bar.x = 0; bar.st = nullptr;
    if (hi - lo > 1) bar = xcd_barrier_post((unsigned*)(args.ws + WS_CTL) + CW_BAR, (volatile LAS unsigned*)((LAS unsigned char*)lds + MISC_OFF) + 8, TID_NOW(wv0));
#ifndef PHMASK
#define PHMASK 0xFFFFFF
#endif
#define PHEN(k) (((PHMASK) >> (k)) & 1)
#ifndef PROBE_REP
#define PROBE_REP 0
#endif
#define NREP(k) ((((PROBE_REP) >> (k)) & 1) + 1)
#define IN(k) (lo <= (k) && (k) < hi)
#define SEAM(k) do { if (IN(k) && IN((k) + 1)) xcd_barrier(bar, TID_NOW(wv0)); } while (0)
#define HN ((bf16*)(F.ws + WS_HN))
#define MIX ((bf16*)(F.ws + WS_MIX))
#define HID ((bf16*)(F.ws + WS_HID))
#define RAWP ((bf16*)(F.ws + WS_HID + H_RAWP))
#define HSORT ((bf16*)(F.ws + WS_P))
#define YB ((bf16*)(F.ws + WS_P))
#define x_in (args.in[0])

    if (PHEN(19) && IN(0)) { for (int rep_ = 0; rep_ < NREP(19); ++rep_) { MKFRAME(); p0_prologue(F, args); } SEAM(0); }

    for (int lp = 0; lp < 2; ++lp) {
        const int pb = 1 + lp * PH_PER_PAIR;
        const int le = 2 * lp, lo_ = 2 * lp + 1;
#define we ((const pg8::bf16_t*)(F.ws + WS_WT_EVEN0 + (size_t)lp * WT_EVEN_BYTES))
#define wo ((const pg8::bf16_t*)(F.ws + WS_WT_ODD0 + (size_t)lp * WT_ODD_BYTES))
        if (PHEN(0) && IN(pb + 0)) { for (int rep_ = 0; rep_ < NREP(0); ++rep_) { MKFRAME();
            norm_phase(F, lp == 0 ? x_in : F.out, F.out, args.in[1] + (size_t)le * D, HN, lp != 0, false, true, nullptr);
            } SEAM(pb + 0); }
        if (PHEN(1) && IN(pb + 1)) { for (int rep_ = 0; rep_ < NREP(1); ++rep_) { MKFRAME();
            pg8::Gemm g{HN, we + WTE_IN / 2, T, EVEN_IN, D}; pg8::StaticOrder S; S.init(T, EVEN_IN, F.G, F.blk);
            pg8::EpiHeadsEven E{(bf16*)(F.ws + WS_P + P_UV), (bf16*)(F.ws + WS_P + P_QS), args.in[4] + (size_t)lp * 256, args.in[7] + (size_t)lp * 64, args.in[8] + (size_t)lp * 64,
                                (const float*)(F.ws + WS_ROPE), (const float*)(F.ws + WS_ROPE) + SEQ * 32};
            pg8::gemm_phase<pg8::EpiHeadsEven, pg8::StaticOrder>(F.lds + RING_OFF, g, S, E, F.tid);
            } SEAM(pb + 1); }
        if (PHEN(2) && IN(pb + 2)) { for (int rep_ = 0; rep_ < NREP(2); ++rep_) { MKFRAME(); banded_phase(F); gmlp_phase(F, lp, args.in[6] + (size_t)lp * 4 * 128, MIX); } SEAM(pb + 2); }
        if (PHEN(3) && IN(pb + 3)) { for (int rep_ = 0; rep_ < NREP(3); ++rep_) { MKFRAME(); merge_even(F, MIX); } SEAM(pb + 3); }
        if (PHEN(4) && IN(pb + 4)) { for (int rep_ = 0; rep_ < NREP(4); ++rep_) { MKFRAME();
            pg8::Gemm g{MIX, we + WTE_OUT / 2, T, D, EVEN_OUT}; pg8::StaticOrder S; S.init(T, D, F.G, F.blk);
            pg8::EpiF32Res E{lp == 0 ? x_in : F.out, F.out, D};
            pg8::gemm_phase<pg8::EpiF32Res, pg8::StaticOrder>(F.lds + RING_OFF, g, S, E, F.tid);
            } SEAM(pb + 4); }
        if (PHEN(5) && IN(pb + 5)) { for (int rep_ = 0; rep_ < NREP(5); ++rep_) { MKFRAME(); norm_phase(F, F.out, F.out, args.in[2] + (size_t)le * D, HN, false, false, true, nullptr); } SEAM(pb + 5); }
        if (PHEN(6) && IN(pb + 6)) { for (int rep_ = 0; rep_ < NREP(6); ++rep_) { MKFRAME();
            pg8::Gemm g{HN, we + WTE_GU / 2, T, 2 * DFF, D}; pg8::StaticOrder S; S.init(T, 2 * DFF, F.G, F.blk);
            pg8::EpiSwiGLU E{HID, DFF, 1.0f};
            pg8::gemm_phase<pg8::EpiSwiGLU, pg8::StaticOrder>(F.lds + RING_OFF, g, S, E, F.tid);
            } SEAM(pb + 6); }
        if (PHEN(7) && IN(pb + 7)) { for (int rep_ = 0; rep_ < NREP(7); ++rep_) { MKFRAME();
            pg8::Gemm g{HID, we + WTE_DN / 2, T, D, DFF}; pg8::StaticOrder S; S.init(T, D, F.G, F.blk);
            pg8::EpiF32Res E{F.out, F.out, D};
            pg8::gemm_phase<pg8::EpiF32Res, pg8::StaticOrder>(F.lds + RING_OFF, g, S, E, F.tid);
            } SEAM(pb + 7); }
        if (PHEN(8) && IN(pb + 8)) { for (int rep_ = 0; rep_ < NREP(8); ++rep_) { MKFRAME(); norm_phase(F, F.out, F.out, args.in[1] + (size_t)lo_ * D, HN, false, false, true, nullptr); } SEAM(pb + 8); }
        if (PHEN(9) && IN(pb + 9)) { for (int rep_ = 0; rep_ < NREP(9); ++rep_) { MKFRAME();
            pg8::Gemm g{HN, wo + WTO_IN / 2, T, ODD_IN, D}; pg8::StaticOrder S; S.init(T, ODD_IN, F.G, F.blk);
            pg8::EpiHeadsOdd E{(bf16*)(F.ws + WS_P + P_QM), (bf16*)(F.ws + WS_P + P_CONV), (float*)(F.ws + WS_CTL + CTL_KMSUM + (size_t)lp * KMSUM_BYTES),
                               args.in[14] + (size_t)lp * 64, args.in[15] + (size_t)lp * 64, (const float*)(F.ws + WS_ROPE), (const float*)(F.ws + WS_ROPE) + SEQ * 32};
            pg8::gemm_phase<pg8::EpiHeadsOdd, pg8::StaticOrder>(F.lds + RING_OFF, g, S, E, F.tid);
            } SEAM(pb + 9); }
        if (PHEN(10) && IN(pb + 10)) { for (int rep_ = 0; rep_ < NREP(10); ++rep_) { MKFRAME(); moba_phase(F, lp + 2 * rep_, MIX); conv_phase(F, (const bf16*)(F.ws + WS_P + P_CONV), args.in[16] + (size_t)lp * 3 * 256, MIX); } SEAM(pb + 10); }
        if (PHEN(11) && IN(pb + 11)) { for (int rep_ = 0; rep_ < NREP(11); ++rep_) { MKFRAME();
            pg8::Gemm g{MIX, wo + WTO_OUT / 2, T, D, ODD_OUT}; pg8::StaticOrder S; S.init(T, D, F.G, F.blk);
            pg8::EpiF32Res E{F.out, F.out, D};
            pg8::gemm_phase<pg8::EpiF32Res, pg8::StaticOrder>(F.lds + RING_OFF, g, S, E, F.tid);
            } SEAM(pb + 11); }
        if (PHEN(12) && IN(pb + 12)) { for (int rep_ = 0; rep_ < NREP(12); ++rep_) { MKFRAME(); norm_phase(F, F.out, F.out, args.in[2] + (size_t)lo_ * D, HN, false, true, true, args.in[18] + (size_t)lp * D * NEXP); } SEAM(pb + 12); }
        if (PHEN(13) && IN(pb + 13)) { for (int rep_ = 0; rep_ < NREP(13); ++rep_) { MKFRAME(); route_phase(F, HN, HSORT); } SEAM(pb + 13); }
        if (PHEN(14) && IN(pb + 14)) { for (int rep_ = 0; rep_ < NREP(14); ++rep_) { MKFRAME();
            const int* tbp = (const int*)(F.ws + WS_MISC + 512 * 1024);
            pg8::MoeOrder S; const int ntiles = __builtin_amdgcn_readfirstlane(tbp[8]); S.init(ntiles * 256, 2 * DFFE, F.G, F.blk);
#pragma unroll
            for (int k = 0; k < 8; ++k) S.tb[k] = __builtin_amdgcn_readfirstlane(tbp[k]);
            S.estride = (size_t)2 * DFFE * D;
            pg8::Gemm g{HSORT, wo + WTO_MGU / 2, ntiles * 256, 2 * DFFE, D};
            pg8::EpiSwiGLU8 E{(unsigned char*)HID, DFFE, 1.0f / W8_SCALE, H8_SCALE};
            pg8::gemm_phase<pg8::EpiSwiGLU8, pg8::MoeOrder, false, true, true>(F.lds + RING_OFF, g, S, E, F.tid);
            } SEAM(pb + 14); }
        if (PHEN(15) && IN(pb + 15)) { for (int rep_ = 0; rep_ < NREP(15); ++rep_) { MKFRAME();
            const int* tbp = (const int*)(F.ws + WS_MISC + 512 * 1024);
            pg8::MoeOrder S; const int ntiles = __builtin_amdgcn_readfirstlane(tbp[8]); S.init(ntiles * 256, D, F.G, F.blk);
#pragma unroll
            for (int k = 0; k < 8; ++k) S.tb[k] = __builtin_amdgcn_readfirstlane(tbp[k]);
            S.estride = (size_t)DFFE * D;
            pg8::Gemm g{HID, wo + WTO_MD / 2, ntiles * 256, D, DFFE};
            pg8::EpiBf16Plain E{YB, D, 1.0f / (W8_SCALE * H8_SCALE)};
            pg8::gemm_phase<pg8::EpiBf16Plain, pg8::MoeOrder, false, true, true>(F.lds + RING_OFF, g, S, E, F.tid);
            } SEAM(pb + 15); }
    }
    if (PHEN(20) && IN(NPH - 1)) { MKFRAME(); norm_phase(F, F.out, F.out, args.in[1], HN, true, false, false, nullptr); }
#undef IN
#undef SEAM
#undef HN
#undef MIX
#undef HID
#undef RAWP
#undef HSORT
#undef YB
#undef x_in
#undef we
#undef wo
}

extern "C" void kernel_launch(void* const* d_in, const int* in_sizes, int n_in, void* d_out, int out_size, void* d_ws, size_t ws_size, hipStream_t stream) {
    static int grid = 0;
    if (grid == 0) {
        if (n_in != 22 || out_size != T * D || ws_size < WS_END) { fprintf(stderr, "kernel_launch: unexpected shapes (n_in %d out %d ws %zu)\n", n_in, out_size, ws_size); grid = -1; return; }
        int dev = 0, cus = 0, per_cu = 0;
        if (hipGetDevice(&dev) != hipSuccess || hipDeviceGetAttribute(&cus, hipDeviceAttributeMultiprocessorCount, dev) != hipSuccess) { grid = -1; return; }
        if (hipFuncSetAttribute((const void*)fwd, hipFuncAttributeMaxDynamicSharedMemorySize, LDS_BYTES) != hipSuccess) { fprintf(stderr, "kernel_launch: hipFuncSetAttribute failed\n"); grid = -1; return; }
        if (hipOccupancyMaxActiveBlocksPerMultiprocessor(&per_cu, (const void*)fwd, NWAVES * 64, LDS_BYTES) != hipSuccess || per_cu < 1) fprintf(stderr, "kernel_launch: occupancy query says %d\n", per_cu);
        (void)hipGetLastError();
        grid = cus;
    }
    if (grid < 0) return;
    (void)hipMemsetAsync((char*)d_ws + WS_CTL, 0, CTL_ZERO_BYTES, stream);
    Args a{};
    for (int i = 0; i < 22; ++i) a.in[i] = (const float*)d_in[i];
    a.out = (float*)d_out; a.ws = (unsigned char*)d_ws;
#if MK_PER_PHASE
    for (int p = 0; p < NPH; ++p) { a.ph_lo = p; a.ph_hi = p + 1; hipLaunchKernelGGL(fwd, dim3(grid), dim3(NWAVES * 64), LDS_BYTES, stream, a); }
#else
    a.ph_lo = 0; a.ph_hi = NPH; hipLaunchKernelGGL(fwd, dim3(grid), dim3(NWAVES * 64), LDS_BYTES, stream, a);
#endif
}
```

```cpp
#include <hip/hip_runtime.h>
#include <cstdio>
#include <cstdint>
#include <type_traits>
#include <hip/hip_bf16.h>


template <int X> __device__ __forceinline__ float xswz(float v) { return __builtin_bit_cast(float, __builtin_amdgcn_ds_swizzle(__builtin_bit_cast(int, v), (X << 10) | 0x1F)); }
template <int X> __device__ __forceinline__ int xswzi(int v) { return __builtin_amdgcn_ds_swizzle(v, (X << 10) | 0x1F); }
__device__ __forceinline__ float xsum32(float v) { float a = v, b = v; asm("s_nop 1\n\tv_permlane32_swap_b32_e32 %0, %1" : "+v"(a), "+v"(b)); return a + b; }
__device__ __forceinline__ int xsum32i(int v) { int a = v, b = v; asm("s_nop 1\n\tv_permlane32_swap_b32_e32 %0, %1" : "+v"(a), "+v"(b)); return a + b; }
__device__ __forceinline__ float xmax32(float v) { float a = v, b = v; asm("s_nop 1\n\tv_permlane32_swap_b32_e32 %0, %1" : "+v"(a), "+v"(b)); return fmaxf(a, b); }


__device__ __forceinline__ int lane_hw() { int l; asm volatile("v_mbcnt_lo_u32_b32 %0, -1, 0\n\tv_mbcnt_hi_u32_b32 %0, -1, %0" : "=v"(l)); return l; }
#define TID_NOW(wv) ((wv) * 64 + lane_hw())

#ifndef NAIVE_MOBA
#define NAIVE_MOBA 0
#endif
#ifndef NAIVE_BANDED
#define NAIVE_BANDED 0
#endif
#ifndef MK_PER_PHASE
#define MK_PER_PHASE 0
#endif

namespace pg8 {
#define PG8_LAS __attribute__((address_space(3)))
typedef unsigned short bf16_t;
typedef short bf16x8 __attribute__((ext_vector_type(8)));
typedef float f32x4 __attribute__((ext_vector_type(4)));
typedef float f32x2 __attribute__((ext_vector_type(2)));
typedef unsigned u32x4 __attribute__((ext_vector_type(4)));
constexpr int BM = 256, BK = 64, HALF = 128, HTB = HALF * BK * 2, STAGE_BYTES = 8 * HTB, NXCD = 8, WGM = 8;
constexpr int GAIN_TAB_OFF = STAGE_BYTES + 1024 + 2048;
constexpr int RS_TAB_OFF = STAGE_BYTES + 1024;

__host__ __device__ __forceinline__ int lds_byte(int r, int c) { const int st = (r >> 4) * 2 + (c >> 5), rr = r & 15, cc = c & 31, ob = rr * 64 + cc * 2; return st * 1024 + (ob ^ (((ob >> 9) & 1) << 5)); }
__host__ __device__ __forceinline__ void stage_rc(int b, int& R, int& C) { const int st = b / 1024, sb = b % 1024, swz = sb ^ (((sb >> 9) & 1) << 5); R = (st >> 1) * 16 + swz / 64; C = (st & 1) * 32 + (swz % 64) / 2; }
__host__ __device__ __forceinline__ int perm32(int rho) { const int n = rho >> 4, i = rho & 15; return 8 * (i >> 2) + 4 * n + (i & 3); }

struct Unit { int pm, pn; };
struct Gemm { const bf16_t* A; const bf16_t* Bt; int M, N, K; };

struct StaticOrder {
    int nM, nN, nwg, G, c;
    __device__ void init(int M, int N, int G_, int c_) { nM = M / BM; nN = N / BM; nwg = nM * nN; G = G_; c = c_; }
    __device__ bool next(int i, Unit& u) const {
        const long L = (long)i * G + c; if (L >= nwg) return false;
        int wgid = (int)L; { const int q = nwg / NXCD, r = nwg % NXCD, xcd = wgid % NXCD, off = wgid / NXCD; wgid = (xcd < r ? xcd * (q + 1) : r * (q + 1) + (xcd - r) * q) + off; }
        const int nig = WGM * nN, gid = wgid / nig, fm = gid * WGM, gsz = (nM - fm) < WGM ? (nM - fm) : WGM;
        u.pm = fm + ((wgid % nig) % gsz); u.pn = (wgid % nig) / gsz; return true;
    }
    __device__ __forceinline__ const char* bbase(const Unit&, const bf16_t* Bt) const { return (const char*)Bt; }
};
struct MoeOrder : StaticOrder {
    int tb[8]; size_t estride;
    __device__ __forceinline__ const char* bbase(const Unit& u, const bf16_t* Bt) const {
        unsigned e = 0;
#pragma unroll
        for (int k = 1; k < 8; ++k) e += ((unsigned)(tb[k] - 1 - u.pm)) >> 31;
        return (const char*)Bt + (size_t)e * estride;
    }
};

__device__ __forceinline__ unsigned cvt_pk_bf16(float lo, float hi) { unsigned r; asm volatile("v_cvt_pk_bf16_f32 %0, %1, %2" : "=v"(r) : "v"(lo), "v"(hi)); return r; }

struct EpiBf16Plain {
    static constexpr bool PERM = true; static constexpr bool NEEDS_RS = false;
    bf16_t* O; int ldc; float sc;
    __device__ __forceinline__ void operator()(const f32x4 (&acc)[2][2][4][2], const Unit& u, int wr, int wc, int fr, int fq) const {
        const int row0 = u.pm * BM + wr * 64 + fr, col0 = u.pn * BM + wc * 32 + 8 * fq;
#pragma unroll
        for (int ai = 0; ai < 2; ++ai)
#pragma unroll
            for (int m = 0; m < 4; ++m) { bf16_t* rowp = O + (size_t)(row0 + ai * HALF + m * 16) * ldc + col0;
#pragma unroll
                for (int bj = 0; bj < 2; ++bj) { const f32x4 v0 = acc[ai][bj][m][0] * sc, v1 = acc[ai][bj][m][1] * sc;
                    u32x4 w; w.x = cvt_pk_bf16(v0[0], v0[1]); w.y = cvt_pk_bf16(v0[2], v0[3]); w.z = cvt_pk_bf16(v1[0], v1[1]); w.w = cvt_pk_bf16(v1[2], v1[3]);
                    *(u32x4*)(rowp + bj * HALF) = w; } }
    }
};
struct EpiF32Res {
    static constexpr bool PERM = false; static constexpr bool NEEDS_RS = false;
    const float* base; float* out; int ldc;
    __device__ __forceinline__ void operator()(const f32x4 (&acc)[2][2][4][2], const Unit& u, int wr, int wc, int fr, int fq) const {
        const int row0 = u.pm * BM + wr * 64 + fr, col0 = u.pn * BM + wc * 32 + 4 * fq;
#pragma unroll
        for (int ai = 0; ai < 2; ++ai)
#pragma unroll
            for (int m = 0; m < 4; ++m) { const size_t off = (size_t)(row0 + ai * HALF + m * 16) * ldc + col0;
#pragma unroll
                for (int bj = 0; bj < 2; ++bj)
#pragma unroll
                    for (int n = 0; n < 2; ++n) { const f32x4 bs = *(const f32x4*)(base + off + bj * HALF + n * 16); *(f32x4*)(out + off + bj * HALF + n * 16) = bs + acc[ai][bj][m][n]; }
                asm volatile("" ::: "memory"); }
    }
};
struct EpiBf16PlainPP {
    static constexpr bool PERM = false; static constexpr bool NEEDS_RS = false;
    bf16_t* O; int ldc; float sc;
    __device__ __forceinline__ void operator()(const f32x4 (&acc)[2][2][4][2], const Unit& u, int wr, int wc, int fr, int fq) const {
        const int row0 = u.pm * BM + wr * 64 + fr, col0 = u.pn * BM + wc * 32 + 8 * fq;
#pragma unroll
        for (int ai = 0; ai < 2; ++ai)
#pragma unroll
            for (int m = 0; m < 4; ++m) { bf16_t* rowp = O + (size_t)(row0 + ai * HALF + m * 16) * ldc + col0;
#pragma unroll
                for (int bj = 0; bj < 2; ++bj) { const f32x4 v0 = acc[ai][bj][m][0] * sc, v1 = acc[ai][bj][m][1] * sc;
                    u32x4 w; w.x = cvt_pk_bf16(v0[0], v0[1]); w.y = cvt_pk_bf16(v0[2], v0[3]); w.z = cvt_pk_bf16(v1[0], v1[1]); w.w = cvt_pk_bf16(v1[2], v1[3]);
                    *(u32x4*)(rowp + bj * HALF) = w; } }
    }
};

struct EpiResX {
    static constexpr bool PERM = false; static constexpr bool NEEDS_RS = false;
    const float* base; float* out; bf16_t* xb; float* ssp; int ldc; float sc;
    __device__ __forceinline__ void operator()(const f32x4 (&acc)[2][2][4][2], const Unit& u, int wr, int wc, int fr, int fq) const {
        const int row0 = u.pm * BM + wr * 64 + fr, col0 = u.pn * BM + wc * 32 + 4 * fq;
        typedef unsigned u32x2 __attribute__((ext_vector_type(2)));
#pragma unroll
        for (int ai = 0; ai < 2; ++ai) {
            f32x4 bs[4][2][2];
#pragma unroll
            for (int m = 0; m < 4; ++m)
#pragma unroll
                for (int bj = 0; bj < 2; ++bj)
#pragma unroll
                    for (int n = 0; n < 2; ++n) bs[m][bj][n] = *(const f32x4*)(base + (size_t)(row0 + ai * HALF + m * 16) * ldc + col0 + bj * HALF + n * 16);
#pragma unroll
            for (int m = 0; m < 4; ++m) { const int row = row0 + ai * HALF + m * 16; const size_t off = (size_t)row * ldc + col0; float ss = 0.f;
#pragma unroll
                for (int bj = 0; bj < 2; ++bj)
#pragma unroll
                    for (int n = 0; n < 2; ++n) { const f32x4 o = bs[m][bj][n] + acc[ai][bj][m][n] * sc;
                        *(f32x4*)(out + off + bj * HALF + n * 16) = o; ss += (o[0] * o[0] + o[1] * o[1]) + (o[2] * o[2] + o[3] * o[3]);
                        u32x2 w; w.x = cvt_pk_bf16(o[0], o[1]); w.y = cvt_pk_bf16(o[2], o[3]); *(u32x2*)(xb + off + bj * HALF + n * 16) = w; }
                ss += xswz<16>(ss); ss = xsum32(ss);
                if (fq == 0) ssp[(size_t)row * 16 + u.pn * 4 + wc] = ss; }
            asm volatile("" ::: "memory"); }
    }
};
__device__ __forceinline__ float rstd_finish(f32x4 p) { float s = (p[0] + p[1]) + (p[2] + p[3]); s += xswz<16>(s); s = xsum32(s); return 1.0f / sqrtf(s * (1.0f / 1024.0f) + 1e-6f); }
__device__ __forceinline__ void rstd8(const float* ssp, int row0, int fq, float (&rs)[8]) {
    f32x4 p[8];
#pragma unroll
    for (int k = 0; k < 8; ++k) p[k] = *(const f32x4*)(ssp + (size_t)(row0 + (k >> 2) * HALF + (k & 3) * 16) * 16 + 4 * fq);
#pragma unroll
    for (int k = 0; k < 8; ++k) rs[k] = rstd_finish(p[k]);
}
__device__ __forceinline__ float silu_mul(float g, float u) { return g * __builtin_amdgcn_rcpf(1.0f + __builtin_amdgcn_exp2f(-1.4426950408889634f * g)) * u; }
struct EpiSwiGLU {
    static constexpr bool PERM = true; static constexpr bool NEEDS_RS = true;
    bf16_t* O; int ldc; float sc; const float* ssp;
    __device__ __forceinline__ void operator()(const f32x4 (&acc)[2][2][4][2], const Unit& u, int wr, int wc, int fr, int fq, const PG8_LAS float* rs) const {
        const int row0 = u.pm * BM + wr * 64 + fr, col0 = u.pn * HALF + wc * 32 + 8 * fq;
        float rs8[8];
#pragma unroll
        for (int k = 0; k < 8; ++k) rs8[k] = rs[(k >> 2) * HALF + wr * 64 + (k & 3) * 16 + fr];
#pragma unroll
        for (int ai = 0; ai < 2; ++ai)
#pragma unroll
            for (int m = 0; m < 4; ++m) { bf16_t* rowp = O + (size_t)(row0 + ai * HALF + m * 16) * ldc + col0;
                const float rs = sc * rs8[ai * 4 + m];
                const f32x4 g0 = acc[ai][0][m][0] * rs, g1 = acc[ai][0][m][1] * rs, u0 = acc[ai][1][m][0] * rs, u1 = acc[ai][1][m][1] * rs;
                u32x4 w; w.x = cvt_pk_bf16(silu_mul(g0[0], u0[0]), silu_mul(g0[1], u0[1])); w.y = cvt_pk_bf16(silu_mul(g0[2], u0[2]), silu_mul(g0[3], u0[3]));
                w.z = cvt_pk_bf16(silu_mul(g1[0], u1[0]), silu_mul(g1[1], u1[1])); w.w = cvt_pk_bf16(silu_mul(g1[2], u1[2]), silu_mul(g1[3], u1[3]));
                *(u32x4*)rowp = w; }
    }
};


__device__ __forceinline__ float gelu_t(float x) { const float y2 = 1.5957691216057308f * (x + 0.044715f * x * x * x); return x * __builtin_amdgcn_rcpf(1.0f + __builtin_amdgcn_exp2f(-1.4426950408889634f * y2)); }
__device__ __forceinline__ void st8(bf16_t* p, const float (&v)[8]) { u32x4 w; w.x = cvt_pk_bf16(v[0], v[1]); w.y = cvt_pk_bf16(v[2], v[3]); w.z = cvt_pk_bf16(v[4], v[5]); w.w = cvt_pk_bf16(v[6], v[7]); *(u32x4*)p = w; }
__device__ __forceinline__ int srow_g(int s, int g) { return g == 0 ? s : (g == 1 ? ((s & 3) * 1024 + (s >> 2)) : ((s & 15) * 256 + (s >> 4))); }
#define PG8_GETROW(x0, x1) do { const f32x4 a0 = acc[ai][0][m][0], a1 = acc[ai][0][m][1], b0 = acc[ai][1][m][0], b1 = acc[ai][1][m][1]; \
    x0[0] = a0[0]; x0[1] = a0[1]; x0[2] = a0[2]; x0[3] = a0[3]; x0[4] = a1[0]; x0[5] = a1[1]; x0[6] = a1[2]; x0[7] = a1[3]; \
    x1[0] = b0[0]; x1[1] = b0[1]; x1[2] = b0[2]; x1[3] = b0[3]; x1[4] = b1[0]; x1[5] = b1[1]; x1[6] = b1[2]; x1[7] = b1[3]; } while (0)
__device__ __forceinline__ void head_norm_rope(float (&x0)[8], float (&x1)[8], const PG8_LAS float* gp, f32x4 c0, f32x4 c1, f32x4 s0, f32x4 s1, float scale) {
    const f32x4 ga = *(const PG8_LAS f32x4*)gp, gb = *(const PG8_LAS f32x4*)(gp + 4), gc = *(const PG8_LAS f32x4*)(gp + 32), gd = *(const PG8_LAS f32x4*)(gp + 36);
    float ss = 0.f;
#pragma unroll
    for (int i = 0; i < 8; ++i) ss += x0[i] * x0[i] + x1[i] * x1[i];
    ss += xswz<16>(ss); ss = xsum32(ss);
    const float rstd = scale / sqrtf(ss * (1.0f / 64.0f) + 1e-6f);
#pragma unroll
    for (int i = 0; i < 8; ++i) { const float a = x0[i] * rstd * (i < 4 ? ga[i & 3] : gb[i & 3]), b = x1[i] * rstd * (i < 4 ? gc[i & 3] : gd[i & 3]); const float c = i < 4 ? c0[i & 3] : c1[i & 3], sv = i < 4 ? s0[i & 3] : s1[i & 3];
        x0[i] = a * c - b * sv; x1[i] = b * c + a * sv; }
}
struct EpiHeadsEven {
    static constexpr bool PERM = false; static constexpr bool NEEDS_RS = true;
    bf16_t* UV; bf16_t* Qs; const float* vgain; const float* qgain; const float* kgain; const float* cs; const float* sn; const float* ssp; const PG8_LAS float* gtab;
    __device__ __forceinline__ void operator()(const f32x4 (&acc)[2][2][4][2], const Unit& u, int wr, int wc, int fr, int fq, const PG8_LAS float* rs) const {
        const int pn = u.pn, row0 = u.pm * BM + wr * 64 + fr;
        const int kind = pn == 0 ? 0 : (pn == 1 ? 1 : (pn < 8 ? 2 : 3));
        const bool isq = pn < 5; const int h = (pn < 5 ? pn - 2 : (pn < 8 ? pn - 5 : pn - 8)) * 4 + wc, grp = h >> 2;
        const PG8_LAS float* gp = gtab + (kind == 1 ? wc * 64 : (isq ? 256 : 320)) + 8 * fq;
        bf16_t* hb = Qs + (kind == 3 ? (size_t)24 * 1024 * 1024 : (isq ? (size_t)0 : (size_t)12 * 1024 * 1024));
        float rs8[8];
#pragma unroll
        for (int k = 0; k < 8; ++k) rs8[k] = rs[(k >> 2) * HALF + wr * 64 + (k & 3) * 16 + fr];
#pragma unroll
        for (int am = 0; am < 4; ++am) { const int ai = am >> 1;
            f32x4 rc[4][4];
            if (kind == 2) {
#pragma unroll
                for (int m = 2 * (am & 1); m < 2 * (am & 1) + 2; ++m) { const int sp = (row0 + ai * HALF + m * 16) & 4095; const float* cp = cs + sp * 32 + 8 * fq; const float* sq_ = sn + sp * 32 + 8 * fq;
                    rc[m][0] = *(const f32x4*)cp; rc[m][1] = *(const f32x4*)(cp + 4); rc[m][2] = *(const f32x4*)sq_; rc[m][3] = *(const f32x4*)(sq_ + 4); } }
#pragma unroll
            for (int m = 2 * (am & 1); m < 2 * (am & 1) + 2; ++m) {
                const int row = row0 + ai * HALF + m * 16, b = row >> 12, s = row & 4095;
                float x0[8], x1[8]; PG8_GETROW(x0, x1);
                { const float rs = rs8[ai * 4 + m];
#pragma unroll
                  for (int i = 0; i < 8; ++i) { x0[i] *= rs; x1[i] *= rs; } }
                if (kind <= 1) {
#pragma unroll
                    for (int i = 0; i < 8; ++i) { x0[i] = gelu_t(x0[i]); x1[i] = gelu_t(x1[i]); }
                    if (kind == 1) { float ss = 0.f;
#pragma unroll
                        for (int i = 0; i < 8; ++i) ss += x0[i] * x0[i] + x1[i] * x1[i];
                        ss += xswz<16>(ss); ss = xsum32(ss);
                        const float rstd = 1.0f / sqrtf(ss * (1.0f / 64.0f) + 1e-6f);
                        { const f32x4 ga = *(const PG8_LAS f32x4*)gp, gb = *(const PG8_LAS f32x4*)(gp + 4), gc = *(const PG8_LAS f32x4*)(gp + 32), gd = *(const PG8_LAS f32x4*)(gp + 36);
#pragma unroll
                        for (int i = 0; i < 8; ++i) { x0[i] *= rstd * (i < 4 ? ga[i & 3] : gb[i & 3]); x1[i] *= rstd * (i < 4 ? gc[i & 3] : gd[i & 3]); } } }
                    bf16_t* d = UV + (size_t)row * 512 + pn * 256 + wc * 64 + 8 * fq; st8(d, x0); st8(d + 32, x1);
                } else {
                    if (kind == 2) head_norm_rope(x0, x1, gp, rc[m][0], rc[m][1], rc[m][2], rc[m][3], isq ? 0.18033688011112042f : 1.0f);
                    bf16_t* d = hb + ((size_t)(b * 12 + h) * 4096 + srow_g(s, grp)) * 64 + 8 * fq; st8(d, x0); st8(d + 32, x1);
                }
            } }
    }
};
struct EpiHeadsOdd {
    static constexpr bool PERM = false; static constexpr bool NEEDS_RS = true;
    bf16_t* Qm; bf16_t* CONV; float* kmsum; const float* qgain; const float* kgain; const float* cs; const float* sn; const float* ssp; const PG8_LAS float* gtab;
    __device__ __forceinline__ void operator()(const f32x4 (&acc)[2][2][4][2], const Unit& u, int wr, int wc, int fr, int fq, const PG8_LAS float* rs) const {
        const int pn = u.pn, row0 = u.pm * BM + wr * 64 + fr;
        const int kind = pn < 6 ? 2 : (pn < 9 ? 3 : 4);
        const bool isq = pn < 3; const int h = (pn % 3) * 4 + wc;
        const PG8_LAS float* gp = gtab + (isq ? 256 : 320) + 8 * fq;
        bf16_t* hb = Qm + (kind == 3 ? (size_t)24 * 1024 * 1024 : (isq ? (size_t)0 : (size_t)12 * 1024 * 1024));
        float rs8[8];
#pragma unroll
        for (int k = 0; k < 8; ++k) rs8[k] = rs[(k >> 2) * HALF + wr * 64 + (k & 3) * 16 + fr];
        float cs0[8], cs1[8];
#pragma unroll
        for (int i = 0; i < 8; ++i) { cs0[i] = 0.f; cs1[i] = 0.f; }
#pragma unroll
        for (int am = 0; am < 4; ++am) { const int ai = am >> 1;
            f32x4 rc[4][4];
            if (kind == 2) {
#pragma unroll
                for (int m = 2 * (am & 1); m < 2 * (am & 1) + 2; ++m) { const int sp = (row0 + ai * HALF + m * 16) & 4095; const float* cp = cs + sp * 32 + 8 * fq; const float* sq_ = sn + sp * 32 + 8 * fq;
                    rc[m][0] = *(const f32x4*)cp; rc[m][1] = *(const f32x4*)(cp + 4); rc[m][2] = *(const f32x4*)sq_; rc[m][3] = *(const f32x4*)(sq_ + 4); } }
#pragma unroll
            for (int m = 2 * (am & 1); m < 2 * (am & 1) + 2; ++m) {
                const int row = row0 + ai * HALF + m * 16, b = row >> 12, s = row & 4095;
                float x0[8], x1[8]; PG8_GETROW(x0, x1);
                { const float rs = rs8[ai * 4 + m];
#pragma unroll
                  for (int i = 0; i < 8; ++i) { x0[i] *= rs; x1[i] *= rs; } }
                if (kind == 4) { bf16_t* d = CONV + (size_t)row * 768 + (pn - 9) * 256 + wc * 64 + 8 * fq; st8(d, x0); st8(d + 32, x1); }
                else {
                    if (kind == 2) { head_norm_rope(x0, x1, gp, rc[m][0], rc[m][1], rc[m][2], rc[m][3], isq ? 0.18033688011112042f : 1.0f);
                        if (!isq) {
#pragma unroll
                            for (int i = 0; i < 8; ++i) { cs0[i] += x0[i]; cs1[i] += x1[i]; } } }
                    bf16_t* d = hb + ((size_t)(b * 12 + h) * 4096 + s) * 64 + 8 * fq; st8(d, x0); st8(d + 32, x1);
                }
            } }
        if (kind == 2 && !isq) {
#pragma unroll
            for (int i = 0; i < 8; ++i) {
                { cs0[i] += xswz<1>(cs0[i]); cs1[i] += xswz<1>(cs1[i]); cs0[i] += xswz<2>(cs0[i]); cs1[i] += xswz<2>(cs1[i]); cs0[i] += xswz<4>(cs0[i]); cs1[i] += xswz<4>(cs1[i]); cs0[i] += xswz<8>(cs0[i]); cs1[i] += xswz<8>(cs1[i]); } }
            if (fr == 0) { const int b = (u.pm * BM) >> 12, blk = u.pm & 15; float* kp = kmsum + ((size_t)(b * 12 + h) * 16 + blk) * 64 + 8 * fq;
#pragma unroll
                for (int i = 0; i < 8; ++i) { atomicAdd(kp + i, cs0[i]); atomicAdd(kp + 32 + i, cs1[i]); } }
        }
    }
};

__device__ __forceinline__ const char* uptr(const char* p) { const unsigned long long b_ = (unsigned long long)p; return (const char*)(((unsigned long long)(unsigned)__builtin_amdgcn_readfirstlane((int)(unsigned)(b_ >> 32)) << 32) | (unsigned)__builtin_amdgcn_readfirstlane((int)(unsigned)b_)); }
__device__ __forceinline__ void glds16s(const void* sbase, unsigned voff, unsigned lds_dst) { unsigned keep;
    asm volatile("s_mov_b32 %0, m0\n\ts_mov_b32 m0, %3\n\ts_nop 0\n\tglobal_load_lds_dwordx4 %1, %2\n\ts_mov_b32 m0, %0" : "=&s"(keep) : "v"(voff), "s"(sbase), "s"(lds_dst) : "memory"); }
typedef int i32x4 __attribute__((ext_vector_type(4)));
typedef int i32x8 __attribute__((ext_vector_type(8)));
__device__ __forceinline__ unsigned pk4_e4m3(float a, float b, float c, float d) {
    a = __builtin_amdgcn_fmed3f(a, -448.f, 448.f); b = __builtin_amdgcn_fmed3f(b, -448.f, 448.f); c = __builtin_amdgcn_fmed3f(c, -448.f, 448.f); d = __builtin_amdgcn_fmed3f(d, -448.f, 448.f);
    int w = __builtin_amdgcn_cvt_pk_fp8_f32(a, b, 0, false); w = __builtin_amdgcn_cvt_pk_fp8_f32(c, d, w, true); return (unsigned)w; }
struct EpiSwiGLU8 {
    static constexpr bool PERM = false; static constexpr bool NEEDS_RS = false;
    unsigned char* O; int ldc; float sc, so;
    __device__ __forceinline__ void operator()(const f32x4 (&acc)[2][2][4][2], const Unit& u, int wr, int wc, int fr, int fq) const {
        const int row0 = u.pm * BM + wr * 64 + fr, col0 = u.pn * HALF + wc * 32 + 8 * fq;
#pragma unroll
        for (int ai = 0; ai < 2; ++ai)
#pragma unroll
            for (int m = 0; m < 4; ++m) { unsigned char* rowp = O + (size_t)(row0 + ai * HALF + m * 16) * ldc + col0;
                const f32x4 g0 = acc[ai][0][m][0] * sc, g1 = acc[ai][0][m][1] * sc, u0 = acc[ai][1][m][0] * (sc * so), u1 = acc[ai][1][m][1] * (sc * so);
                typedef unsigned u32x2 __attribute__((ext_vector_type(2)));
                u32x2 w; w.x = pk4_e4m3(silu_mul(g0[0], u0[0]), silu_mul(g0[1], u0[1]), silu_mul(g0[2], u0[2]), silu_mul(g0[3], u0[3]));
                w.y = pk4_e4m3(silu_mul(g1[0], u1[0]), silu_mul(g1[1], u1[1]), silu_mul(g1[2], u1[2]), silu_mul(g1[3], u1[3]));
                *(u32x2*)rowp = w; }
    }
};
template <class Epi, class Sched, bool ALIGN_EPI = true, bool SP2 = true, bool FP8 = false>
__device__ __forceinline__ void gemm_phase(PG8_LAS unsigned char* lds, const Gemm g, const Sched& S, const Epi& E, int tid_in) {
    int tid_ = tid_in; asm volatile("" : "+v"(tid_));
    const int tid = tid_, wid = __builtin_amdgcn_readfirstlane(tid >> 6), lane = tid & 63, wr = wid >> 2, wc = wid & 3, fr = lane & 15, fq = lane >> 4;
    const int Kb = FP8 ? g.K : 2 * g.K, nt = Kb / 128;
    unsigned voffA[2], voffB[2];
#pragma unroll
    for (int i = 0; i < 2; ++i) { int R, C; stage_rc(tid * 16 + i * 8192, R, C); const int Rb = Epi::PERM ? ((R & ~31) + perm32(R & 31)) : R;
        voffA[i] = (unsigned)(R * Kb + 2 * C); voffB[i] = (unsigned)(Rb * Kb + 2 * C); }
    const size_t kstep = (size_t)128;
    const size_t hstep = (size_t)HALF * Kb;
    const size_t tstep = 2 * hstep;
    const unsigned ldsw = (unsigned)wid * 1024u;
    const unsigned lds0 = (unsigned)(uintptr_t)lds;
    const int fcol = FP8 ? (32 * (fq >> 1) + 16 * (fq & 1)) : fq * 8;
    const int aoff = lds_byte(wr * 64 + fr, fcol), boff = lds_byte(wc * 32 + fr, fcol);
#define PG8_SA(b, h) (((b) * 2 + (h)) * HTB)
#define PG8_SB(b, h) ((4 + (b) * 2 + (h)) * HTB)
#define PG8_STAGE(bufoff, gbase, voff) do { _Pragma("unroll") for (int _i = 0; _i < 2; ++_i) \
        glds16s((const void*)(gbase), (voff)[_i], (unsigned)__builtin_amdgcn_readfirstlane((int)(lds0 + (bufoff) + ldsw + _i * 8192))); } while (0)
#define PG8_RD16(p) (*(const PG8_LAS i32x4*)(p))
#define PG8_CAT8(lo, hi) __builtin_shufflevector((lo), (hi), 0, 1, 2, 3, 4, 5, 6, 7)
#define PG8_LDA(dst, b, h) do { if constexpr (FP8) { _Pragma("unroll") for (int m = 0; m < 4; ++m) dst##8[m] = PG8_CAT8(PG8_RD16(lds + PG8_SA(b, h) + aoff + m * 2048), PG8_RD16(lds + PG8_SA(b, h) + aoff + m * 2048 + 16)); } \
        else { _Pragma("unroll") for (int m = 0; m < 4; ++m) _Pragma("unroll") for (int k = 0; k < 2; ++k) dst[m][k] = *(const PG8_LAS bf16x8*)(lds + PG8_SA(b, h) + aoff + m * 2048 + k * 1024); } } while (0)
#define PG8_LDB(dst, b, h) do { if constexpr (FP8) { _Pragma("unroll") for (int n = 0; n < 2; ++n) dst##8[n] = PG8_CAT8(PG8_RD16(lds + PG8_SB(b, h) + boff + n * 2048), PG8_RD16(lds + PG8_SB(b, h) + boff + n * 2048 + 16)); } \
        else { _Pragma("unroll") for (int n = 0; n < 2; ++n) _Pragma("unroll") for (int k = 0; k < 2; ++k) dst[n][k] = *(const PG8_LAS bf16x8*)(lds + PG8_SB(b, h) + boff + n * 2048 + k * 1024); } } while (0)
#define PG8_MMA(ai, bj, At, Bt) do { __builtin_amdgcn_s_setprio(1); \
        if constexpr (FP8) { _Pragma("unroll") for (int m = 0; m < 4; ++m) _Pragma("unroll") for (int n = 0; n < 2; ++n) \
            acc[ai][bj][m][n] = __builtin_amdgcn_mfma_scale_f32_16x16x128_f8f6f4(Bt##8[n], At##8[m], acc[ai][bj][m][n], 0, 0, 0, 0, 0, 0); } \
        else { _Pragma("unroll") for (int m = 0; m < 4; ++m) _Pragma("unroll") for (int n = 0; n < 2; ++n) _Pragma("unroll") for (int k = 0; k < 2; ++k) \
            acc[ai][bj][m][n] = __builtin_amdgcn_mfma_f32_16x16x32_bf16(Bt[n][k], At[m][k], acc[ai][bj][m][n], 0, 0, 0); } \
        __builtin_amdgcn_s_setprio(0); } while (0)
#define PG8_WAIT_V(n) asm volatile("s_waitcnt vmcnt(" #n ")" ::: "memory")
#define PG8_WAIT_L(n) asm volatile("s_waitcnt lgkmcnt(" #n ")" ::: "memory")
#define PG8_BAR __builtin_amdgcn_s_barrier()
#define PG8_SCHED __builtin_amdgcn_sched_barrier(0)
    Unit cur, nxt; int ui = 0;
    if (!S.next(0, cur)) return;
    f32x4 acc[2][2][4][2];
#pragma unroll
    for (int a = 0; a < 2; ++a)
#pragma unroll
        for (int b = 0; b < 2; ++b)
#pragma unroll
            for (int m = 0; m < 4; ++m)
#pragma unroll
                for (int n = 0; n < 2; ++n) acc[a][b][m][n] = (f32x4){0.f, 0.f, 0.f, 0.f};
    bf16x8 At[4][2], B0[2][2], B1[2][2]; i32x8 At8[4], B08[2], B18[2];
    if constexpr (Epi::NEEDS_RS) { const float* pp = E.ssp + ((size_t)cur.pm * BM + (tid >> 1)) * 16 + 8 * (tid & 1); const f32x4 q0 = *(const f32x4*)pp, q1 = *(const f32x4*)(pp + 4);
        float sq = ((q0[0] + q0[1]) + (q0[2] + q0[3])) + ((q1[0] + q1[1]) + (q1[2] + q1[3])); sq += xswz<1>(sq);
        if (!(tid & 1)) ((PG8_LAS float*)(lds + RS_TAB_OFF))[tid >> 1] = 1.0f / sqrtf(sq * (1.0f / 1024.0f) + 1e-6f); }
    const char* cA = uptr((const char*)g.A + (size_t)cur.pm * tstep); const char* cB = uptr(S.bbase(cur, g.Bt) + (size_t)cur.pn * tstep);
    if constexpr (SP2) {
        PG8_STAGE(PG8_SB(0, 0), cB, voffB); PG8_STAGE(PG8_SB(0, 1), cB + hstep, voffB); PG8_STAGE(PG8_SA(0, 0), cA, voffA); PG8_STAGE(PG8_SA(0, 1), cA + hstep, voffA);
        if (wr == 1) PG8_BAR;
        PG8_WAIT_V(2); PG8_BAR;
        PG8_STAGE(PG8_SB(1, 0), cB + kstep, voffB); PG8_STAGE(PG8_SA(1, 0), cA + kstep, voffA); PG8_STAGE(PG8_SB(1, 1), cB + hstep + kstep, voffB);
        PG8_WAIT_V(6); PG8_BAR;
    } else {
        PG8_STAGE(PG8_SB(0, 0), cB, voffB); PG8_STAGE(PG8_SA(0, 0), cA, voffA); PG8_STAGE(PG8_SB(0, 1), cB + hstep, voffB); PG8_STAGE(PG8_SA(0, 1), cA + hstep, voffA);
        if (wr == 1) PG8_BAR;
        PG8_WAIT_V(4); PG8_BAR;
        PG8_STAGE(PG8_SB(1, 0), cB + kstep, voffB); PG8_STAGE(PG8_SA(1, 0), cA + kstep, voffA); PG8_STAGE(PG8_SB(1, 1), cB + hstep + kstep, voffB);
        PG8_WAIT_V(6); PG8_BAR;
    }
    for (;;) {
        const bool has_next = S.next(ui + 1, nxt);
        const char* nA = uptr(has_next ? (const char*)g.A + (size_t)nxt.pm * tstep : cA); const char* nB = uptr(has_next ? S.bbase(nxt, g.Bt) + (size_t)nxt.pn * tstep : cB);
        for (int t = 0; t < nt; t += 2) {
            const bool last = (t == nt - 2);
            const char* a1 = cA + (size_t)(t + 1) * kstep;
            const char* a2 = last ? nA : cA + (size_t)(t + 2) * kstep; const char* b2 = last ? nB : cB + (size_t)(t + 2) * kstep;
            const char* a3 = a2 + kstep; const char* b3 = b2 + kstep;
            if constexpr (SP2) {
            PG8_LDB(B0, 0, 0); PG8_LDB(B1, 0, 1); PG8_SCHED; PG8_LDA(At, 0, 0); PG8_STAGE(PG8_SA(1, 1), a1 + hstep, voffA);
            PG8_WAIT_V(8); PG8_WAIT_L(0); PG8_BAR; PG8_MMA(0, 0, At, B0); PG8_MMA(0, 1, At, B1); PG8_BAR; PG8_SCHED;
            PG8_LDA(At, 0, 1); PG8_STAGE(PG8_SB(0, 0), b2, voffB); PG8_STAGE(PG8_SB(0, 1), b2 + hstep, voffB); PG8_STAGE(PG8_SA(0, 0), a2, voffA);
            PG8_WAIT_V(8); PG8_WAIT_L(0); PG8_BAR; PG8_MMA(1, 0, At, B0); PG8_MMA(1, 1, At, B1); PG8_BAR; PG8_SCHED;
            PG8_LDB(B0, 1, 0); PG8_LDB(B1, 1, 1); PG8_SCHED; PG8_LDA(At, 1, 0); PG8_STAGE(PG8_SA(0, 1), a2 + hstep, voffA);
            PG8_WAIT_V(8); PG8_WAIT_L(0); PG8_BAR; PG8_MMA(0, 0, At, B0); PG8_MMA(0, 1, At, B1); PG8_BAR; PG8_SCHED;
            PG8_LDA(At, 1, 1); PG8_STAGE(PG8_SB(1, 0), b3, voffB); PG8_STAGE(PG8_SB(1, 1), b3 + hstep, voffB); PG8_STAGE(PG8_SA(1, 0), a3, voffA);
            PG8_WAIT_V(8); PG8_WAIT_L(0); PG8_BAR; PG8_MMA(1, 0, At, B0); PG8_MMA(1, 1, At, B1); PG8_BAR; PG8_SCHED;
            } else {
            PG8_LDB(B0, 0, 0); PG8_SCHED; PG8_LDA(At, 0, 0); PG8_STAGE(PG8_SA(1, 1), a1 + hstep, voffA);
            PG8_WAIT_L(8); PG8_BAR; PG8_WAIT_L(0); PG8_MMA(0, 0, At, B0); PG8_BAR; PG8_SCHED;
            PG8_LDB(B1, 0, 1); PG8_STAGE(PG8_SB(0, 0), b2, voffB);
            PG8_BAR; PG8_WAIT_L(0); PG8_MMA(0, 1, At, B1); PG8_BAR;
            PG8_LDA(At, 0, 1); PG8_STAGE(PG8_SA(0, 0), a2, voffA);
            PG8_BAR; PG8_WAIT_L(0); PG8_MMA(1, 0, At, B0); PG8_BAR; PG8_SCHED;
            PG8_STAGE(PG8_SB(0, 1), b2 + hstep, voffB);
            PG8_WAIT_V(6); PG8_BAR; PG8_MMA(1, 1, At, B1); PG8_BAR;
            PG8_LDB(B0, 1, 0); PG8_SCHED; PG8_LDA(At, 1, 0); PG8_STAGE(PG8_SA(0, 1), a2 + hstep, voffA);
            PG8_WAIT_L(8); PG8_BAR; PG8_WAIT_L(0); PG8_MMA(0, 0, At, B0); PG8_BAR; PG8_SCHED;
            PG8_LDB(B1, 1, 1); PG8_STAGE(PG8_SB(1, 0), b3, voffB);
            PG8_BAR; PG8_WAIT_L(0); PG8_MMA(0, 1, At, B1); PG8_BAR;
            PG8_LDA(At, 1, 1); PG8_STAGE(PG8_SA(1, 0), a3, voffA);
            PG8_BAR; PG8_WAIT_L(0); PG8_MMA(1, 0, At, B0); PG8_BAR; PG8_SCHED;
            PG8_STAGE(PG8_SB(1, 1), b3 + hstep, voffB);
            PG8_WAIT_V(6); PG8_BAR; PG8_MMA(1, 1, At, B1); PG8_BAR;
            }
        }
        if constexpr (ALIGN_EPI) { if (wr == 0) PG8_BAR; }
        { int l_; asm volatile("v_mbcnt_lo_u32_b32 %0, -1, 0\n\tv_mbcnt_hi_u32_b32 %0, -1, %0" : "=v"(l_));
          if constexpr (Epi::NEEDS_RS) {
              const int t_ = wid * 64 + l_; f32x4 q0, q1; q0 = (f32x4){0.f, 0.f, 0.f, 0.f}; q1 = q0;
              if (has_next) { const float* pp = E.ssp + ((size_t)nxt.pm * BM + (t_ >> 1)) * 16 + 8 * (t_ & 1); q0 = *(const f32x4*)pp; q1 = *(const f32x4*)(pp + 4); }
              E(acc, cur, wr, wc, l_ & 15, l_ >> 4, (const PG8_LAS float*)(lds + RS_TAB_OFF) + (ui & 1) * 256);
              if (has_next) { float sq = ((q0[0] + q0[1]) + (q0[2] + q0[3])) + ((q1[0] + q1[1]) + (q1[2] + q1[3])); sq += xswz<1>(sq);
                  if (!(t_ & 1)) ((PG8_LAS float*)(lds + RS_TAB_OFF))[((ui + 1) & 1) * 256 + (t_ >> 1)] = 1.0f / sqrtf(sq * (1.0f / 1024.0f) + 1e-6f); }
          } else E(acc, cur, wr, wc, l_ & 15, l_ >> 4); }
        if (!has_next) break;
#pragma unroll
        for (int a = 0; a < 2; ++a)
#pragma unroll
            for (int b = 0; b < 2; ++b)
#pragma unroll
                for (int m = 0; m < 4; ++m)
#pragma unroll
                    for (int n = 0; n < 2; ++n) acc[a][b][m][n] = (f32x4){0.f, 0.f, 0.f, 0.f};
        cur = nxt; cA = nA; cB = nB; ++ui;
        if constexpr (ALIGN_EPI) { if (wr == 1) PG8_BAR; }
    }
    PG8_WAIT_V(0);
    if constexpr (!ALIGN_EPI) { if (wr == 0) PG8_BAR; }
    PG8_BAR;
#undef PG8_SA
#undef PG8_SB
#undef PG8_STAGE
#undef PG8_LDA
#undef PG8_RD16
#undef PG8_CAT8
#undef PG8_LDB
#undef PG8_MMA
#undef PG8_WAIT_V
#undef PG8_WAIT_L
#undef PG8_BAR
#undef PG8_SCHED
}
}


namespace att {
using bf16x8=__attribute__((ext_vector_type(8)))short;
using s16x4=__attribute__((ext_vector_type(4)))short;
using f32x16=__attribute__((ext_vector_type(16)))float;
using u32x4=__attribute__((ext_vector_type(4)))unsigned;
typedef unsigned short bf16;
constexpr int D=64,DM=64;
constexpr int NW=8,QBLK=32,QB=QBLK*NW,KVBLK=64;
__device__ __forceinline__ int crow(int r,int hi){return (r&3)+8*(r>>2)+4*hi;}
#define SBAR() __builtin_amdgcn_sched_barrier(0)
constexpr int NSLOT=3, SLOTB=8192;
constexpr int LDS_K=0, LDS_V=NSLOT*SLOTB, LDS_WS=2*NSLOT*SLOTB, LDS_OST=LDS_WS+NW*64*4, LDS_KM=LDS_OST+NW*4096, LDS_TK=LDS_KM+4096, LDS_BYTES=LDS_TK+64;
constexpr float C2=0.125f*1.4426950408889634f;
__device__ __forceinline__ void glds16(const void*gsrc,unsigned lds_dst){unsigned keep;
  asm volatile("s_mov_b32 %0, m0\n\ts_mov_b32 m0, %2\n\ts_nop 0\n\tglobal_load_lds_dwordx4 %1, off\n\ts_mov_b32 m0, %0":"=&s"(keep):"v"(gsrc),"s"(lds_dst):"memory");}
__device__ __forceinline__ float max3f(float a,float b,float c){float r;asm("v_max3_f32 %0, %1, %2, %3":"=v"(r):"v"(a),"v"(b),"v"(c));return r;}
__device__ __forceinline__ float max2f(float a,float b){float r;asm("v_max_f32_e32 %0, %1, %2":"=v"(r):"v"(a),"v"(b));return r;}
__device__ __forceinline__ float fadd_s(float a,float b){float r;asm("v_add_f32_e32 %0, %1, %2":"=v"(r):"v"(a),"v"(b));return r;}
__device__ __forceinline__ float fsub_s(float a,float b){float r;asm("v_sub_f32_e32 %0, %1, %2":"=v"(r):"v"(a),"v"(b));return r;}
typedef float f32x2_t __attribute__((ext_vector_type(2))); typedef __bf16 bf16x2_t __attribute__((ext_vector_type(2)));
__device__ __forceinline__ unsigned cvtpk_s(float lo,float hi){f32x2_t v={lo,hi};bf16x2_t b=__builtin_convertvector(v,bf16x2_t);return __builtin_bit_cast(unsigned,b);}
#define WAIT_BAR(N) asm volatile("s_waitcnt vmcnt(" #N ") lgkmcnt(0)\n\ts_barrier":::"memory")
__device__ __forceinline__ void qkt(f32x16&p0,f32x16&p1,const char*Kslot,const bf16x8*qr,int r32,int hi){ const f32x16 zero16=f32x16{};
  const char*kb=Kslot+hi*1024+r32*16;
  #pragma unroll
  for(int d0=0;d0<4;++d0){
    const bf16x8 b0=*reinterpret_cast<const bf16x8*>(kb+d0*2048);
    const bf16x8 b1=*reinterpret_cast<const bf16x8*>(kb+d0*2048+512);
    if(d0==0){p0=__builtin_amdgcn_mfma_f32_32x32x16_bf16(b0,qr[0],zero16,0,0,0);p1=__builtin_amdgcn_mfma_f32_32x32x16_bf16(b1,qr[0],zero16,0,0,0);}
    else{p0=__builtin_amdgcn_mfma_f32_32x32x16_bf16(b0,qr[d0],p0,0,0,0);p1=__builtin_amdgcn_mfma_f32_32x32x16_bf16(b1,qr[d0],p1,0,0,0);}}
}
typedef __attribute__((address_space(3))) const char* lds_cptr;
typedef short v4i16_t __attribute__((ext_vector_type(4)));
__device__ __forceinline__ void kload8(bf16x8*kf,lds_cptr kp){
  kf[0]=*(const __attribute__((address_space(3))) bf16x8*)(kp);      kf[1]=*(const __attribute__((address_space(3))) bf16x8*)(kp+512);
  kf[2]=*(const __attribute__((address_space(3))) bf16x8*)(kp+2048); kf[3]=*(const __attribute__((address_space(3))) bf16x8*)(kp+2560);
  kf[4]=*(const __attribute__((address_space(3))) bf16x8*)(kp+4096); kf[5]=*(const __attribute__((address_space(3))) bf16x8*)(kp+4608);
  kf[6]=*(const __attribute__((address_space(3))) bf16x8*)(kp+6144); kf[7]=*(const __attribute__((address_space(3))) bf16x8*)(kp+6656);
}
__device__ __forceinline__ void kload2(bf16x8*kf,lds_cptr kp,int j){ kf[2*j]=*(const __attribute__((address_space(3))) bf16x8*)(kp+j*2048); kf[2*j+1]=*(const __attribute__((address_space(3))) bf16x8*)(kp+j*2048+512); }
__device__ __forceinline__ s16x4 vtr(lds_cptr p){ return __builtin_bit_cast(s16x4,__builtin_amdgcn_ds_read_tr16_b64_v4i16((__attribute__((address_space(3))) v4i16_t*)p)); }
__device__ __forceinline__ float rowmax(const f32x16&p0,const f32x16&p1){
  float a=max3f(p0[0],p0[1],p1[0]),b=max3f(p0[2],p0[3],p1[1]);a=max3f(a,p1[2],p1[3]);
  #pragma unroll
  for(int r=4;r<16;r+=4){a=max3f(a,p0[r],p0[r+1]);b=max3f(b,p0[r+2],p0[r+3]);a=max3f(a,p1[r],p1[r+1]);b=max3f(b,p1[r+2],p1[r+3]);}
  const float m=max2f(a,b);
  auto rr=__builtin_amdgcn_permlane32_swap(__float_as_uint(m),__float_as_uint(m),false,false);
  return max2f(__uint_as_float(rr[0]),__uint_as_float(rr[1]));
}
__device__ __forceinline__ void pv(f32x16*o,int vb,bf16x8 pa0,bf16x8 pa1,bf16x8 pa2,bf16x8 pa3){
  #pragma unroll
  for(int d0=0;d0<2;++d0){s16x4 lo[4],hi[4];
    #pragma unroll
    for(int ks=0;ks<4;++ks){
      asm volatile("ds_read_b64_tr_b16 %0,%1 offset:%c2":"=&v"(lo[ks]):"v"(vb),"i"(d0*4096+ks*1024):"memory");
      asm volatile("ds_read_b64_tr_b16 %0,%1 offset:%c2":"=&v"(hi[ks]):"v"(vb),"i"(d0*4096+ks*1024+512):"memory");}
    asm volatile("s_waitcnt lgkmcnt(0)":::"memory");SBAR();
    #define PK(k) (bf16x8){lo[k][0],lo[k][1],lo[k][2],lo[k][3],hi[k][0],hi[k][1],hi[k][2],hi[k][3]}
    o[d0]=__builtin_amdgcn_mfma_f32_32x32x16_bf16(pa0,PK(0),o[d0],0,0,0);
    o[d0]=__builtin_amdgcn_mfma_f32_32x32x16_bf16(pa1,PK(1),o[d0],0,0,0);
    o[d0]=__builtin_amdgcn_mfma_f32_32x32x16_bf16(pa2,PK(2),o[d0],0,0,0);
    o[d0]=__builtin_amdgcn_mfma_f32_32x32x16_bf16(pa3,PK(3),o[d0],0,0,0);
    #undef PK
  }
}
template<int MODE> __device__ __forceinline__ void amask(f32x16&p0,f32x16&p1,int a,int nb,unsigned sel,int qabs,int qrel,int hi,float mhat){
  const float NEG=-INFINITY;
  if(MODE==0){
    if(a>=nb){ const int kb=64*(a-nb)+4*hi;
      #pragma unroll
      for(int r=0;r<16;++r){const int kv=kb+(r&3)+8*(r>>2); p0[r]=(kv>qrel)?NEG:p0[r]-mhat; p1[r]=(kv+32>qrel)?NEG:p1[r]-mhat;} }
    else { const float bias=((sel>>(a>>2))&1u)?-mhat:NEG;
      #pragma unroll
      for(int r=0;r<16;++r){ p0[r]+=bias; p1[r]+=bias; } }
  } else {
    const int base=qabs-64*a-4*hi;
    #pragma unroll
    for(int r=0;r<16;++r){const int c=(r&3)+8*(r>>2); p0[r]=((unsigned)(base-c)>128u)?NEG:p0[r]-mhat; p1[r]=((unsigned)(base-c-32)>128u)?NEG:p1[r]-mhat;}
  }
}
#ifndef ATTN_STORE16
#define ATTN_STORE16(p,v) (*(u32x4*)(p)=(v))
#endif
template<int MODE,int THRL,int opitch> __device__ __forceinline__ void attn_unit(const bf16*Qs,int q0,int tile0,int NT,unsigned sel,bf16*O,float*LSE,char*shm,int tid_in){
  const bf16*Ks=Qs+12*1024*1024,*Vs=Qs+24*1024*1024;
  int tid_=tid_in; asm volatile("":"+v"(tid_));
  const int tid=tid_,lane=tid&63,r32=lane&31,hi=lane>>5; const int wid=__builtin_amdgcn_readfirstlane(tid>>6);
  const int nb=NT-4;
  const bf16*Qw=Qs+(long)(q0+wid*QBLK)*DM;
  const lds_cptr shm3=(lds_cptr)shm;
  const unsigned lds0=(unsigned)(uintptr_t)shm3;
  float*wsf=(float*)(shm+LDS_WS)+wid*64;
  const bf16*ksrc=Ks+(long)lane*DM+wid*8;
  const bf16*vsrc=Vs+(long)(16*(wid&3)+(lane>>2))*DM+(wid>>2)*32+(lane&3)*8;
  const unsigned kdst=lds0+LDS_K+wid*1024, vdst=lds0+LDS_V+wid*1024;
  #define TM(t) (MODE==0 ? ((t)==0 ? nb : ((t)<=nb ? (t)-1 : (t))) : tile0+(t))
  #define DMA_K(t,slot) glds16(ksrc+(long)TM(t)*KVBLK*DM,(unsigned)__builtin_amdgcn_readfirstlane(kdst+(slot)))
  #define DMA_V(t,slot) glds16(vsrc+(long)TM(t)*KVBLK*DM,(unsigned)__builtin_amdgcn_readfirstlane(vdst+(slot)))
  const char*Kbase=shm+LDS_K; bf16x8 kf[8];
  const lds_cptr kp0=shm3+LDS_K+hi*1024+r32*16; const lds_cptr vp0=shm3+LDS_V+((lane>>4)&1)*32+(lane&3)*8+(4*hi+((lane&15)>>2))*64;
  DMA_K(0,0);DMA_V(0,0);DMA_K(1,SLOTB);
  bf16x8 qr[4];
  #pragma unroll
  for(int d0=0;d0<4;++d0)qr[d0]=*reinterpret_cast<const bf16x8*>(&Qw[(long)r32*DM+d0*16+hi*8]);
  float mhat=0.f,l_reg=0.f;f32x16 o[2];o[0]=f32x16{};o[1]=f32x16{};const f32x16 zero16=f32x16{};
  const int qrel=wid*QBLK+r32, qabs=q0+qrel;
  #define CMASK(P0,P1,t) amask<MODE>(P0,P1,TM(t),nb,sel,qabs,qrel,hi,mhat)
  bool resc=false;
  #define START(P0,P1) do{ const float rm=rowmax(P0,P1); resc=false; \
    { const float dl=__builtin_fmaxf(rm,0.f); mhat=fadd_s(mhat,dl); \
      _Pragma("unroll") for(int r=0;r<16;++r){P0[r]=fsub_s(P0[r],dl);P1[r]=fsub_s(P1[r],dl);} } \
    _Pragma("unroll") for(int r=0;r<16;++r)P0[r]=__builtin_amdgcn_exp2f(P0[r]); }while(0)
  #define RESC() do{ if(resc){ asm volatile("s_waitcnt lgkmcnt(0)":::"memory"); \
      _Pragma("unroll") for(int d_=0;d_<2;++d_) _Pragma("unroll") for(int r=0;r<16;++r)o[d_][r]*=wsf[crow(r,hi)]; } }while(0)
  f32x16 pA0,pA1,pB0,pB1;
  int sl_prev=0,sl_cur=0,sl_next=SLOTB;
  #define ROT() do{sl_prev=sl_cur;sl_cur=sl_next;sl_next=(sl_next==(NSLOT-1)*SLOTB)?0:sl_next+SLOTB;}while(0)
  DMA_K(2,2*SLOTB);
  WAIT_BAR(3);
  qkt(pA0,pA1,Kbase,qr,r32,hi);asm volatile("s_nop 15\n\ts_nop 7":"+v"(pA0),"+v"(pA1));CMASK(pA0,pA1,0);
  START(pA0,pA1);
  _Pragma("unroll") for(int r=0;r<16;++r)pA1[r]=__builtin_amdgcn_exp2f(pA1[r]);
  WAIT_BAR(0);
  DMA_K(3,0);DMA_V(1,SLOTB);
  ROT();
  kload8(kf,kp0+sl_cur);
  WAIT_BAR(2);
  s16x4 vlo[8],vhi[8]; u32x4 pw0,pw1,pw2,pw3;
  #define PKW(P,B) cvtpk_s(P[B],P[B+1])
  #define PAF(k) __builtin_bit_cast(bf16x8,pw##k)
  #define VFR(i) (bf16x8){vlo[i][0],vlo[i][1],vlo[i][2],vlo[i][3],vhi[i][0],vhi[i][1],vhi[i][2],vhi[i][3]}
  #define PIN(x) asm volatile("":"+v"(x))
  #define MX3(a,b,c) __builtin_fmaxf(__builtin_fmaxf((a),(b)),(c))
  #define GAPA(MF,A0,A1,A2,A3,W0,W1,PW) do{ MF; sacc+=A0; sacc+=A1; sacc+=A2; sacc+=A3; PIN(sacc); W0; W1; PIN(PW); SBAR(); }while(0)
  #define EX(v) __builtin_amdgcn_exp2f(v)
  #define GAPB(MF,X,B) do{ MF; X[B]=EX(X[B]); X[B+1]=EX(X[B+1]); X[B+2]=EX(X[B+2]); X[B+3]=EX(X[B+3]); PIN(X); SBAR(); }while(0)
  #define VRD(i) do{ vlo[i]=vtr(vp_+(((i)>>2)*4096+((i)&3)*1024)); vhi[i]=vtr(vp_+(((i)>>2)*4096+((i)&3)*1024+512)); }while(0)
  #define KRD(G,j) do{ if(G){ kload2(kf,kp0+sl_next,j); SBAR(); } }while(0)
  #define STEP(C0,C1,P0,P1,t,GK,GV,GL) do{ SBAR(); \
    const lds_cptr vp_=vp0+sl_prev; \
    VRD(0); SBAR(); float sacc=(P0[0]+P0[1]); \
    GAPA(C0=__builtin_amdgcn_mfma_f32_32x32x16_bf16(kf[0],qr[0],zero16,0,0,0), P0[2],P0[3],P0[4],P0[5],     pw0[0]=PKW(P0,0), pw0[1]=PKW(P0,2), pw0); \
    VRD(4); SBAR(); GAPA(C1=__builtin_amdgcn_mfma_f32_32x32x16_bf16(kf[1],qr[0],zero16,0,0,0), P0[6],P0[7],P0[8],P0[9],     pw0[2]=PKW(P0,4), pw0[3]=PKW(P0,6), pw0); \
    VRD(1); SBAR(); GAPA(C0=__builtin_amdgcn_mfma_f32_32x32x16_bf16(kf[2],qr[1],C0,0,0,0),   P0[10],P0[11],P0[12],P0[13], pw1[0]=PKW(P0,8), pw1[1]=PKW(P0,10), pw1); \
    VRD(5); SBAR(); GAPA(C1=__builtin_amdgcn_mfma_f32_32x32x16_bf16(kf[3],qr[1],C1,0,0,0),   P0[14],P0[15],P1[0],P1[1],   pw1[2]=PKW(P0,12),pw1[3]=PKW(P0,14), pw1); \
    VRD(2); SBAR(); GAPA(C0=__builtin_amdgcn_mfma_f32_32x32x16_bf16(kf[4],qr[2],C0,0,0,0),   P1[2],P1[3],P1[4],P1[5],     pw2[0]=PKW(P1,0), pw2[1]=PKW(P1,2), pw2); \
    VRD(6); SBAR(); GAPA(C1=__builtin_amdgcn_mfma_f32_32x32x16_bf16(kf[5],qr[2],C1,0,0,0),   P1[6],P1[7],P1[8],P1[9],     pw2[2]=PKW(P1,4), pw2[3]=PKW(P1,6), pw2); \
    VRD(3); SBAR(); GAPA(C0=__builtin_amdgcn_mfma_f32_32x32x16_bf16(kf[6],qr[3],C0,0,0,0),   P1[10],P1[11],P1[12],P1[13], pw3[0]=PKW(P1,8), pw3[1]=PKW(P1,10), pw3); \
    VRD(7); SBAR(); GAPA(C1=__builtin_amdgcn_mfma_f32_32x32x16_bf16(kf[7],qr[3],C1,0,0,0),   P1[14],P1[15],0.f,0.f,       pw3[2]=PKW(P1,12),pw3[3]=PKW(P1,14), pw3); \
    l_reg+=sacc; \
    if(GK){DMA_K((t)+3,sl_cur);} if(GV){DMA_V((t)+1,sl_next);} \
    CMASK(C0,C1,t); \
    { float a=MX3(C0[0],C0[1],C1[0]),b=MX3(C0[2],C0[3],C1[1]); a=MX3(a,C1[2],C1[3]); \
      _Pragma("unroll") for(int r=4;r<16;r+=4){a=MX3(a,C0[r],C0[r+1]);b=MX3(b,C0[r+2],C0[r+3]);a=MX3(a,C1[r],C1[r+1]);b=MX3(b,C1[r+2],C1[r+3]);} \
      float rm=__builtin_fmaxf(a,b); { auto rr=__builtin_amdgcn_permlane32_swap(__float_as_uint(rm),__float_as_uint(rm),false,false); rm=__builtin_fmaxf(__uint_as_float(rr[0]),__uint_as_float(rr[1])); } \
      resc=false; \
      if(__builtin_expect(__any(rm>(float)THRL),0)){ const float dl=__builtin_fmaxf(rm,0.f); mhat+=dl; \
        _Pragma("unroll") for(int r=0;r<16;++r){C0[r]-=dl;C1[r]-=dl;} \
        const float f=__builtin_amdgcn_exp2f(-dl); l_reg*=f; if(hi==0)wsf[r32]=f; resc=true; } } \
    SBAR(); \
    GAPB(o[0]=__builtin_amdgcn_mfma_f32_32x32x16_bf16(PAF(0),VFR(0),o[0],0,0,0), C0,0); \
    GAPB(o[1]=__builtin_amdgcn_mfma_f32_32x32x16_bf16(PAF(0),VFR(4),o[1],0,0,0), C0,4); \
    KRD(GL,0); GAPB(o[0]=__builtin_amdgcn_mfma_f32_32x32x16_bf16(PAF(1),VFR(1),o[0],0,0,0), C0,8); \
    KRD(GL,1); GAPB(o[1]=__builtin_amdgcn_mfma_f32_32x32x16_bf16(PAF(1),VFR(5),o[1],0,0,0), C0,12); \
    KRD(GL,2); GAPB(o[0]=__builtin_amdgcn_mfma_f32_32x32x16_bf16(PAF(2),VFR(2),o[0],0,0,0), C1,0); \
    KRD(GL,3); GAPB(o[1]=__builtin_amdgcn_mfma_f32_32x32x16_bf16(PAF(2),VFR(6),o[1],0,0,0), C1,4); \
    GAPB(o[0]=__builtin_amdgcn_mfma_f32_32x32x16_bf16(PAF(3),VFR(3),o[0],0,0,0), C1,8); \
    GAPB(o[1]=__builtin_amdgcn_mfma_f32_32x32x16_bf16(PAF(3),VFR(7),o[1],0,0,0), C1,12); \
    }while(0)
  #define ENDW(tt) do{ if((tt)+3<NT){WAIT_BAR(2);} else if((tt)+2<NT){WAIT_BAR(1);} else {WAIT_BAR(0);} }while(0)
  int t=1;
  for(;t+1<NT;t+=2){
    STEP(pB0,pB1,pA0,pA1,t,(t+3<NT),(t+1<NT),(t+1<NT));       ENDW(t);   RESC(); ROT();
    STEP(pA0,pA1,pB0,pB1,t+1,(t+4<NT),(t+2<NT),(t+2<NT));     ENDW(t+1); RESC(); ROT();
  }
  STEP(pB0,pB1,pA0,pA1,NT-1,false,false,false); RESC();
  { float sacc=pB0[0]+pB0[1]; _Pragma("unroll") for(int r=2;r<16;++r)sacc+=pB0[r]; _Pragma("unroll") for(int r=0;r<16;++r)sacc+=pB1[r]; l_reg+=sacc;
    pw0=(u32x4){PKW(pB0,0),PKW(pB0,2),PKW(pB0,4),PKW(pB0,6)};pw1=(u32x4){PKW(pB0,8),PKW(pB0,10),PKW(pB0,12),PKW(pB0,14)};pw2=(u32x4){PKW(pB1,0),PKW(pB1,2),PKW(pB1,4),PKW(pB1,6)};pw3=(u32x4){PKW(pB1,8),PKW(pB1,10),PKW(pB1,12),PKW(pB1,14)};
    SBAR(); pv(o,(int)(unsigned)(uintptr_t)vp0+sl_cur,PAF(0),PAF(1),PAF(2),PAF(3)); }
  #undef PKW
  #undef PAF
  #undef VFR
  #undef PIN
  #undef MX3
  #undef GAPA
  #undef GAPB
  #undef EX
  #undef VRD
  #undef KRD
  #undef STEP
  #undef ENDW
  {auto rr=__builtin_amdgcn_permlane32_swap(__float_as_uint(l_reg),__float_as_uint(l_reg),false,false);l_reg=__uint_as_float(rr[0])+__uint_as_float(rr[1]);}
  if(MODE==1 && hi==0) LSE[qrel]=0.6931471805599453f*(mhat+__log2f(l_reg));
  if(hi==0)wsf[32+r32]=l_reg;asm volatile("s_waitcnt lgkmcnt(0)":::"memory");
  float rli[16];
  #pragma unroll
  for(int r=0;r<16;++r)rli[r]=__builtin_amdgcn_rcpf(wsf[32+crow(r,hi)]);
  bf16*Ow=O+(long)(wid*QBLK)*opitch;
  { __hip_bfloat16*stg=(__hip_bfloat16*)(shm+LDS_OST)+wid*2048;
    #pragma unroll
    for(int r=0;r<16;++r){const int orow=crow(r,hi);
      #pragma unroll
      for(int d0=0;d0<2;++d0)stg[orow*64+d0*32+r32]=__float2bfloat16(o[d0][r]*rli[r]);}
    asm volatile("s_waitcnt lgkmcnt(0)":::"memory");
    #pragma unroll
    for(int i=0;i<4;++i){const int row=i*8+(lane>>3),ch=lane&7; const u32x4 v=*(const u32x4*)(stg+row*64+ch*8); ATTN_STORE16(Ow+(long)row*opitch+ch*8,v);} }
  asm volatile("s_waitcnt lgkmcnt(0)\n\ts_barrier":::"memory");
  #undef DMA_K
  #undef DMA_V
  #undef TM
  #undef CMASK
  #undef START
  #undef RESC
  #undef ROT
}
#undef SBAR
#undef WAIT_BAR
}

constexpr int NWAVES = 8;
constexpr int NB = 4, SEQ = 4096, T = NB * SEQ, D = 1024;
constexpr int EVEN_IN = 2816, EVEN_OUT = 512, ODD_IN = 3072, ODD_OUT = 1024, DFF = 2816, NEXP = 8, DFFE = 3584;
constexpr int MOE_ROWS = 2 * T + NEXP * 256;
constexpr float EPS = 1e-6f;
constexpr size_t MiB = 1u << 20;
constexpr size_t WS_CTL = 0, CTL_ZERO_BYTES = 2 * MiB;
constexpr size_t WS_ROPE = 2 * MiB;
constexpr size_t WS_MISC = 3 * MiB;
constexpr size_t WS_KMEAN = 4 * MiB;
constexpr size_t WS_SSP = 5 * MiB;
constexpr size_t WS_WT = 8 * MiB;
constexpr size_t WT_EVEN_BYTES = 23 * MiB, WT_ODD_BYTES = 176 * MiB;
constexpr size_t WTE_IN = 0, WTE_OUT = 5 * MiB + MiB / 2, WTE_GU = 6 * MiB + MiB / 2, WTE_DN = 17 * MiB + MiB / 2;
constexpr size_t WTO_IN = 0, WTO_OUT = 6 * MiB, WTO_MGU = 8 * MiB, WTO_MD = 120 * MiB;
constexpr size_t WS_WT_EVEN0 = WS_WT, WS_WT_ODD0 = WS_WT + 2 * WT_EVEN_BYTES;
constexpr size_t WS_HN = WS_WT + 2 * WT_EVEN_BYTES + 2 * WT_ODD_BYTES;
constexpr size_t WS_P = WS_HN + 32 * MiB;
constexpr size_t WS_MIX = WS_P + 96 * MiB;
constexpr size_t WS_HID = WS_MIX + 32 * MiB;
constexpr size_t WS_END = WS_HID + 238 * MiB;
static_assert(WS_HN == 406 * MiB && WS_END == 804 * MiB, "ws map");
constexpr size_t P_UV = 0, P_QS = 16 * MiB, P_KS = 40 * MiB, P_VS = 64 * MiB, P_QM = 0, P_KM = 24 * MiB, P_VM = 48 * MiB;
constexpr size_t H_RAWP = 0, H_OG = 96 * MiB, H_LSE = 120 * MiB;
constexpr int CW_TMO = 0, CW_CODE = 1, CW_BAR = 4096;
constexpr size_t CTL_KMSUM = 256 * 1024, KMSUM_BYTES = 256 * 1024;
constexpr size_t P_CONV = 72 * MiB;
constexpr int RING_OFF = 0, RING_BYTES = 131072, LDSCTL_OFF = RING_BYTES, MISC_OFF = LDSCTL_OFF + 320, LDS_BYTES = 147456;

#define GAS __attribute__((address_space(1)))
#define LAS __attribute__((address_space(3)))
typedef unsigned short bf16;
typedef unsigned v4u __attribute__((ext_vector_type(4)));
typedef unsigned v2u __attribute__((ext_vector_type(2)));
typedef float f32x4 __attribute__((ext_vector_type(4)));
typedef GAS unsigned gu32;
#define RLX_AGENT __ATOMIC_RELAXED, __HIP_MEMORY_SCOPE_AGENT
#define LDS_WAIT() asm volatile("s_waitcnt lgkmcnt(0)" ::: "memory")
#define VM_WAIT() asm volatile("s_waitcnt vmcnt(0)" ::: "memory")
__device__ __forceinline__ unsigned f2bf(float f) { unsigned u = __builtin_bit_cast(unsigned, f); return (u + 0x7fffu + ((u >> 16) & 1u)) >> 16; }
__device__ __forceinline__ unsigned pk2(float lo, float hi) { return f2bf(lo) | (f2bf(hi) << 16); }
__device__ __forceinline__ float bf2f(unsigned short b) { return __builtin_bit_cast(float, ((unsigned)b) << 16); }
__device__ __forceinline__ float bflo(unsigned w) { return __builtin_bit_cast(float, w << 16); }
__device__ __forceinline__ float bfhi(unsigned w) { return __builtin_bit_cast(float, w & 0xffff0000u); }

#define XB_TMO      128
#define XB_XCNT(j)  (256  + 64 * (j))
#define XB_XSUB(j)  (1280 + 64 * (j))
#define XB_XGEN(j)  (2304 + 64 * (j))
#define XB_TOP      3328
#define XB_TOPGEN   3392
#define XCD_BAR_WORDS 3456
#define XB_SPIN_CAP (1u << 22)
__device__ __forceinline__ unsigned xb_ld(unsigned* p)              { return __hip_atomic_load(p, __ATOMIC_RELAXED, __HIP_MEMORY_SCOPE_AGENT); }
__device__ __forceinline__ unsigned xb_add(unsigned* p, unsigned v) { return __hip_atomic_fetch_add(p, v, __ATOMIC_RELAXED, __HIP_MEMORY_SCOPE_AGENT); }
__device__ __forceinline__ unsigned xb_xcc_id() { return (unsigned)__builtin_amdgcn_s_getreg((3 << 11) | 20) & 0xFu; }
#define XB_SPIN(cond, bar) do { unsigned _sp = 0; while (cond) { __builtin_amdgcn_s_sleep(1); \
    if ((++_sp & 255u) == 0u) { if (xb_ld(&(bar)[XB_TMO])) break; if (_sp > XB_SPIN_CAP) { atomicAdd(&(bar)[XB_TMO], 1u); break; } } } } while (0)
struct XcdBarrier { unsigned* bar; unsigned x; volatile LAS unsigned* st; };
__device__ __forceinline__ XcdBarrier xcd_barrier_post(unsigned* bar, volatile LAS unsigned* st, int tid) {
    XcdBarrier b; b.bar = bar; b.x = xb_xcc_id(); b.st = st;
    if (tid == 0) { unsigned* bp = bar; asm volatile("" : "+v"(bp)); (void)xb_add(&bp[XB_XCNT(b.x)], 1u); }
    return b;
}
__device__ __forceinline__ void xcd_barrier_complete(unsigned* bar, unsigned x, unsigned& nloc, unsigned& nx) {
    const unsigned G = gridDim.x * gridDim.y * gridDim.z;
    unsigned sum, cnt, mine, sp = 0u;
    for (;;) {
        sum = 0u; cnt = 0u; mine = 0u;
#pragma unroll
        for (unsigned j = 0; j < 16; ++j) { const unsigned c = xb_ld(&bar[XB_XCNT(j)]); sum += c; cnt += (c > 0u) ? 1u : 0u; mine = (j == x) ? c : mine; }
        if (sum == G) break;
        __builtin_amdgcn_s_sleep(1);
        if ((++sp & 255u) == 0u) { if (xb_ld(&bar[XB_TMO])) break; if (sp > XB_SPIN_CAP) { atomicAdd(&bar[XB_TMO], 1u); break; } }
    }
    nloc = mine > 0u ? mine : 1u; nx = cnt > 0u ? cnt : 1u;
}
__device__ __forceinline__ void xcd_barrier(const XcdBarrier& b, int tid) {
    asm volatile("s_waitcnt vmcnt(0)" ::: "memory");
    __syncthreads();
    if (tid == 0) {
        unsigned* bar = b.bar; asm volatile("" : "+v"(bar));
        __builtin_amdgcn_s_waitcnt(0);
        unsigned nloc = b.st[0], nx = b.st[1];
        if (nloc == 0u) { xcd_barrier_complete(bar, b.x, nloc, nx); b.st[0] = nloc; b.st[1] = nx; }
        const unsigned old = xb_add(&bar[XB_XSUB(b.x)], 1u);
        const unsigned gen = old / nloc;
        if (old + 1u == (gen + 1u) * nloc) {
            __builtin_amdgcn_fence(__ATOMIC_RELEASE, "agent");
            asm volatile("s_waitcnt vmcnt(0)" ::: "memory");
            const unsigned og = xb_add(&bar[XB_TOP], 1u);
            const unsigned tg = og / nx;
            if (og + 1u == (tg + 1u) * nx) xb_add(&bar[XB_TOPGEN], 1u);
            else XB_SPIN(xb_ld(&bar[XB_TOPGEN]) == tg, bar);
            __builtin_amdgcn_fence(__ATOMIC_ACQUIRE, "agent");
            xb_add(&bar[XB_XGEN(b.x)], 1u);
            asm volatile("s_waitcnt vmcnt(0)" ::: "memory");
        } else {
            XB_SPIN(xb_ld(&bar[XB_XGEN(b.x)]) == gen, bar);
            __builtin_amdgcn_fence(__ATOMIC_ACQUIRE, "agent");
            asm volatile("s_waitcnt vmcnt(0)" ::: "memory");
        }
    }
    __syncthreads();
}

struct Args { const float* in[22]; float* out; unsigned char* ws; int ph_lo, ph_hi; };
struct Frame {
    LAS unsigned char* lds; volatile LAS unsigned* MISC; gu32* ctl;
    int tid, lane, wave, G, blk;
    unsigned char* ws; float* out; const __attribute__((address_space(4))) struct Args* ap;
};
struct Route { int e1, e2; float g1, g2; };

__device__ __forceinline__ float wave_sum(float v) { v += xswz<1>(v); v += xswz<2>(v); v += xswz<4>(v); v += xswz<8>(v); v += xswz<16>(v); return xsum32(v); }
__device__ __forceinline__ float wave_max(float v) { v = fmaxf(v, xswz<1>(v)); v = fmaxf(v, xswz<2>(v)); v = fmaxf(v, xswz<4>(v)); v = fmaxf(v, xswz<8>(v)); v = fmaxf(v, xswz<16>(v)); return xmax32(v); }
__device__ __forceinline__ int wave_sumi(int v) { v += xswzi<1>(v); v += xswzi<2>(v); v += xswzi<4>(v); v += xswzi<8>(v); v += xswzi<16>(v); return xsum32i(v); }
__device__ __forceinline__ float gelu_tanh(float x) {
    const float y = 0.7978845608028654f * (x + 0.044715f * x * x * x);
    const float e = __expf(2.0f * y);
    const float th = 1.0f - 2.0f / (e + 1.0f);
    return 0.5f * x * (1.0f + th);
}

__device__ __forceinline__ int rowmap_base(int mode, int n);
__device__ __forceinline__ int rowmap(int mode, int n) {
    const int r = rowmap_base(mode & 7, n);
    if (!(mode & 8)) return r;
    const int c = r & 31; return (r & ~31) + 16 * ((c >> 2) & 1) + 4 * (c >> 3) + (c & 3);
}
__device__ __forceinline__ int rowmap_base(int mode, int n) {
    if (mode == 0) return n;
    if (mode == 3) { const int w = n & 255, wc = w >> 6, dd = w & 63, bj = dd >> 5, e = dd & 31, fq = e >> 3, nn = (e >> 2) & 1, j = e & 3; return (n & ~255) + 128 * bj + 32 * wc + 16 * nn + 4 * fq + j; }
    return 256 * (n >> 7) + (n & 127) + (mode == 2 ? 128 : 0);
}
constexpr float H8_SCALE = 8.0f;
constexpr float W8_SCALE = 64.0f;
__device__ __forceinline__ unsigned pk4_fp8(float a, float b, float c, float d) { int w = __builtin_amdgcn_cvt_pk_fp8_f32(a, b, 0, false); w = __builtin_amdgcn_cvt_pk_fp8_f32(c, d, w, true); return (unsigned)w; }
struct TItem { const float* W; bf16* WT; const float* gain; int K, N, mode, fp8, k0, n0; };
__device__ __forceinline__ void p0_item_load(const TItem& t, int lane, f32x4 (&v)[8]) {
    const float* src = t.W + (size_t)(t.k0 + (lane >> 4)) * t.N + t.n0 + (lane & 15) * 4;
#pragma unroll
    for (int i = 0; i < 8; ++i) v[i] = __builtin_nontemporal_load((const f32x4*)(src + (size_t)(4 * i) * t.N));
    if (t.gain) {
#pragma unroll
        for (int i = 0; i < 8; ++i) v[i] = v[i] * t.gain[t.k0 + 4 * i + (lane >> 4)]; }
}
__device__ __forceinline__ void p0_item_finish(const TItem& t, int lane, const f32x4 (&v)[8], LAS float* scr) {
    const int K = t.K;
#pragma unroll
    for (int i = 0; i < 8; ++i) *(LAS f32x4*)(scr + (4 * i + (lane >> 4)) * 68 + (lane & 15) * 4) = v[i];
    LDS_WAIT(); asm volatile("" ::: "memory");
    if (t.fp8) { unsigned char* d8 = (unsigned char*)t.WT + (size_t)rowmap(t.mode, t.n0 + lane) * K + t.k0;
#pragma unroll
        for (int q = 0; q < 2; ++q) { v4u o;
            o.x = pk4_fp8(scr[(16 * q + 0) * 68 + lane] * W8_SCALE, scr[(16 * q + 1) * 68 + lane] * W8_SCALE, scr[(16 * q + 2) * 68 + lane] * W8_SCALE, scr[(16 * q + 3) * 68 + lane] * W8_SCALE);
            o.y = pk4_fp8(scr[(16 * q + 4) * 68 + lane] * W8_SCALE, scr[(16 * q + 5) * 68 + lane] * W8_SCALE, scr[(16 * q + 6) * 68 + lane] * W8_SCALE, scr[(16 * q + 7) * 68 + lane] * W8_SCALE);
            o.z = pk4_fp8(scr[(16 * q + 8) * 68 + lane] * W8_SCALE, scr[(16 * q + 9) * 68 + lane] * W8_SCALE, scr[(16 * q + 10) * 68 + lane] * W8_SCALE, scr[(16 * q + 11) * 68 + lane] * W8_SCALE);
            o.w = pk4_fp8(scr[(16 * q + 12) * 68 + lane] * W8_SCALE, scr[(16 * q + 13) * 68 + lane] * W8_SCALE, scr[(16 * q + 14) * 68 + lane] * W8_SCALE, scr[(16 * q + 15) * 68 + lane] * W8_SCALE);
            *(GAS v4u*)(d8 + 16 * q) = o; }
    } else {
    bf16* dst = t.WT + (size_t)rowmap(t.mode, t.n0 + lane) * K + t.k0;
#pragma unroll
    for (int q = 0; q < 4; ++q) { v4u o;
        o.x = pk2(scr[(8 * q + 0) * 68 + lane], scr[(8 * q + 1) * 68 + lane]); o.y = pk2(scr[(8 * q + 2) * 68 + lane], scr[(8 * q + 3) * 68 + lane]);
        o.z = pk2(scr[(8 * q + 4) * 68 + lane], scr[(8 * q + 5) * 68 + lane]); o.w = pk2(scr[(8 * q + 6) * 68 + lane], scr[(8 * q + 7) * 68 + lane]);
        *(GAS v4u*)(dst + 8 * q) = o; } }
    LDS_WAIT(); asm volatile("" ::: "memory");
}
struct WDesc { const float* src; bf16* dst; const float* gain; int K, N, nbatch, mode, fp8; size_t dst_bstride; };
__device__ __forceinline__ WDesc get_desc(const Args& a, int d) {
    const int layer = d / 10, k = d % 10; unsigned char* ws = a.ws;
    bf16* we = (bf16*)(ws + WS_WT_EVEN0 + (size_t)layer * WT_EVEN_BYTES); bf16* wo = (bf16*)(ws + WS_WT_ODD0 + (size_t)layer * WT_ODD_BYTES);
    WDesc w; w.nbatch = 1; w.mode = 0; w.dst_bstride = 0; w.fp8 = 0; w.gain = nullptr;
    switch (k) {
    case 0: w.src = a.in[3] + (size_t)layer * D * EVEN_IN; w.dst = we + WTE_IN / 2; w.K = D; w.N = EVEN_IN; w.mode = 3; w.gain = a.in[1] + (size_t)(2 * layer) * D; break;
    case 1: w.src = a.in[9] + (size_t)layer * EVEN_OUT * D; w.dst = we + WTE_OUT / 2; w.K = EVEN_OUT; w.N = D; break;
    case 2: w.src = a.in[10] + (size_t)layer * D * DFF; w.dst = we + WTE_GU / 2; w.K = D; w.N = DFF; w.mode = 1; w.gain = a.in[2] + (size_t)(2 * layer) * D; break;
    case 3: w.src = a.in[11] + (size_t)layer * D * DFF; w.dst = we + WTE_GU / 2; w.K = D; w.N = DFF; w.mode = 2; w.gain = a.in[2] + (size_t)(2 * layer) * D; break;
    case 4: w.src = a.in[12] + (size_t)layer * DFF * D; w.dst = we + WTE_DN / 2; w.K = DFF; w.N = D; break;
    case 5: w.src = a.in[13] + (size_t)layer * D * ODD_IN; w.dst = wo + WTO_IN / 2; w.K = D; w.N = ODD_IN; w.mode = 3; w.gain = a.in[1] + (size_t)(2 * layer + 1) * D; break;
    case 6: w.src = a.in[17] + (size_t)layer * ODD_OUT * D; w.dst = wo + WTO_OUT / 2; w.K = ODD_OUT; w.N = D; break;
    case 7: w.src = a.in[19] + (size_t)layer * NEXP * D * DFFE; w.dst = wo + WTO_MGU / 2; w.K = D; w.N = DFFE; w.mode = 1 | 8; w.nbatch = NEXP; w.dst_bstride = (size_t)DFFE * D; w.fp8 = 1; break;
    case 8: w.src = a.in[20] + (size_t)layer * NEXP * D * DFFE; w.dst = wo + WTO_MGU / 2; w.K = D; w.N = DFFE; w.mode = 2 | 8; w.nbatch = NEXP; w.dst_bstride = (size_t)DFFE * D; w.fp8 = 1; break;
    default: w.src = a.in[21] + (size_t)layer * NEXP * DFFE * D; w.dst = wo + WTO_MD / 2; w.K = DFFE; w.N = D; w.mode = 8; w.nbatch = NEXP; w.dst_bstride = (size_t)DFFE * D / 2; w.fp8 = 1; break;
    }
    return w;
}
__device__ __forceinline__ void xstats_phase(Frame& F, const float* xsrc, float* xdst, bf16* xb, bool do_combine, bool write_xb);
__device__ __forceinline__ void p0_prologue(Frame& F, const Args& a) {
    LAS float* scr = (LAS float*)(F.lds + RING_OFF + F.wave * 16384);
    const int gw = F.blk * NWAVES + F.wave, NGW = F.G * NWAVES;
    auto locate = [&](long it, TItem& t) -> bool {
        for (int d = 0; d < 20; ++d) { const WDesc w = get_desc(a, d); const long per = (long)(w.K / 32) * (w.N / 64), n = per * w.nbatch;
            if (it < n) { const int bt = (int)(it / per), r = (int)(it % per), nblk = w.N / 64;
                t.W = w.src + (size_t)bt * w.K * w.N; t.WT = w.dst + (size_t)bt * w.dst_bstride; t.K = w.K; t.N = w.N; t.mode = w.mode; t.fp8 = w.fp8; t.gain = w.gain; t.k0 = 32 * (r / nblk); t.n0 = 64 * (r % nblk); return true; }
            it -= n; }
        return false; };
    { TItem cur, nxt; f32x4 va[8], vb[8]; long it = gw; bool have = locate(it, cur);
      if (have) p0_item_load(cur, F.lane, va);
      while (have) {
          const bool hn = locate(it + NGW, nxt);
          if (hn) p0_item_load(nxt, F.lane, vb);
          p0_item_finish(cur, F.lane, va, scr);
          if (!hn) break;
          it += NGW; const bool h2 = locate(it + NGW, cur);
          if (h2) p0_item_load(cur, F.lane, va);
          p0_item_finish(nxt, F.lane, vb, scr);
          if (!h2) break;
          it += NGW; } }
    xstats_phase(F, a.in[0], nullptr, (bf16*)(a.ws + WS_HN), false, true);
    { float* wtg = (float*)(a.ws + WS_KMEAN); const float* wsp = a.in[5];
      for (int i = F.blk * 512 + F.tid; i < 2 * 4 * 128 * 128; i += F.G * 512) { const int lg = i >> 14, j = (i >> 7) & 127, ii = i & 127; wtg[i] = (j <= ii) ? wsp[(size_t)lg * 16384 + ii * 128 + j] : 0.f; } }
    float* cs = (float*)(a.ws + WS_ROPE); float* sn = cs + SEQ * 32;
    for (int i = F.blk * 512 + F.tid; i < SEQ * 32; i += F.G * 512) { const int pos = i >> 5, j = i & 31;
        const float inv = 1.0f / powf(10000.0f, (float)j * (1.0f / 32.0f)); const float ang = (float)pos * inv;
        cs[i] = cosf(ang); sn[i] = sinf(ang); }
}

__device__ __forceinline__ void xstats_phase(Frame& F, const float* xsrc, float* xdst, bf16* xb, bool do_combine, bool write_xb) {
    unsigned char* ws = F.ws;
    const Route* route = (const Route*)(ws + WS_MISC); const int* slots = (const int*)(ws + WS_MISC + 256 * 1024); float* ssp = (float*)(ws + WS_SSP);
    const bf16* Y = (const bf16*)(ws + WS_P);
    const int lane = F.lane;
    for (int row = F.blk * NWAVES + F.wave; row < T; row += F.G * NWAVES) {
        const f32x4* xr = (const f32x4*)(xsrc + (size_t)row * D) + lane;
        f32x4 v[4];
#pragma unroll
        for (int j = 0; j < 4; ++j) v[j] = xr[64 * j];
        if (do_combine) {
            const Route r = route[row]; const int s1 = slots[2 * row], s2 = slots[2 * row + 1];
            const v2u* y1 = (const v2u*)(Y + (size_t)s1 * D) + lane; const v2u* y2 = (const v2u*)(Y + (size_t)s2 * D) + lane;
#pragma unroll
            for (int j = 0; j < 4; ++j) { const v2u a = y1[64 * j], b = y2[64 * j];
                v[j].x += r.g1 * bflo(a.x) + r.g2 * bflo(b.x); v[j].y += r.g1 * bfhi(a.x) + r.g2 * bfhi(b.x);
                v[j].z += r.g1 * bflo(a.y) + r.g2 * bflo(b.y); v[j].w += r.g1 * bfhi(a.y) + r.g2 * bfhi(b.y); }
            f32x4* xo = (f32x4*)(xdst + (size_t)row * D) + lane;
#pragma unroll
            for (int j = 0; j < 4; ++j) xo[64 * j] = v[j];
        }
        if (write_xb) {
            float ss = 0.f;
#pragma unroll
            for (int j = 0; j < 4; ++j) ss += (v[j].x * v[j].x + v[j].y * v[j].y) + (v[j].z * v[j].z + v[j].w * v[j].w);
            ss = wave_sum(ss);
            v2u* o8 = (v2u*)(xb + (size_t)row * D) + lane;
#pragma unroll
            for (int j = 0; j < 4; ++j) { v2u o; o.x = pk2(v[j].x, v[j].y); o.y = pk2(v[j].z, v[j].w); o8[64 * j] = o; }
            if (lane < 16) ssp[(size_t)row * 16 + lane] = lane == 0 ? ss : 0.f;
        }
    }
}
__device__ __forceinline__ void router_phase(Frame& F, const bf16* xb, const float* gain, const float* router_w) {
    unsigned char* ws = F.ws;
    Route* route = (Route*)(ws + WS_MISC); int* ccnt = (int*)(ws + WS_MISC + 384 * 1024); const float* ssp = (const float*)(ws + WS_SSP);
    LAS float* wr = (LAS float*)(F.lds + RING_OFF);
    LAS int* lcnt = (LAS int*)(F.lds + RING_OFF + 32768);
    for (int i = F.tid; i < 8192; i += 512) { const int d = i >> 3, e = i & 7; wr[e * 1024 + d] = router_w[i] * gain[d]; }
    const int lane = F.lane;
    for (int c = F.blk; c < T / 64; c += F.G) {
        if (F.tid < 8) lcnt[F.tid] = 0;
        __syncthreads();
        for (int k = 0; k < 8; ++k) {
            const int row = c * 64 + F.wave * 8 + k;
            const v2u* xr = (const v2u*)(xb + (size_t)row * D) + lane;
            f32x4 v[4];
#pragma unroll
            for (int j = 0; j < 4; ++j) { const v2u a = xr[64 * j]; v[j] = (f32x4){bflo(a.x), bfhi(a.x), bflo(a.y), bfhi(a.y)}; }
            float sq = lane < 16 ? ssp[(size_t)row * 16 + lane] : 0.f; sq = wave_sum(sq);
            const float rstd = 1.0f / sqrtf(sq * (1.0f / D) + EPS);
            float lg[8];
#pragma unroll
            for (int e = 0; e < 8; ++e) { float sacc = 0.f;
#pragma unroll
                for (int j = 0; j < 4; ++j) { const f32x4 w = *((const LAS f32x4*)(wr + e * 1024) + lane + 64 * j); sacc += (v[j].x * w.x + v[j].y * w.y) + (v[j].z * w.z + v[j].w * w.w); }
                lg[e] = wave_sum(sacc) * rstd; }
            int e1 = 0; float v1 = lg[0];
#pragma unroll
            for (int e = 1; e < 8; ++e) if (lg[e] > v1) { v1 = lg[e]; e1 = e; }
            int e2 = -1; float v2 = -INFINITY;
#pragma unroll
            for (int e = 0; e < 8; ++e) if (e != e1 && lg[e] > v2) { v2 = lg[e]; e2 = e; }
            const float g2 = 1.0f / (1.0f + __expf(v1 - v2)), g1 = 1.0f - g2;
            if (lane == 0) { Route r; r.e1 = e1; r.e2 = e2; r.g1 = g1; r.g2 = g2; route[row] = r; __hip_atomic_fetch_add(&lcnt[e1], 1, __ATOMIC_RELAXED, __HIP_MEMORY_SCOPE_WORKGROUP); __hip_atomic_fetch_add(&lcnt[e2], 1, __ATOMIC_RELAXED, __HIP_MEMORY_SCOPE_WORKGROUP); }
        }
        __syncthreads();
        if (F.tid < 8) ccnt[c * 8 + F.tid] = lcnt[F.tid];
        __syncthreads();
    }
}

__device__ __forceinline__ void route_phase(Frame& F, const bf16* hn, bf16* hsort, const float* gain) {
    unsigned char* ws = F.ws;
    const Route* route = (const Route*)(ws + WS_MISC); int* slots = (int*)(ws + WS_MISC + 256 * 1024); const int* ccnt = (const int*)(ws + WS_MISC + 384 * 1024); int* tile_base = (int*)(ws + WS_MISC + 512 * 1024);
    LAS int* tot = (LAS int*)(F.lds + RING_OFF); LAS int* bef = tot + 8; LAS int* base = tot + 16; LAS int* sl = tot + 32;
    for (int c = F.blk; c < T / 64; c += F.G) {
        { const int e = F.wave; int t = 0, b = 0;
#pragma unroll
            for (int q = 0; q < 4; ++q) { const int ch = F.lane * 4 + q; const int v = ccnt[ch * 8 + e]; t += v; b += (ch < c) ? v : 0; }
            t = wave_sumi(t); b = wave_sumi(b);
            if (F.lane == 0) { tot[e] = t; bef[e] = b; } }
        __syncthreads();
        if (F.tid == 0) { int acc = 0;
            for (int e = 0; e < 8; ++e) { base[e] = acc; if (c == 0) tile_base[e] = acc >> 8; acc += (tot[e] + 255) & ~255; }
            if (c == 0) tile_base[8] = acc >> 8; }
        __syncthreads();
        if (F.wave == 0) {
            const int row = c * 64 + F.lane; const Route r = route[row];
            int run[8];
#pragma unroll
            for (int e = 0; e < 8; ++e) run[e] = base[e] + bef[e];
#pragma unroll
            for (int k = 0; k < 2; ++k) { const int me = k ? r.e2 : r.e1; int myslot = 0;
#pragma unroll
                for (int e = 0; e < 8; ++e) { const unsigned long long m = __ballot(me == e); const int rank = __popcll(m & ((1ull << F.lane) - 1ull));
                    if (me == e) myslot = run[e] + rank; run[e] += __popcll(m); }
                slots[2 * row + k] = myslot; sl[2 * F.lane + k] = myslot; }
        }
        __syncthreads();
        { const float* ssp = (const float*)(ws + WS_SSP);
          f32x4 gq[4];
#pragma unroll
          for (int q = 0; q < 4; ++q) gq[q] = *((const f32x4*)gain + 4 * F.lane + q);
          for (int p = F.wave; p < 128; p += NWAVES) { const int row = c * 64 + (p >> 1); const int s = sl[p];
            float sq = F.lane < 16 ? ssp[(size_t)row * 16 + F.lane] : 0.f; sq = wave_sum(sq); const float rs = 1.0f / sqrtf(sq * (1.0f / D) + EPS);
            const v4u* src = (const v4u*)(hn + (size_t)row * D) + 2 * F.lane; const v4u a = src[0], b = src[1];
            v4u o; o.x = pk4_fp8(bflo(a.x) * rs * gq[0].x, bfhi(a.x) * rs * gq[0].y, bflo(a.y) * rs * gq[0].z, bfhi(a.y) * rs * gq[0].w); o.y = pk4_fp8(bflo(a.z) * rs * gq[1].x, bfhi(a.z) * rs * gq[1].y, bflo(a.w) * rs * gq[1].z, bfhi(a.w) * rs * gq[1].w);
            o.z = pk4_fp8(bflo(b.x) * rs * gq[2].x, bfhi(b.x) * rs * gq[2].y, bflo(b.y) * rs * gq[2].z, bfhi(b.y) * rs * gq[2].w); o.w = pk4_fp8(bflo(b.z) * rs * gq[3].x, bfhi(b.z) * rs * gq[3].y, bflo(b.w) * rs * gq[3].z, bfhi(b.w) * rs * gq[3].w);
            *((v4u*)((unsigned char*)hsort + (size_t)s * D) + F.lane) = o; } }
        __syncthreads();
    }
}

__device__ __forceinline__ int srow(int s, int g) { return g == 0 ? s : (g == 1 ? ((s & 3) * 1024 + (s >> 2)) : ((s & 15) * 256 + (s >> 4))); }
__device__ __forceinline__ float rope_apply(float n, int lane, const float* cs, const float* sn, int s) {
    const float partner = __shfl_xor(n, 32); const int j = lane & 31; const float c = cs[s * 32 + j], si = sn[s * 32 + j];
    return lane < 32 ? n * c - partner * si : n * c + partner * si;
}
__device__ __forceinline__ void post_even(Frame& F, const bf16* rawp, const float* vgain, const float* qgain, const float* kgain) {
    unsigned char* ws = F.ws; bf16* UV = (bf16*)(ws + WS_P + P_UV); bf16* Qs = (bf16*)(ws + WS_P + P_QS); bf16* Ks = (bf16*)(ws + WS_P + P_KS); bf16* Vs = (bf16*)(ws + WS_P + P_VS);
    const float* cs = (const float*)(ws + WS_ROPE); const float* sn = cs + SEQ * 32;
    const int lane = F.lane; const float qg = qgain[lane], kg = kgain[lane];
    const long nitems = (long)T * 44;
    for (long it = (long)F.blk * NWAVES + F.wave; it < nitems; it += (long)F.G * NWAVES) {
        const int row = (int)(it / 44), u = (int)(it % 44), b = row >> 12, s = row & 4095;
        const float v = bf2f(rawp[(size_t)row * EVEN_IN + 64 * u + lane]);
        if (u < 4) { UV[(size_t)row * 512 + 64 * u + lane] = (bf16)f2bf(gelu_tanh(v)); }
        else if (u < 8) { const float z = gelu_tanh(v); const float ss = wave_sum(z * z); const float o = z * (1.0f / sqrtf(ss * (1.0f / 64) + EPS)) * vgain[(u - 4) * 64 + lane];
            UV[(size_t)row * 512 + 64 * u + lane] = (bf16)f2bf(o); }
        else if (u < 32) { const bool isq = u < 20; const int h = isq ? u - 8 : u - 20; const float ss = wave_sum(v * v);
            const float n = v * (1.0f / sqrtf(ss * (1.0f / 64) + EPS)) * (isq ? qg : kg); const float o = rope_apply(n, lane, cs, sn, s);
            (isq ? Qs : Ks)[((size_t)(b * 12 + h) * SEQ + srow(s, h >> 2)) * 64 + lane] = (bf16)f2bf(isq ? o * att::C2 : o); }
        else { const int h = u - 32; Vs[((size_t)(b * 12 + h) * SEQ + srow(s, h >> 2)) * 64 + lane] = (bf16)f2bf(v); }
    }
}
__device__ __forceinline__ void post_odd(Frame& F, const bf16* rawp, const float* qgain, const float* kgain) {
    unsigned char* ws = F.ws; bf16* Qm = (bf16*)(ws + WS_P + P_QM); bf16* Km = (bf16*)(ws + WS_P + P_KM); bf16* Vm = (bf16*)(ws + WS_P + P_VM);
    const float* cs = (const float*)(ws + WS_ROPE); const float* sn = cs + SEQ * 32;
    const int lane = F.lane; const float qg = qgain[lane], kg = kgain[lane];
    const long nitems = (long)T * 36;
    for (long it = (long)F.blk * NWAVES + F.wave; it < nitems; it += (long)F.G * NWAVES) {
        const int row = (int)(it / 36), u = (int)(it % 36), b = row >> 12, s = row & 4095;
        const float v = bf2f(rawp[(size_t)row * ODD_IN + 64 * u + lane]);
        if (u < 24) { const bool isq = u < 12; const int h = isq ? u : u - 12; const float ss = wave_sum(v * v);
            const float n = v * (1.0f / sqrtf(ss * (1.0f / 64) + EPS)) * (isq ? qg : kg); const float o = rope_apply(n, lane, cs, sn, s);
            (isq ? Qm : Km)[((size_t)(b * 12 + h) * SEQ + s) * 64 + lane] = (bf16)f2bf(isq ? o * att::C2 : o); }
        else { const int h = u - 24; Vm[((size_t)(b * 12 + h) * SEQ + s) * 64 + lane] = (bf16)f2bf(v); }
    }
}
__device__ __forceinline__ void kmean_phase(Frame& F) {
    const bf16* Km = (const bf16*)(F.ws + WS_P + P_KM); float* km = (float*)(F.ws + WS_KMEAN);
    for (int it = F.blk * NWAVES + F.wave; it < 48 * 16; it += F.G * NWAVES) {
        const bf16* k = Km + (size_t)it * 256 * 64 + F.lane; float s = 0.f;
        for (int r = 0; r < 256; ++r) s += bf2f(k[r * 64]);
        km[it * 64 + F.lane] = s * (1.0f / 256.0f);
    }
}

__device__ __forceinline__ void load_row64(const bf16* p, float (&q)[64]) {
    const v4u* p4 = (const v4u*)p;
#pragma unroll
    for (int i = 0; i < 8; ++i) { const v4u w = p4[i]; q[8 * i + 0] = bflo(w.x); q[8 * i + 1] = bfhi(w.x); q[8 * i + 2] = bflo(w.y); q[8 * i + 3] = bfhi(w.y); q[8 * i + 4] = bflo(w.z); q[8 * i + 5] = bfhi(w.z); q[8 * i + 6] = bflo(w.w); q[8 * i + 7] = bfhi(w.w); }
}
__device__ __forceinline__ float dot_row64(const bf16* p, const float (&q)[64]) {
    const v4u* p4 = (const v4u*)p; float s = 0.f;
#pragma unroll
    for (int i = 0; i < 8; ++i) { const v4u w = p4[i]; s += q[8 * i + 0] * bflo(w.x) + q[8 * i + 1] * bfhi(w.x) + q[8 * i + 2] * bflo(w.y) + q[8 * i + 3] * bfhi(w.y) + q[8 * i + 4] * bflo(w.z) + q[8 * i + 5] * bfhi(w.z) + q[8 * i + 6] * bflo(w.w) + q[8 * i + 7] * bfhi(w.w); }
    return s;
}
__device__ __forceinline__ void banded_naive(Frame& F) {
    unsigned char* ws = F.ws; const bf16* Qs = (const bf16*)(ws + WS_P + P_QS); const bf16* Ks = (const bf16*)(ws + WS_P + P_KS); const bf16* Vs = (const bf16*)(ws + WS_P + P_VS);
    bf16* OG = (bf16*)(ws + WS_HID + H_OG); float* LSE = (float*)(ws + WS_HID + H_LSE);
    LAS float* pl = (LAS float*)(F.lds + RING_OFF) + F.wave * 256;
    const int lane = F.lane;
    for (int it = F.blk * NWAVES + F.wave; it < 48 * SEQ; it += F.G * NWAVES) {
        const int bh = it >> 12, rp = it & 4095, b = bh / 12, h = bh % 12, g = h >> 2, dil = g == 0 ? 1 : (g == 1 ? 4 : 16), L = SEQ / dil;
        const int i = rp % L, r = rp / L, s = i * dil + r, nk = (i < 128 ? i : 128) + 1, first = rp - (nk - 1);
        float q[64]; load_row64(Qs + ((size_t)bh * SEQ + rp) * 64, q);
        float sc[3]; float m = -INFINITY;
#pragma unroll
        for (int kk = 0; kk < 3; ++kk) { const int j = lane + 64 * kk; sc[kk] = -INFINITY; if (j < nk) { sc[kk] = 0.6931471805599453f * dot_row64(Ks + ((size_t)bh * SEQ + first + j) * 64, q); } m = fmaxf(m, sc[kk]); }
        m = wave_max(m); float l = 0.f;
#pragma unroll
        for (int kk = 0; kk < 3; ++kk) { const float p = (lane + 64 * kk < nk) ? __expf(sc[kk] - m) : 0.f; pl[lane + 64 * kk] = p; l += p; }
        l = wave_sum(l); LDS_WAIT();
        float acc = 0.f; const bf16* vb = Vs + ((size_t)bh * SEQ + first) * 64 + lane;
        for (int j = 0; j < nk; ++j) acc += pl[j] * bf2f(vb[(size_t)j * 64]);
        const size_t orow = ((size_t)g * T + (size_t)b * SEQ + s) * 4 + (h & 3);
        OG[orow * 64 + lane] = (bf16)f2bf(acc / l);
        if (lane == 0) LSE[orow] = m + __logf(l);
        LDS_WAIT();
    }
}
__device__ __forceinline__ void merge_even(Frame& F, bf16* mix) {
    const bf16* OG = (const bf16*)(F.ws + WS_HID + H_OG); const float* LSE = (const float*)(F.ws + WS_HID + H_LSE);
    for (int t = F.blk * 512 + F.tid; t < T * 4 * 8; t += F.G * 512) {
        const int it = t >> 3, part = t & 7, row = it >> 2, hg = it & 3, b = row >> 12, s = row & 4095;
        const size_t i0 = ((size_t)0 * 16 + b * 4 + hg) * SEQ + srow(s, 0), i1 = ((size_t)1 * 16 + b * 4 + hg) * SEQ + srow(s, 1), i2 = ((size_t)2 * 16 + b * 4 + hg) * SEQ + srow(s, 2);
        const float l0 = LSE[i0], l1 = LSE[i1], l2 = LSE[i2]; const float m = fmaxf(l0, fmaxf(l1, l2));
        float w0 = __expf(l0 - m), w1 = __expf(l1 - m), w2 = __expf(l2 - m); const float inv = 1.0f / (w0 + w1 + w2); w0 *= inv; w1 *= inv; w2 *= inv;
        const v4u a = *(const v4u*)(OG + i0 * 64 + part * 8), bb = *(const v4u*)(OG + i1 * 64 + part * 8), c = *(const v4u*)(OG + i2 * 64 + part * 8);
        v4u o;
        o.x = pk2(w0 * bflo(a.x) + w1 * bflo(bb.x) + w2 * bflo(c.x), w0 * bfhi(a.x) + w1 * bfhi(bb.x) + w2 * bfhi(c.x));
        o.y = pk2(w0 * bflo(a.y) + w1 * bflo(bb.y) + w2 * bflo(c.y), w0 * bfhi(a.y) + w1 * bfhi(bb.y) + w2 * bfhi(c.y));
        o.z = pk2(w0 * bflo(a.z) + w1 * bflo(bb.z) + w2 * bflo(c.z), w0 * bfhi(a.z) + w1 * bfhi(bb.z) + w2 * bfhi(c.z));
        o.w = pk2(w0 * bflo(a.w) + w1 * bflo(bb.w) + w2 * bflo(c.w), w0 * bfhi(a.w) + w1 * bfhi(bb.w) + w2 * bfhi(c.w));
        *(v4u*)(mix + (size_t)row * EVEN_OUT + 256 + hg * 64 + part * 8) = o;
    }
}
__device__ __forceinline__ void gmlp_phase(Frame& F, int lp, const float* bsp, bf16* mix) {
    const bf16* UV = (const bf16*)(F.ws + WS_P + P_UV); const float* wtg = (const float*)(F.ws + WS_KMEAN) + (size_t)lp * 4 * 16384;
    LAS float* WT = (LAS float*)(F.lds + RING_OFF);
    LAS float* VL = WT + 128 * 128;
    const int tid = F.tid; int gl = -1;
    for (int unit = F.blk; unit < (T / 128) * 4; unit += F.G) {
        const int c = unit >> 2, g = unit & 3, row0 = c * 128;
        __syncthreads();
        if (g != gl) { gl = g; const f32x4* src = (const f32x4*)(wtg + (size_t)g * 16384);
#pragma unroll
            for (int q = 0; q < 8; ++q) *((LAS f32x4*)WT + tid + 512 * q) = src[tid + 512 * q]; }
        { const int j = tid >> 2, d8 = (tid & 3) * 16;
          const v4u a = *(const v4u*)(UV + (size_t)(row0 + j) * 512 + 256 + g * 64 + d8), b = *(const v4u*)(UV + (size_t)(row0 + j) * 512 + 256 + g * 64 + d8 + 8);
          LAS f32x4* vd = (LAS f32x4*)(VL + j * 64 + d8);
          vd[0] = (f32x4){bflo(a.x), bfhi(a.x), bflo(a.y), bfhi(a.y)}; vd[1] = (f32x4){bflo(a.z), bfhi(a.z), bflo(a.w), bfhi(a.w)};
          vd[2] = (f32x4){bflo(b.x), bfhi(b.x), bflo(b.y), bfhi(b.y)}; vd[3] = (f32x4){bflo(b.z), bfhi(b.z), bflo(b.w), bfhi(b.w)}; }
        __syncthreads();
        const int i0 = 4 * (tid >> 4), d0 = 4 * (tid & 15);
        f32x4 acc[4];
#pragma unroll
        for (int a = 0; a < 4; ++a) acc[a] = (f32x4){0.f, 0.f, 0.f, 0.f};
        const int jmax = i0 + 3;
        for (int j = 0; j <= jmax; ++j) { const f32x4 w = *(const LAS f32x4*)(WT + j * 128 + i0); const f32x4 v = *(const LAS f32x4*)(VL + j * 64 + d0);
            acc[0] += w.x * v; acc[1] += w.y * v; acc[2] += w.z * v; acc[3] += w.w * v; }
#pragma unroll
        for (int a = 0; a < 4; ++a) { const int i = i0 + a; const float bb = bsp[g * 128 + i]; const size_t row = row0 + i;
            const v2u uu = *(const v2u*)(UV + row * 512 + g * 64 + d0);
            v2u o; o.x = pk2(bflo(uu.x) * (acc[a].x + bb), bfhi(uu.x) * (acc[a].y + bb)); o.y = pk2(bflo(uu.y) * (acc[a].z + bb), bfhi(uu.y) * (acc[a].w + bb));
            *(v2u*)(mix + row * EVEN_OUT + g * 64 + d0) = o; }
    }
    __syncthreads();
}
__device__ __forceinline__ void moba_naive(Frame& F, bf16* mix) {
    unsigned char* ws = F.ws; const bf16* Qm = (const bf16*)(ws + WS_P + P_QM); const bf16* Km = (const bf16*)(ws + WS_P + P_KM); const bf16* Vm = (const bf16*)(ws + WS_P + P_VM);
    const float* km = (const float*)(ws + WS_KMEAN);
    LAS float* sc = (LAS float*)(F.lds + RING_OFF) + F.wave * 1024;
    const int lane = F.lane;
    for (int it = F.blk * NWAVES + F.wave; it < 48 * SEQ; it += F.G * NWAVES) {
        const int bh = it >> 12, s = it & 4095, b = bh / 12, h = bh % 12, qb = s >> 8;
        float q[64]; load_row64(Qm + ((size_t)bh * SEQ + s) * 64, q);
        float gate = -INFINITY;
        if (lane < qb) { const f32x4* kp = (const f32x4*)(km + ((size_t)bh * 16 + lane) * 64); float a = 0.f;
#pragma unroll
            for (int i = 0; i < 16; ++i) { const f32x4 w = kp[i]; a += q[4 * i] * w.x + q[4 * i + 1] * w.y + q[4 * i + 2] * w.z + q[4 * i + 3] * w.w; }
            gate = a; }
        unsigned sel = 1u << qb;
        for (int r = 0; r < 3; ++r) { float v = gate; int idx = lane;
#pragma unroll
            for (int o = 1; o < 64; o <<= 1) { const float ov = __shfl_xor(v, o); const int oi = __shfl_xor(idx, o); if (ov > v || (ov == v && oi < idx)) { v = ov; idx = oi; } }
            if (v > -INFINITY) { sel |= 1u << idx; if (lane == idx) gate = -INFINITY; } }
        int cnt = 0; float m = -INFINITY;
        for (int n = 0; n <= qb; ++n) { if (!((sel >> n) & 1u)) continue;
#pragma unroll
            for (int kk = 0; kk < 4; ++kk) { const int key = n * 256 + kk * 64 + lane; float x = -INFINITY;
                if (key <= s) x = 0.6931471805599453f * dot_row64(Km + ((size_t)bh * SEQ + key) * 64, q);
                sc[cnt * 256 + kk * 64 + lane] = x; m = fmaxf(m, x); }
            ++cnt; }
        m = wave_max(m); float l = 0.f; LDS_WAIT();
        for (int i = lane; i < cnt * 256; i += 64) { const float p = __expf(sc[i] - m); sc[i] = p; l += p; }
        l = wave_sum(l); LDS_WAIT();
        float acc = 0.f; int c2 = 0;
        for (int n = 0; n <= qb; ++n) { if (!((sel >> n) & 1u)) continue;
            const bf16* vb = Vm + ((size_t)bh * SEQ + n * 256) * 64 + lane; const int kend = (n == qb) ? (s & 255) + 1 : 256;
            for (int kk = 0; kk < kend; ++kk) acc += sc[c2 * 256 + kk] * bf2f(vb[(size_t)kk * 64]);
            ++c2; }
        mix[((size_t)b * SEQ + s) * ODD_OUT + h * 64 + lane] = (bf16)f2bf(acc / l);
        LDS_WAIT();
    }
}
__device__ __forceinline__ void conv_phase(Frame& F, const bf16* cv, const float* cw, bf16* mix) {
    for (int it = F.blk * 512 + F.tid; it < T * 32; it += F.G * 512) {
        const int row = it >> 5, c = (it & 31) * 8, s = row & 4095;
        const bf16* p = cv + (size_t)row * 768 + c;
        const v4u bg = *(const v4u*)p, c0 = *(const v4u*)(p + 256), x0 = *(const v4u*)(p + 512);
        v4u c1 = (v4u){0u, 0u, 0u, 0u}, x1 = c1, c2 = c1, x2 = c1;
        if (s >= 1) { c1 = *(const v4u*)(p + 256 - 768); x1 = *(const v4u*)(p + 512 - 768); }
        if (s >= 2) { c2 = *(const v4u*)(p + 256 - 1536); x2 = *(const v4u*)(p + 512 - 1536); }
        const f32x4 wa0 = *(const f32x4*)(cw + c), wa1 = *(const f32x4*)(cw + c + 4), wb0 = *(const f32x4*)(cw + 256 + c), wb1 = *(const f32x4*)(cw + 256 + c + 4), wc0 = *(const f32x4*)(cw + 512 + c), wc1 = *(const f32x4*)(cw + 512 + c + 4);
        const unsigned bgw[4] = {bg.x, bg.y, bg.z, bg.w}, c0w[4] = {c0.x, c0.y, c0.z, c0.w}, x0w[4] = {x0.x, x0.y, x0.z, x0.w}, c1w[4] = {c1.x, c1.y, c1.z, c1.w}, x1w[4] = {x1.x, x1.y, x1.z, x1.w}, c2w[4] = {c2.x, c2.y, c2.z, c2.w}, x2w[4] = {x2.x, x2.y, x2.z, x2.w};
        const float w0[8] = {wa0.x, wa0.y, wa0.z, wa0.w, wa1.x, wa1.y, wa1.z, wa1.w}, w1[8] = {wb0.x, wb0.y, wb0.z, wb0.w, wb1.x, wb1.y, wb1.z, wb1.w}, w2[8] = {wc0.x, wc0.y, wc0.z, wc0.w, wc1.x, wc1.y, wc1.z, wc1.w};
        unsigned ow[4];
#pragma unroll
        for (int k = 0; k < 4; ++k) {
            const float ylo = w0[2 * k] * (bflo(c2w[k]) * bflo(x2w[k])) + w1[2 * k] * (bflo(c1w[k]) * bflo(x1w[k])) + w2[2 * k] * (bflo(c0w[k]) * bflo(x0w[k]));
            const float yhi = w0[2 * k + 1] * (bfhi(c2w[k]) * bfhi(x2w[k])) + w1[2 * k + 1] * (bfhi(c1w[k]) * bfhi(x1w[k])) + w2[2 * k + 1] * (bfhi(c0w[k]) * bfhi(x0w[k]));
            ow[k] = pk2(bflo(bgw[k]) * ylo, bfhi(bgw[k]) * yhi); }
        *(v4u*)(mix + (size_t)row * ODD_OUT + 768 + c) = (v4u){ow[0], ow[1], ow[2], ow[3]};
    }
}

constexpr int CW_QMOBA = 8192;
__device__ __forceinline__ void moba_phase(Frame& F, int lp, bf16* mix) {
    unsigned char* ws = F.ws; const bf16* Qm = (const bf16*)(ws + WS_P + P_QM); const bf16* Km = (const bf16*)(ws + WS_P + P_KM); const bf16* Vm = (const bf16*)(ws + WS_P + P_VM);
    const float* km = (const float*)(ws + WS_CTL + CTL_KMSUM + (size_t)(lp & 1) * KMSUM_BYTES);
    char* shm = (char*)F.lds + RING_OFF; LAS unsigned char* l3 = F.lds + RING_OFF;
    LAS float* kml = (LAS float*)(l3 + att::LDS_KM); volatile LAS int* tkw = (volatile LAS int*)(l3 + att::LDS_TK);
    unsigned* head = (unsigned*)(F.ctl + CW_QMOBA + 64 * lp);
    const int tid = F.tid, wid = F.wave;
    for (;;) {
        if (tid == 0) { unsigned* hp = head; asm volatile("" : "+v"(hp)); tkw[0] = (int)__hip_atomic_fetch_add(hp, 1u, __ATOMIC_RELAXED, __HIP_MEMORY_SCOPE_AGENT); }
        __syncthreads();
        const int tk = __builtin_amdgcn_readfirstlane(tkw[0]);
        if (tk >= 48 * 16) break;
        const int qb = 15 - tk / 48, bh = tk % 48, b = bh / 12, h = bh % 12;
        int lane_ = F.lane; asm volatile("" : "+v"(lane_)); const int r32 = lane_ & 31, hi = lane_ >> 5;
        ((LAS v2u*)kml)[tid] = ((const v2u*)(km + (size_t)bh * 1024))[tid];
        __syncthreads();
        unsigned sel = 0u;
        { const bf16* qrow = Qm + ((size_t)bh * SEQ + qb * 256 + wid * 32 + r32) * 64 + hi * 8;
          float qf[32];
#pragma unroll
          for (int d0 = 0; d0 < 4; ++d0) { const v4u w = *(const v4u*)(qrow + d0 * 16);
              qf[8 * d0 + 0] = bflo(w.x); qf[8 * d0 + 1] = bfhi(w.x); qf[8 * d0 + 2] = bflo(w.y); qf[8 * d0 + 3] = bfhi(w.y); qf[8 * d0 + 4] = bflo(w.z); qf[8 * d0 + 5] = bfhi(w.z); qf[8 * d0 + 6] = bflo(w.w); qf[8 * d0 + 7] = bfhi(w.w); }
          float v1 = -INFINITY, v2 = -INFINITY, v3 = -INFINITY; int i1 = 0, i2 = 0, i3 = 0;
          for (int n = 0; n < qb; ++n) { float a = 0.f;
#pragma unroll
              for (int d0 = 0; d0 < 4; ++d0) { const f32x4 k0 = *(const LAS f32x4*)(kml + n * 64 + d0 * 16 + hi * 8), k1 = *(const LAS f32x4*)(kml + n * 64 + d0 * 16 + hi * 8 + 4);
                  a += qf[8 * d0 + 0] * k0.x + qf[8 * d0 + 1] * k0.y + qf[8 * d0 + 2] * k0.z + qf[8 * d0 + 3] * k0.w + qf[8 * d0 + 4] * k1.x + qf[8 * d0 + 5] * k1.y + qf[8 * d0 + 6] * k1.z + qf[8 * d0 + 7] * k1.w; }
              a = xsum32(a);
              if (a > v1) { v3 = v2; i3 = i2; v2 = v1; i2 = i1; v1 = a; i1 = n; } else if (a > v2) { v3 = v2; i3 = i2; v2 = a; i2 = n; } else if (a > v3) { v3 = a; i3 = n; } }
          if (v1 > -INFINITY) sel |= 1u << i1; if (v2 > -INFINITY) sel |= 1u << i2; if (v3 > -INFINITY) sel |= 1u << i3; }
        const size_t sb = (size_t)bh * SEQ * 64;
        att::attn_unit<0, 8, ODD_OUT>(Qm + sb, qb * 256, 0, 4 * (qb + 1), sel, mix + ((size_t)b * SEQ + qb * 256) * ODD_OUT + h * 64, nullptr, shm, tid);
    }
    __syncthreads();
}
__device__ __forceinline__ void banded_phase(Frame& F) {
    unsigned char* ws = F.ws; const bf16* Qs = (const bf16*)(ws + WS_P + P_QS); const bf16* Ks = (const bf16*)(ws + WS_P + P_KS); const bf16* Vs = (const bf16*)(ws + WS_P + P_VS);
    bf16* OG = (bf16*)(ws + WS_HID + H_OG); float* LSE = (float*)(ws + WS_HID + H_LSE);
    char* shm = (char*)F.lds + RING_OFF;
    for (int u = F.blk; u < 768; u += F.G) {
        const int g = u >> 8, rem = u & 255, b = rem >> 6, hg = (rem >> 4) & 3, u16 = rem & 15, h = g * 4 + hg, bh = b * 12 + h;
        const int dil = g == 0 ? 1 : (g == 1 ? 4 : 16), L = SEQ / dil, row0 = 256 * u16, r = row0 / L, q0s = row0 % L;
        const int tile0 = (q0s >> 6) >= 2 ? (q0s >> 6) - 2 : 0, NT = (q0s >> 6) + 4 - tile0;
        const size_t sb = ((size_t)bh * SEQ + (size_t)r * L) * 64;
        const size_t orow = ((size_t)g * 16 + b * 4 + hg) * SEQ + row0;
        att::attn_unit<1, 8, 64>(Qs + sb, q0s, tile0, NT, 0u, OG + orow * 64, LSE + orow, shm, F.tid);
    }
    __syncthreads();
}

constexpr int PH_PER_PAIR = 14, NPH = 1 + 2 * PH_PER_PAIR + 1;
__global__ void __launch_bounds__(NWAVES * 64, 2) fwd(Args args) {
    extern __shared__ __attribute__((aligned(16))) unsigned char lds[];
    const int wv0 = __builtin_amdgcn_readfirstlane((int)threadIdx.x >> 6);
#define MKFRAME() Frame F; { int t_ = TID_NOW(wv0); asm volatile("" : "+v"(t_)); int b_ = blockIdx.x; asm volatile("" : "+s"(b_)); \
    F.lds = (LAS unsigned char*)lds; F.MISC = (volatile LAS unsigned*)(F.lds + MISC_OFF); F.tid = t_; F.lane = t_ & 63; F.wave = __builtin_amdgcn_readfirstlane(t_ >> 6); \
    const __attribute__((address_space(4))) Args* ap = (const __attribute__((address_space(4))) Args*)__builtin_amdgcn_kernarg_segment_ptr(); asm volatile("" : "+s"(ap));     \
    unsigned char* w_ = ap->ws; asm volatile("" : "+s"(w_)); F.G = gridDim.x; F.blk = b_; F.ws = w_; F.out = ap->out; F.ctl = (gu32*)(w_ + WS_CTL); F.ap = ap; }
    for (int u = TID_NOW(wv0); u < (LDS_BYTES - LDSCTL_OFF) / 4; u += NWAVES * 64) ((LAS unsigned*)((LAS unsigned char*)lds + LDSCTL_OFF))[u] = 0u;
    __syncthreads();
    const int lo = args.ph_lo, hi = args.ph_hi;
    XcdBarrier bar; bar.bar = (unsigned*)(args.ws + WS_CTL) + CW_BAR; bar.x = 0; bar.st = nullptr;
    if (hi - lo > 1) bar = xcd_barrier_post((unsigned*)(args.ws + WS_CTL) + CW_BAR, (volatile LAS unsigned*)((LAS unsigned char*)lds + MISC_OFF) + 8, TID_NOW(wv0));
#ifndef PHMASK
#define PHMASK 0xFFFFFF
#endif
#define PHEN(k) (((PHMASK) >> (k)) & 1)
#ifndef PROBE_REP
#define PROBE_REP 0
#endif
#define NREP(k) ((((PROBE_REP) >> (k)) & 1) + 1)
#define IN(k) (lo <= (k) && (k) < hi)
#define SEAM(k) do { if (IN(k) && IN((k) + 1)) xcd_barrier(bar, TID_NOW(wv0)); } while (0)
#define HN ((bf16*)(F.ws + WS_HN))
#define MIX ((bf16*)(F.ws + WS_MIX))
#define HID ((bf16*)(F.ws + WS_HID))
#define RAWP ((bf16*)(F.ws + WS_HID + H_RAWP))
#define HSORT ((bf16*)(F.ws + WS_P))
#define YB ((bf16*)(F.ws + WS_P))
#define x_in (F.ap->in[0])

    if (PHEN(19) && IN(0)) { for (int rep_ = 0; rep_ < NREP(19); ++rep_) { MKFRAME(); p0_prologue(F, args); } SEAM(0); }

    for (int lp = 0; lp < 2; ++lp) {
        const int pb = 1 + lp * PH_PER_PAIR;
        const int le = 2 * lp, lo_ = 2 * lp + 1;
#define we ((const pg8::bf16_t*)(F.ws + WS_WT_EVEN0 + (size_t)lp * WT_EVEN_BYTES))
#define wo ((const pg8::bf16_t*)(F.ws + WS_WT_ODD0 + (size_t)lp * WT_ODD_BYTES))
        if (lp != 0 && PHEN(0) && IN(pb + 0)) { { MKFRAME();
            xstats_phase(F, F.out, F.out, HN, true, true); } SEAM(pb + 0); }
        if (PHEN(1) && IN(pb + 1)) { for (int rep_ = 0; rep_ < NREP(1); ++rep_) { MKFRAME();
            pg8::Gemm g{HN, we + WTE_IN / 2, T, EVEN_IN, D}; pg8::StaticOrder S; S.init(T, EVEN_IN, F.G, F.blk);
            { LAS float* gt = (LAS float*)(F.lds + pg8::GAIN_TAB_OFF);
              if (F.tid < 256) gt[F.tid] = (F.ap->in[4] + (size_t)lp * 256)[F.tid]; else if (F.tid < 320) gt[F.tid] = (F.ap->in[7] + (size_t)lp * 64)[F.tid - 256]; else if (F.tid < 384) gt[F.tid] = (F.ap->in[8] + (size_t)lp * 64)[F.tid - 320];
              __syncthreads(); }
            pg8::EpiHeadsEven E{(bf16*)(F.ws + WS_P + P_UV), (bf16*)(F.ws + WS_P + P_QS), F.ap->in[4] + (size_t)lp * 256, F.ap->in[7] + (size_t)lp * 64, F.ap->in[8] + (size_t)lp * 64,
                                (const float*)(F.ws + WS_ROPE), (const float*)(F.ws + WS_ROPE) + SEQ * 32, (const float*)(F.ws + WS_SSP), (const LAS float*)(F.lds + pg8::GAIN_TAB_OFF)};
            pg8::gemm_phase<pg8::EpiHeadsEven, pg8::StaticOrder>(F.lds + RING_OFF, g, S, E, F.tid);
            } SEAM(pb + 1); }
        if (PHEN(2) && IN(pb + 2)) { for (int rep_ = 0; rep_ < NREP(2); ++rep_) { MKFRAME(); banded_phase(F); gmlp_phase(F, lp, F.ap->in[6] + (size_t)lp * 4 * 128, MIX); } SEAM(pb + 2); }
        if (PHEN(3) && IN(pb + 3)) { for (int rep_ = 0; rep_ < NREP(3); ++rep_) { MKFRAME(); merge_even(F, MIX); } SEAM(pb + 3); }
        if (PHEN(4) && IN(pb + 4)) { { MKFRAME();
            pg8::Gemm g{MIX, we + WTE_OUT / 2, T, D, EVEN_OUT}; pg8::StaticOrder S; S.init(T, D, F.G, F.blk);
            pg8::EpiResX E{lp == 0 ? x_in : F.out, F.out, HN, (float*)(F.ws + WS_SSP), D, 1.0f};
            pg8::gemm_phase<pg8::EpiResX, pg8::StaticOrder>(F.lds + RING_OFF, g, S, E, F.tid);
            } SEAM(pb + 4); }
        if (PHEN(5) && IN(pb + 5)) { for (int rep_ = 0; rep_ < NREP(5); ++rep_) { MKFRAME();
            pg8::Gemm g{HN, we + WTE_GU / 2, T, 2 * DFF, D}; pg8::StaticOrder S; S.init(T, 2 * DFF, F.G, F.blk);
            pg8::EpiSwiGLU E{HID, DFF, 1.0f, (const float*)(F.ws + WS_SSP)};
            pg8::gemm_phase<pg8::EpiSwiGLU, pg8::StaticOrder>(F.lds + RING_OFF, g, S, E, F.tid);
            } SEAM(pb + 5); }
        if (PHEN(6) && IN(pb + 6)) { { MKFRAME();
            pg8::Gemm g{HID, we + WTE_DN / 2, T, D, DFF}; pg8::StaticOrder S; S.init(T, D, F.G, F.blk);
            pg8::EpiResX E{F.out, F.out, HN, (float*)(F.ws + WS_SSP), D, 1.0f};
            pg8::gemm_phase<pg8::EpiResX, pg8::StaticOrder>(F.lds + RING_OFF, g, S, E, F.tid);
            } SEAM(pb + 6); }
        if (PHEN(7) && IN(pb + 7)) { for (int rep_ = 0; rep_ < NREP(7); ++rep_) { MKFRAME();
            pg8::Gemm g{HN, wo + WTO_IN / 2, T, ODD_IN, D}; pg8::StaticOrder S; S.init(T, ODD_IN, F.G, F.blk);
            { LAS float* gt = (LAS float*)(F.lds + pg8::GAIN_TAB_OFF);
              if (F.tid >= 256 && F.tid < 320) gt[F.tid] = (F.ap->in[14] + (size_t)lp * 64)[F.tid - 256]; else if (F.tid >= 320 && F.tid < 384) gt[F.tid] = (F.ap->in[15] + (size_t)lp * 64)[F.tid - 320];
              __syncthreads(); }
            pg8::EpiHeadsOdd E{(bf16*)(F.ws + WS_P + P_QM), (bf16*)(F.ws + WS_P + P_CONV), (float*)(F.ws + WS_CTL + CTL_KMSUM + (size_t)lp * KMSUM_BYTES),
                               F.ap->in[14] + (size_t)lp * 64, F.ap->in[15] + (size_t)lp * 64, (const float*)(F.ws + WS_ROPE), (const float*)(F.ws + WS_ROPE) + SEQ * 32, (const float*)(F.ws + WS_SSP), (const LAS float*)(F.lds + pg8::GAIN_TAB_OFF)};
            pg8::gemm_phase<pg8::EpiHeadsOdd, pg8::StaticOrder>(F.lds + RING_OFF, g, S, E, F.tid);
            } SEAM(pb + 7); }
        if (PHEN(8) && IN(pb + 8)) { for (int rep_ = 0; rep_ < NREP(8); ++rep_) { MKFRAME(); moba_phase(F, lp + 2 * rep_, MIX); conv_phase(F, (const bf16*)(F.ws + WS_P + P_CONV), F.ap->in[16] + (size_t)lp * 3 * 256, MIX); } SEAM(pb + 8); }
        if (PHEN(9) && IN(pb + 9)) { { MKFRAME();
            pg8::Gemm g{MIX, wo + WTO_OUT / 2, T, D, ODD_OUT}; pg8::StaticOrder S; S.init(T, D, F.G, F.blk);
            pg8::EpiResX E{F.out, F.out, HN, (float*)(F.ws + WS_SSP), D, 1.0f};
            pg8::gemm_phase<pg8::EpiResX, pg8::StaticOrder>(F.lds + RING_OFF, g, S, E, F.tid);
            } SEAM(pb + 9); }
        if (PHEN(10) && IN(pb + 10)) { for (int rep_ = 0; rep_ < NREP(10); ++rep_) { MKFRAME(); router_phase(F, HN, F.ap->in[2] + (size_t)lo_ * D, F.ap->in[18] + (size_t)lp * D * NEXP); } SEAM(pb + 10); }
        if (PHEN(11) && IN(pb + 11)) { for (int rep_ = 0; rep_ < NREP(11); ++rep_) { MKFRAME(); route_phase(F, HN, HSORT, F.ap->in[2] + (size_t)lo_ * D); } SEAM(pb + 11); }
        if (PHEN(12) && IN(pb + 12)) { for (int rep_ = 0; rep_ < NREP(12); ++rep_) { MKFRAME();
            const int* tbp = (const int*)(F.ws + WS_MISC + 512 * 1024);
            pg8::MoeOrder S; const int ntiles = __builtin_amdgcn_readfirstlane(tbp[8]); S.init(ntiles * 256, 2 * DFFE, F.G, F.blk);
#pragma unroll
            for (int k = 0; k < 8; ++k) S.tb[k] = __builtin_amdgcn_readfirstlane(tbp[k]);
            S.estride = (size_t)2 * DFFE * D;
            pg8::Gemm g{HSORT, wo + WTO_MGU / 2, ntiles * 256, 2 * DFFE, D};
            pg8::EpiSwiGLU8 E{(unsigned char*)HID, DFFE, 1.0f / W8_SCALE, H8_SCALE};
            pg8::gemm_phase<pg8::EpiSwiGLU8, pg8::MoeOrder, false, true, true>(F.lds + RING_OFF, g, S, E, F.tid);
            } SEAM(pb + 12); }
        if (PHEN(13) && IN(pb + 13)) { for (int rep_ = 0; rep_ < NREP(13); ++rep_) { MKFRAME();
            const int* tbp = (const int*)(F.ws + WS_MISC + 512 * 1024);
            pg8::MoeOrder S; const int ntiles = __builtin_amdgcn_readfirstlane(tbp[8]); S.init(ntiles * 256, D, F.G, F.blk);
#pragma unroll
            for (int k = 0; k < 8; ++k) S.tb[k] = __builtin_amdgcn_readfirstlane(tbp[k]);
            S.estride = (size_t)DFFE * D;
            pg8::Gemm g{HID, wo + WTO_MD / 2, ntiles * 256, D, DFFE};
            pg8::EpiBf16PlainPP E{YB, D, 1.0f / (W8_SCALE * H8_SCALE)};
            pg8::gemm_phase<pg8::EpiBf16PlainPP, pg8::MoeOrder, false, true, true>(F.lds + RING_OFF, g, S, E, F.tid);
            } SEAM(pb + 13); }
    }
    if (PHEN(20) && IN(NPH - 1)) { MKFRAME(); xstats_phase(F, F.out, F.out, HN, true, false); }
#undef IN
#undef SEAM
#undef HN
#undef MIX
#undef HID
#undef RAWP
#undef HSORT
#undef YB
#undef x_in
#undef we
#undef wo
}

extern "C" void kernel_launch(void* const* d_in, const int* in_sizes, int n_in, void* d_out, int out_size, void* d_ws, size_t ws_size, hipStream_t stream) {
    static int grid = 0;
    if (grid == 0) {
        if (n_in != 22 || out_size != T * D || ws_size < WS_END) { fprintf(stderr, "kernel_launch: unexpected shapes (n_in %d out %d ws %zu)\n", n_in, out_size, ws_size); grid = -1; return; }
        int dev = 0, cus = 0, per_cu = 0;
        if (hipGetDevice(&dev) != hipSuccess || hipDeviceGetAttribute(&cus, hipDeviceAttributeMultiprocessorCount, dev) != hipSuccess) { grid = -1; return; }
        if (hipFuncSetAttribute((const void*)fwd, hipFuncAttributeMaxDynamicSharedMemorySize, LDS_BYTES) != hipSuccess) { fprintf(stderr, "kernel_launch: hipFuncSetAttribute failed\n"); grid = -1; return; }
        if (hipOccupancyMaxActiveBlocksPerMultiprocessor(&per_cu, (const void*)fwd, NWAVES * 64, LDS_BYTES) != hipSuccess || per_cu < 1) fprintf(stderr, "kernel_launch: occupancy query says %d\n", per_cu);
        (void)hipGetLastError();
        grid = cus;
    }
    if (grid < 0) return;
    (void)hipMemsetAsync((char*)d_ws + WS_CTL, 0, CTL_ZERO_BYTES, stream);
    Args a{};
    for (int i = 0; i < 22; ++i) a.in[i] = (const float*)d_in[i];
    a.out = (float*)d_out; a.ws = (unsigned char*)d_ws;
#if MK_PER_PHASE
    for (int p = 0; p < NPH; ++p) { a.ph_lo = p; a.ph_hi = p + 1; hipLaunchKernelGGL(fwd, dim3(grid), dim3(NWAVES * 64), LDS_BYTES, stream, a); }
#else
    a.ph_lo = 0; a.ph_hi = NPH; hipLaunchKernelGGL(fwd, dim3(grid), dim3(NWAVES * 64), LDS_BYTES, stream, a);
#endif
}
```

```cpp
#include <hip/hip_runtime.h>
#include <cstdio>
#include <cstdint>
#include <type_traits>
#include <hip/hip_bf16.h>


template <int X> __device__ __forceinline__ float xswz(float v) { return __builtin_bit_cast(float, __builtin_amdgcn_ds_swizzle(__builtin_bit_cast(int, v), (X << 10) | 0x1F)); }
template <int X> __device__ __forceinline__ int xswzi(int v) { return __builtin_amdgcn_ds_swizzle(v, (X << 10) | 0x1F); }
__device__ __forceinline__ float xsum32(float v) { float a = v, b = v; asm("s_nop 1\n\tv_permlane32_swap_b32_e32 %0, %1" : "+v"(a), "+v"(b)); return a + b; }
__device__ __forceinline__ int xsum32i(int v) { int a = v, b = v; asm("s_nop 1\n\tv_permlane32_swap_b32_e32 %0, %1" : "+v"(a), "+v"(b)); return a + b; }
__device__ __forceinline__ float xmax32(float v) { float a = v, b = v; asm("s_nop 1\n\tv_permlane32_swap_b32_e32 %0, %1" : "+v"(a), "+v"(b)); return fmaxf(a, b); }


__device__ __forceinline__ int lane_hw() { int l; asm volatile("v_mbcnt_lo_u32_b32 %0, -1, 0\n\tv_mbcnt_hi_u32_b32 %0, -1, %0" : "=v"(l)); return l; }
#define TID_NOW(wv) ((wv) * 64 + lane_hw())

#ifndef NAIVE_MOBA
#define NAIVE_MOBA 0
#endif
#ifndef NAIVE_BANDED
#define NAIVE_BANDED 0
#endif
#ifndef Q_INPROJ
#define Q_INPROJ 2
#endif
#ifndef Q_FFN
#define Q_FFN 2
#endif
#ifndef MK_PER_PHASE
#define MK_PER_PHASE 0
#endif

namespace pg8 {
#define PG8_LAS __attribute__((address_space(3)))
typedef unsigned short bf16_t;
typedef short bf16x8 __attribute__((ext_vector_type(8)));
typedef float f32x4 __attribute__((ext_vector_type(4)));
typedef float f32x2 __attribute__((ext_vector_type(2)));
typedef unsigned u32x4 __attribute__((ext_vector_type(4)));
constexpr int BM = 256, BK = 64, HALF = 128, HTB = HALF * BK * 2, STAGE_BYTES = 8 * HTB, NXCD = 8, WGM = 8;
constexpr int GAIN_TAB_OFF = STAGE_BYTES + 1024 + 2048;
constexpr int RS_TAB_OFF = STAGE_BYTES + 1024;

__host__ __device__ __forceinline__ int lds_byte(int r, int c) { const int st = (r >> 4) * 2 + (c >> 5), rr = r & 15, cc = c & 31, ob = rr * 64 + cc * 2; return st * 1024 + (ob ^ (((ob >> 9) & 1) << 5)); }
__host__ __device__ __forceinline__ void stage_rc(int b, int& R, int& C) { const int st = b / 1024, sb = b % 1024, swz = sb ^ (((sb >> 9) & 1) << 5); R = (st >> 1) * 16 + swz / 64; C = (st & 1) * 32 + (swz % 64) / 2; }
__host__ __device__ __forceinline__ int perm32(int rho) { const int n = rho >> 4, i = rho & 15; return 8 * (i >> 2) + 4 * n + (i & 3); }

struct Unit { int pm, pn; };
struct Gemm { const bf16_t* A; const bf16_t* Bt; int M, N, K; };

struct StaticOrder {
    int nM, nN, nwg, G, c;
    __device__ void init(int M, int N, int G_, int c_) { nM = M / BM; nN = N / BM; nwg = nM * nN; G = G_; c = c_; }
    __device__ bool next(int i, Unit& u) const {
        const long L = (long)i * G + c; if (L >= nwg) return false;
        int wgid = (int)L; { const int q = nwg / NXCD, r = nwg % NXCD, xcd = wgid % NXCD, off = wgid / NXCD; wgid = (xcd < r ? xcd * (q + 1) : r * (q + 1) + (xcd - r) * q) + off; }
        const int nig = WGM * nN, gid = wgid / nig, fm = gid * WGM, gsz = (nM - fm) < WGM ? (nM - fm) : WGM;
        u.pm = fm + ((wgid % nig) % gsz); u.pn = (wgid % nig) / gsz; return true;
    }
    __device__ __forceinline__ const char* bbase(const Unit&, const bf16_t* Bt) const { return (const char*)Bt; }
};
struct MoeOrder : StaticOrder {
    int tb[8]; size_t estride;
    __device__ __forceinline__ const char* bbase(const Unit& u, const bf16_t* Bt) const {
        unsigned e = 0;
#pragma unroll
        for (int k = 1; k < 8; ++k) e += ((unsigned)(tb[k] - 1 - u.pm)) >> 31;
        return (const char*)Bt + (size_t)e * estride;
    }
};

__device__ __forceinline__ unsigned cvt_pk_bf16(float lo, float hi) { unsigned r; asm volatile("v_cvt_pk_bf16_f32 %0, %1, %2" : "=v"(r) : "v"(lo), "v"(hi)); return r; }

struct EpiBf16Plain {
    static constexpr bool PERM = true; static constexpr bool NEEDS_RS = false;
    bf16_t* O; int ldc; float sc;
    __device__ __forceinline__ void operator()(const f32x4 (&acc)[2][2][4][2], const Unit& u, int wr, int wc, int fr, int fq) const {
        const int row0 = u.pm * BM + wr * 64 + fr, col0 = u.pn * BM + wc * 32 + 8 * fq;
#pragma unroll
        for (int ai = 0; ai < 2; ++ai)
#pragma unroll
            for (int m = 0; m < 4; ++m) { bf16_t* rowp = O + (size_t)(row0 + ai * HALF + m * 16) * ldc + col0;
#pragma unroll
                for (int bj = 0; bj < 2; ++bj) { const f32x4 v0 = acc[ai][bj][m][0] * sc, v1 = acc[ai][bj][m][1] * sc;
                    u32x4 w; w.x = cvt_pk_bf16(v0[0], v0[1]); w.y = cvt_pk_bf16(v0[2], v0[3]); w.z = cvt_pk_bf16(v1[0], v1[1]); w.w = cvt_pk_bf16(v1[2], v1[3]);
                    *(u32x4*)(rowp + bj * HALF) = w; } }
    }
};
struct EpiF32Res {
    static constexpr bool PERM = false; static constexpr bool NEEDS_RS = false;
    const float* base; float* out; int ldc;
    __device__ __forceinline__ void operator()(const f32x4 (&acc)[2][2][4][2], const Unit& u, int wr, int wc, int fr, int fq) const {
        const int row0 = u.pm * BM + wr * 64 + fr, col0 = u.pn * BM + wc * 32 + 4 * fq;
#pragma unroll
        for (int ai = 0; ai < 2; ++ai)
#pragma unroll
            for (int m = 0; m < 4; ++m) { const size_t off = (size_t)(row0 + ai * HALF + m * 16) * ldc + col0;
#pragma unroll
                for (int bj = 0; bj < 2; ++bj)
#pragma unroll
                    for (int n = 0; n < 2; ++n) { const f32x4 bs = *(const f32x4*)(base + off + bj * HALF + n * 16); *(f32x4*)(out + off + bj * HALF + n * 16) = bs + acc[ai][bj][m][n]; }
                asm volatile("" ::: "memory"); }
    }
};
struct EpiBf16PlainPP {
    static constexpr bool PERM = false; static constexpr bool NEEDS_RS = false;
    bf16_t* O; int ldc; float sc;
    __device__ __forceinline__ void operator()(const f32x4 (&acc)[2][2][4][2], const Unit& u, int wr, int wc, int fr, int fq) const {
        const int row0 = u.pm * BM + wr * 64 + fr, col0 = u.pn * BM + wc * 32 + 8 * fq;
#pragma unroll
        for (int ai = 0; ai < 2; ++ai)
#pragma unroll
            for (int m = 0; m < 4; ++m) { bf16_t* rowp = O + (size_t)(row0 + ai * HALF + m * 16) * ldc + col0;
#pragma unroll
                for (int bj = 0; bj < 2; ++bj) { const f32x4 v0 = acc[ai][bj][m][0] * sc, v1 = acc[ai][bj][m][1] * sc;
                    u32x4 w; w.x = cvt_pk_bf16(v0[0], v0[1]); w.y = cvt_pk_bf16(v0[2], v0[3]); w.z = cvt_pk_bf16(v1[0], v1[1]); w.w = cvt_pk_bf16(v1[2], v1[3]);
                    *(u32x4*)(rowp + bj * HALF) = w; } }
    }
};

struct EpiResX {
    static constexpr bool PERM = false; static constexpr bool NEEDS_RS = false;
    const float* base; float* out; bf16_t* xb; float* ssp; int ldc; float sc;
    __device__ __forceinline__ void operator()(const f32x4 (&acc)[2][2][4][2], const Unit& u, int wr, int wc, int fr, int fq) const {
        const int row0 = u.pm * BM + wr * 64 + fr, col0 = u.pn * BM + wc * 32 + 4 * fq;
        typedef unsigned u32x2 __attribute__((ext_vector_type(2)));
#pragma unroll
        for (int ai = 0; ai < 2; ++ai) {
            f32x4 bs[4][2][2];
#pragma unroll
            for (int m = 0; m < 4; ++m)
#pragma unroll
                for (int bj = 0; bj < 2; ++bj)
#pragma unroll
                    for (int n = 0; n < 2; ++n) bs[m][bj][n] = *(const f32x4*)(base + (size_t)(row0 + ai * HALF + m * 16) * ldc + col0 + bj * HALF + n * 16);
#pragma unroll
            for (int m = 0; m < 4; ++m) { const int row = row0 + ai * HALF + m * 16; const size_t off = (size_t)row * ldc + col0; float ss = 0.f;
#pragma unroll
                for (int bj = 0; bj < 2; ++bj)
#pragma unroll
                    for (int n = 0; n < 2; ++n) { const f32x4 o = bs[m][bj][n] + acc[ai][bj][m][n] * sc;
                        *(f32x4*)(out + off + bj * HALF + n * 16) = o; ss += (o[0] * o[0] + o[1] * o[1]) + (o[2] * o[2] + o[3] * o[3]);
                        u32x2 w; w.x = cvt_pk_bf16(o[0], o[1]); w.y = cvt_pk_bf16(o[2], o[3]); *(u32x2*)(xb + off + bj * HALF + n * 16) = w; }
                ss += xswz<16>(ss); ss = xsum32(ss);
                if (fq == 0) ssp[(size_t)row * 16 + u.pn * 4 + wc] = ss; }
            asm volatile("" ::: "memory"); }
    }
};
__device__ __forceinline__ float rstd_finish(f32x4 p) { float s = (p[0] + p[1]) + (p[2] + p[3]); s += xswz<16>(s); s = xsum32(s); return 1.0f / sqrtf(s * (1.0f / 1024.0f) + 1e-6f); }
__device__ __forceinline__ void rstd8(const float* ssp, int row0, int fq, float (&rs)[8]) {
    f32x4 p[8];
#pragma unroll
    for (int k = 0; k < 8; ++k) p[k] = *(const f32x4*)(ssp + (size_t)(row0 + (k >> 2) * HALF + (k & 3) * 16) * 16 + 4 * fq);
#pragma unroll
    for (int k = 0; k < 8; ++k) rs[k] = rstd_finish(p[k]);
}
__device__ __forceinline__ float silu_mul(float g, float u) { return g * __builtin_amdgcn_rcpf(1.0f + __builtin_amdgcn_exp2f(-1.4426950408889634f * g)) * u; }
struct EpiSwiGLU {
    static constexpr bool PERM = true; static constexpr bool NEEDS_RS = true;
    bf16_t* O; int ldc; float sc; const float* ssp;
    __device__ __forceinline__ void operator()(const f32x4 (&acc)[2][2][4][2], const Unit& u, int wr, int wc, int fr, int fq, const PG8_LAS float* rs) const {
        const int row0 = u.pm * BM + wr * 64 + fr, col0 = u.pn * HALF + wc * 32 + 8 * fq;
        float rs8[8];
#pragma unroll
        for (int k = 0; k < 8; ++k) rs8[k] = rs[(k >> 2) * HALF + wr * 64 + (k & 3) * 16 + fr];
#pragma unroll
        for (int ai = 0; ai < 2; ++ai)
#pragma unroll
            for (int m = 0; m < 4; ++m) { bf16_t* rowp = O + (size_t)(row0 + ai * HALF + m * 16) * ldc + col0;
                const float rs = sc * rs8[ai * 4 + m];
                const f32x4 g0 = acc[ai][0][m][0] * rs, g1 = acc[ai][0][m][1] * rs, u0 = acc[ai][1][m][0] * rs, u1 = acc[ai][1][m][1] * rs;
                u32x4 w; w.x = cvt_pk_bf16(silu_mul(g0[0], u0[0]), silu_mul(g0[1], u0[1])); w.y = cvt_pk_bf16(silu_mul(g0[2], u0[2]), silu_mul(g0[3], u0[3]));
                w.z = cvt_pk_bf16(silu_mul(g1[0], u1[0]), silu_mul(g1[1], u1[1])); w.w = cvt_pk_bf16(silu_mul(g1[2], u1[2]), silu_mul(g1[3], u1[3]));
                *(u32x4*)rowp = w; }
    }
};


__device__ __forceinline__ float gelu_t(float x) { const float y2 = 1.5957691216057308f * (x + 0.044715f * x * x * x); return x * __builtin_amdgcn_rcpf(1.0f + __builtin_amdgcn_exp2f(-1.4426950408889634f * y2)); }
__device__ __forceinline__ void st8(bf16_t* p, const float (&v)[8]) { u32x4 w; w.x = cvt_pk_bf16(v[0], v[1]); w.y = cvt_pk_bf16(v[2], v[3]); w.z = cvt_pk_bf16(v[4], v[5]); w.w = cvt_pk_bf16(v[6], v[7]); *(u32x4*)p = w; }
__device__ __forceinline__ int srow_g(int s, int g) { return g == 0 ? s : (g == 1 ? ((s & 3) * 1024 + (s >> 2)) : ((s & 15) * 256 + (s >> 4))); }
#define PG8_GETROW(x0, x1) do { const f32x4 a0 = acc[ai][0][m][0], a1 = acc[ai][0][m][1], b0 = acc[ai][1][m][0], b1 = acc[ai][1][m][1]; \
    x0[0] = a0[0]; x0[1] = a0[1]; x0[2] = a0[2]; x0[3] = a0[3]; x0[4] = a1[0]; x0[5] = a1[1]; x0[6] = a1[2]; x0[7] = a1[3]; \
    x1[0] = b0[0]; x1[1] = b0[1]; x1[2] = b0[2]; x1[3] = b0[3]; x1[4] = b1[0]; x1[5] = b1[1]; x1[6] = b1[2]; x1[7] = b1[3]; } while (0)
__device__ __forceinline__ void head_norm_rope(float (&x0)[8], float (&x1)[8], const PG8_LAS float* gp, f32x4 c0, f32x4 c1, f32x4 s0, f32x4 s1, float scale) {
    const f32x4 ga = *(const PG8_LAS f32x4*)gp, gb = *(const PG8_LAS f32x4*)(gp + 4), gc = *(const PG8_LAS f32x4*)(gp + 32), gd = *(const PG8_LAS f32x4*)(gp + 36);
    float ss = 0.f;
#pragma unroll
    for (int i = 0; i < 8; ++i) ss += x0[i] * x0[i] + x1[i] * x1[i];
    ss += xswz<16>(ss); ss = xsum32(ss);
    const float rstd = scale / sqrtf(ss * (1.0f / 64.0f) + 1e-6f);
#pragma unroll
    for (int i = 0; i < 8; ++i) { const float a = x0[i] * rstd * (i < 4 ? ga[i & 3] : gb[i & 3]), b = x1[i] * rstd * (i < 4 ? gc[i & 3] : gd[i & 3]); const float c = i < 4 ? c0[i & 3] : c1[i & 3], sv = i < 4 ? s0[i & 3] : s1[i & 3];
        x0[i] = a * c - b * sv; x1[i] = b * c + a * sv; }
}
struct EpiHeadsEven {
    static constexpr bool PERM = false; static constexpr bool NEEDS_RS = true;
    bf16_t* UV; bf16_t* Qs; const float* vgain; const float* qgain; const float* kgain; const float* cs; const float* sn; const float* ssp; const PG8_LAS float* gtab;
    __device__ __forceinline__ void operator()(const f32x4 (&acc)[2][2][4][2], const Unit& u, int wr, int wc, int fr, int fq, const PG8_LAS float* rs) const {
        const int pn = u.pn, row0 = u.pm * BM + wr * 64 + fr;
        const int kind = pn == 0 ? 0 : (pn == 1 ? 1 : (pn < 8 ? 2 : 3));
        const bool isq = pn < 5; const int h = (pn < 5 ? pn - 2 : (pn < 8 ? pn - 5 : pn - 8)) * 4 + wc, grp = h >> 2;
        const PG8_LAS float* gp = gtab + (kind == 1 ? wc * 64 : (isq ? 256 : 320)) + 8 * fq;
        bf16_t* hb = Qs + (kind == 3 ? (size_t)24 * 1024 * 1024 : (isq ? (size_t)0 : (size_t)12 * 1024 * 1024));
        float rs8[8];
#pragma unroll
        for (int k = 0; k < 8; ++k) rs8[k] = rs[(k >> 2) * HALF + wr * 64 + (k & 3) * 16 + fr];
#pragma unroll
        for (int am = 0; am < 4; ++am) { const int ai = am >> 1;
            f32x4 rc[4][4];
            if (kind == 2) {
#pragma unroll
                for (int m = 2 * (am & 1); m < 2 * (am & 1) + 2; ++m) { const int sp = (row0 + ai * HALF + m * 16) & 4095; const float* cp = cs + sp * 32 + 8 * fq; const float* sq_ = sn + sp * 32 + 8 * fq;
                    rc[m][0] = *(const f32x4*)cp; rc[m][1] = *(const f32x4*)(cp + 4); rc[m][2] = *(const f32x4*)sq_; rc[m][3] = *(const f32x4*)(sq_ + 4); } }
#pragma unroll
            for (int m = 2 * (am & 1); m < 2 * (am & 1) + 2; ++m) {
                const int row = row0 + ai * HALF + m * 16, b = row >> 12, s = row & 4095;
                float x0[8], x1[8]; PG8_GETROW(x0, x1);
                { const float rs = rs8[ai * 4 + m];
#pragma unroll
                  for (int i = 0; i < 8; ++i) { x0[i] *= rs; x1[i] *= rs; } }
                if (kind <= 1) {
#pragma unroll
                    for (int i = 0; i < 8; ++i) { x0[i] = gelu_t(x0[i]); x1[i] = gelu_t(x1[i]); }
                    if (kind == 1) { float ss = 0.f;
#pragma unroll
                        for (int i = 0; i < 8; ++i) ss += x0[i] * x0[i] + x1[i] * x1[i];
                        ss += xswz<16>(ss); ss = xsum32(ss);
                        const float rstd = 1.0f / sqrtf(ss * (1.0f / 64.0f) + 1e-6f);
                        { const f32x4 ga = *(const PG8_LAS f32x4*)gp, gb = *(const PG8_LAS f32x4*)(gp + 4), gc = *(const PG8_LAS f32x4*)(gp + 32), gd = *(const PG8_LAS f32x4*)(gp + 36);
#pragma unroll
                        for (int i = 0; i < 8; ++i) { x0[i] *= rstd * (i < 4 ? ga[i & 3] : gb[i & 3]); x1[i] *= rstd * (i < 4 ? gc[i & 3] : gd[i & 3]); } } }
                    bf16_t* d = UV + (size_t)row * 512 + pn * 256 + wc * 64 + 8 * fq; st8(d, x0); st8(d + 32, x1);
                } else {
                    if (kind == 2) head_norm_rope(x0, x1, gp, rc[m][0], rc[m][1], rc[m][2], rc[m][3], isq ? 0.18033688011112042f : 1.0f);
                    bf16_t* d = hb + ((size_t)(b * 12 + h) * 4096 + srow_g(s, grp)) * 64 + 8 * fq; st8(d, x0); st8(d + 32, x1);
                }
            } }
    }
};
struct EpiHeadsOdd {
    static constexpr bool PERM = false; static constexpr bool NEEDS_RS = true;
    bf16_t* Qm; bf16_t* CONV; float* kmsum; const float* qgain; const float* kgain; const float* cs; const float* sn; const float* ssp; const PG8_LAS float* gtab;
    __device__ __forceinline__ void operator()(const f32x4 (&acc)[2][2][4][2], const Unit& u, int wr, int wc, int fr, int fq, const PG8_LAS float* rs) const {
        const int pn = u.pn, row0 = u.pm * BM + wr * 64 + fr;
        const int kind = pn < 6 ? 2 : (pn < 9 ? 3 : 4);
        const bool isq = pn < 3; const int h = (pn % 3) * 4 + wc;
        const PG8_LAS float* gp = gtab + (isq ? 256 : 320) + 8 * fq;
        bf16_t* hb = Qm + (kind == 3 ? (size_t)24 * 1024 * 1024 : (isq ? (size_t)0 : (size_t)12 * 1024 * 1024));
        float rs8[8];
#pragma unroll
        for (int k = 0; k < 8; ++k) rs8[k] = rs[(k >> 2) * HALF + wr * 64 + (k & 3) * 16 + fr];
        float cs0[8], cs1[8];
#pragma unroll
        for (int i = 0; i < 8; ++i) { cs0[i] = 0.f; cs1[i] = 0.f; }
#pragma unroll
        for (int am = 0; am < 4; ++am) { const int ai = am >> 1;
            f32x4 rc[4][4];
            if (kind == 2) {
#pragma unroll
                for (int m = 2 * (am & 1); m < 2 * (am & 1) + 2; ++m) { const int sp = (row0 + ai * HALF + m * 16) & 4095; const float* cp = cs + sp * 32 + 8 * fq; const float* sq_ = sn + sp * 32 + 8 * fq;
                    rc[m][0] = *(const f32x4*)cp; rc[m][1] = *(const f32x4*)(cp + 4); rc[m][2] = *(const f32x4*)sq_; rc[m][3] = *(const f32x4*)(sq_ + 4); } }
#pragma unroll
            for (int m = 2 * (am & 1); m < 2 * (am & 1) + 2; ++m) {
                const int row = row0 + ai * HALF + m * 16, b = row >> 12, s = row & 4095;
                float x0[8], x1[8]; PG8_GETROW(x0, x1);
                { const float rs = rs8[ai * 4 + m];
#pragma unroll
                  for (int i = 0; i < 8; ++i) { x0[i] *= rs; x1[i] *= rs; } }
                if (kind == 4) { bf16_t* d = CONV + (size_t)row * 768 + (pn - 9) * 256 + wc * 64 + 8 * fq; st8(d, x0); st8(d + 32, x1); }
                else {
                    if (kind == 2) { head_norm_rope(x0, x1, gp, rc[m][0], rc[m][1], rc[m][2], rc[m][3], isq ? 0.18033688011112042f : 1.0f);
                        if (!isq) {
#pragma unroll
                            for (int i = 0; i < 8; ++i) { cs0[i] += x0[i]; cs1[i] += x1[i]; } } }
                    bf16_t* d = hb + ((size_t)(b * 12 + h) * 4096 + s) * 64 + 8 * fq; st8(d, x0); st8(d + 32, x1);
                }
            } }
        if (kind == 2 && !isq) {
#pragma unroll
            for (int i = 0; i < 8; ++i) {
                { cs0[i] += xswz<1>(cs0[i]); cs1[i] += xswz<1>(cs1[i]); cs0[i] += xswz<2>(cs0[i]); cs1[i] += xswz<2>(cs1[i]); cs0[i] += xswz<4>(cs0[i]); cs1[i] += xswz<4>(cs1[i]); cs0[i] += xswz<8>(cs0[i]); cs1[i] += xswz<8>(cs1[i]); } }
            if (fr == 0) { const int b = (u.pm * BM) >> 12, blk = u.pm & 15; float* kp = kmsum + ((size_t)(b * 12 + h) * 16 + blk) * 64 + 8 * fq;
#pragma unroll
                for (int i = 0; i < 8; ++i) { atomicAdd(kp + i, cs0[i]); atomicAdd(kp + 32 + i, cs1[i]); } }
        }
    }
};

__device__ __forceinline__ const char* uptr(const char* p) { const unsigned long long b_ = (unsigned long long)p; return (const char*)(((unsigned long long)(unsigned)__builtin_amdgcn_readfirstlane((int)(unsigned)(b_ >> 32)) << 32) | (unsigned)__builtin_amdgcn_readfirstlane((int)(unsigned)b_)); }
__device__ __forceinline__ void glds16s(const void* sbase, unsigned voff, unsigned lds_dst) { unsigned keep;
    asm volatile("s_mov_b32 %0, m0\n\ts_mov_b32 m0, %3\n\ts_nop 0\n\tglobal_load_lds_dwordx4 %1, %2\n\ts_mov_b32 m0, %0" : "=&s"(keep) : "v"(voff), "s"(sbase), "s"(lds_dst) : "memory"); }
typedef int i32x4 __attribute__((ext_vector_type(4)));
typedef int i32x8 __attribute__((ext_vector_type(8)));
__device__ __forceinline__ unsigned pk4_e4m3(float a, float b, float c, float d) {
    a = __builtin_amdgcn_fmed3f(a, -448.f, 448.f); b = __builtin_amdgcn_fmed3f(b, -448.f, 448.f); c = __builtin_amdgcn_fmed3f(c, -448.f, 448.f); d = __builtin_amdgcn_fmed3f(d, -448.f, 448.f);
    int w = __builtin_amdgcn_cvt_pk_fp8_f32(a, b, 0, false); w = __builtin_amdgcn_cvt_pk_fp8_f32(c, d, w, true); return (unsigned)w; }
struct EpiSwiGLU8 {
    static constexpr bool PERM = false; static constexpr bool NEEDS_RS = true;
    unsigned char* O; int ldc; float sc, so; const float* ssp;
    __device__ __forceinline__ void operator()(const f32x4 (&acc)[2][2][4][2], const Unit& u, int wr, int wc, int fr, int fq, const PG8_LAS float* rs) const {
        const int row0 = u.pm * BM + wr * 64 + fr, col0 = u.pn * HALF + wc * 32 + 8 * fq;
#pragma unroll
        for (int ai = 0; ai < 2; ++ai)
#pragma unroll
            for (int m = 0; m < 4; ++m) { unsigned char* rowp = O + (size_t)(row0 + ai * HALF + m * 16) * ldc + col0;
                const float rsc = sc * rs[ai * HALF + wr * 64 + m * 16 + fr];
                const f32x4 g0 = acc[ai][0][m][0] * rsc, g1 = acc[ai][0][m][1] * rsc, u0 = acc[ai][1][m][0] * (rsc * so), u1 = acc[ai][1][m][1] * (rsc * so);
                typedef unsigned u32x2 __attribute__((ext_vector_type(2)));
                u32x2 w; w.x = pk4_e4m3(silu_mul(g0[0], u0[0]), silu_mul(g0[1], u0[1]), silu_mul(g0[2], u0[2]), silu_mul(g0[3], u0[3]));
                w.y = pk4_e4m3(silu_mul(g1[0], u1[0]), silu_mul(g1[1], u1[1]), silu_mul(g1[2], u1[2]), silu_mul(g1[3], u1[3]));
                *(u32x2*)rowp = w; }
    }
};
template <class Epi, class Sched, bool ALIGN_EPI = true, bool SP2 = true, int QM = 0>
__device__ __forceinline__ void gemm_phase(PG8_LAS unsigned char* lds, const Gemm g, const Sched& S, const Epi& E, int tid_in) {
    int tid_ = tid_in; asm volatile("" : "+v"(tid_));
    const int tid = tid_, wid = __builtin_amdgcn_readfirstlane(tid >> 6), lane = tid & 63, wr = wid >> 2, wc = wid & 3, fr = lane & 15, fq = lane >> 4;
    constexpr bool FP8 = (QM == 1);
    const int Kb = QM ? g.K : 2 * g.K, nt = Kb / 128;
    unsigned voffA[2], voffB[2];
#pragma unroll
    for (int i = 0; i < 2; ++i) { int R, C; stage_rc(tid * 16 + i * 8192, R, C); const int Rb = Epi::PERM ? ((R & ~31) + perm32(R & 31)) : R;
        voffA[i] = (unsigned)(R * Kb + 2 * C); voffB[i] = (unsigned)(Rb * Kb + 2 * C); }
    const size_t kstep = (size_t)128;
    const size_t hstep = (size_t)HALF * Kb;
    const size_t tstep = 2 * hstep;
    const unsigned ldsw = (unsigned)wid * 1024u;
    const unsigned lds0 = (unsigned)(uintptr_t)lds;
    const int fcol = FP8 ? (32 * (fq >> 1) + 16 * (fq & 1)) : fq * 8;
    const int aoff = lds_byte(wr * 64 + fr, fcol), boff = lds_byte(wc * 32 + fr, fcol);
#define PG8_SA(b, h) (((b) * 2 + (h)) * HTB)
#define PG8_SB(b, h) ((4 + (b) * 2 + (h)) * HTB)
#define PG8_STAGE(bufoff, gbase, voff) do { _Pragma("unroll") for (int _i = 0; _i < 2; ++_i) \
        glds16s((const void*)(gbase), (voff)[_i], (unsigned)__builtin_amdgcn_readfirstlane((int)(lds0 + (bufoff) + ldsw + _i * 8192))); } while (0)
#define PG8_RD16(p) (*(const PG8_LAS i32x4*)(p))
#define PG8_CAT8(lo, hi) __builtin_shufflevector((lo), (hi), 0, 1, 2, 3, 4, 5, 6, 7)
#define PG8_LDA(dst, b, h) do { if constexpr (FP8) { _Pragma("unroll") for (int m = 0; m < 4; ++m) dst##8[m] = PG8_CAT8(PG8_RD16(lds + PG8_SA(b, h) + aoff + m * 2048), PG8_RD16(lds + PG8_SA(b, h) + aoff + m * 2048 + 16)); } \
        else { _Pragma("unroll") for (int m = 0; m < 4; ++m) _Pragma("unroll") for (int k = 0; k < 2; ++k) dst[m][k] = *(const PG8_LAS bf16x8*)(lds + PG8_SA(b, h) + aoff + m * 2048 + k * 1024); } } while (0)
#define PG8_LDB(dst, b, h) do { if constexpr (FP8) { _Pragma("unroll") for (int n = 0; n < 2; ++n) dst##8[n] = PG8_CAT8(PG8_RD16(lds + PG8_SB(b, h) + boff + n * 2048), PG8_RD16(lds + PG8_SB(b, h) + boff + n * 2048 + 16)); } \
        else { _Pragma("unroll") for (int n = 0; n < 2; ++n) _Pragma("unroll") for (int k = 0; k < 2; ++k) dst[n][k] = *(const PG8_LAS bf16x8*)(lds + PG8_SB(b, h) + boff + n * 2048 + k * 1024); } } while (0)
#define PG8_MMA(ai, bj, At, Bt) do { __builtin_amdgcn_s_setprio(1); \
        if constexpr (FP8) { _Pragma("unroll") for (int m = 0; m < 4; ++m) _Pragma("unroll") for (int n = 0; n < 2; ++n) \
            acc[ai][bj][m][n] = __builtin_amdgcn_mfma_scale_f32_16x16x128_f8f6f4(Bt##8[n], At##8[m], acc[ai][bj][m][n], 0, 0, 0, 0, 0, 0); } \
        else if constexpr (QM == 2) { _Pragma("unroll") for (int m = 0; m < 4; ++m) _Pragma("unroll") for (int n = 0; n < 2; ++n) _Pragma("unroll") for (int k = 0; k < 2; ++k) \
            acc[ai][bj][m][n] = __builtin_bit_cast(f32x4, __builtin_amdgcn_mfma_i32_16x16x64_i8(__builtin_bit_cast(i32x4, Bt[n][k]), __builtin_bit_cast(i32x4, At[m][k]), __builtin_bit_cast(i32x4, acc[ai][bj][m][n]), 0, 0, 0)); } \
        else { _Pragma("unroll") for (int m = 0; m < 4; ++m) _Pragma("unroll") for (int n = 0; n < 2; ++n) _Pragma("unroll") for (int k = 0; k < 2; ++k) \
            acc[ai][bj][m][n] = __builtin_amdgcn_mfma_f32_16x16x32_bf16(Bt[n][k], At[m][k], acc[ai][bj][m][n], 0, 0, 0); } \
        __builtin_amdgcn_s_setprio(0); } while (0)
#define PG8_WAIT_V(n) asm volatile("s_waitcnt vmcnt(" #n ")" ::: "memory")
#define PG8_WAIT_L(n) asm volatile("s_waitcnt lgkmcnt(" #n ")" ::: "memory")
#define PG8_BAR __builtin_amdgcn_s_barrier()
#define PG8_SCHED __builtin_amdgcn_sched_barrier(0)
    Unit cur, nxt; int ui = 0;
    if (!S.next(0, cur)) return;
    f32x4 acc[2][2][4][2];
#pragma unroll
    for (int a = 0; a < 2; ++a)
#pragma unroll
        for (int b = 0; b < 2; ++b)
#pragma unroll
            for (int m = 0; m < 4; ++m)
#pragma unroll
                for (int n = 0; n < 2; ++n) acc[a][b][m][n] = (f32x4){0.f, 0.f, 0.f, 0.f};
    bf16x8 At[4][2], B0[2][2], B1[2][2]; i32x8 At8[4], B08[2], B18[2];
    if constexpr (Epi::NEEDS_RS) { if (tid < 256) ((PG8_LAS float*)(lds + RS_TAB_OFF))[tid] = E.ssp[(size_t)cur.pm * BM + tid]; }
    const char* cA = uptr((const char*)g.A + (size_t)cur.pm * tstep); const char* cB = uptr(S.bbase(cur, g.Bt) + (size_t)cur.pn * tstep);
    if constexpr (SP2) {
        PG8_STAGE(PG8_SB(0, 0), cB, voffB); PG8_STAGE(PG8_SB(0, 1), cB + hstep, voffB); PG8_STAGE(PG8_SA(0, 0), cA, voffA); PG8_STAGE(PG8_SA(0, 1), cA + hstep, voffA);
        if (wr == 1) PG8_BAR;
        PG8_WAIT_V(2); PG8_BAR;
        PG8_STAGE(PG8_SB(1, 0), cB + kstep, voffB); PG8_STAGE(PG8_SA(1, 0), cA + kstep, voffA); PG8_STAGE(PG8_SB(1, 1), cB + hstep + kstep, voffB);
        PG8_WAIT_V(6); PG8_BAR;
    } else {
        PG8_STAGE(PG8_SB(0, 0), cB, voffB); PG8_STAGE(PG8_SA(0, 0), cA, voffA); PG8_STAGE(PG8_SB(0, 1), cB + hstep, voffB); PG8_STAGE(PG8_SA(0, 1), cA + hstep, voffA);
        if (wr == 1) PG8_BAR;
        PG8_WAIT_V(4); PG8_BAR;
        PG8_STAGE(PG8_SB(1, 0), cB + kstep, voffB); PG8_STAGE(PG8_SA(1, 0), cA + kstep, voffA); PG8_STAGE(PG8_SB(1, 1), cB + hstep + kstep, voffB);
        PG8_WAIT_V(6); PG8_BAR;
    }
    for (;;) {
        const bool has_next = S.next(ui + 1, nxt);
        const char* nA = uptr(has_next ? (const char*)g.A + (size_t)nxt.pm * tstep : cA); const char* nB = uptr(has_next ? S.bbase(nxt, g.Bt) + (size_t)nxt.pn * tstep : cB);
        for (int t = 0; t < nt; t += 2) {
            const bool last = (t == nt - 2);
            const char* a1 = cA + (size_t)(t + 1) * kstep;
            const char* a2 = last ? nA : cA + (size_t)(t + 2) * kstep; const char* b2 = last ? nB : cB + (size_t)(t + 2) * kstep;
            const char* a3 = a2 + kstep; const char* b3 = b2 + kstep;
            if constexpr (SP2) {
            PG8_LDB(B0, 0, 0); PG8_LDB(B1, 0, 1); PG8_SCHED; PG8_LDA(At, 0, 0); PG8_STAGE(PG8_SA(1, 1), a1 + hstep, voffA);
            PG8_WAIT_V(8); PG8_WAIT_L(0); PG8_BAR; PG8_MMA(0, 0, At, B0); PG8_MMA(0, 1, At, B1); PG8_BAR; PG8_SCHED;
            PG8_LDA(At, 0, 1); PG8_STAGE(PG8_SB(0, 0), b2, voffB); PG8_STAGE(PG8_SB(0, 1), b2 + hstep, voffB); PG8_STAGE(PG8_SA(0, 0), a2, voffA);
            PG8_WAIT_V(8); PG8_WAIT_L(0); PG8_BAR; PG8_MMA(1, 0, At, B0); PG8_MMA(1, 1, At, B1); PG8_BAR; PG8_SCHED;
            PG8_LDB(B0, 1, 0); PG8_LDB(B1, 1, 1); PG8_SCHED; PG8_LDA(At, 1, 0); PG8_STAGE(PG8_SA(0, 1), a2 + hstep, voffA);
            PG8_WAIT_V(8); PG8_WAIT_L(0); PG8_BAR; PG8_MMA(0, 0, At, B0); PG8_MMA(0, 1, At, B1); PG8_BAR; PG8_SCHED;
            PG8_LDA(At, 1, 1); PG8_STAGE(PG8_SB(1, 0), b3, voffB); PG8_STAGE(PG8_SB(1, 1), b3 + hstep, voffB); PG8_STAGE(PG8_SA(1, 0), a3, voffA);
            PG8_WAIT_V(8); PG8_WAIT_L(0); PG8_BAR; PG8_MMA(1, 0, At, B0); PG8_MMA(1, 1, At, B1); PG8_BAR; PG8_SCHED;
            } else {
            PG8_LDB(B0, 0, 0); PG8_SCHED; PG8_LDA(At, 0, 0); PG8_STAGE(PG8_SA(1, 1), a1 + hstep, voffA);
            PG8_WAIT_L(8); PG8_BAR; PG8_WAIT_L(0); PG8_MMA(0, 0, At, B0); PG8_BAR; PG8_SCHED;
            PG8_LDB(B1, 0, 1); PG8_STAGE(PG8_SB(0, 0), b2, voffB);
            PG8_BAR; PG8_WAIT_L(0); PG8_MMA(0, 1, At, B1); PG8_BAR;
            PG8_LDA(At, 0, 1); PG8_STAGE(PG8_SA(0, 0), a2, voffA);
            PG8_BAR; PG8_WAIT_L(0); PG8_MMA(1, 0, At, B0); PG8_BAR; PG8_SCHED;
            PG8_STAGE(PG8_SB(0, 1), b2 + hstep, voffB);
            PG8_WAIT_V(6); PG8_BAR; PG8_MMA(1, 1, At, B1); PG8_BAR;
            PG8_LDB(B0, 1, 0); PG8_SCHED; PG8_LDA(At, 1, 0); PG8_STAGE(PG8_SA(0, 1), a2 + hstep, voffA);
            PG8_WAIT_L(8); PG8_BAR; PG8_WAIT_L(0); PG8_MMA(0, 0, At, B0); PG8_BAR; PG8_SCHED;
            PG8_LDB(B1, 1, 1); PG8_STAGE(PG8_SB(1, 0), b3, voffB);
            PG8_BAR; PG8_WAIT_L(0); PG8_MMA(0, 1, At, B1); PG8_BAR;
            PG8_LDA(At, 1, 1); PG8_STAGE(PG8_SA(1, 0), a3, voffA);
            PG8_BAR; PG8_WAIT_L(0); PG8_MMA(1, 0, At, B0); PG8_BAR; PG8_SCHED;
            PG8_STAGE(PG8_SB(1, 1), b3 + hstep, voffB);
            PG8_WAIT_V(6); PG8_BAR; PG8_MMA(1, 1, At, B1); PG8_BAR;
            }
        }
        if constexpr (ALIGN_EPI) { if (wr == 0) PG8_BAR; }
        { int l_; asm volatile("v_mbcnt_lo_u32_b32 %0, -1, 0\n\tv_mbcnt_hi_u32_b32 %0, -1, %0" : "=v"(l_));
          if constexpr (QM == 2) {
#pragma unroll
              for (int a_ = 0; a_ < 2; ++a_)
#pragma unroll
                  for (int b_ = 0; b_ < 2; ++b_)
#pragma unroll
                      for (int m_ = 0; m_ < 4; ++m_)
#pragma unroll
                          for (int n_ = 0; n_ < 2; ++n_) acc[a_][b_][m_][n_] = __builtin_convertvector(__builtin_bit_cast(i32x4, acc[a_][b_][m_][n_]), f32x4); }
          if constexpr (Epi::NEEDS_RS) {
              const int t_ = wid * 64 + l_; float q0 = 0.f;
              if (has_next && t_ < 256) q0 = E.ssp[(size_t)nxt.pm * BM + t_];
              E(acc, cur, wr, wc, l_ & 15, l_ >> 4, (const PG8_LAS float*)(lds + RS_TAB_OFF) + (ui & 1) * 256);
              if (has_next && t_ < 256) ((PG8_LAS float*)(lds + RS_TAB_OFF))[((ui + 1) & 1) * 256 + t_] = q0;
          } else E(acc, cur, wr, wc, l_ & 15, l_ >> 4); }
        if (!has_next) break;
#pragma unroll
        for (int a = 0; a < 2; ++a)
#pragma unroll
            for (int b = 0; b < 2; ++b)
#pragma unroll
                for (int m = 0; m < 4; ++m)
#pragma unroll
                    for (int n = 0; n < 2; ++n) acc[a][b][m][n] = (f32x4){0.f, 0.f, 0.f, 0.f};
        cur = nxt; cA = nA; cB = nB; ++ui;
        if constexpr (ALIGN_EPI) { if (wr == 1) PG8_BAR; }
    }
    PG8_WAIT_V(0);
    if constexpr (!ALIGN_EPI) { if (wr == 0) PG8_BAR; }
    PG8_BAR;
#undef PG8_SA
#undef PG8_SB
#undef PG8_STAGE
#undef PG8_LDA
#undef PG8_RD16
#undef PG8_CAT8
#undef PG8_LDB
#undef PG8_MMA
#undef PG8_WAIT_V
#undef PG8_WAIT_L
#undef PG8_BAR
#undef PG8_SCHED
}
}


namespace att {
using bf16x8=__attribute__((ext_vector_type(8)))short;
using s16x4=__attribute__((ext_vector_type(4)))short;
using f32x16=__attribute__((ext_vector_type(16)))float;
using u32x4=__attribute__((ext_vector_type(4)))unsigned;
typedef unsigned short bf16;
constexpr int D=64,DM=64;
constexpr int NW=8,QBLK=32,QB=QBLK*NW,KVBLK=64;
__device__ __forceinline__ int crow(int r,int hi){return (r&3)+8*(r>>2)+4*hi;}
#define SBAR() __builtin_amdgcn_sched_barrier(0)
constexpr int NSLOT=3, SLOTB=8192;
constexpr int LDS_K=0, LDS_V=NSLOT*SLOTB, LDS_WS=2*NSLOT*SLOTB, LDS_OST=LDS_WS+NW*64*4, LDS_KM=LDS_OST+NW*4096, LDS_TK=LDS_KM+4096, LDS_BYTES=LDS_TK+64;
constexpr float C2=0.125f*1.4426950408889634f;
__device__ __forceinline__ void glds16(const void*gsrc,unsigned lds_dst){unsigned keep;
  asm volatile("s_mov_b32 %0, m0\n\ts_mov_b32 m0, %2\n\ts_nop 0\n\tglobal_load_lds_dwordx4 %1, off\n\ts_mov_b32 m0, %0":"=&s"(keep):"v"(gsrc),"s"(lds_dst):"memory");}
__device__ __forceinline__ float max3f(float a,float b,float c){float r;asm("v_max3_f32 %0, %1, %2, %3":"=v"(r):"v"(a),"v"(b),"v"(c));return r;}
__device__ __forceinline__ float max2f(float a,float b){float r;asm("v_max_f32_e32 %0, %1, %2":"=v"(r):"v"(a),"v"(b));return r;}
__device__ __forceinline__ float fadd_s(float a,float b){float r;asm("v_add_f32_e32 %0, %1, %2":"=v"(r):"v"(a),"v"(b));return r;}
__device__ __forceinline__ float fsub_s(float a,float b){float r;asm("v_sub_f32_e32 %0, %1, %2":"=v"(r):"v"(a),"v"(b));return r;}
typedef float f32x2_t __attribute__((ext_vector_type(2))); typedef __bf16 bf16x2_t __attribute__((ext_vector_type(2)));
__device__ __forceinline__ unsigned cvtpk_s(float lo,float hi){f32x2_t v={lo,hi};bf16x2_t b=__builtin_convertvector(v,bf16x2_t);return __builtin_bit_cast(unsigned,b);}
#define WAIT_BAR(N) asm volatile("s_waitcnt vmcnt(" #N ") lgkmcnt(0)\n\ts_barrier":::"memory")
__device__ __forceinline__ void qkt(f32x16&p0,f32x16&p1,const char*Kslot,const bf16x8*qr,int r32,int hi){ const f32x16 zero16=f32x16{};
  const char*kb=Kslot+hi*1024+r32*16;
  #pragma unroll
  for(int d0=0;d0<4;++d0){
    const bf16x8 b0=*reinterpret_cast<const bf16x8*>(kb+d0*2048);
    const bf16x8 b1=*reinterpret_cast<const bf16x8*>(kb+d0*2048+512);
    if(d0==0){p0=__builtin_amdgcn_mfma_f32_32x32x16_bf16(b0,qr[0],zero16,0,0,0);p1=__builtin_amdgcn_mfma_f32_32x32x16_bf16(b1,qr[0],zero16,0,0,0);}
    else{p0=__builtin_amdgcn_mfma_f32_32x32x16_bf16(b0,qr[d0],p0,0,0,0);p1=__builtin_amdgcn_mfma_f32_32x32x16_bf16(b1,qr[d0],p1,0,0,0);}}
}
typedef __attribute__((address_space(3))) const char* lds_cptr;
typedef short v4i16_t __attribute__((ext_vector_type(4)));
__device__ __forceinline__ void kload8(bf16x8*kf,lds_cptr kp){
  kf[0]=*(const __attribute__((address_space(3))) bf16x8*)(kp);      kf[1]=*(const __attribute__((address_space(3))) bf16x8*)(kp+512);
  kf[2]=*(const __attribute__((address_space(3))) bf16x8*)(kp+2048); kf[3]=*(const __attribute__((address_space(3))) bf16x8*)(kp+2560);
  kf[4]=*(const __attribute__((address_space(3))) bf16x8*)(kp+4096); kf[5]=*(const __attribute__((address_space(3))) bf16x8*)(kp+4608);
  kf[6]=*(const __attribute__((address_space(3))) bf16x8*)(kp+6144); kf[7]=*(const __attribute__((address_space(3))) bf16x8*)(kp+6656);
}
__device__ __forceinline__ void kload2(bf16x8*kf,lds_cptr kp,int j){ kf[2*j]=*(const __attribute__((address_space(3))) bf16x8*)(kp+j*2048); kf[2*j+1]=*(const __attribute__((address_space(3))) bf16x8*)(kp+j*2048+512); }
__device__ __forceinline__ s16x4 vtr(lds_cptr p){ return __builtin_bit_cast(s16x4,__builtin_amdgcn_ds_read_tr16_b64_v4i16((__attribute__((address_space(3))) v4i16_t*)p)); }
__device__ __forceinline__ float rowmax(const f32x16&p0,const f32x16&p1){
  float a=max3f(p0[0],p0[1],p1[0]),b=max3f(p0[2],p0[3],p1[1]);a=max3f(a,p1[2],p1[3]);
  #pragma unroll
  for(int r=4;r<16;r+=4){a=max3f(a,p0[r],p0[r+1]);b=max3f(b,p0[r+2],p0[r+3]);a=max3f(a,p1[r],p1[r+1]);b=max3f(b,p1[r+2],p1[r+3]);}
  const float m=max2f(a,b);
  auto rr=__builtin_amdgcn_permlane32_swap(__float_as_uint(m),__float_as_uint(m),false,false);
  return max2f(__uint_as_float(rr[0]),__uint_as_float(rr[1]));
}
__device__ __forceinline__ void pv(f32x16*o,int vb,bf16x8 pa0,bf16x8 pa1,bf16x8 pa2,bf16x8 pa3){
  #pragma unroll
  for(int d0=0;d0<2;++d0){s16x4 lo[4],hi[4];
    #pragma unroll
    for(int ks=0;ks<4;++ks){
      asm volatile("ds_read_b64_tr_b16 %0,%1 offset:%c2":"=&v"(lo[ks]):"v"(vb),"i"(d0*4096+ks*1024):"memory");
      asm volatile("ds_read_b64_tr_b16 %0,%1 offset:%c2":"=&v"(hi[ks]):"v"(vb),"i"(d0*4096+ks*1024+512):"memory");}
    asm volatile("s_waitcnt lgkmcnt(0)":::"memory");SBAR();
    #define PK(k) (bf16x8){lo[k][0],lo[k][1],lo[k][2],lo[k][3],hi[k][0],hi[k][1],hi[k][2],hi[k][3]}
    o[d0]=__builtin_amdgcn_mfma_f32_32x32x16_bf16(pa0,PK(0),o[d0],0,0,0);
    o[d0]=__builtin_amdgcn_mfma_f32_32x32x16_bf16(pa1,PK(1),o[d0],0,0,0);
    o[d0]=__builtin_amdgcn_mfma_f32_32x32x16_bf16(pa2,PK(2),o[d0],0,0,0);
    o[d0]=__builtin_amdgcn_mfma_f32_32x32x16_bf16(pa3,PK(3),o[d0],0,0,0);
    #undef PK
  }
}
template<int MODE> __device__ __forceinline__ void amask(f32x16&p0,f32x16&p1,int a,int nb,unsigned sel,int qabs,int qrel,int hi,float mhat){
  const float NEG=-INFINITY;
  if(MODE==0){
    if(a>=nb){ const int kb=64*(a-nb)+4*hi;
      #pragma unroll
      for(int r=0;r<16;++r){const int kv=kb+(r&3)+8*(r>>2); p0[r]=(kv>qrel)?NEG:p0[r]-mhat; p1[r]=(kv+32>qrel)?NEG:p1[r]-mhat;} }
    else { const float bias=((sel>>(a>>2))&1u)?-mhat:NEG;
      #pragma unroll
      for(int r=0;r<16;++r){ p0[r]+=bias; p1[r]+=bias; } }
  } else {
    const int base=qabs-64*a-4*hi;
    #pragma unroll
    for(int r=0;r<16;++r){const int c=(r&3)+8*(r>>2); p0[r]=((unsigned)(base-c)>128u)?NEG:p0[r]-mhat; p1[r]=((unsigned)(base-c-32)>128u)?NEG:p1[r]-mhat;}
  }
}
#ifndef ATTN_STORE16
#define ATTN_STORE16(p,v) (*(u32x4*)(p)=(v))
#endif
template<int MODE,int THRL,int opitch> __device__ __forceinline__ void attn_unit(const bf16*Qs,int q0,int tile0,int NT,unsigned sel,bf16*O,float*LSE,char*shm,int tid_in){
  const bf16*Ks=Qs+12*1024*1024,*Vs=Qs+24*1024*1024;
  int tid_=tid_in; asm volatile("":"+v"(tid_));
  const int tid=tid_,lane=tid&63,r32=lane&31,hi=lane>>5; const int wid=__builtin_amdgcn_readfirstlane(tid>>6);
  const int nb=NT-4;
  const bf16*Qw=Qs+(long)(q0+wid*QBLK)*DM;
  const lds_cptr shm3=(lds_cptr)shm;
  const unsigned lds0=(unsigned)(uintptr_t)shm3;
  float*wsf=(float*)(shm+LDS_WS)+wid*64;
  const bf16*ksrc=Ks+(long)lane*DM+wid*8;
  const bf16*vsrc=Vs+(long)(16*(wid&3)+(lane>>2))*DM+(wid>>2)*32+(lane&3)*8;
  const unsigned kdst=lds0+LDS_K+wid*1024, vdst=lds0+LDS_V+wid*1024;
  #define TM(t) (MODE==0 ? ((t)==0 ? nb : ((t)<=nb ? (t)-1 : (t))) : tile0+(t))
  #define DMA_K(t,slot) glds16(ksrc+(long)TM(t)*KVBLK*DM,(unsigned)__builtin_amdgcn_readfirstlane(kdst+(slot)))
  #define DMA_V(t,slot) glds16(vsrc+(long)TM(t)*KVBLK*DM,(unsigned)__builtin_amdgcn_readfirstlane(vdst+(slot)))
  const char*Kbase=shm+LDS_K; bf16x8 kf[8];
  const lds_cptr kp0=shm3+LDS_K+hi*1024+r32*16; const lds_cptr vp0=shm3+LDS_V+((lane>>4)&1)*32+(lane&3)*8+(4*hi+((lane&15)>>2))*64;
  DMA_K(0,0);DMA_V(0,0);DMA_K(1,SLOTB);
  bf16x8 qr[4];
  #pragma unroll
  for(int d0=0;d0<4;++d0)qr[d0]=*reinterpret_cast<const bf16x8*>(&Qw[(long)r32*DM+d0*16+hi*8]);
  float mhat=0.f,l_reg=0.f;f32x16 o[2];o[0]=f32x16{};o[1]=f32x16{};const f32x16 zero16=f32x16{};
  const int qrel=wid*QBLK+r32, qabs=q0+qrel;
  #define CMASK(P0,P1,t) amask<MODE>(P0,P1,TM(t),nb,sel,qabs,qrel,hi,mhat)
  bool resc=false;
  #define START(P0,P1) do{ const float rm=rowmax(P0,P1); resc=false; \
    { const float dl=__builtin_fmaxf(rm,0.f); mhat=fadd_s(mhat,dl); \
      _Pragma("unroll") for(int r=0;r<16;++r){P0[r]=fsub_s(P0[r],dl);P1[r]=fsub_s(P1[r],dl);} } \
    _Pragma("unroll") for(int r=0;r<16;++r)P0[r]=__builtin_amdgcn_exp2f(P0[r]); }while(0)
  #define RESC() do{ if(resc){ asm volatile("s_waitcnt lgkmcnt(0)":::"memory"); \
      _Pragma("unroll") for(int d_=0;d_<2;++d_) _Pragma("unroll") for(int r=0;r<16;++r)o[d_][r]*=wsf[crow(r,hi)]; } }while(0)
  f32x16 pA0,pA1,pB0,pB1;
  int sl_prev=0,sl_cur=0,sl_next=SLOTB;
  #define ROT() do{sl_prev=sl_cur;sl_cur=sl_next;sl_next=(sl_next==(NSLOT-1)*SLOTB)?0:sl_next+SLOTB;}while(0)
  DMA_K(2,2*SLOTB);
  WAIT_BAR(3);
  qkt(pA0,pA1,Kbase,qr,r32,hi);asm volatile("s_nop 15\n\ts_nop 7":"+v"(pA0),"+v"(pA1));CMASK(pA0,pA1,0);
  START(pA0,pA1);
  _Pragma("unroll") for(int r=0;r<16;++r)pA1[r]=__builtin_amdgcn_exp2f(pA1[r]);
  WAIT_BAR(0);
  DMA_K(3,0);DMA_V(1,SLOTB);
  ROT();
  kload8(kf,kp0+sl_cur);
  WAIT_BAR(2);
  s16x4 vlo[8],vhi[8]; u32x4 pw0,pw1,pw2,pw3;
  #define PKW(P,B) cvtpk_s(P[B],P[B+1])
  #define PAF(k) __builtin_bit_cast(bf16x8,pw##k)
  #define VFR(i) (bf16x8){vlo[i][0],vlo[i][1],vlo[i][2],vlo[i][3],vhi[i][0],vhi[i][1],vhi[i][2],vhi[i][3]}
  #define PIN(x) asm volatile("":"+v"(x))
  #define MX3(a,b,c) __builtin_fmaxf(__builtin_fmaxf((a),(b)),(c))
  #define GAPA(MF,A0,A1,A2,A3,W0,W1,PW) do{ MF; sacc+=A0; sacc+=A1; sacc+=A2; sacc+=A3; PIN(sacc); W0; W1; PIN(PW); SBAR(); }while(0)
  #define EX(v) __builtin_amdgcn_exp2f(v)
  #define GAPB(MF,X,B) do{ MF; X[B]=EX(X[B]); X[B+1]=EX(X[B+1]); X[B+2]=EX(X[B+2]); X[B+3]=EX(X[B+3]); PIN(X); SBAR(); }while(0)
  #define VRD(i) do{ vlo[i]=vtr(vp_+(((i)>>2)*4096+((i)&3)*1024)); vhi[i]=vtr(vp_+(((i)>>2)*4096+((i)&3)*1024+512)); }while(0)
  #define KRD(G,j) do{ if(G){ kload2(kf,kp0+sl_next,j); SBAR(); } }while(0)
  #define STEP(C0,C1,P0,P1,t,GK,GV,GL) do{ SBAR(); \
    const lds_cptr vp_=vp0+sl_prev; \
    VRD(0); SBAR(); float sacc=(P0[0]+P0[1]); \
    GAPA(C0=__builtin_amdgcn_mfma_f32_32x32x16_bf16(kf[0],qr[0],zero16,0,0,0), P0[2],P0[3],P0[4],P0[5],     pw0[0]=PKW(P0,0), pw0[1]=PKW(P0,2), pw0); \
    VRD(4); SBAR(); GAPA(C1=__builtin_amdgcn_mfma_f32_32x32x16_bf16(kf[1],qr[0],zero16,0,0,0), P0[6],P0[7],P0[8],P0[9],     pw0[2]=PKW(P0,4), pw0[3]=PKW(P0,6), pw0); \
    VRD(1); SBAR(); GAPA(C0=__builtin_amdgcn_mfma_f32_32x32x16_bf16(kf[2],qr[1],C0,0,0,0),   P0[10],P0[11],P0[12],P0[13], pw1[0]=PKW(P0,8), pw1[1]=PKW(P0,10), pw1); \
    VRD(5); SBAR(); GAPA(C1=__builtin_amdgcn_mfma_f32_32x32x16_bf16(kf[3],qr[1],C1,0,0,0),   P0[14],P0[15],P1[0],P1[1],   pw1[2]=PKW(P0,12),pw1[3]=PKW(P0,14), pw1); \
    VRD(2); SBAR(); GAPA(C0=__builtin_amdgcn_mfma_f32_32x32x16_bf16(kf[4],qr[2],C0,0,0,0),   P1[2],P1[3],P1[4],P1[5],     pw2[0]=PKW(P1,0), pw2[1]=PKW(P1,2), pw2); \
    VRD(6); SBAR(); GAPA(C1=__builtin_amdgcn_mfma_f32_32x32x16_bf16(kf[5],qr[2],C1,0,0,0),   P1[6],P1[7],P1[8],P1[9],     pw2[2]=PKW(P1,4), pw2[3]=PKW(P1,6), pw2); \
    VRD(3); SBAR(); GAPA(C0=__builtin_amdgcn_mfma_f32_32x32x16_bf16(kf[6],qr[3],C0,0,0,0),   P1[10],P1[11],P1[12],P1[13], pw3[0]=PKW(P1,8), pw3[1]=PKW(P1,10), pw3); \
    VRD(7); SBAR(); GAPA(C1=__builtin_amdgcn_mfma_f32_32x32x16_bf16(kf[7],qr[3],C1,0,0,0),   P1[14],P1[15],0.f,0.f,       pw3[2]=PKW(P1,12),pw3[3]=PKW(P1,14), pw3); \
    l_reg+=sacc; \
    if(GK){DMA_K((t)+3,sl_cur);} if(GV){DMA_V((t)+1,sl_next);} \
    CMASK(C0,C1,t); \
    { float a=MX3(C0[0],C0[1],C1[0]),b=MX3(C0[2],C0[3],C1[1]); a=MX3(a,C1[2],C1[3]); \
      _Pragma("unroll") for(int r=4;r<16;r+=4){a=MX3(a,C0[r],C0[r+1]);b=MX3(b,C0[r+2],C0[r+3]);a=MX3(a,C1[r],C1[r+1]);b=MX3(b,C1[r+2],C1[r+3]);} \
      float rm=__builtin_fmaxf(a,b); { auto rr=__builtin_amdgcn_permlane32_swap(__float_as_uint(rm),__float_as_uint(rm),false,false); rm=__builtin_fmaxf(__uint_as_float(rr[0]),__uint_as_float(rr[1])); } \
      resc=false; \
      if(__builtin_expect(__any(rm>(float)THRL),0)){ const float dl=__builtin_fmaxf(rm,0.f); mhat+=dl; \
        _Pragma("unroll") for(int r=0;r<16;++r){C0[r]-=dl;C1[r]-=dl;} \
        const float f=__builtin_amdgcn_exp2f(-dl); l_reg*=f; if(hi==0)wsf[r32]=f; resc=true; } } \
    SBAR(); \
    GAPB(o[0]=__builtin_amdgcn_mfma_f32_32x32x16_bf16(PAF(0),VFR(0),o[0],0,0,0), C0,0); \
    GAPB(o[1]=__builtin_amdgcn_mfma_f32_32x32x16_bf16(PAF(0),VFR(4),o[1],0,0,0), C0,4); \
    KRD(GL,0); GAPB(o[0]=__builtin_amdgcn_mfma_f32_32x32x16_bf16(PAF(1),VFR(1),o[0],0,0,0), C0,8); \
    KRD(GL,1); GAPB(o[1]=__builtin_amdgcn_mfma_f32_32x32x16_bf16(PAF(1),VFR(5),o[1],0,0,0), C0,12); \
    KRD(GL,2); GAPB(o[0]=__builtin_amdgcn_mfma_f32_32x32x16_bf16(PAF(2),VFR(2),o[0],0,0,0), C1,0); \
    KRD(GL,3); GAPB(o[1]=__builtin_amdgcn_mfma_f32_32x32x16_bf16(PAF(2),VFR(6),o[1],0,0,0), C1,4); \
    GAPB(o[0]=__builtin_amdgcn_mfma_f32_32x32x16_bf16(PAF(3),VFR(3),o[0],0,0,0), C1,8); \
    GAPB(o[1]=__builtin_amdgcn_mfma_f32_32x32x16_bf16(PAF(3),VFR(7),o[1],0,0,0), C1,12); \
    }while(0)
  #define ENDW(tt) do{ if((tt)+3<NT){WAIT_BAR(2);} else if((tt)+2<NT){WAIT_BAR(1);} else {WAIT_BAR(0);} }while(0)
  int t=1;
  for(;t+1<NT;t+=2){
    STEP(pB0,pB1,pA0,pA1,t,(t+3<NT),(t+1<NT),(t+1<NT));       ENDW(t);   RESC(); ROT();
    STEP(pA0,pA1,pB0,pB1,t+1,(t+4<NT),(t+2<NT),(t+2<NT));     ENDW(t+1); RESC(); ROT();
  }
  STEP(pB0,pB1,pA0,pA1,NT-1,false,false,false); RESC();
  { float sacc=pB0[0]+pB0[1]; _Pragma("unroll") for(int r=2;r<16;++r)sacc+=pB0[r]; _Pragma("unroll") for(int r=0;r<16;++r)sacc+=pB1[r]; l_reg+=sacc;
    pw0=(u32x4){PKW(pB0,0),PKW(pB0,2),PKW(pB0,4),PKW(pB0,6)};pw1=(u32x4){PKW(pB0,8),PKW(pB0,10),PKW(pB0,12),PKW(pB0,14)};pw2=(u32x4){PKW(pB1,0),PKW(pB1,2),PKW(pB1,4),PKW(pB1,6)};pw3=(u32x4){PKW(pB1,8),PKW(pB1,10),PKW(pB1,12),PKW(pB1,14)};
    SBAR(); pv(o,(int)(unsigned)(uintptr_t)vp0+sl_cur,PAF(0),PAF(1),PAF(2),PAF(3)); }
  #undef PKW
  #undef PAF
  #undef VFR
  #undef PIN
  #undef MX3
  #undef GAPA
  #undef GAPB
  #undef EX
  #undef VRD
  #undef KRD
  #undef STEP
  #undef ENDW
  {auto rr=__builtin_amdgcn_permlane32_swap(__float_as_uint(l_reg),__float_as_uint(l_reg),false,false);l_reg=__uint_as_float(rr[0])+__uint_as_float(rr[1]);}
  if(MODE==1 && hi==0) LSE[qrel]=0.6931471805599453f*(mhat+__log2f(l_reg));
  if(hi==0)wsf[32+r32]=l_reg;asm volatile("s_waitcnt lgkmcnt(0)":::"memory");
  float rli[16];
  #pragma unroll
  for(int r=0;r<16;++r)rli[r]=__builtin_amdgcn_rcpf(wsf[32+crow(r,hi)]);
  bf16*Ow=O+(long)(wid*QBLK)*opitch;
  { __hip_bfloat16*stg=(__hip_bfloat16*)(shm+LDS_OST)+wid*2048;
    #pragma unroll
    for(int r=0;r<16;++r){const int orow=crow(r,hi);
      #pragma unroll
      for(int d0=0;d0<2;++d0)stg[orow*64+d0*32+r32]=__float2bfloat16(o[d0][r]*rli[r]);}
    asm volatile("s_waitcnt lgkmcnt(0)":::"memory");
    #pragma unroll
    for(int i=0;i<4;++i){const int row=i*8+(lane>>3),ch=lane&7; const u32x4 v=*(const u32x4*)(stg+row*64+ch*8); ATTN_STORE16(Ow+(long)row*opitch+ch*8,v);} }
  asm volatile("s_waitcnt lgkmcnt(0)\n\ts_barrier":::"memory");
  #undef DMA_K
  #undef DMA_V
  #undef TM
  #undef CMASK
  #undef START
  #undef RESC
  #undef ROT
}
#undef SBAR
#undef WAIT_BAR
}

constexpr int NWAVES = 8;
constexpr int NB = 4, SEQ = 4096, T = NB * SEQ, D = 1024;
constexpr int EVEN_IN = 2816, EVEN_OUT = 512, ODD_IN = 3072, ODD_OUT = 1024, DFF = 2816, NEXP = 8, DFFE = 3584;
constexpr int MOE_ROWS = 2 * T + NEXP * 256;
constexpr float EPS = 1e-6f;
constexpr size_t MiB = 1u << 20;
constexpr size_t WS_CTL = 0, CTL_ZERO_BYTES = 2 * MiB;
constexpr size_t WS_ROPE = 2 * MiB;
constexpr size_t WS_MISC = 3 * MiB;
constexpr size_t WS_KMEAN = 4 * MiB;
constexpr size_t WS_SSP = 5 * MiB;
constexpr size_t WS_WT = 8 * MiB;
constexpr size_t WT_EVEN_BYTES = 23 * MiB, WT_ODD_BYTES = 176 * MiB;
constexpr size_t WTE_IN = 0, WTE_OUT = 5 * MiB + MiB / 2, WTE_GU = 6 * MiB + MiB / 2, WTE_DN = 17 * MiB + MiB / 2;
constexpr size_t WTO_IN = 0, WTO_OUT = 6 * MiB, WTO_MGU = 8 * MiB, WTO_MD = 120 * MiB;
constexpr size_t WS_WT_EVEN0 = WS_WT, WS_WT_ODD0 = WS_WT + 2 * WT_EVEN_BYTES;
constexpr size_t WS_HN = WS_WT + 2 * WT_EVEN_BYTES + 2 * WT_ODD_BYTES;
constexpr size_t WS_P = WS_HN + 32 * MiB;
constexpr size_t WS_MIX = WS_P + 96 * MiB;
constexpr size_t WS_HID = WS_MIX + 32 * MiB;
constexpr size_t WS_END = WS_HID + 238 * MiB;
static_assert(WS_HN == 406 * MiB && WS_END == 804 * MiB, "ws map");
constexpr size_t P_UV = 0, P_QS = 16 * MiB, P_KS = 40 * MiB, P_VS = 64 * MiB, P_QM = 0, P_KM = 24 * MiB, P_VM = 48 * MiB;
constexpr size_t H_RAWP = 0, H_OG = 96 * MiB, H_LSE = 120 * MiB;
constexpr int CW_TMO = 0, CW_CODE = 1, CW_BAR = 4096;
constexpr size_t CTL_KMSUM = 256 * 1024, KMSUM_BYTES = 256 * 1024;
constexpr size_t P_CONV = 72 * MiB;
constexpr int RING_OFF = 0, RING_BYTES = 131072, LDSCTL_OFF = RING_BYTES, MISC_OFF = LDSCTL_OFF + 320, LDS_BYTES = 147456;

#define GAS __attribute__((address_space(1)))
#define LAS __attribute__((address_space(3)))
typedef unsigned short bf16;
typedef unsigned v4u __attribute__((ext_vector_type(4)));
typedef unsigned v2u __attribute__((ext_vector_type(2)));
typedef float f32x4 __attribute__((ext_vector_type(4)));
typedef GAS unsigned gu32;
#define RLX_AGENT __ATOMIC_RELAXED, __HIP_MEMORY_SCOPE_AGENT
#define LDS_WAIT() asm volatile("s_waitcnt lgkmcnt(0)" ::: "memory")
#define VM_WAIT() asm volatile("s_waitcnt vmcnt(0)" ::: "memory")
__device__ __forceinline__ unsigned f2bf(float f) { unsigned u = __builtin_bit_cast(unsigned, f); return (u + 0x7fffu + ((u >> 16) & 1u)) >> 16; }
__device__ __forceinline__ unsigned pk2(float lo, float hi) { return f2bf(lo) | (f2bf(hi) << 16); }
__device__ __forceinline__ unsigned pk4_i8(float a, float b, float c, float d) {
    const int ia = (int)rintf(__builtin_amdgcn_fmed3f(a, -127.f, 127.f)), ib = (int)rintf(__builtin_amdgcn_fmed3f(b, -127.f, 127.f)), ic = (int)rintf(__builtin_amdgcn_fmed3f(c, -127.f, 127.f)), id = (int)rintf(__builtin_amdgcn_fmed3f(d, -127.f, 127.f));
    return (unsigned)(ia & 255) | ((unsigned)(ib & 255) << 8) | ((unsigned)(ic & 255) << 16) | ((unsigned)id << 24); }
constexpr float WQ_SCALE = 127.0f / 0.140625f;
__device__ __forceinline__ float bf2f(unsigned short b) { return __builtin_bit_cast(float, ((unsigned)b) << 16); }
__device__ __forceinline__ float bflo(unsigned w) { return __builtin_bit_cast(float, w << 16); }
__device__ __forceinline__ float bfhi(unsigned w) { return __builtin_bit_cast(float, w & 0xffff0000u); }

#define XB_TMO      128
#define XB_XCNT(j)  (256  + 64 * (j))
#define XB_XSUB(j)  (1280 + 64 * (j))
#define XB_XGEN(j)  (2304 + 64 * (j))
#define XB_TOP      3328
#define XB_TOPGEN   3392
#define XCD_BAR_WORDS 3456
#define XB_SPIN_CAP (1u << 22)
__device__ __forceinline__ unsigned xb_ld(unsigned* p)              { return __hip_atomic_load(p, __ATOMIC_RELAXED, __HIP_MEMORY_SCOPE_AGENT); }
__device__ __forceinline__ unsigned xb_add(unsigned* p, unsigned v) { return __hip_atomic_fetch_add(p, v, __ATOMIC_RELAXED, __HIP_MEMORY_SCOPE_AGENT); }
__device__ __forceinline__ unsigned xb_xcc_id() { return (unsigned)__builtin_amdgcn_s_getreg((3 << 11) | 20) & 0xFu; }
#define XB_SPIN(cond, bar) do { unsigned _sp = 0; while (cond) { __builtin_amdgcn_s_sleep(1); \
    if ((++_sp & 255u) == 0u) { if (xb_ld(&(bar)[XB_TMO])) break; if (_sp > XB_SPIN_CAP) { atomicAdd(&(bar)[XB_TMO], 1u); break; } } } } while (0)
struct XcdBarrier { unsigned* bar; unsigned x; volatile LAS unsigned* st; };
__device__ __forceinline__ XcdBarrier xcd_barrier_post(unsigned* bar, volatile LAS unsigned* st, int tid) {
    XcdBarrier b; b.bar = bar; b.x = xb_xcc_id(); b.st = st;
    if (tid == 0) { unsigned* bp = bar; asm volatile("" : "+v"(bp)); (void)xb_add(&bp[XB_XCNT(b.x)], 1u); }
    return b;
}
__device__ __forceinline__ void xcd_barrier_complete(unsigned* bar, unsigned x, unsigned& nloc, unsigned& nx) {
    const unsigned G = gridDim.x * gridDim.y * gridDim.z;
    unsigned sum, cnt, mine, sp = 0u;
    for (;;) {
        sum = 0u; cnt = 0u; mine = 0u;
#pragma unroll
        for (unsigned j = 0; j < 16; ++j) { const unsigned c = xb_ld(&bar[XB_XCNT(j)]); sum += c; cnt += (c > 0u) ? 1u : 0u; mine = (j == x) ? c : mine; }
        if (sum == G) break;
        __builtin_amdgcn_s_sleep(1);
        if ((++sp & 255u) == 0u) { if (xb_ld(&bar[XB_TMO])) break; if (sp > XB_SPIN_CAP) { atomicAdd(&bar[XB_TMO], 1u); break; } }
    }
    nloc = mine > 0u ? mine : 1u; nx = cnt > 0u ? cnt : 1u;
}
__device__ __forceinline__ void xcd_barrier(const XcdBarrier& b, int tid) {
    asm volatile("s_waitcnt vmcnt(0)" ::: "memory");
    __syncthreads();
    if (tid == 0) {
        unsigned* bar = b.bar; asm volatile("" : "+v"(bar));
        __builtin_amdgcn_s_waitcnt(0);
        unsigned nloc = b.st[0], nx = b.st[1];
        if (nloc == 0u) { xcd_barrier_complete(bar, b.x, nloc, nx); b.st[0] = nloc; b.st[1] = nx; }
        const unsigned old = xb_add(&bar[XB_XSUB(b.x)], 1u);
        const unsigned gen = old / nloc;
        if (old + 1u == (gen + 1u) * nloc) {
            __builtin_amdgcn_fence(__ATOMIC_RELEASE, "agent");
            asm volatile("s_waitcnt vmcnt(0)" ::: "memory");
            const unsigned og = xb_add(&bar[XB_TOP], 1u);
            const unsigned tg = og / nx;
            if (og + 1u == (tg + 1u) * nx) xb_add(&bar[XB_TOPGEN], 1u);
            else XB_SPIN(xb_ld(&bar[XB_TOPGEN]) == tg, bar);
            __builtin_amdgcn_fence(__ATOMIC_ACQUIRE, "agent");
            xb_add(&bar[XB_XGEN(b.x)], 1u);
            asm volatile("s_waitcnt vmcnt(0)" ::: "memory");
        } else {
            XB_SPIN(xb_ld(&bar[XB_XGEN(b.x)]) == gen, bar);
            __builtin_amdgcn_fence(__ATOMIC_ACQUIRE, "agent");
            asm volatile("s_waitcnt vmcnt(0)" ::: "memory");
        }
    }
    __syncthreads();
}

struct Args { const float* in[22]; float* out; unsigned char* ws; int ph_lo, ph_hi; };
struct Frame {
    LAS unsigned char* lds; volatile LAS unsigned* MISC; gu32* ctl;
    int tid, lane, wave, G, blk;
    unsigned char* ws; float* out; const __attribute__((address_space(4))) struct Args* ap;
};
struct Route { int e1, e2; float g1, g2; };

__device__ __forceinline__ float wave_sum(float v) { v += xswz<1>(v); v += xswz<2>(v); v += xswz<4>(v); v += xswz<8>(v); v += xswz<16>(v); return xsum32(v); }
__device__ __forceinline__ float wave_max(float v) { v = fmaxf(v, xswz<1>(v)); v = fmaxf(v, xswz<2>(v)); v = fmaxf(v, xswz<4>(v)); v = fmaxf(v, xswz<8>(v)); v = fmaxf(v, xswz<16>(v)); return xmax32(v); }
__device__ __forceinline__ int wave_sumi(int v) { v += xswzi<1>(v); v += xswzi<2>(v); v += xswzi<4>(v); v += xswzi<8>(v); v += xswzi<16>(v); return xsum32i(v); }
__device__ __forceinline__ float gelu_tanh(float x) {
    const float y = 0.7978845608028654f * (x + 0.044715f * x * x * x);
    const float e = __expf(2.0f * y);
    const float th = 1.0f - 2.0f / (e + 1.0f);
    return 0.5f * x * (1.0f + th);
}

__device__ __forceinline__ int rowmap_base(int mode, int n);
__device__ __forceinline__ int rowmap(int mode, int n) {
    const int r = rowmap_base(mode & 7, n);
    if (!(mode & 8)) return r;
    const int c = r & 31; return (r & ~31) + 16 * ((c >> 2) & 1) + 4 * (c >> 3) + (c & 3);
}
__device__ __forceinline__ int rowmap_base(int mode, int n) {
    if (mode == 0) return n;
    if (mode == 3) { const int w = n & 255, wc = w >> 6, dd = w & 63, bj = dd >> 5, e = dd & 31, fq = e >> 3, nn = (e >> 2) & 1, j = e & 3; return (n & ~255) + 128 * bj + 32 * wc + 16 * nn + 4 * fq + j; }
    return 256 * (n >> 7) + (n & 127) + (mode == 2 ? 128 : 0);
}
constexpr float H8_SCALE = 8.0f;
constexpr float W8_SCALE = 64.0f;
__device__ __forceinline__ unsigned pk4_fp8(float a, float b, float c, float d) { int w = __builtin_amdgcn_cvt_pk_fp8_f32(a, b, 0, false); w = __builtin_amdgcn_cvt_pk_fp8_f32(c, d, w, true); return (unsigned)w; }
struct TItem { const float* W; bf16* WT; const float* gain; int K, N, mode, fp8, k0, n0; };
__device__ __forceinline__ void p0_item_load(const TItem& t, int lane, f32x4 (&v)[8]) {
    const float* src = t.W + (size_t)(t.k0 + (lane >> 4)) * t.N + t.n0 + (lane & 15) * 4;
#pragma unroll
    for (int i = 0; i < 8; ++i) v[i] = __builtin_nontemporal_load((const f32x4*)(src + (size_t)(4 * i) * t.N));
    if (t.gain) {
#pragma unroll
        for (int i = 0; i < 8; ++i) v[i] = v[i] * t.gain[t.k0 + 4 * i + (lane >> 4)]; }
}
__device__ __forceinline__ void p0_item_finish(const TItem& t, int lane, const f32x4 (&v)[8], LAS float* scr) {
    const int K = t.K;
#pragma unroll
    for (int i = 0; i < 8; ++i) *(LAS f32x4*)(scr + (4 * i + (lane >> 4)) * 68 + (lane & 15) * 4) = v[i];
    LDS_WAIT(); asm volatile("" ::: "memory");
    if (t.fp8 == 1) { unsigned char* d8 = (unsigned char*)t.WT + (size_t)rowmap(t.mode, t.n0 + lane) * K + t.k0;
#pragma unroll
        for (int q = 0; q < 2; ++q) { v4u o;
            o.x = pk4_fp8(scr[(16 * q + 0) * 68 + lane] * W8_SCALE, scr[(16 * q + 1) * 68 + lane] * W8_SCALE, scr[(16 * q + 2) * 68 + lane] * W8_SCALE, scr[(16 * q + 3) * 68 + lane] * W8_SCALE);
            o.y = pk4_fp8(scr[(16 * q + 4) * 68 + lane] * W8_SCALE, scr[(16 * q + 5) * 68 + lane] * W8_SCALE, scr[(16 * q + 6) * 68 + lane] * W8_SCALE, scr[(16 * q + 7) * 68 + lane] * W8_SCALE);
            o.z = pk4_fp8(scr[(16 * q + 8) * 68 + lane] * W8_SCALE, scr[(16 * q + 9) * 68 + lane] * W8_SCALE, scr[(16 * q + 10) * 68 + lane] * W8_SCALE, scr[(16 * q + 11) * 68 + lane] * W8_SCALE);
            o.w = pk4_fp8(scr[(16 * q + 12) * 68 + lane] * W8_SCALE, scr[(16 * q + 13) * 68 + lane] * W8_SCALE, scr[(16 * q + 14) * 68 + lane] * W8_SCALE, scr[(16 * q + 15) * 68 + lane] * W8_SCALE);
            *(GAS v4u*)(d8 + 16 * q) = o; }
    } else if (t.fp8 == 2) { unsigned char* d8 = (unsigned char*)t.WT + (size_t)rowmap(t.mode, t.n0 + lane) * K + t.k0;
#pragma unroll
        for (int q = 0; q < 2; ++q) { v4u o;
            o.x = pk4_i8(scr[(16 * q + 0) * 68 + lane] * WQ_SCALE, scr[(16 * q + 1) * 68 + lane] * WQ_SCALE, scr[(16 * q + 2) * 68 + lane] * WQ_SCALE, scr[(16 * q + 3) * 68 + lane] * WQ_SCALE);
            o.y = pk4_i8(scr[(16 * q + 4) * 68 + lane] * WQ_SCALE, scr[(16 * q + 5) * 68 + lane] * WQ_SCALE, scr[(16 * q + 6) * 68 + lane] * WQ_SCALE, scr[(16 * q + 7) * 68 + lane] * WQ_SCALE);
            o.z = pk4_i8(scr[(16 * q + 8) * 68 + lane] * WQ_SCALE, scr[(16 * q + 9) * 68 + lane] * WQ_SCALE, scr[(16 * q + 10) * 68 + lane] * WQ_SCALE, scr[(16 * q + 11) * 68 + lane] * WQ_SCALE);
            o.w = pk4_i8(scr[(16 * q + 12) * 68 + lane] * WQ_SCALE, scr[(16 * q + 13) * 68 + lane] * WQ_SCALE, scr[(16 * q + 14) * 68 + lane] * WQ_SCALE, scr[(16 * q + 15) * 68 + lane] * WQ_SCALE);
            *(GAS v4u*)(d8 + 16 * q) = o; }
    } else {
    bf16* dst = t.WT + (size_t)rowmap(t.mode, t.n0 + lane) * K + t.k0;
#pragma unroll
    for (int q = 0; q < 4; ++q) { v4u o;
        o.x = pk2(scr[(8 * q + 0) * 68 + lane], scr[(8 * q + 1) * 68 + lane]); o.y = pk2(scr[(8 * q + 2) * 68 + lane], scr[(8 * q + 3) * 68 + lane]);
        o.z = pk2(scr[(8 * q + 4) * 68 + lane], scr[(8 * q + 5) * 68 + lane]); o.w = pk2(scr[(8 * q + 6) * 68 + lane], scr[(8 * q + 7) * 68 + lane]);
        *(GAS v4u*)(dst + 8 * q) = o; } }
    LDS_WAIT(); asm volatile("" ::: "memory");
}
struct WDesc { const float* src; bf16* dst; const float* gain; int K, N, nbatch, mode, fp8; size_t dst_bstride; };
__device__ __forceinline__ WDesc get_desc(const Args& a, int d) {
    const int layer = d / 10, k = d % 10; unsigned char* ws = a.ws;
    bf16* we = (bf16*)(ws + WS_WT_EVEN0 + (size_t)layer * WT_EVEN_BYTES); bf16* wo = (bf16*)(ws + WS_WT_ODD0 + (size_t)layer * WT_ODD_BYTES);
    WDesc w; w.nbatch = 1; w.mode = 0; w.dst_bstride = 0; w.fp8 = 0; w.gain = nullptr;
    switch (k) {
    case 0: w.src = a.in[3] + (size_t)layer * D * EVEN_IN; w.dst = we + WTE_IN / 2; w.K = D; w.N = EVEN_IN; w.mode = 3; w.fp8 = Q_INPROJ; break;
    case 1: w.src = a.in[9] + (size_t)layer * EVEN_OUT * D; w.dst = we + WTE_OUT / 2; w.K = EVEN_OUT; w.N = D; break;
    case 2: w.src = a.in[10] + (size_t)layer * D * DFF; w.dst = we + WTE_GU / 2; w.K = D; w.N = DFF; w.mode = 1; w.fp8 = Q_FFN; break;
    case 3: w.src = a.in[11] + (size_t)layer * D * DFF; w.dst = we + WTE_GU / 2; w.K = D; w.N = DFF; w.mode = 2; w.fp8 = Q_FFN; break;
    case 4: w.src = a.in[12] + (size_t)layer * DFF * D; w.dst = we + WTE_DN / 2; w.K = DFF; w.N = D; break;
    case 5: w.src = a.in[13] + (size_t)layer * D * ODD_IN; w.dst = wo + WTO_IN / 2; w.K = D; w.N = ODD_IN; w.mode = 3; w.fp8 = Q_INPROJ; break;
    case 6: w.src = a.in[17] + (size_t)layer * ODD_OUT * D; w.dst = wo + WTO_OUT / 2; w.K = ODD_OUT; w.N = D; break;
    case 7: w.src = a.in[19] + (size_t)layer * NEXP * D * DFFE; w.dst = wo + WTO_MGU / 2; w.K = D; w.N = DFFE; w.mode = 1 | 8; w.nbatch = NEXP; w.dst_bstride = (size_t)DFFE * D; w.fp8 = 2; break;
    case 8: w.src = a.in[20] + (size_t)layer * NEXP * D * DFFE; w.dst = wo + WTO_MGU / 2; w.K = D; w.N = DFFE; w.mode = 2 | 8; w.nbatch = NEXP; w.dst_bstride = (size_t)DFFE * D; w.fp8 = 2; break;
    default: w.src = a.in[21] + (size_t)layer * NEXP * DFFE * D; w.dst = wo + WTO_MD / 2; w.K = DFFE; w.N = D; w.mode = 8; w.nbatch = NEXP; w.dst_bstride = (size_t)DFFE * D / 2; w.fp8 = 1; break;
    }
    return w;
}
__device__ __forceinline__ void p0_prologue(Frame& F, const Args& a) {
    LAS float* scr = (LAS float*)(F.lds + RING_OFF + F.wave * 16384);
    const int gw = F.blk * NWAVES + F.wave, NGW = F.G * NWAVES;
    auto locate = [&](long it, TItem& t) -> bool {
        for (int d = 0; d < 20; ++d) { const WDesc w = get_desc(a, d); const long per = (long)(w.K / 32) * (w.N / 64), n = per * w.nbatch;
            if (it < n) { const int bt = (int)(it / per), r = (int)(it % per), nblk = w.N / 64;
                t.W = w.src + (size_t)bt * w.K * w.N; t.WT = w.dst + (size_t)bt * w.dst_bstride; t.K = w.K; t.N = w.N; t.mode = w.mode; t.fp8 = w.fp8; t.gain = w.gain; t.k0 = 32 * (r / nblk); t.n0 = 64 * (r % nblk); return true; }
            it -= n; }
        return false; };
    { TItem cur, nxt; f32x4 va[8], vb[8]; long it = gw; bool have = locate(it, cur);
      if (have) p0_item_load(cur, F.lane, va);
      while (have) {
          const bool hn = locate(it + NGW, nxt);
          if (hn) p0_item_load(nxt, F.lane, vb);
          p0_item_finish(cur, F.lane, va, scr);
          if (!hn) break;
          it += NGW; const bool h2 = locate(it + NGW, cur);
          if (h2) p0_item_load(cur, F.lane, va);
          p0_item_finish(nxt, F.lane, vb, scr);
          if (!h2) break;
          it += NGW; } }
    { float* wtg = (float*)(a.ws + WS_KMEAN); const float* wsp = a.in[5];
      for (int i = F.blk * 512 + F.tid; i < 2 * 4 * 128 * 128; i += F.G * 512) { const int lg = i >> 14, j = (i >> 7) & 127, ii = i & 127; wtg[i] = (j <= ii) ? wsp[(size_t)lg * 16384 + ii * 128 + j] : 0.f; } }
    float* cs = (float*)(a.ws + WS_ROPE); float* sn = cs + SEQ * 32;
    for (int i = F.blk * 512 + F.tid; i < SEQ * 32; i += F.G * 512) { const int pos = i >> 5, j = i & 31;
        const float inv = 1.0f / powf(10000.0f, (float)j * (1.0f / 32.0f)); const float ang = (float)pos * inv;
        cs[i] = cosf(ang); sn[i] = sinf(ang); }
}

__device__ __forceinline__ void norm_phase(Frame& F, const float* xsrc, float* xdst, const float* gain, bf16* hn, bool do_combine, bool do_router, bool write_hn, const float* router_w, bool out_i8 = true) {
    unsigned char* ws = F.ws;
    const Route* route = (const Route*)(ws + WS_MISC); const int* slots = (const int*)(ws + WS_MISC + 256 * 1024); int* ccnt = (int*)(ws + WS_MISC + 384 * 1024);
    const bf16* Y = (const bf16*)(ws + WS_P);
    LAS float* wr = (LAS float*)(F.lds + RING_OFF);
    LAS int* lcnt = (LAS int*)(F.lds + RING_OFF + 32768);
    if (do_router) { for (int i = F.tid; i < 8192; i += 512) { const int d = i >> 3, e = i & 7; wr[e * 1024 + d] = router_w[i]; } }
    const int lane = F.lane;
    f32x4 gv[4];
#pragma unroll
    for (int j = 0; j < 4; ++j) gv[j] = *((const f32x4*)gain + lane + 64 * j);
    for (int c = F.blk; c < T / 64; c += F.G) {
        if (do_router) { if (F.tid < 8) lcnt[F.tid] = 0; }
        __syncthreads();
        for (int k = 0; k < 8; ++k) {
            const int row = c * 64 + F.wave * 8 + k;
            const f32x4* xr = (const f32x4*)(xsrc + (size_t)row * D) + lane;
            f32x4 v[4];
#pragma unroll
            for (int j = 0; j < 4; ++j) v[j] = xr[64 * j];
            if (do_combine) {
                const Route r = route[row]; const int s1 = slots[2 * row], s2 = slots[2 * row + 1];
                const v2u* y1 = (const v2u*)(Y + (size_t)s1 * D) + lane; const v2u* y2 = (const v2u*)(Y + (size_t)s2 * D) + lane;
#pragma unroll
                for (int j = 0; j < 4; ++j) { const v2u a = y1[64 * j], b = y2[64 * j];
                    v[j].x += r.g1 * bflo(a.x) + r.g2 * bflo(b.x); v[j].y += r.g1 * bfhi(a.x) + r.g2 * bfhi(b.x);
                    v[j].z += r.g1 * bflo(a.y) + r.g2 * bflo(b.y); v[j].w += r.g1 * bfhi(a.y) + r.g2 * bfhi(b.y); }
                f32x4* xo = (f32x4*)(xdst + (size_t)row * D) + lane;
#pragma unroll
                for (int j = 0; j < 4; ++j) xo[64 * j] = v[j];
            }
            if (write_hn) {
                float ss = 0.f;
#pragma unroll
                for (int j = 0; j < 4; ++j) ss += (v[j].x * v[j].x + v[j].y * v[j].y) + (v[j].z * v[j].z + v[j].w * v[j].w);
                ss = wave_sum(ss);
                const float rstd = 1.0f / sqrtf(ss * (1.0f / D) + EPS);
#pragma unroll
                for (int j = 0; j < 4; ++j) v[j] = v[j] * rstd * gv[j];
                if (!out_i8) { v2u* o8 = (v2u*)(hn + (size_t)row * D) + lane;
#pragma unroll
                    for (int j = 0; j < 4; ++j) { v2u o; o.x = pk2(v[j].x, v[j].y); o.y = pk2(v[j].z, v[j].w); o8[64 * j] = o; }
                    if (lane == 0) ((float*)(ws + WS_SSP))[row] = 1.0f; }
                else { float mx = 0.f;
#pragma unroll
                  for (int j = 0; j < 4; ++j) mx = fmaxf(fmaxf(mx, fmaxf(fabsf(v[j].x), fabsf(v[j].y))), fmaxf(fabsf(v[j].z), fabsf(v[j].w)));
                  mx = fmaxf(wave_max(mx), 1e-20f); const float qs = 127.0f / mx;
                  unsigned* o4 = (unsigned*)((unsigned char*)hn + (size_t)row * D) + lane;
#pragma unroll
                  for (int j = 0; j < 4; ++j) o4[64 * j] = pk4_i8(v[j].x * qs, v[j].y * qs, v[j].z * qs, v[j].w * qs);
                  if (lane == 0) ((float*)(ws + WS_SSP))[row] = mx * (1.0f / 127.0f) * (1.0f / WQ_SCALE); }
                if (do_router) {
                    float lg[8];
#pragma unroll
                    for (int e = 0; e < 8; ++e) { float s = 0.f;
#pragma unroll
                        for (int j = 0; j < 4; ++j) { const f32x4 w = *((const LAS f32x4*)(wr + e * 1024) + lane + 64 * j); s += (v[j].x * w.x + v[j].y * w.y) + (v[j].z * w.z + v[j].w * w.w); }
                        lg[e] = wave_sum(s); }
                    int e1 = 0; float v1 = lg[0];
#pragma unroll
                    for (int e = 1; e < 8; ++e) if (lg[e] > v1) { v1 = lg[e]; e1 = e; }
                    int e2 = -1; float v2 = -INFINITY;
#pragma unroll
                    for (int e = 0; e < 8; ++e) if (e != e1 && lg[e] > v2) { v2 = lg[e]; e2 = e; }
                    const float g2 = 1.0f / (1.0f + __expf(v1 - v2)), g1 = 1.0f - g2;
                    if (lane == 0) { Route r; r.e1 = e1; r.e2 = e2; r.g1 = g1; r.g2 = g2; ((Route*)route)[row] = r; __hip_atomic_fetch_add(&lcnt[e1], 1, __ATOMIC_RELAXED, __HIP_MEMORY_SCOPE_WORKGROUP); __hip_atomic_fetch_add(&lcnt[e2], 1, __ATOMIC_RELAXED, __HIP_MEMORY_SCOPE_WORKGROUP); }
                }
            }
        }
        __syncthreads();
        if (do_router) { if (F.tid < 8) ccnt[c * 8 + F.tid] = lcnt[F.tid]; }
        __syncthreads();
    }
}

__device__ __forceinline__ void route_phase(Frame& F, const bf16* hn, bf16* hsort) {
    unsigned char* ws = F.ws;
    const Route* route = (const Route*)(ws + WS_MISC); int* slots = (int*)(ws + WS_MISC + 256 * 1024); const int* ccnt = (const int*)(ws + WS_MISC + 384 * 1024); int* tile_base = (int*)(ws + WS_MISC + 512 * 1024);
    LAS int* tot = (LAS int*)(F.lds + RING_OFF); LAS int* bef = tot + 8; LAS int* base = tot + 16; LAS int* sl = tot + 32;
    for (int c = F.blk; c < T / 64; c += F.G) {
        { const int e = F.wave; int t = 0, b = 0;
#pragma unroll
            for (int q = 0; q < 4; ++q) { const int ch = F.lane * 4 + q; const int v = ccnt[ch * 8 + e]; t += v; b += (ch < c) ? v : 0; }
            t = wave_sumi(t); b = wave_sumi(b);
            if (F.lane == 0) { tot[e] = t; bef[e] = b; } }
        __syncthreads();
        if (F.tid == 0) { int acc = 0;
            for (int e = 0; e < 8; ++e) { base[e] = acc; if (c == 0) tile_base[e] = acc >> 8; acc += (tot[e] + 255) & ~255; }
            if (c == 0) tile_base[8] = acc >> 8; }
        __syncthreads();
        if (F.wave == 0) {
            const int row = c * 64 + F.lane; const Route r = route[row];
            int run[8];
#pragma unroll
            for (int e = 0; e < 8; ++e) run[e] = base[e] + bef[e];
#pragma unroll
            for (int k = 0; k < 2; ++k) { const int me = k ? r.e2 : r.e1; int myslot = 0;
#pragma unroll
                for (int e = 0; e < 8; ++e) { const unsigned long long m = __ballot(me == e); const int rank = __popcll(m & ((1ull << F.lane) - 1ull));
                    if (me == e) myslot = run[e] + rank; run[e] += __popcll(m); }
                slots[2 * row + k] = myslot; sl[2 * F.lane + k] = myslot; }
        }
        __syncthreads();
        { const float* rsc = (const float*)(ws + WS_SSP); float* ssc = (float*)(ws + WS_SSP + 128 * 1024);
          for (int p = F.wave; p < 128; p += NWAVES) { const int row = c * 64 + (p >> 1); const int s = sl[p];
            *((v4u*)((unsigned char*)hsort + (size_t)s * D) + F.lane) = *((const v4u*)((const unsigned char*)hn + (size_t)row * D) + F.lane);
            if (F.lane == 0) ssc[s] = rsc[row]; } }
        __syncthreads();
    }
}

__device__ __forceinline__ int srow(int s, int g) { return g == 0 ? s : (g == 1 ? ((s & 3) * 1024 + (s >> 2)) : ((s & 15) * 256 + (s >> 4))); }
__device__ __forceinline__ float rope_apply(float n, int lane, const float* cs, const float* sn, int s) {
    const float partner = __shfl_xor(n, 32); const int j = lane & 31; const float c = cs[s * 32 + j], si = sn[s * 32 + j];
    return lane < 32 ? n * c - partner * si : n * c + partner * si;
}
__device__ __forceinline__ void post_even(Frame& F, const bf16* rawp, const float* vgain, const float* qgain, const float* kgain) {
    unsigned char* ws = F.ws; bf16* UV = (bf16*)(ws + WS_P + P_UV); bf16* Qs = (bf16*)(ws + WS_P + P_QS); bf16* Ks = (bf16*)(ws + WS_P + P_KS); bf16* Vs = (bf16*)(ws + WS_P + P_VS);
    const float* cs = (const float*)(ws + WS_ROPE); const float* sn = cs + SEQ * 32;
    const int lane = F.lane; const float qg = qgain[lane], kg = kgain[lane];
    const long nitems = (long)T * 44;
    for (long it = (long)F.blk * NWAVES + F.wave; it < nitems; it += (long)F.G * NWAVES) {
        const int row = (int)(it / 44), u = (int)(it % 44), b = row >> 12, s = row & 4095;
        const float v = bf2f(rawp[(size_t)row * EVEN_IN + 64 * u + lane]);
        if (u < 4) { UV[(size_t)row * 512 + 64 * u + lane] = (bf16)f2bf(gelu_tanh(v)); }
        else if (u < 8) { const float z = gelu_tanh(v); const float ss = wave_sum(z * z); const float o = z * (1.0f / sqrtf(ss * (1.0f / 64) + EPS)) * vgain[(u - 4) * 64 + lane];
            UV[(size_t)row * 512 + 64 * u + lane] = (bf16)f2bf(o); }
        else if (u < 32) { const bool isq = u < 20; const int h = isq ? u - 8 : u - 20; const float ss = wave_sum(v * v);
            const float n = v * (1.0f / sqrtf(ss * (1.0f / 64) + EPS)) * (isq ? qg : kg); const float o = rope_apply(n, lane, cs, sn, s);
            (isq ? Qs : Ks)[((size_t)(b * 12 + h) * SEQ + srow(s, h >> 2)) * 64 + lane] = (bf16)f2bf(isq ? o * att::C2 : o); }
        else { const int h = u - 32; Vs[((size_t)(b * 12 + h) * SEQ + srow(s, h >> 2)) * 64 + lane] = (bf16)f2bf(v); }
    }
}
__device__ __forceinline__ void post_odd(Frame& F, const bf16* rawp, const float* qgain, const float* kgain) {
    unsigned char* ws = F.ws; bf16* Qm = (bf16*)(ws + WS_P + P_QM); bf16* Km = (bf16*)(ws + WS_P + P_KM); bf16* Vm = (bf16*)(ws + WS_P + P_VM);
    const float* cs = (const float*)(ws + WS_ROPE); const float* sn = cs + SEQ * 32;
    const int lane = F.lane; const float qg = qgain[lane], kg = kgain[lane];
    const long nitems = (long)T * 36;
    for (long it = (long)F.blk * NWAVES + F.wave; it < nitems; it += (long)F.G * NWAVES) {
        const int row = (int)(it / 36), u = (int)(it % 36), b = row >> 12, s = row & 4095;
        const float v = bf2f(rawp[(size_t)row * ODD_IN + 64 * u + lane]);
        if (u < 24) { const bool isq = u < 12; const int h = isq ? u : u - 12; const float ss = wave_sum(v * v);
            const float n = v * (1.0f / sqrtf(ss * (1.0f / 64) + EPS)) * (isq ? qg : kg); const float o = rope_apply(n, lane, cs, sn, s);
            (isq ? Qm : Km)[((size_t)(b * 12 + h) * SEQ + s) * 64 + lane] = (bf16)f2bf(isq ? o * att::C2 : o); }
        else { const int h = u - 24; Vm[((size_t)(b * 12 + h) * SEQ + s) * 64 + lane] = (bf16)f2bf(v); }
    }
}
__device__ __forceinline__ void kmean_phase(Frame& F) {
    const bf16* Km = (const bf16*)(F.ws + WS_P + P_KM); float* km = (float*)(F.ws + WS_KMEAN);
    for (int it = F.blk * NWAVES + F.wave; it < 48 * 16; it += F.G * NWAVES) {
        const bf16* k = Km + (size_t)it * 256 * 64 + F.lane; float s = 0.f;
        for (int r = 0; r < 256; ++r) s += bf2f(k[r * 64]);
        km[it * 64 + F.lane] = s * (1.0f / 256.0f);
    }
}

__device__ __forceinline__ void load_row64(const bf16* p, float (&q)[64]) {
    const v4u* p4 = (const v4u*)p;
#pragma unroll
    for (int i = 0; i < 8; ++i) { const v4u w = p4[i]; q[8 * i + 0] = bflo(w.x); q[8 * i + 1] = bfhi(w.x); q[8 * i + 2] = bflo(w.y); q[8 * i + 3] = bfhi(w.y); q[8 * i + 4] = bflo(w.z); q[8 * i + 5] = bfhi(w.z); q[8 * i + 6] = bflo(w.w); q[8 * i + 7] = bfhi(w.w); }
}
__device__ __forceinline__ float dot_row64(const bf16* p, const float (&q)[64]) {
    const v4u* p4 = (const v4u*)p; float s = 0.f;
#pragma unroll
    for (int i = 0; i < 8; ++i) { const v4u w = p4[i]; s += q[8 * i + 0] * bflo(w.x) + q[8 * i + 1] * bfhi(w.x) + q[8 * i + 2] * bflo(w.y) + q[8 * i + 3] * bfhi(w.y) + q[8 * i + 4] * bflo(w.z) + q[8 * i + 5] * bfhi(w.z) + q[8 * i + 6] * bflo(w.w) + q[8 * i + 7] * bfhi(w.w); }
    return s;
}
__device__ __forceinline__ void banded_naive(Frame& F) {
    unsigned char* ws = F.ws; const bf16* Qs = (const bf16*)(ws + WS_P + P_QS); const bf16* Ks = (const bf16*)(ws + WS_P + P_KS); const bf16* Vs = (const bf16*)(ws + WS_P + P_VS);
    bf16* OG = (bf16*)(ws + WS_HID + H_OG); float* LSE = (float*)(ws + WS_HID + H_LSE);
    LAS float* pl = (LAS float*)(F.lds + RING_OFF) + F.wave * 256;
    const int lane = F.lane;
    for (int it = F.blk * NWAVES + F.wave; it < 48 * SEQ; it += F.G * NWAVES) {
        const int bh = it >> 12, rp = it & 4095, b = bh / 12, h = bh % 12, g = h >> 2, dil = g == 0 ? 1 : (g == 1 ? 4 : 16), L = SEQ / dil;
        const int i = rp % L, r = rp / L, s = i * dil + r, nk = (i < 128 ? i : 128) + 1, first = rp - (nk - 1);
        float q[64]; load_row64(Qs + ((size_t)bh * SEQ + rp) * 64, q);
        float sc[3]; float m = -INFINITY;
#pragma unroll
        for (int kk = 0; kk < 3; ++kk) { const int j = lane + 64 * kk; sc[kk] = -INFINITY; if (j < nk) { sc[kk] = 0.6931471805599453f * dot_row64(Ks + ((size_t)bh * SEQ + first + j) * 64, q); } m = fmaxf(m, sc[kk]); }
        m = wave_max(m); float l = 0.f;
#pragma unroll
        for (int kk = 0; kk < 3; ++kk) { const float p = (lane + 64 * kk < nk) ? __expf(sc[kk] - m) : 0.f; pl[lane + 64 * kk] = p; l += p; }
        l = wave_sum(l); LDS_WAIT();
        float acc = 0.f; const bf16* vb = Vs + ((size_t)bh * SEQ + first) * 64 + lane;
        for (int j = 0; j < nk; ++j) acc += pl[j] * bf2f(vb[(size_t)j * 64]);
        const size_t orow = ((size_t)g * T + (size_t)b * SEQ + s) * 4 + (h & 3);
        OG[orow * 64 + lane] = (bf16)f2bf(acc / l);
        if (lane == 0) LSE[orow] = m + __logf(l);
        LDS_WAIT();
    }
}
__device__ __forceinline__ void merge_even(Frame& F, bf16* mix) {
    const bf16* OG = (const bf16*)(F.ws + WS_HID + H_OG); const float* LSE = (const float*)(F.ws + WS_HID + H_LSE);
    for (int t = F.blk * 512 + F.tid; t < T * 4 * 8; t += F.G * 512) {
        const int it = t >> 3, part = t & 7, row = it >> 2, hg = it & 3, b = row >> 12, s = row & 4095;
        const size_t i0 = ((size_t)0 * 16 + b * 4 + hg) * SEQ + srow(s, 0), i1 = ((size_t)1 * 16 + b * 4 + hg) * SEQ + srow(s, 1), i2 = ((size_t)2 * 16 + b * 4 + hg) * SEQ + srow(s, 2);
        const float l0 = LSE[i0], l1 = LSE[i1], l2 = LSE[i2]; const float m = fmaxf(l0, fmaxf(l1, l2));
        float w0 = __expf(l0 - m), w1 = __expf(l1 - m), w2 = __expf(l2 - m); const float inv = 1.0f / (w0 + w1 + w2); w0 *= inv; w1 *= inv; w2 *= inv;
        const v4u a = *(const v4u*)(OG + i0 * 64 + part * 8), bb = *(const v4u*)(OG + i1 * 64 + part * 8), c = *(const v4u*)(OG + i2 * 64 + part * 8);
        v4u o;
        o.x = pk2(w0 * bflo(a.x) + w1 * bflo(bb.x) + w2 * bflo(c.x), w0 * bfhi(a.x) + w1 * bfhi(bb.x) + w2 * bfhi(c.x));
        o.y = pk2(w0 * bflo(a.y) + w1 * bflo(bb.y) + w2 * bflo(c.y), w0 * bfhi(a.y) + w1 * bfhi(bb.y) + w2 * bfhi(c.y));
        o.z = pk2(w0 * bflo(a.z) + w1 * bflo(bb.z) + w2 * bflo(c.z), w0 * bfhi(a.z) + w1 * bfhi(bb.z) + w2 * bfhi(c.z));
        o.w = pk2(w0 * bflo(a.w) + w1 * bflo(bb.w) + w2 * bflo(c.w), w0 * bfhi(a.w) + w1 * bfhi(bb.w) + w2 * bfhi(c.w));
        *(v4u*)(mix + (size_t)row * EVEN_OUT + 256 + hg * 64 + part * 8) = o;
    }
}
__device__ __forceinline__ void gmlp_phase(Frame& F, int lp, const float* bsp, bf16* mix) {
    const bf16* UV = (const bf16*)(F.ws + WS_P + P_UV); const float* wtg = (const float*)(F.ws + WS_KMEAN) + (size_t)lp * 4 * 16384;
    LAS float* WT = (LAS float*)(F.lds + RING_OFF);
    LAS float* VL = WT + 128 * 128;
    const int tid = F.tid; int gl = -1;
    for (int unit = F.blk; unit < (T / 128) * 4; unit += F.G) {
        const int c = unit >> 2, g = unit & 3, row0 = c * 128;
        __syncthreads();
        if (g != gl) { gl = g; const f32x4* src = (const f32x4*)(wtg + (size_t)g * 16384);
#pragma unroll
            for (int q = 0; q < 8; ++q) *((LAS f32x4*)WT + tid + 512 * q) = src[tid + 512 * q]; }
        { const int j = tid >> 2, d8 = (tid & 3) * 16;
          const v4u a = *(const v4u*)(UV + (size_t)(row0 + j) * 512 + 256 + g * 64 + d8), b = *(const v4u*)(UV + (size_t)(row0 + j) * 512 + 256 + g * 64 + d8 + 8);
          LAS f32x4* vd = (LAS f32x4*)(VL + j * 64 + d8);
          vd[0] = (f32x4){bflo(a.x), bfhi(a.x), bflo(a.y), bfhi(a.y)}; vd[1] = (f32x4){bflo(a.z), bfhi(a.z), bflo(a.w), bfhi(a.w)};
          vd[2] = (f32x4){bflo(b.x), bfhi(b.x), bflo(b.y), bfhi(b.y)}; vd[3] = (f32x4){bflo(b.z), bfhi(b.z), bflo(b.w), bfhi(b.w)}; }
        __syncthreads();
        const int i0 = 4 * (tid >> 4), d0 = 4 * (tid & 15);
        f32x4 acc[4];
#pragma unroll
        for (int a = 0; a < 4; ++a) acc[a] = (f32x4){0.f, 0.f, 0.f, 0.f};
        const int jmax = i0 + 3;
        for (int j = 0; j <= jmax; ++j) { const f32x4 w = *(const LAS f32x4*)(WT + j * 128 + i0); const f32x4 v = *(const LAS f32x4*)(VL + j * 64 + d0);
            acc[0] += w.x * v; acc[1] += w.y * v; acc[2] += w.z * v; acc[3] += w.w * v; }
#pragma unroll
        for (int a = 0; a < 4; ++a) { const int i = i0 + a; const float bb = bsp[g * 128 + i]; const size_t row = row0 + i;
            const v2u uu = *(const v2u*)(UV + row * 512 + g * 64 + d0);
            v2u o; o.x = pk2(bflo(uu.x) * (acc[a].x + bb), bfhi(uu.x) * (acc[a].y + bb)); o.y = pk2(bflo(uu.y) * (acc[a].z + bb), bfhi(uu.y) * (acc[a].w + bb));
            *(v2u*)(mix + row * EVEN_OUT + g * 64 + d0) = o; }
    }
    __syncthreads();
}
__device__ __forceinline__ void moba_naive(Frame& F, bf16* mix) {
    unsigned char* ws = F.ws; const bf16* Qm = (const bf16*)(ws + WS_P + P_QM); const bf16* Km = (const bf16*)(ws + WS_P + P_KM); const bf16* Vm = (const bf16*)(ws + WS_P + P_VM);
    const float* km = (const float*)(ws + WS_KMEAN);
    LAS float* sc = (LAS float*)(F.lds + RING_OFF) + F.wave * 1024;
    const int lane = F.lane;
    for (int it = F.blk * NWAVES + F.wave; it < 48 * SEQ; it += F.G * NWAVES) {
        const int bh = it >> 12, s = it & 4095, b = bh / 12, h = bh % 12, qb = s >> 8;
        float q[64]; load_row64(Qm + ((size_t)bh * SEQ + s) * 64, q);
        float gate = -INFINITY;
        if (lane < qb) { const f32x4* kp = (const f32x4*)(km + ((size_t)bh * 16 + lane) * 64); float a = 0.f;
#pragma unroll
            for (int i = 0; i < 16; ++i) { const f32x4 w = kp[i]; a += q[4 * i] * w.x + q[4 * i + 1] * w.y + q[4 * i + 2] * w.z + q[4 * i + 3] * w.w; }
            gate = a; }
        unsigned sel = 1u << qb;
        for (int r = 0; r < 3; ++r) { float v = gate; int idx = lane;
#pragma unroll
            for (int o = 1; o < 64; o <<= 1) { const float ov = __shfl_xor(v, o); const int oi = __shfl_xor(idx, o); if (ov > v || (ov == v && oi < idx)) { v = ov; idx = oi; } }
            if (v > -INFINITY) { sel |= 1u << idx; if (lane == idx) gate = -INFINITY; } }
        int cnt = 0; float m = -INFINITY;
        for (int n = 0; n <= qb; ++n) { if (!((sel >> n) & 1u)) continue;
#pragma unroll
            for (int kk = 0; kk < 4; ++kk) { const int key = n * 256 + kk * 64 + lane; float x = -INFINITY;
                if (key <= s) x = 0.6931471805599453f * dot_row64(Km + ((size_t)bh * SEQ + key) * 64, q);
                sc[cnt * 256 + kk * 64 + lane] = x; m = fmaxf(m, x); }
            ++cnt; }
        m = wave_max(m); float l = 0.f; LDS_WAIT();
        for (int i = lane; i < cnt * 256; i += 64) { const float p = __expf(sc[i] - m); sc[i] = p; l += p; }
        l = wave_sum(l); LDS_WAIT();
        float acc = 0.f; int c2 = 0;
        for (int n = 0; n <= qb; ++n) { if (!((sel >> n) & 1u)) continue;
            const bf16* vb = Vm + ((size_t)bh * SEQ + n * 256) * 64 + lane; const int kend = (n == qb) ? (s & 255) + 1 : 256;
            for (int kk = 0; kk < kend; ++kk) acc += sc[c2 * 256 + kk] * bf2f(vb[(size_t)kk * 64]);
            ++c2; }
        mix[((size_t)b * SEQ + s) * ODD_OUT + h * 64 + lane] = (bf16)f2bf(acc / l);
        LDS_WAIT();
    }
}
__device__ __forceinline__ void conv_phase(Frame& F, const bf16* cv, const float* cw, bf16* mix) {
    for (int it = F.blk * 512 + F.tid; it < T * 32; it += F.G * 512) {
        const int row = it >> 5, c = (it & 31) * 8, s = row & 4095;
        const bf16* p = cv + (size_t)row * 768 + c;
        const v4u bg = *(const v4u*)p, c0 = *(const v4u*)(p + 256), x0 = *(const v4u*)(p + 512);
        v4u c1 = (v4u){0u, 0u, 0u, 0u}, x1 = c1, c2 = c1, x2 = c1;
        if (s >= 1) { c1 = *(const v4u*)(p + 256 - 768); x1 = *(const v4u*)(p + 512 - 768); }
        if (s >= 2) { c2 = *(const v4u*)(p + 256 - 1536); x2 = *(const v4u*)(p + 512 - 1536); }
        const f32x4 wa0 = *(const f32x4*)(cw + c), wa1 = *(const f32x4*)(cw + c + 4), wb0 = *(const f32x4*)(cw + 256 + c), wb1 = *(const f32x4*)(cw + 256 + c + 4), wc0 = *(const f32x4*)(cw + 512 + c), wc1 = *(const f32x4*)(cw + 512 + c + 4);
        const unsigned bgw[4] = {bg.x, bg.y, bg.z, bg.w}, c0w[4] = {c0.x, c0.y, c0.z, c0.w}, x0w[4] = {x0.x, x0.y, x0.z, x0.w}, c1w[4] = {c1.x, c1.y, c1.z, c1.w}, x1w[4] = {x1.x, x1.y, x1.z, x1.w}, c2w[4] = {c2.x, c2.y, c2.z, c2.w}, x2w[4] = {x2.x, x2.y, x2.z, x2.w};
        const float w0[8] = {wa0.x, wa0.y, wa0.z, wa0.w, wa1.x, wa1.y, wa1.z, wa1.w}, w1[8] = {wb0.x, wb0.y, wb0.z, wb0.w, wb1.x, wb1.y, wb1.z, wb1.w}, w2[8] = {wc0.x, wc0.y, wc0.z, wc0.w, wc1.x, wc1.y, wc1.z, wc1.w};
        unsigned ow[4];
#pragma unroll
        for (int k = 0; k < 4; ++k) {
            const float ylo = w0[2 * k] * (bflo(c2w[k]) * bflo(x2w[k])) + w1[2 * k] * (bflo(c1w[k]) * bflo(x1w[k])) + w2[2 * k] * (bflo(c0w[k]) * bflo(x0w[k]));
            const float yhi = w0[2 * k + 1] * (bfhi(c2w[k]) * bfhi(x2w[k])) + w1[2 * k + 1] * (bfhi(c1w[k]) * bfhi(x1w[k])) + w2[2 * k + 1] * (bfhi(c0w[k]) * bfhi(x0w[k]));
            ow[k] = pk2(bflo(bgw[k]) * ylo, bfhi(bgw[k]) * yhi); }
        *(v4u*)(mix + (size_t)row * ODD_OUT + 768 + c) = (v4u){ow[0], ow[1], ow[2], ow[3]};
    }
}

constexpr int CW_QMOBA = 8192;
__device__ __forceinline__ void moba_phase(Frame& F, int lp, bf16* mix) {
    unsigned char* ws = F.ws; const bf16* Qm = (const bf16*)(ws + WS_P + P_QM); const bf16* Km = (const bf16*)(ws + WS_P + P_KM); const bf16* Vm = (const bf16*)(ws + WS_P + P_VM);
    const float* km = (const float*)(ws + WS_CTL + CTL_KMSUM + (size_t)(lp & 1) * KMSUM_BYTES);
    char* shm = (char*)F.lds + RING_OFF; LAS unsigned char* l3 = F.lds + RING_OFF;
    LAS float* kml = (LAS float*)(l3 + att::LDS_KM); volatile LAS int* tkw = (volatile LAS int*)(l3 + att::LDS_TK);
    unsigned* head = (unsigned*)(F.ctl + CW_QMOBA + 64 * lp);
    const int tid = F.tid, wid = F.wave;
    for (;;) {
        if (tid == 0) { unsigned* hp = head; asm volatile("" : "+v"(hp)); tkw[0] = (int)__hip_atomic_fetch_add(hp, 1u, __ATOMIC_RELAXED, __HIP_MEMORY_SCOPE_AGENT); }
        __syncthreads();
        const int tk = __builtin_amdgcn_readfirstlane(tkw[0]);
        if (tk >= 48 * 16) break;
        const int qb = 15 - tk / 48, bh = tk % 48, b = bh / 12, h = bh % 12;
        int lane_ = F.lane; asm volatile("" : "+v"(lane_)); const int r32 = lane_ & 31, hi = lane_ >> 5;
        ((LAS v2u*)kml)[tid] = ((const v2u*)(km + (size_t)bh * 1024))[tid];
        __syncthreads();
        unsigned sel = 0u;
        { const bf16* qrow = Qm + ((size_t)bh * SEQ + qb * 256 + wid * 32 + r32) * 64 + hi * 8;
          float qf[32];
#pragma unroll
          for (int d0 = 0; d0 < 4; ++d0) { const v4u w = *(const v4u*)(qrow + d0 * 16);
              qf[8 * d0 + 0] = bflo(w.x); qf[8 * d0 + 1] = bfhi(w.x); qf[8 * d0 + 2] = bflo(w.y); qf[8 * d0 + 3] = bfhi(w.y); qf[8 * d0 + 4] = bflo(w.z); qf[8 * d0 + 5] = bfhi(w.z); qf[8 * d0 + 6] = bflo(w.w); qf[8 * d0 + 7] = bfhi(w.w); }
          float v1 = -INFINITY, v2 = -INFINITY, v3 = -INFINITY; int i1 = 0, i2 = 0, i3 = 0;
          for (int n = 0; n < qb; ++n) { float a = 0.f;
#pragma unroll
              for (int d0 = 0; d0 < 4; ++d0) { const f32x4 k0 = *(const LAS f32x4*)(kml + n * 64 + d0 * 16 + hi * 8), k1 = *(const LAS f32x4*)(kml + n * 64 + d0 * 16 + hi * 8 + 4);
                  a += qf[8 * d0 + 0] * k0.x + qf[8 * d0 + 1] * k0.y + qf[8 * d0 + 2] * k0.z + qf[8 * d0 + 3] * k0.w + qf[8 * d0 + 4] * k1.x + qf[8 * d0 + 5] * k1.y + qf[8 * d0 + 6] * k1.z + qf[8 * d0 + 7] * k1.w; }
              a = xsum32(a);
              if (a > v1) { v3 = v2; i3 = i2; v2 = v1; i2 = i1; v1 = a; i1 = n; } else if (a > v2) { v3 = v2; i3 = i2; v2 = a; i2 = n; } else if (a > v3) { v3 = a; i3 = n; } }
          if (v1 > -INFINITY) sel |= 1u << i1; if (v2 > -INFINITY) sel |= 1u << i2; if (v3 > -INFINITY) sel |= 1u << i3; }
        const size_t sb = (size_t)bh * SEQ * 64;
        att::attn_unit<0, 8, ODD_OUT>(Qm + sb, qb * 256, 0, 4 * (qb + 1), sel, mix + ((size_t)b * SEQ + qb * 256) * ODD_OUT + h * 64, nullptr, shm, tid);
    }
    __syncthreads();
}
__device__ __forceinline__ void banded_phase(Frame& F) {
    unsigned char* ws = F.ws; const bf16* Qs = (const bf16*)(ws + WS_P + P_QS); const bf16* Ks = (const bf16*)(ws + WS_P + P_KS); const bf16* Vs = (const bf16*)(ws + WS_P + P_VS);
    bf16* OG = (bf16*)(ws + WS_HID + H_OG); float* LSE = (float*)(ws + WS_HID + H_LSE);
    char* shm = (char*)F.lds + RING_OFF;
    for (int u = F.blk; u < 768; u += F.G) {
        const int g = u >> 8, rem = u & 255, b = rem >> 6, hg = (rem >> 4) & 3, u16 = rem & 15, h = g * 4 + hg, bh = b * 12 + h;
        const int dil = g == 0 ? 1 : (g == 1 ? 4 : 16), L = SEQ / dil, row0 = 256 * u16, r = row0 / L, q0s = row0 % L;
        const int tile0 = (q0s >> 6) >= 2 ? (q0s >> 6) - 2 : 0, NT = (q0s >> 6) + 4 - tile0;
        const size_t sb = ((size_t)bh * SEQ + (size_t)r * L) * 64;
        const size_t orow = ((size_t)g * 16 + b * 4 + hg) * SEQ + row0;
        att::attn_unit<1, 8, 64>(Qs + sb, q0s, tile0, NT, 0u, OG + orow * 64, LSE + orow, shm, F.tid);
    }
    __syncthreads();
}

constexpr int PH_PER_PAIR = 16, NPH = 1 + 2 * PH_PER_PAIR + 1;
__global__ void __launch_bounds__(NWAVES * 64, 2) fwd(Args args) {
    extern __shared__ __attribute__((aligned(16))) unsigned char lds[];
    const int wv0 = __builtin_amdgcn_readfirstlane((int)threadIdx.x >> 6);
#define MKFRAME() Frame F; { int t_ = TID_NOW(wv0); asm volatile("" : "+v"(t_)); int b_ = blockIdx.x; asm volatile("" : "+s"(b_)); \
    F.lds = (LAS unsigned char*)lds; F.MISC = (volatile LAS unsigned*)(F.lds + MISC_OFF); F.tid = t_; F.lane = t_ & 63; F.wave = __builtin_amdgcn_readfirstlane(t_ >> 6); \
    const __attribute__((address_space(4))) Args* ap = (const __attribute__((address_space(4))) Args*)__builtin_amdgcn_kernarg_segment_ptr(); asm volatile("" : "+s"(ap));     \
    unsigned char* w_ = ap->ws; asm volatile("" : "+s"(w_)); F.G = gridDim.x; F.blk = b_; F.ws = w_; F.out = ap->out; F.ctl = (gu32*)(w_ + WS_CTL); F.ap = ap; }
    for (int u = TID_NOW(wv0); u < (LDS_BYTES - LDSCTL_OFF) / 4; u += NWAVES * 64) ((LAS unsigned*)((LAS unsigned char*)lds + LDSCTL_OFF))[u] = 0u;
    __syncthreads();
    const int lo = args.ph_lo, hi = args.ph_hi;
    XcdBarrier bar; bar.bar = (unsigned*)(args.ws + WS_CTL) + CW_BAR; bar.x = 0; bar.st = nullptr;
    if (hi - lo > 1) bar = xcd_barrier_post((unsigned*)(args.ws + WS_CTL) + CW_BAR, (volatile LAS unsigned*)((LAS unsigned char*)lds + MISC_OFF) + 8, TID_NOW(wv0));
#ifndef PHMASK
#define PHMASK 0xFFFFFF
#endif
#define PHEN(k) (((PHMASK) >> (k)) & 1)
#ifndef PROBE_REP
#define PROBE_REP 0
#endif
#define NREP(k) ((((PROBE_REP) >> (k)) & 1) + 1)
#define IN(k) (lo <= (k) && (k) < hi)
#define SEAM(k) do { if (IN(k) && IN((k) + 1)) xcd_barrier(bar, TID_NOW(wv0)); } while (0)
#define HN ((bf16*)(F.ws + WS_HN))
#define MIX ((bf16*)(F.ws + WS_MIX))
#define HID ((bf16*)(F.ws + WS_HID))
#define RAWP ((bf16*)(F.ws + WS_HID + H_RAWP))
#define HSORT ((bf16*)(F.ws + WS_P))
#define YB ((bf16*)(F.ws + WS_P))
#define x_in (F.ap->in[0])

    if (PHEN(19) && IN(0)) { for (int rep_ = 0; rep_ < NREP(19); ++rep_) { MKFRAME(); p0_prologue(F, args); } SEAM(0); }

    for (int lp = 0; lp < 2; ++lp) {
        const int pb = 1 + lp * PH_PER_PAIR;
        const int le = 2 * lp, lo_ = 2 * lp + 1;
#define we ((const pg8::bf16_t*)(F.ws + WS_WT_EVEN0 + (size_t)lp * WT_EVEN_BYTES))
#define wo ((const pg8::bf16_t*)(F.ws + WS_WT_ODD0 + (size_t)lp * WT_ODD_BYTES))
        if (PHEN(0) && IN(pb + 0)) { { MKFRAME();
            norm_phase(F, lp == 0 ? x_in : F.out, F.out, F.ap->in[1] + (size_t)le * D, HN, lp != 0, false, true, nullptr, Q_INPROJ == 2); } SEAM(pb + 0); }
        if (PHEN(1) && IN(pb + 1)) { for (int rep_ = 0; rep_ < NREP(1); ++rep_) { MKFRAME();
            { LAS float* gt = (LAS float*)(F.lds + pg8::GAIN_TAB_OFF);
              if (F.tid < 256) gt[F.tid] = (F.ap->in[4] + (size_t)lp * 256)[F.tid]; else if (F.tid < 320) gt[F.tid] = (F.ap->in[7] + (size_t)lp * 64)[F.tid - 256]; else if (F.tid < 384) gt[F.tid] = (F.ap->in[8] + (size_t)lp * 64)[F.tid - 320];
              __syncthreads(); }
            pg8::Gemm g{HN, we + WTE_IN / 2, T, EVEN_IN, D}; pg8::StaticOrder S; S.init(T, EVEN_IN, F.G, F.blk);
            pg8::EpiHeadsEven E{(bf16*)(F.ws + WS_P + P_UV), (bf16*)(F.ws + WS_P + P_QS), F.ap->in[4] + (size_t)lp * 256, F.ap->in[7] + (size_t)lp * 64, F.ap->in[8] + (size_t)lp * 64,
                                (const float*)(F.ws + WS_ROPE), (const float*)(F.ws + WS_ROPE) + SEQ * 32, (const float*)(F.ws + WS_SSP), (const LAS float*)(F.lds + pg8::GAIN_TAB_OFF)};
            pg8::gemm_phase<pg8::EpiHeadsEven, pg8::StaticOrder, true, true, Q_INPROJ>(F.lds + RING_OFF, g, S, E, F.tid);
            } SEAM(pb + 1); }
        if (PHEN(2) && IN(pb + 2)) { for (int rep_ = 0; rep_ < NREP(2); ++rep_) { MKFRAME(); banded_phase(F); gmlp_phase(F, lp, F.ap->in[6] + (size_t)lp * 4 * 128, MIX); } SEAM(pb + 2); }
        if (PHEN(3) && IN(pb + 3)) { for (int rep_ = 0; rep_ < NREP(3); ++rep_) { MKFRAME(); merge_even(F, MIX); } SEAM(pb + 3); }
        if (PHEN(4) && IN(pb + 4)) { { MKFRAME();
            pg8::Gemm g{MIX, we + WTE_OUT / 2, T, D, EVEN_OUT}; pg8::StaticOrder S; S.init(T, D, F.G, F.blk);
            pg8::EpiF32Res E{lp == 0 ? x_in : F.out, F.out, D};
            pg8::gemm_phase<pg8::EpiF32Res, pg8::StaticOrder>(F.lds + RING_OFF, g, S, E, F.tid);
            } SEAM(pb + 4); }
        if (PHEN(5) && IN(pb + 5)) { { MKFRAME(); norm_phase(F, F.out, F.out, F.ap->in[2] + (size_t)le * D, HN, false, false, true, nullptr, Q_FFN == 2); } SEAM(pb + 5); }
        if (PHEN(6) && IN(pb + 6)) { for (int rep_ = 0; rep_ < NREP(6); ++rep_) { MKFRAME();
            pg8::Gemm g{HN, we + WTE_GU / 2, T, 2 * DFF, D}; pg8::StaticOrder S; S.init(T, 2 * DFF, F.G, F.blk);
            pg8::EpiSwiGLU E{HID, DFF, 1.0f, (const float*)(F.ws + WS_SSP)};
            pg8::gemm_phase<pg8::EpiSwiGLU, pg8::StaticOrder, true, true, Q_FFN>(F.lds + RING_OFF, g, S, E, F.tid);
            } SEAM(pb + 6); }
        if (PHEN(7) && IN(pb + 7)) { { MKFRAME();
            pg8::Gemm g{HID, we + WTE_DN / 2, T, D, DFF}; pg8::StaticOrder S; S.init(T, D, F.G, F.blk);
            pg8::EpiF32Res E{F.out, F.out, D};
            pg8::gemm_phase<pg8::EpiF32Res, pg8::StaticOrder>(F.lds + RING_OFF, g, S, E, F.tid);
            } SEAM(pb + 7); }
        if (PHEN(8) && IN(pb + 8)) { { MKFRAME(); norm_phase(F, F.out, F.out, F.ap->in[1] + (size_t)lo_ * D, HN, false, false, true, nullptr, Q_INPROJ == 2); } SEAM(pb + 8); }
        if (PHEN(9) && IN(pb + 9)) { for (int rep_ = 0; rep_ < NREP(9); ++rep_) { MKFRAME();
            { LAS float* gt = (LAS float*)(F.lds + pg8::GAIN_TAB_OFF);
              if (F.tid >= 256 && F.tid < 320) gt[F.tid] = (F.ap->in[14] + (size_t)lp * 64)[F.tid - 256]; else if (F.tid >= 320 && F.tid < 384) gt[F.tid] = (F.ap->in[15] + (size_t)lp * 64)[F.tid - 320];
              __syncthreads(); }
            pg8::Gemm g{HN, wo + WTO_IN / 2, T, ODD_IN, D}; pg8::StaticOrder S; S.init(T, ODD_IN, F.G, F.blk);
            pg8::EpiHeadsOdd E{(bf16*)(F.ws + WS_P + P_QM), (bf16*)(F.ws + WS_P + P_CONV), (float*)(F.ws + WS_CTL + CTL_KMSUM + (size_t)lp * KMSUM_BYTES),
                               F.ap->in[14] + (size_t)lp * 64, F.ap->in[15] + (size_t)lp * 64, (const float*)(F.ws + WS_ROPE), (const float*)(F.ws + WS_ROPE) + SEQ * 32, (const float*)(F.ws + WS_SSP), (const LAS float*)(F.lds + pg8::GAIN_TAB_OFF)};
            pg8::gemm_phase<pg8::EpiHeadsOdd, pg8::StaticOrder, true, true, Q_INPROJ>(F.lds + RING_OFF, g, S, E, F.tid);
            } SEAM(pb + 9); }
        if (PHEN(10) && IN(pb + 10)) { for (int rep_ = 0; rep_ < NREP(10); ++rep_) { MKFRAME(); moba_phase(F, lp + 2 * rep_, MIX); conv_phase(F, (const bf16*)(F.ws + WS_P + P_CONV), F.ap->in[16] + (size_t)lp * 3 * 256, MIX); } SEAM(pb + 10); }
        if (PHEN(11) && IN(pb + 11)) { { MKFRAME();
            pg8::Gemm g{MIX, wo + WTO_OUT / 2, T, D, ODD_OUT}; pg8::StaticOrder S; S.init(T, D, F.G, F.blk);
            pg8::EpiF32Res E{F.out, F.out, D};
            pg8::gemm_phase<pg8::EpiF32Res, pg8::StaticOrder>(F.lds + RING_OFF, g, S, E, F.tid);
            } SEAM(pb + 11); }
        if (PHEN(12) && IN(pb + 12)) { { MKFRAME(); norm_phase(F, F.out, F.out, F.ap->in[2] + (size_t)lo_ * D, HN, false, true, true, F.ap->in[18] + (size_t)lp * D * NEXP); } SEAM(pb + 12); }
        if (PHEN(13) && IN(pb + 13)) { for (int rep_ = 0; rep_ < NREP(13); ++rep_) { MKFRAME(); route_phase(F, HN, HSORT); } SEAM(pb + 13); }
        if (PHEN(14) && IN(pb + 14)) { for (int rep_ = 0; rep_ < NREP(14); ++rep_) { MKFRAME();
            const int* tbp = (const int*)(F.ws + WS_MISC + 512 * 1024);
            pg8::MoeOrder S; const int ntiles = __builtin_amdgcn_readfirstlane(tbp[8]); S.init(ntiles * 256, 2 * DFFE, F.G, F.blk);
#pragma unroll
            for (int k = 0; k < 8; ++k) S.tb[k] = __builtin_amdgcn_readfirstlane(tbp[k]);
            S.estride = (size_t)2 * DFFE * D;
            pg8::Gemm g{HSORT, wo + WTO_MGU / 2, ntiles * 256, 2 * DFFE, D};
            pg8::EpiSwiGLU8 E{(unsigned char*)HID, DFFE, 1.0f, H8_SCALE, (const float*)(F.ws + WS_SSP + 128 * 1024)};
            pg8::gemm_phase<pg8::EpiSwiGLU8, pg8::MoeOrder, false, true, 2>(F.lds + RING_OFF, g, S, E, F.tid);
            } SEAM(pb + 14); }
        if (PHEN(15) && IN(pb + 15)) { for (int rep_ = 0; rep_ < NREP(15); ++rep_) { MKFRAME();
            const int* tbp = (const int*)(F.ws + WS_MISC + 512 * 1024);
            pg8::MoeOrder S; const int ntiles = __builtin_amdgcn_readfirstlane(tbp[8]); S.init(ntiles * 256, D, F.G, F.blk);
#pragma unroll
            for (int k = 0; k < 8; ++k) S.tb[k] = __builtin_amdgcn_readfirstlane(tbp[k]);
            S.estride = (size_t)DFFE * D;
            pg8::Gemm g{HID, wo + WTO_MD / 2, ntiles * 256, D, DFFE};
            pg8::EpiBf16PlainPP E{YB, D, 1.0f / (W8_SCALE * H8_SCALE)};
            pg8::gemm_phase<pg8::EpiBf16PlainPP, pg8::MoeOrder, false, true, 1>(F.lds + RING_OFF, g, S, E, F.tid);
            } SEAM(pb + 15); }
    }
    if (PHEN(20) && IN(NPH - 1)) { MKFRAME(); norm_phase(F, F.out, F.out, F.ap->in[1], HN, true, false, false, nullptr); }
#undef IN
#undef SEAM
#undef HN
#undef MIX
#undef HID
#undef RAWP
#undef HSORT
#undef YB
#undef x_in
#undef we
#undef wo
}

extern "C" void kernel_launch(void* const* d_in, const int* in_sizes, int n_in, void* d_out, int out_size, void* d_ws, size_t ws_size, hipStream_t stream) {
    static int grid = 0;
    if (grid == 0) {
        if (n_in != 22 || out_size != T * D || ws_size < WS_END) { fprintf(stderr, "kernel_launch: unexpected shapes (n_in %d out %d ws %zu)\n", n_in, out_size, ws_size); grid = -1; return; }
        int dev = 0, cus = 0, per_cu = 0;
        if (hipGetDevice(&dev) != hipSuccess || hipDeviceGetAttribute(&cus, hipDeviceAttributeMultiprocessorCount, dev) != hipSuccess) { grid = -1; return; }
        if (hipFuncSetAttribute((const void*)fwd, hipFuncAttributeMaxDynamicSharedMemorySize, LDS_BYTES) != hipSuccess) { fprintf(stderr, "kernel_launch: hipFuncSetAttribute failed\n"); grid = -1; return; }
        if (hipOccupancyMaxActiveBlocksPerMultiprocessor(&per_cu, (const void*)fwd, NWAVES * 64, LDS_BYTES) != hipSuccess || per_cu < 1) fprintf(stderr, "kernel_launch: occupancy query says %d\n", per_cu);
        (void)hipGetLastError();
        grid = cus;
    }
    if (grid < 0) return;
    (void)hipMemsetAsync((char*)d_ws + WS_CTL, 0, CTL_ZERO_BYTES, stream);
    Args a{};
    for (int i = 0; i < 22; ++i) a.in[i] = (const float*)d_in[i];
    a.out = (float*)d_out; a.ws = (unsigned char*)d_ws;
#if MK_PER_PHASE
    for (int p = 0; p < NPH; ++p) { a.ph_lo = p; a.ph_hi = p + 1; hipLaunchKernelGGL(fwd, dim3(grid), dim3(NWAVES * 64), LDS_BYTES, stream, a); }
#else
    a.ph_lo = 0; a.ph_hi = NPH; hipLaunchKernelGGL(fwd, dim3(grid), dim3(NWAVES * 64), LDS_BYTES, stream, a);
#endif
}
```

```cpp
#include <hip/hip_runtime.h>
#include <cstdio>
#include <cstdint>
#include <type_traits>
#include <hip/hip_bf16.h>


template <int X> __device__ __forceinline__ float xswz(float v) { return __builtin_bit_cast(float, __builtin_amdgcn_ds_swizzle(__builtin_bit_cast(int, v), (X << 10) | 0x1F)); }
template <int X> __device__ __forceinline__ int xswzi(int v) { return __builtin_amdgcn_ds_swizzle(v, (X << 10) | 0x1F); }
__device__ __forceinline__ float xsum32(float v) { float a = v, b = v; asm("s_nop 1\n\tv_permlane32_swap_b32_e32 %0, %1" : "+v"(a), "+v"(b)); return a + b; }
__device__ __forceinline__ int xsum32i(int v) { int a = v, b = v; asm("s_nop 1\n\tv_permlane32_swap_b32_e32 %0, %1" : "+v"(a), "+v"(b)); return a + b; }
__device__ __forceinline__ float xmax32(float v) { float a = v, b = v; asm("s_nop 1\n\tv_permlane32_swap_b32_e32 %0, %1" : "+v"(a), "+v"(b)); return fmaxf(a, b); }


__device__ __forceinline__ int lane_hw() { int l; asm volatile("v_mbcnt_lo_u32_b32 %0, -1, 0\n\tv_mbcnt_hi_u32_b32 %0, -1, %0" : "=v"(l)); return l; }
#define TID_NOW(wv) ((wv) * 64 + lane_hw())

#ifndef NAIVE_MOBA
#define NAIVE_MOBA 0
#endif
#ifndef NAIVE_BANDED
#define NAIVE_BANDED 0
#endif
#ifndef Q_INPROJ
#define Q_INPROJ 2
#endif
#ifndef Q_FFN
#define Q_FFN 2
#endif
#ifndef MK_PER_PHASE
#define MK_PER_PHASE 0
#endif

namespace pg8 {
#define PG8_LAS __attribute__((address_space(3)))
typedef unsigned short bf16_t;
typedef short bf16x8 __attribute__((ext_vector_type(8)));
typedef float f32x4 __attribute__((ext_vector_type(4)));
typedef float f32x2 __attribute__((ext_vector_type(2)));
typedef unsigned u32x4 __attribute__((ext_vector_type(4)));
constexpr int BM = 256, BK = 64, HALF = 128, HTB = HALF * BK * 2, STAGE_BYTES = 8 * HTB, NXCD = 8, WGM = 8;
constexpr int GAIN_TAB_OFF = STAGE_BYTES + 1024 + 2048;
constexpr int RS_TAB_OFF = STAGE_BYTES + 1024;

__host__ __device__ __forceinline__ int lds_byte(int r, int c) { const int st = (r >> 4) * 2 + (c >> 5), rr = r & 15, cc = c & 31, ob = rr * 64 + cc * 2; return st * 1024 + (ob ^ (((ob >> 9) & 1) << 5)); }
__host__ __device__ __forceinline__ void stage_rc(int b, int& R, int& C) { const int st = b / 1024, sb = b % 1024, swz = sb ^ (((sb >> 9) & 1) << 5); R = (st >> 1) * 16 + swz / 64; C = (st & 1) * 32 + (swz % 64) / 2; }
__host__ __device__ __forceinline__ int perm32(int rho) { const int n = rho >> 4, i = rho & 15; return 8 * (i >> 2) + 4 * n + (i & 3); }

struct Unit { int pm, pn; };
struct Gemm { const bf16_t* A; const bf16_t* Bt; int M, N, K; };

struct StaticOrder {
    int nM, nN, nwg, G, c;
    __device__ void init(int M, int N, int G_, int c_) { nM = M / BM; nN = N / BM; nwg = nM * nN; G = G_; c = c_; }
    __device__ bool next(int i, Unit& u) const {
        const long L = (long)i * G + c; if (L >= nwg) return false;
        int wgid = (int)L; { const int q = nwg / NXCD, r = nwg % NXCD, xcd = wgid % NXCD, off = wgid / NXCD; wgid = (xcd < r ? xcd * (q + 1) : r * (q + 1) + (xcd - r) * q) + off; }
        const int nig = WGM * nN, gid = wgid / nig, fm = gid * WGM, gsz = (nM - fm) < WGM ? (nM - fm) : WGM;
        u.pm = fm + ((wgid % nig) % gsz); u.pn = (wgid % nig) / gsz; return true;
    }
    __device__ __forceinline__ const char* bbase(const Unit&, const bf16_t* Bt) const { return (const char*)Bt; }
};
struct MoeOrder : StaticOrder {
    int tb[8]; size_t estride;
    __device__ __forceinline__ const char* bbase(const Unit& u, const bf16_t* Bt) const {
        unsigned e = 0;
#pragma unroll
        for (int k = 1; k < 8; ++k) e += ((unsigned)(tb[k] - 1 - u.pm)) >> 31;
        return (const char*)Bt + (size_t)e * estride;
    }
};

__device__ __forceinline__ unsigned cvt_pk_bf16(float lo, float hi) { unsigned r; asm volatile("v_cvt_pk_bf16_f32 %0, %1, %2" : "=v"(r) : "v"(lo), "v"(hi)); return r; }

struct EpiBf16Plain {
    static constexpr bool PERM = true; static constexpr bool NEEDS_RS = false;
    bf16_t* O; int ldc; float sc;
    __device__ __forceinline__ void operator()(const f32x4 (&acc)[2][2][4][2], const Unit& u, int wr, int wc, int fr, int fq) const {
        const int row0 = u.pm * BM + wr * 64 + fr, col0 = u.pn * BM + wc * 32 + 8 * fq;
#pragma unroll
        for (int ai = 0; ai < 2; ++ai)
#pragma unroll
            for (int m = 0; m < 4; ++m) { bf16_t* rowp = O + (size_t)(row0 + ai * HALF + m * 16) * ldc + col0;
#pragma unroll
                for (int bj = 0; bj < 2; ++bj) { const f32x4 v0 = acc[ai][bj][m][0] * sc, v1 = acc[ai][bj][m][1] * sc;
                    u32x4 w; w.x = cvt_pk_bf16(v0[0], v0[1]); w.y = cvt_pk_bf16(v0[2], v0[3]); w.z = cvt_pk_bf16(v1[0], v1[1]); w.w = cvt_pk_bf16(v1[2], v1[3]);
                    *(u32x4*)(rowp + bj * HALF) = w; } }
    }
};
struct EpiF32Res {
    static constexpr bool PERM = false; static constexpr bool NEEDS_RS = false;
    const float* base; float* out; int ldc;
    __device__ __forceinline__ void operator()(const f32x4 (&acc)[2][2][4][2], const Unit& u, int wr, int wc, int fr, int fq) const {
        const int row0 = u.pm * BM + wr * 64 + fr, col0 = u.pn * BM + wc * 32 + 4 * fq;
#pragma unroll
        for (int ai = 0; ai < 2; ++ai)
#pragma unroll
            for (int m = 0; m < 4; ++m) { const size_t off = (size_t)(row0 + ai * HALF + m * 16) * ldc + col0;
#pragma unroll
                for (int bj = 0; bj < 2; ++bj)
#pragma unroll
                    for (int n = 0; n < 2; ++n) { const f32x4 bs = *(const f32x4*)(base + off + bj * HALF + n * 16); *(f32x4*)(out + off + bj * HALF + n * 16) = bs + acc[ai][bj][m][n]; }
                asm volatile("" ::: "memory"); }
    }
};
struct EpiBf16PlainPP {
    static constexpr bool PERM = false; static constexpr bool NEEDS_RS = false;
    bf16_t* O; int ldc; float sc;
    __device__ __forceinline__ void operator()(const f32x4 (&acc)[2][2][4][2], const Unit& u, int wr, int wc, int fr, int fq) const {
        const int row0 = u.pm * BM + wr * 64 + fr, col0 = u.pn * BM + wc * 32 + 8 * fq;
#pragma unroll
        for (int ai = 0; ai < 2; ++ai)
#pragma unroll
            for (int m = 0; m < 4; ++m) { bf16_t* rowp = O + (size_t)(row0 + ai * HALF + m * 16) * ldc + col0;
#pragma unroll
                for (int bj = 0; bj < 2; ++bj) { const f32x4 v0 = acc[ai][bj][m][0] * sc, v1 = acc[ai][bj][m][1] * sc;
                    u32x4 w; w.x = cvt_pk_bf16(v0[0], v0[1]); w.y = cvt_pk_bf16(v0[2], v0[3]); w.z = cvt_pk_bf16(v1[0], v1[1]); w.w = cvt_pk_bf16(v1[2], v1[3]);
                    *(u32x4*)(rowp + bj * HALF) = w; } }
    }
};

struct EpiResX {
    static constexpr bool PERM = false; static constexpr bool NEEDS_RS = false;
    const float* base; float* out; bf16_t* xb; float* ssp; int ldc; float sc;
    __device__ __forceinline__ void operator()(const f32x4 (&acc)[2][2][4][2], const Unit& u, int wr, int wc, int fr, int fq) const {
        const int row0 = u.pm * BM + wr * 64 + fr, col0 = u.pn * BM + wc * 32 + 4 * fq;
        typedef unsigned u32x2 __attribute__((ext_vector_type(2)));
#pragma unroll
        for (int ai = 0; ai < 2; ++ai) {
            f32x4 bs[4][2][2];
#pragma unroll
            for (int m = 0; m < 4; ++m)
#pragma unroll
                for (int bj = 0; bj < 2; ++bj)
#pragma unroll
                    for (int n = 0; n < 2; ++n) bs[m][bj][n] = *(const f32x4*)(base + (size_t)(row0 + ai * HALF + m * 16) * ldc + col0 + bj * HALF + n * 16);
#pragma unroll
            for (int m = 0; m < 4; ++m) { const int row = row0 + ai * HALF + m * 16; const size_t off = (size_t)row * ldc + col0; float ss = 0.f;
#pragma unroll
                for (int bj = 0; bj < 2; ++bj)
#pragma unroll
                    for (int n = 0; n < 2; ++n) { const f32x4 o = bs[m][bj][n] + acc[ai][bj][m][n] * sc;
                        *(f32x4*)(out + off + bj * HALF + n * 16) = o; ss += (o[0] * o[0] + o[1] * o[1]) + (o[2] * o[2] + o[3] * o[3]);
                        u32x2 w; w.x = cvt_pk_bf16(o[0], o[1]); w.y = cvt_pk_bf16(o[2], o[3]); *(u32x2*)(xb + off + bj * HALF + n * 16) = w; }
                ss += xswz<16>(ss); ss = xsum32(ss);
                if (fq == 0) ssp[(size_t)row * 16 + u.pn * 4 + wc] = ss; }
            asm volatile("" ::: "memory"); }
    }
};
__device__ __forceinline__ float rstd_finish(f32x4 p) { float s = (p[0] + p[1]) + (p[2] + p[3]); s += xswz<16>(s); s = xsum32(s); return 1.0f / sqrtf(s * (1.0f / 1024.0f) + 1e-6f); }
__device__ __forceinline__ void rstd8(const float* ssp, int row0, int fq, float (&rs)[8]) {
    f32x4 p[8];
#pragma unroll
    for (int k = 0; k < 8; ++k) p[k] = *(const f32x4*)(ssp + (size_t)(row0 + (k >> 2) * HALF + (k & 3) * 16) * 16 + 4 * fq);
#pragma unroll
    for (int k = 0; k < 8; ++k) rs[k] = rstd_finish(p[k]);
}
__device__ __forceinline__ float silu_mul(float g, float u) { return g * __builtin_amdgcn_rcpf(1.0f + __builtin_amdgcn_exp2f(-1.4426950408889634f * g)) * u; }
struct EpiSwiGLU {
    static constexpr bool PERM = true; static constexpr bool NEEDS_RS = true;
    bf16_t* O; int ldc; float sc; const float* ssp;
    __device__ __forceinline__ void operator()(const f32x4 (&acc)[2][2][4][2], const Unit& u, int wr, int wc, int fr, int fq, const PG8_LAS float* rs) const {
        const int row0 = u.pm * BM + wr * 64 + fr, col0 = u.pn * HALF + wc * 32 + 8 * fq;
        float rs8[8];
#pragma unroll
        for (int k = 0; k < 8; ++k) rs8[k] = rs[(k >> 2) * HALF + wr * 64 + (k & 3) * 16 + fr];
#pragma unroll
        for (int ai = 0; ai < 2; ++ai)
#pragma unroll
            for (int m = 0; m < 4; ++m) { bf16_t* rowp = O + (size_t)(row0 + ai * HALF + m * 16) * ldc + col0;
                const float rs = sc * rs8[ai * 4 + m];
                const f32x4 g0 = acc[ai][0][m][0] * rs, g1 = acc[ai][0][m][1] * rs, u0 = acc[ai][1][m][0] * rs, u1 = acc[ai][1][m][1] * rs;
                u32x4 w; w.x = cvt_pk_bf16(silu_mul(g0[0], u0[0]), silu_mul(g0[1], u0[1])); w.y = cvt_pk_bf16(silu_mul(g0[2], u0[2]), silu_mul(g0[3], u0[3]));
                w.z = cvt_pk_bf16(silu_mul(g1[0], u1[0]), silu_mul(g1[1], u1[1])); w.w = cvt_pk_bf16(silu_mul(g1[2], u1[2]), silu_mul(g1[3], u1[3]));
                *(u32x4*)rowp = w; }
    }
};


__device__ __forceinline__ float gelu_t(float x) { const float y2 = 1.5957691216057308f * (x + 0.044715f * x * x * x); return x * __builtin_amdgcn_rcpf(1.0f + __builtin_amdgcn_exp2f(-1.4426950408889634f * y2)); }
__device__ __forceinline__ void st8(bf16_t* p, const float (&v)[8]) { u32x4 w; w.x = cvt_pk_bf16(v[0], v[1]); w.y = cvt_pk_bf16(v[2], v[3]); w.z = cvt_pk_bf16(v[4], v[5]); w.w = cvt_pk_bf16(v[6], v[7]); *(u32x4*)p = w; }
__device__ __forceinline__ int srow_g(int s, int g) { return g == 0 ? s : (g == 1 ? ((s & 3) * 1024 + (s >> 2)) : ((s & 15) * 256 + (s >> 4))); }
#define PG8_GETROW(x0, x1) do { const f32x4 a0 = acc[ai][0][m][0], a1 = acc[ai][0][m][1], b0 = acc[ai][1][m][0], b1 = acc[ai][1][m][1]; \
    x0[0] = a0[0]; x0[1] = a0[1]; x0[2] = a0[2]; x0[3] = a0[3]; x0[4] = a1[0]; x0[5] = a1[1]; x0[6] = a1[2]; x0[7] = a1[3]; \
    x1[0] = b0[0]; x1[1] = b0[1]; x1[2] = b0[2]; x1[3] = b0[3]; x1[4] = b1[0]; x1[5] = b1[1]; x1[6] = b1[2]; x1[7] = b1[3]; } while (0)
__device__ __forceinline__ void head_norm_rope(float (&x0)[8], float (&x1)[8], const PG8_LAS float* gp, f32x4 c0, f32x4 c1, f32x4 s0, f32x4 s1, float scale) {
    const f32x4 ga = *(const PG8_LAS f32x4*)gp, gb = *(const PG8_LAS f32x4*)(gp + 4), gc = *(const PG8_LAS f32x4*)(gp + 32), gd = *(const PG8_LAS f32x4*)(gp + 36);
    float ss = 0.f;
#pragma unroll
    for (int i = 0; i < 8; ++i) ss += x0[i] * x0[i] + x1[i] * x1[i];
    ss += xswz<16>(ss); ss = xsum32(ss);
    const float rstd = scale / sqrtf(ss * (1.0f / 64.0f) + 1e-6f);
#pragma unroll
    for (int i = 0; i < 8; ++i) { const float a = x0[i] * rstd * (i < 4 ? ga[i & 3] : gb[i & 3]), b = x1[i] * rstd * (i < 4 ? gc[i & 3] : gd[i & 3]); const float c = i < 4 ? c0[i & 3] : c1[i & 3], sv = i < 4 ? s0[i & 3] : s1[i & 3];
        x0[i] = a * c - b * sv; x1[i] = b * c + a * sv; }
}
struct EpiHeadsEven {
    static constexpr bool PERM = false; static constexpr bool NEEDS_RS = true;
    bf16_t* UV; bf16_t* Qs; const float* vgain; const float* qgain; const float* kgain; const float* cs; const float* sn; const float* ssp; const PG8_LAS float* gtab;
    __device__ __forceinline__ void operator()(const f32x4 (&acc)[2][2][4][2], const Unit& u, int wr, int wc, int fr, int fq, const PG8_LAS float* rs) const {
        const int pn = u.pn, row0 = u.pm * BM + wr * 64 + fr;
        const int kind = pn == 0 ? 0 : (pn == 1 ? 1 : (pn < 8 ? 2 : 3));
        const bool isq = pn < 5; const int h = (pn < 5 ? pn - 2 : (pn < 8 ? pn - 5 : pn - 8)) * 4 + wc, grp = h >> 2;
        const PG8_LAS float* gp = gtab + (kind == 1 ? wc * 64 : (isq ? 256 : 320)) + 8 * fq;
        bf16_t* hb = Qs + (kind == 3 ? (size_t)24 * 1024 * 1024 : (isq ? (size_t)0 : (size_t)12 * 1024 * 1024));
        float rs8[8];
#pragma unroll
        for (int k = 0; k < 8; ++k) rs8[k] = rs[(k >> 2) * HALF + wr * 64 + (k & 3) * 16 + fr];
#pragma unroll
        for (int am = 0; am < 4; ++am) { const int ai = am >> 1;
            f32x4 rc[4][4];
            if (kind == 2) {
#pragma unroll
                for (int m = 2 * (am & 1); m < 2 * (am & 1) + 2; ++m) { const int sp = (row0 + ai * HALF + m * 16) & 4095; const float* cp = cs + sp * 32 + 8 * fq; const float* sq_ = sn + sp * 32 + 8 * fq;
                    rc[m][0] = *(const f32x4*)cp; rc[m][1] = *(const f32x4*)(cp + 4); rc[m][2] = *(const f32x4*)sq_; rc[m][3] = *(const f32x4*)(sq_ + 4); } }
#pragma unroll
            for (int m = 2 * (am & 1); m < 2 * (am & 1) + 2; ++m) {
                const int row = row0 + ai * HALF + m * 16, b = row >> 12, s = row & 4095;
                float x0[8], x1[8]; PG8_GETROW(x0, x1);
                { const float rs = rs8[ai * 4 + m];
#pragma unroll
                  for (int i = 0; i < 8; ++i) { x0[i] *= rs; x1[i] *= rs; } }
                if (kind <= 1) {
#pragma unroll
                    for (int i = 0; i < 8; ++i) { x0[i] = gelu_t(x0[i]); x1[i] = gelu_t(x1[i]); }
                    if (kind == 1) { float ss = 0.f;
#pragma unroll
                        for (int i = 0; i < 8; ++i) ss += x0[i] * x0[i] + x1[i] * x1[i];
                        ss += xswz<16>(ss); ss = xsum32(ss);
                        const float rstd = 1.0f / sqrtf(ss * (1.0f / 64.0f) + 1e-6f);
                        { const f32x4 ga = *(const PG8_LAS f32x4*)gp, gb = *(const PG8_LAS f32x4*)(gp + 4), gc = *(const PG8_LAS f32x4*)(gp + 32), gd = *(const PG8_LAS f32x4*)(gp + 36);
#pragma unroll
                        for (int i = 0; i < 8; ++i) { x0[i] *= rstd * (i < 4 ? ga[i & 3] : gb[i & 3]); x1[i] *= rstd * (i < 4 ? gc[i & 3] : gd[i & 3]); } } }
                    bf16_t* d = UV + (size_t)row * 512 + pn * 256 + wc * 64 + 8 * fq; st8(d, x0); st8(d + 32, x1);
                } else {
                    if (kind == 2) head_norm_rope(x0, x1, gp, rc[m][0], rc[m][1], rc[m][2], rc[m][3], isq ? 0.18033688011112042f : 1.0f);
                    bf16_t* d = hb + ((size_t)(b * 12 + h) * 4096 + srow_g(s, grp)) * 64 + 8 * fq; st8(d, x0); st8(d + 32, x1);
                }
            } }
    }
};
struct EpiHeadsOdd {
    static constexpr bool PERM = false; static constexpr bool NEEDS_RS = true;
    bf16_t* Qm; bf16_t* CONV; float* kmsum; const float* qgain; const float* kgain; const float* cs; const float* sn; const float* ssp; const PG8_LAS float* gtab;
    __device__ __forceinline__ void operator()(const f32x4 (&acc)[2][2][4][2], const Unit& u, int wr, int wc, int fr, int fq, const PG8_LAS float* rs) const {
        const int pn = u.pn, row0 = u.pm * BM + wr * 64 + fr;
        const int kind = pn < 6 ? 2 : (pn < 9 ? 3 : 4);
        const bool isq = pn < 3; const int h = (pn % 3) * 4 + wc;
        const PG8_LAS float* gp = gtab + (isq ? 256 : 320) + 8 * fq;
        bf16_t* hb = Qm + (kind == 3 ? (size_t)24 * 1024 * 1024 : (isq ? (size_t)0 : (size_t)12 * 1024 * 1024));
        float rs8[8];
#pragma unroll
        for (int k = 0; k < 8; ++k) rs8[k] = rs[(k >> 2) * HALF + wr * 64 + (k & 3) * 16 + fr];
        float cs0[8], cs1[8];
#pragma unroll
        for (int i = 0; i < 8; ++i) { cs0[i] = 0.f; cs1[i] = 0.f; }
#pragma unroll
        for (int am = 0; am < 4; ++am) { const int ai = am >> 1;
            f32x4 rc[4][4];
            if (kind == 2) {
#pragma unroll
                for (int m = 2 * (am & 1); m < 2 * (am & 1) + 2; ++m) { const int sp = (row0 + ai * HALF + m * 16) & 4095; const float* cp = cs + sp * 32 + 8 * fq; const float* sq_ = sn + sp * 32 + 8 * fq;
                    rc[m][0] = *(const f32x4*)cp; rc[m][1] = *(const f32x4*)(cp + 4); rc[m][2] = *(const f32x4*)sq_; rc[m][3] = *(const f32x4*)(sq_ + 4); } }
#pragma unroll
            for (int m = 2 * (am & 1); m < 2 * (am & 1) + 2; ++m) {
                const int row = row0 + ai * HALF + m * 16, b = row >> 12, s = row & 4095;
                float x0[8], x1[8]; PG8_GETROW(x0, x1);
                { const float rs = rs8[ai * 4 + m];
#pragma unroll
                  for (int i = 0; i < 8; ++i) { x0[i] *= rs; x1[i] *= rs; } }
                if (kind == 4) { bf16_t* d = CONV + (size_t)row * 768 + (pn - 9) * 256 + wc * 64 + 8 * fq; st8(d, x0); st8(d + 32, x1); }
                else {
                    if (kind == 2) { head_norm_rope(x0, x1, gp, rc[m][0], rc[m][1], rc[m][2], rc[m][3], isq ? 0.18033688011112042f : 1.0f);
                        if (!isq) {
#pragma unroll
                            for (int i = 0; i < 8; ++i) { cs0[i] += x0[i]; cs1[i] += x1[i]; } } }
                    bf16_t* d = hb + ((size_t)(b * 12 + h) * 4096 + s) * 64 + 8 * fq; st8(d, x0); st8(d + 32, x1);
                }
            } }
        if (kind == 2 && !isq) {
#pragma unroll
            for (int i = 0; i < 8; ++i) {
                { cs0[i] += xswz<1>(cs0[i]); cs1[i] += xswz<1>(cs1[i]); cs0[i] += xswz<2>(cs0[i]); cs1[i] += xswz<2>(cs1[i]); cs0[i] += xswz<4>(cs0[i]); cs1[i] += xswz<4>(cs1[i]); cs0[i] += xswz<8>(cs0[i]); cs1[i] += xswz<8>(cs1[i]); } }
            if (fr == 0) { const int b = (u.pm * BM) >> 12, blk = u.pm & 15; float* kp = kmsum + ((size_t)(b * 12 + h) * 16 + blk) * 64 + 8 * fq;
#pragma unroll
                for (int i = 0; i < 8; ++i) { atomicAdd(kp + i, cs0[i]); atomicAdd(kp + 32 + i, cs1[i]); } }
        }
    }
};

__device__ __forceinline__ const char* uptr(const char* p) { const unsigned long long b_ = (unsigned long long)p; return (const char*)(((unsigned long long)(unsigned)__builtin_amdgcn_readfirstlane((int)(unsigned)(b_ >> 32)) << 32) | (unsigned)__builtin_amdgcn_readfirstlane((int)(unsigned)b_)); }
__device__ __forceinline__ void glds16s(const void* sbase, unsigned voff, unsigned lds_dst) { unsigned keep;
    asm volatile("s_mov_b32 %0, m0\n\ts_mov_b32 m0, %3\n\ts_nop 0\n\tglobal_load_lds_dwordx4 %1, %2\n\ts_mov_b32 m0, %0" : "=&s"(keep) : "v"(voff), "s"(sbase), "s"(lds_dst) : "memory"); }
typedef int i32x4 __attribute__((ext_vector_type(4)));
typedef int i32x8 __attribute__((ext_vector_type(8)));
__device__ __forceinline__ unsigned pk4_e4m3(float a, float b, float c, float d) {
    a = __builtin_amdgcn_fmed3f(a, -448.f, 448.f); b = __builtin_amdgcn_fmed3f(b, -448.f, 448.f); c = __builtin_amdgcn_fmed3f(c, -448.f, 448.f); d = __builtin_amdgcn_fmed3f(d, -448.f, 448.f);
    int w = __builtin_amdgcn_cvt_pk_fp8_f32(a, b, 0, false); w = __builtin_amdgcn_cvt_pk_fp8_f32(c, d, w, true); return (unsigned)w; }
struct EpiSwiGLU8 {
    static constexpr bool PERM = false; static constexpr bool NEEDS_RS = true;
    unsigned char* O; int ldc; float sc, so; const float* ssp;
    __device__ __forceinline__ void operator()(const f32x4 (&acc)[2][2][4][2], const Unit& u, int wr, int wc, int fr, int fq, const PG8_LAS float* rs) const {
        const int row0 = u.pm * BM + wr * 64 + fr, col0 = u.pn * HALF + wc * 32 + 8 * fq;
#pragma unroll
        for (int ai = 0; ai < 2; ++ai)
#pragma unroll
            for (int m = 0; m < 4; ++m) { unsigned char* rowp = O + (size_t)(row0 + ai * HALF + m * 16) * ldc + col0;
                const float rsc = sc * rs[ai * HALF + wr * 64 + m * 16 + fr];
                const f32x4 g0 = acc[ai][0][m][0] * rsc, g1 = acc[ai][0][m][1] * rsc, u0 = acc[ai][1][m][0] * (rsc * so), u1 = acc[ai][1][m][1] * (rsc * so);
                typedef unsigned u32x2 __attribute__((ext_vector_type(2)));
                u32x2 w; w.x = pk4_e4m3(silu_mul(g0[0], u0[0]), silu_mul(g0[1], u0[1]), silu_mul(g0[2], u0[2]), silu_mul(g0[3], u0[3]));
                w.y = pk4_e4m3(silu_mul(g1[0], u1[0]), silu_mul(g1[1], u1[1]), silu_mul(g1[2], u1[2]), silu_mul(g1[3], u1[3]));
                *(u32x2*)rowp = w; }
    }
};
template <class Epi, class Sched, bool ALIGN_EPI = true, bool SP2 = true, int QM = 0>
__device__ __forceinline__ void gemm_phase(PG8_LAS unsigned char* lds, const Gemm g, const Sched& S, const Epi& E, int tid_in) {
    int tid_ = tid_in; asm volatile("" : "+v"(tid_));
    const int tid = tid_, wid = __builtin_amdgcn_readfirstlane(tid >> 6), lane = tid & 63, wr = wid >> 2, wc = wid & 3, fr = lane & 15, fq = lane >> 4;
    constexpr bool FP8 = (QM == 1);
    const int Kb = QM ? g.K : 2 * g.K, nt = Kb / 128;
    unsigned voffA[2], voffB[2];
#pragma unroll
    for (int i = 0; i < 2; ++i) { int R, C; stage_rc(tid * 16 + i * 8192, R, C); const int Rb = Epi::PERM ? ((R & ~31) + perm32(R & 31)) : R;
        voffA[i] = (unsigned)(R * Kb + 2 * C); voffB[i] = (unsigned)(Rb * Kb + 2 * C); }
    const size_t kstep = (size_t)128;
    const size_t hstep = (size_t)HALF * Kb;
    const size_t tstep = 2 * hstep;
    const unsigned ldsw = (unsigned)wid * 1024u;
    const unsigned lds0 = (unsigned)(uintptr_t)lds;
    const int fcol = FP8 ? (32 * (fq >> 1) + 16 * (fq & 1)) : fq * 8;
    const int aoff = lds_byte(wr * 64 + fr, fcol), boff = lds_byte(wc * 32 + fr, fcol);
#define PG8_SA(b, h) (((b) * 2 + (h)) * HTB)
#define PG8_SB(b, h) ((4 + (b) * 2 + (h)) * HTB)
#define PG8_STAGE(bufoff, gbase, voff) do { _Pragma("unroll") for (int _i = 0; _i < 2; ++_i) \
        glds16s((const void*)(gbase), (voff)[_i], (unsigned)__builtin_amdgcn_readfirstlane((int)(lds0 + (bufoff) + ldsw + _i * 8192))); } while (0)
#define PG8_RD16(p) (*(const PG8_LAS i32x4*)(p))
#define PG8_CAT8(lo, hi) __builtin_shufflevector((lo), (hi), 0, 1, 2, 3, 4, 5, 6, 7)
#define PG8_LDA(dst, b, h) do { if constexpr (FP8) { _Pragma("unroll") for (int m = 0; m < 4; ++m) dst##8[m] = PG8_CAT8(PG8_RD16(lds + PG8_SA(b, h) + aoff + m * 2048), PG8_RD16(lds + PG8_SA(b, h) + aoff + m * 2048 + 16)); } \
        else { _Pragma("unroll") for (int m = 0; m < 4; ++m) _Pragma("unroll") for (int k = 0; k < 2; ++k) dst[m][k] = *(const PG8_LAS bf16x8*)(lds + PG8_SA(b, h) + aoff + m * 2048 + k * 1024); } } while (0)
#define PG8_LDB(dst, b, h) do { if constexpr (FP8) { _Pragma("unroll") for (int n = 0; n < 2; ++n) dst##8[n] = PG8_CAT8(PG8_RD16(lds + PG8_SB(b, h) + boff + n * 2048), PG8_RD16(lds + PG8_SB(b, h) + boff + n * 2048 + 16)); } \
        else { _Pragma("unroll") for (int n = 0; n < 2; ++n) _Pragma("unroll") for (int k = 0; k < 2; ++k) dst[n][k] = *(const PG8_LAS bf16x8*)(lds + PG8_SB(b, h) + boff + n * 2048 + k * 1024); } } while (0)
#define PG8_MMA(ai, bj, At, Bt) do { __builtin_amdgcn_s_setprio(1); \
        if constexpr (FP8) { _Pragma("unroll") for (int m = 0; m < 4; ++m) _Pragma("unroll") for (int n = 0; n < 2; ++n) \
            acc[ai][bj][m][n] = __builtin_amdgcn_mfma_scale_f32_16x16x128_f8f6f4(Bt##8[n], At##8[m], acc[ai][bj][m][n], 0, 0, 0, 0, 0, 0); } \
        else if constexpr (QM == 2) { _Pragma("unroll") for (int m = 0; m < 4; ++m) _Pragma("unroll") for (int n = 0; n < 2; ++n) _Pragma("unroll") for (int k = 0; k < 2; ++k) \
            acc[ai][bj][m][n] = __builtin_bit_cast(f32x4, __builtin_amdgcn_mfma_i32_16x16x64_i8(__builtin_bit_cast(i32x4, Bt[n][k]), __builtin_bit_cast(i32x4, At[m][k]), __builtin_bit_cast(i32x4, acc[ai][bj][m][n]), 0, 0, 0)); } \
        else { _Pragma("unroll") for (int m = 0; m < 4; ++m) _Pragma("unroll") for (int n = 0; n < 2; ++n) _Pragma("unroll") for (int k = 0; k < 2; ++k) \
            acc[ai][bj][m][n] = __builtin_amdgcn_mfma_f32_16x16x32_bf16(Bt[n][k], At[m][k], acc[ai][bj][m][n], 0, 0, 0); } \
        __builtin_amdgcn_s_setprio(0); } while (0)
#define PG8_WAIT_V(n) asm volatile("s_waitcnt vmcnt(" #n ")" ::: "memory")
#define PG8_WAIT_L(n) asm volatile("s_waitcnt lgkmcnt(" #n ")" ::: "memory")
#define PG8_BAR __builtin_amdgcn_s_barrier()
#define PG8_SCHED __builtin_amdgcn_sched_barrier(0)
    Unit cur, nxt; int ui = 0;
    if (!S.next(0, cur)) return;
    f32x4 acc[2][2][4][2];
#pragma unroll
    for (int a = 0; a < 2; ++a)
#pragma unroll
        for (int b = 0; b < 2; ++b)
#pragma unroll
            for (int m = 0; m < 4; ++m)
#pragma unroll
                for (int n = 0; n < 2; ++n) acc[a][b][m][n] = (f32x4){0.f, 0.f, 0.f, 0.f};
    bf16x8 At[4][2], B0[2][2], B1[2][2]; i32x8 At8[4], B08[2], B18[2];
    if constexpr (Epi::NEEDS_RS) { if (tid < 256) ((PG8_LAS float*)(lds + RS_TAB_OFF))[tid] = E.ssp[(size_t)cur.pm * BM + tid]; }
    const char* cA = uptr((const char*)g.A + (size_t)cur.pm * tstep); const char* cB = uptr(S.bbase(cur, g.Bt) + (size_t)cur.pn * tstep);
    if constexpr (SP2) {
        PG8_STAGE(PG8_SB(0, 0), cB, voffB); PG8_STAGE(PG8_SB(0, 1), cB + hstep, voffB); PG8_STAGE(PG8_SA(0, 0), cA, voffA); PG8_STAGE(PG8_SA(0, 1), cA + hstep, voffA);
        if (wr == 1) PG8_BAR;
        PG8_WAIT_V(2); PG8_BAR;
        PG8_STAGE(PG8_SB(1, 0), cB + kstep, voffB); PG8_STAGE(PG8_SA(1, 0), cA + kstep, voffA); PG8_STAGE(PG8_SB(1, 1), cB + hstep + kstep, voffB);
        PG8_WAIT_V(6); PG8_BAR;
    } else {
        PG8_STAGE(PG8_SB(0, 0), cB, voffB); PG8_STAGE(PG8_SA(0, 0), cA, voffA); PG8_STAGE(PG8_SB(0, 1), cB + hstep, voffB); PG8_STAGE(PG8_SA(0, 1), cA + hstep, voffA);
        if (wr == 1) PG8_BAR;
        PG8_WAIT_V(4); PG8_BAR;
        PG8_STAGE(PG8_SB(1, 0), cB + kstep, voffB); PG8_STAGE(PG8_SA(1, 0), cA + kstep, voffA); PG8_STAGE(PG8_SB(1, 1), cB + hstep + kstep, voffB);
        PG8_WAIT_V(6); PG8_BAR;
    }
    for (;;) {
        const bool has_next = S.next(ui + 1, nxt);
        const char* nA = uptr(has_next ? (const char*)g.A + (size_t)nxt.pm * tstep : cA); const char* nB = uptr(has_next ? S.bbase(nxt, g.Bt) + (size_t)nxt.pn * tstep : cB);
        for (int t = 0; t < nt; t += 2) {
            const bool last = (t == nt - 2);
            const char* a1 = cA + (size_t)(t + 1) * kstep;
            const char* a2 = last ? nA : cA + (size_t)(t + 2) * kstep; const char* b2 = last ? nB : cB + (size_t)(t + 2) * kstep;
            const char* a3 = a2 + kstep; const char* b3 = b2 + kstep;
            if constexpr (SP2) {
            PG8_LDB(B0, 0, 0); PG8_LDB(B1, 0, 1); PG8_SCHED; PG8_LDA(At, 0, 0); PG8_STAGE(PG8_SA(1, 1), a1 + hstep, voffA);
            PG8_WAIT_V(8); PG8_WAIT_L(0); PG8_BAR; PG8_MMA(0, 0, At, B0); PG8_MMA(0, 1, At, B1); PG8_BAR; PG8_SCHED;
            PG8_LDA(At, 0, 1); PG8_STAGE(PG8_SB(0, 0), b2, voffB); PG8_STAGE(PG8_SB(0, 1), b2 + hstep, voffB); PG8_STAGE(PG8_SA(0, 0), a2, voffA);
            PG8_WAIT_V(8); PG8_WAIT_L(0); PG8_BAR; PG8_MMA(1, 0, At, B0); PG8_MMA(1, 1, At, B1); PG8_BAR; PG8_SCHED;
            PG8_LDB(B0, 1, 0); PG8_LDB(B1, 1, 1); PG8_SCHED; PG8_LDA(At, 1, 0); PG8_STAGE(PG8_SA(0, 1), a2 + hstep, voffA);
            PG8_WAIT_V(8); PG8_WAIT_L(0); PG8_BAR; PG8_MMA(0, 0, At, B0); PG8_MMA(0, 1, At, B1); PG8_BAR; PG8_SCHED;
            PG8_LDA(At, 1, 1); PG8_STAGE(PG8_SB(1, 0), b3, voffB); PG8_STAGE(PG8_SB(1, 1), b3 + hstep, voffB); PG8_STAGE(PG8_SA(1, 0), a3, voffA);
            PG8_WAIT_V(8); PG8_WAIT_L(0); PG8_BAR; PG8_MMA(1, 0, At, B0); PG8_MMA(1, 1, At, B1); PG8_BAR; PG8_SCHED;
            } else {
            PG8_LDB(B0, 0, 0); PG8_SCHED; PG8_LDA(At, 0, 0); PG8_STAGE(PG8_SA(1, 1), a1 + hstep, voffA);
            PG8_WAIT_L(8); PG8_BAR; PG8_WAIT_L(0); PG8_MMA(0, 0, At, B0); PG8_BAR; PG8_SCHED;
            PG8_LDB(B1, 0, 1); PG8_STAGE(PG8_SB(0, 0), b2, voffB);
            PG8_BAR; PG8_WAIT_L(0); PG8_MMA(0, 1, At, B1); PG8_BAR;
            PG8_LDA(At, 0, 1); PG8_STAGE(PG8_SA(0, 0), a2, voffA);
            PG8_BAR; PG8_WAIT_L(0); PG8_MMA(1, 0, At, B0); PG8_BAR; PG8_SCHED;
            PG8_STAGE(PG8_SB(0, 1), b2 + hstep, voffB);
            PG8_WAIT_V(6); PG8_BAR; PG8_MMA(1, 1, At, B1); PG8_BAR;
            PG8_LDB(B0, 1, 0); PG8_SCHED; PG8_LDA(At, 1, 0); PG8_STAGE(PG8_SA(0, 1), a2 + hstep, voffA);
            PG8_WAIT_L(8); PG8_BAR; PG8_WAIT_L(0); PG8_MMA(0, 0, At, B0); PG8_BAR; PG8_SCHED;
            PG8_LDB(B1, 1, 1); PG8_STAGE(PG8_SB(1, 0), b3, voffB);
            PG8_BAR; PG8_WAIT_L(0); PG8_MMA(0, 1, At, B1); PG8_BAR;
            PG8_LDA(At, 1, 1); PG8_STAGE(PG8_SA(1, 0), a3, voffA);
            PG8_BAR; PG8_WAIT_L(0); PG8_MMA(1, 0, At, B0); PG8_BAR; PG8_SCHED;
            PG8_STAGE(PG8_SB(1, 1), b3 + hstep, voffB);
            PG8_WAIT_V(6); PG8_BAR; PG8_MMA(1, 1, At, B1); PG8_BAR;
            }
        }
        if constexpr (ALIGN_EPI) { if (wr == 0) PG8_BAR; }
        { int l_; asm volatile("v_mbcnt_lo_u32_b32 %0, -1, 0\n\tv_mbcnt_hi_u32_b32 %0, -1, %0" : "=v"(l_));
          if constexpr (QM == 2) {
#pragma unroll
              for (int a_ = 0; a_ < 2; ++a_)
#pragma unroll
                  for (int b_ = 0; b_ < 2; ++b_)
#pragma unroll
                      for (int m_ = 0; m_ < 4; ++m_)
#pragma unroll
                          for (int n_ = 0; n_ < 2; ++n_) acc[a_][b_][m_][n_] = __builtin_convertvector(__builtin_bit_cast(i32x4, acc[a_][b_][m_][n_]), f32x4); }
          if constexpr (Epi::NEEDS_RS) {
              const int t_ = wid * 64 + l_; float q0 = 0.f;
              if (has_next && t_ < 256) q0 = E.ssp[(size_t)nxt.pm * BM + t_];
              E(acc, cur, wr, wc, l_ & 15, l_ >> 4, (const PG8_LAS float*)(lds + RS_TAB_OFF) + (ui & 1) * 256);
              if (has_next && t_ < 256) ((PG8_LAS float*)(lds + RS_TAB_OFF))[((ui + 1) & 1) * 256 + t_] = q0;
          } else E(acc, cur, wr, wc, l_ & 15, l_ >> 4); }
        if (!has_next) break;
#pragma unroll
        for (int a = 0; a < 2; ++a)
#pragma unroll
            for (int b = 0; b < 2; ++b)
#pragma unroll
                for (int m = 0; m < 4; ++m)
#pragma unroll
                    for (int n = 0; n < 2; ++n) acc[a][b][m][n] = (f32x4){0.f, 0.f, 0.f, 0.f};
        cur = nxt; cA = nA; cB = nB; ++ui;
        if constexpr (ALIGN_EPI) { if (wr == 1) PG8_BAR; }
    }
    PG8_WAIT_V(0);
    if constexpr (!ALIGN_EPI) { if (wr == 0) PG8_BAR; }
    PG8_BAR;
#undef PG8_SA
#undef PG8_SB
#undef PG8_STAGE
#undef PG8_LDA
#undef PG8_RD16
#undef PG8_CAT8
#undef PG8_LDB
#undef PG8_MMA
#undef PG8_WAIT_V
#undef PG8_WAIT_L
#undef PG8_BAR
#undef PG8_SCHED
}
}


namespace att {
using bf16x8=__attribute__((ext_vector_type(8)))short;
using s16x4=__attribute__((ext_vector_type(4)))short;
using f32x16=__attribute__((ext_vector_type(16)))float;
using u32x4=__attribute__((ext_vector_type(4)))unsigned;
typedef unsigned short bf16;
constexpr int D=64,DM=64;
constexpr int NW=8,QBLK=32,QB=QBLK*NW,KVBLK=64;
__device__ __forceinline__ int crow(int r,int hi){return (r&3)+8*(r>>2)+4*hi;}
#define SBAR() __builtin_amdgcn_sched_barrier(0)
constexpr int NSLOT=3, SLOTB=8192;
constexpr int LDS_K=0, LDS_V=NSLOT*SLOTB, LDS_WS=2*NSLOT*SLOTB, LDS_OST=LDS_WS+NW*64*4, LDS_KM=LDS_OST+NW*4096, LDS_TK=LDS_KM+4096, LDS_BYTES=LDS_TK+64;
constexpr float C2=0.125f*1.4426950408889634f;
__device__ __forceinline__ void glds16(const void*gsrc,unsigned lds_dst){unsigned keep;
  asm volatile("s_mov_b32 %0, m0\n\ts_mov_b32 m0, %2\n\ts_nop 0\n\tglobal_load_lds_dwordx4 %1, off\n\ts_mov_b32 m0, %0":"=&s"(keep):"v"(gsrc),"s"(lds_dst):"memory");}
__device__ __forceinline__ float max3f(float a,float b,float c){float r;asm("v_max3_f32 %0, %1, %2, %3":"=v"(r):"v"(a),"v"(b),"v"(c));return r;}
__device__ __forceinline__ float max2f(float a,float b){float r;asm("v_max_f32_e32 %0, %1, %2":"=v"(r):"v"(a),"v"(b));return r;}
__device__ __forceinline__ float fadd_s(float a,float b){float r;asm("v_add_f32_e32 %0, %1, %2":"=v"(r):"v"(a),"v"(b));return r;}
__device__ __forceinline__ float fsub_s(float a,float b){float r;asm("v_sub_f32_e32 %0, %1, %2":"=v"(r):"v"(a),"v"(b));return r;}
typedef float f32x2_t __attribute__((ext_vector_type(2))); typedef __bf16 bf16x2_t __attribute__((ext_vector_type(2)));
__device__ __forceinline__ unsigned cvtpk_s(float lo,float hi){f32x2_t v={lo,hi};bf16x2_t b=__builtin_convertvector(v,bf16x2_t);return __builtin_bit_cast(unsigned,b);}
#define WAIT_BAR(N) asm volatile("s_waitcnt vmcnt(" #N ") lgkmcnt(0)\n\ts_barrier":::"memory")
__device__ __forceinline__ void qkt(f32x16&p0,f32x16&p1,const char*Kslot,const bf16x8*qr,int r32,int hi){ const f32x16 zero16=f32x16{};
  const char*kb=Kslot+hi*1024+r32*16;
  #pragma unroll
  for(int d0=0;d0<4;++d0){
    const bf16x8 b0=*reinterpret_cast<const bf16x8*>(kb+d0*2048);
    const bf16x8 b1=*reinterpret_cast<const bf16x8*>(kb+d0*2048+512);
    if(d0==0){p0=__builtin_amdgcn_mfma_f32_32x32x16_bf16(b0,qr[0],zero16,0,0,0);p1=__builtin_amdgcn_mfma_f32_32x32x16_bf16(b1,qr[0],zero16,0,0,0);}
    else{p0=__builtin_amdgcn_mfma_f32_32x32x16_bf16(b0,qr[d0],p0,0,0,0);p1=__builtin_amdgcn_mfma_f32_32x32x16_bf16(b1,qr[d0],p1,0,0,0);}}
}
typedef __attribute__((address_space(3))) const char* lds_cptr;
typedef short v4i16_t __attribute__((ext_vector_type(4)));
__device__ __forceinline__ void kload8(bf16x8*kf,lds_cptr kp){
  kf[0]=*(const __attribute__((address_space(3))) bf16x8*)(kp);      kf[1]=*(const __attribute__((address_space(3))) bf16x8*)(kp+512);
  kf[2]=*(const __attribute__((address_space(3))) bf16x8*)(kp+2048); kf[3]=*(const __attribute__((address_space(3))) bf16x8*)(kp+2560);
  kf[4]=*(const __attribute__((address_space(3))) bf16x8*)(kp+4096); kf[5]=*(const __attribute__((address_space(3))) bf16x8*)(kp+4608);
  kf[6]=*(const __attribute__((address_space(3))) bf16x8*)(kp+6144); kf[7]=*(const __attribute__((address_space(3))) bf16x8*)(kp+6656);
}
__device__ __forceinline__ void kload2(bf16x8*kf,lds_cptr kp,int j){ kf[2*j]=*(const __attribute__((address_space(3))) bf16x8*)(kp+j*2048); kf[2*j+1]=*(const __attribute__((address_space(3))) bf16x8*)(kp+j*2048+512); }
__device__ __forceinline__ s16x4 vtr(lds_cptr p){ return __builtin_bit_cast(s16x4,__builtin_amdgcn_ds_read_tr16_b64_v4i16((__attribute__((address_space(3))) v4i16_t*)p)); }
__device__ __forceinline__ float rowmax(const f32x16&p0,const f32x16&p1){
  float a=max3f(p0[0],p0[1],p1[0]),b=max3f(p0[2],p0[3],p1[1]);a=max3f(a,p1[2],p1[3]);
  #pragma unroll
  for(int r=4;r<16;r+=4){a=max3f(a,p0[r],p0[r+1]);b=max3f(b,p0[r+2],p0[r+3]);a=max3f(a,p1[r],p1[r+1]);b=max3f(b,p1[r+2],p1[r+3]);}
  const float m=max2f(a,b);
  auto rr=__builtin_amdgcn_permlane32_swap(__float_as_uint(m),__float_as_uint(m),false,false);
  return max2f(__uint_as_float(rr[0]),__uint_as_float(rr[1]));
}
__device__ __forceinline__ void pv(f32x16*o,int vb,bf16x8 pa0,bf16x8 pa1,bf16x8 pa2,bf16x8 pa3){
  #pragma unroll
  for(int d0=0;d0<2;++d0){s16x4 lo[4],hi[4];
    #pragma unroll
    for(int ks=0;ks<4;++ks){
      asm volatile("ds_read_b64_tr_b16 %0,%1 offset:%c2":"=&v"(lo[ks]):"v"(vb),"i"(d0*4096+ks*1024):"memory");
      asm volatile("ds_read_b64_tr_b16 %0,%1 offset:%c2":"=&v"(hi[ks]):"v"(vb),"i"(d0*4096+ks*1024+512):"memory");}
    asm volatile("s_waitcnt lgkmcnt(0)":::"memory");SBAR();
    #define PK(k) (bf16x8){lo[k][0],lo[k][1],lo[k][2],lo[k][3],hi[k][0],hi[k][1],hi[k][2],hi[k][3]}
    o[d0]=__builtin_amdgcn_mfma_f32_32x32x16_bf16(pa0,PK(0),o[d0],0,0,0);
    o[d0]=__builtin_amdgcn_mfma_f32_32x32x16_bf16(pa1,PK(1),o[d0],0,0,0);
    o[d0]=__builtin_amdgcn_mfma_f32_32x32x16_bf16(pa2,PK(2),o[d0],0,0,0);
    o[d0]=__builtin_amdgcn_mfma_f32_32x32x16_bf16(pa3,PK(3),o[d0],0,0,0);
    #undef PK
  }
}
template<int MODE> __device__ __forceinline__ void amask(f32x16&p0,f32x16&p1,int a,int nb,unsigned sel,int qabs,int qrel,int hi,float mhat){
  const float NEG=-INFINITY;
  if(MODE==0){
    if(a>=nb){ const int kb=64*(a-nb)+4*hi;
      #pragma unroll
      for(int r=0;r<16;++r){const int kv=kb+(r&3)+8*(r>>2); p0[r]=(kv>qrel)?NEG:p0[r]-mhat; p1[r]=(kv+32>qrel)?NEG:p1[r]-mhat;} }
    else { const float bias=((sel>>(a>>2))&1u)?-mhat:NEG;
      #pragma unroll
      for(int r=0;r<16;++r){ p0[r]+=bias; p1[r]+=bias; } }
  } else {
    const int base=qabs-64*a-4*hi;
    #pragma unroll
    for(int r=0;r<16;++r){const int c=(r&3)+8*(r>>2); p0[r]=((unsigned)(base-c)>128u)?NEG:p0[r]-mhat; p1[r]=((unsigned)(base-c-32)>128u)?NEG:p1[r]-mhat;}
  }
}
#ifndef ATTN_STORE16
#define ATTN_STORE16(p,v) (*(u32x4*)(p)=(v))
#endif
template<int MODE,int THRL,int opitch> __device__ __forceinline__ void attn_unit(const bf16*Qs,int q0,int tile0,int NT,unsigned sel,bf16*O,float*LSE,char*shm,int tid_in){
  const bf16*Ks=Qs+12*1024*1024,*Vs=Qs+24*1024*1024;
  int tid_=tid_in; asm volatile("":"+v"(tid_));
  const int tid=tid_,lane=tid&63,r32=lane&31,hi=lane>>5; const int wid=__builtin_amdgcn_readfirstlane(tid>>6);
  const int nb=NT-4;
  const bf16*Qw=Qs+(long)(q0+wid*QBLK)*DM;
  const lds_cptr shm3=(lds_cptr)shm;
  const unsigned lds0=(unsigned)(uintptr_t)shm3;
  float*wsf=(float*)(shm+LDS_WS)+wid*64;
  const bf16*ksrc=Ks+(long)lane*DM+wid*8;
  const bf16*vsrc=Vs+(long)(16*(wid&3)+(lane>>2))*DM+(wid>>2)*32+(lane&3)*8;
  const unsigned kdst=lds0+LDS_K+wid*1024, vdst=lds0+LDS_V+wid*1024;
  #define TM(t) (MODE==0 ? ((t)==0 ? nb : ((t)<=nb ? (t)-1 : (t))) : tile0+(t))
  #define DMA_K(t,slot) glds16(ksrc+(long)TM(t)*KVBLK*DM,(unsigned)__builtin_amdgcn_readfirstlane(kdst+(slot)))
  #define DMA_V(t,slot) glds16(vsrc+(long)TM(t)*KVBLK*DM,(unsigned)__builtin_amdgcn_readfirstlane(vdst+(slot)))
  const char*Kbase=shm+LDS_K; bf16x8 kf[8];
  const lds_cptr kp0=shm3+LDS_K+hi*1024+r32*16; const lds_cptr vp0=shm3+LDS_V+((lane>>4)&1)*32+(lane&3)*8+(4*hi+((lane&15)>>2))*64;
  DMA_K(0,0);DMA_V(0,0);DMA_K(1,SLOTB);
  bf16x8 qr[4];
  #pragma unroll
  for(int d0=0;d0<4;++d0)qr[d0]=*reinterpret_cast<const bf16x8*>(&Qw[(long)r32*DM+d0*16+hi*8]);
  float mhat=0.f,l_reg=0.f;f32x16 o[2];o[0]=f32x16{};o[1]=f32x16{};const f32x16 zero16=f32x16{};
  const int qrel=wid*QBLK+r32, qabs=q0+qrel;
  #define CMASK(P0,P1,t) amask<MODE>(P0,P1,TM(t),nb,sel,qabs,qrel,hi,mhat)
  bool resc=false;
  #define START(P0,P1) do{ const float rm=rowmax(P0,P1); resc=false; \
    { const float dl=__builtin_fmaxf(rm,0.f); mhat=fadd_s(mhat,dl); \
      _Pragma("unroll") for(int r=0;r<16;++r){P0[r]=fsub_s(P0[r],dl);P1[r]=fsub_s(P1[r],dl);} } \
    _Pragma("unroll") for(int r=0;r<16;++r)P0[r]=__builtin_amdgcn_exp2f(P0[r]); }while(0)
  #define RESC() do{ if(resc){ asm volatile("s_waitcnt lgkmcnt(0)":::"memory"); \
      _Pragma("unroll") for(int d_=0;d_<2;++d_) _Pragma("unroll") for(int r=0;r<16;++r)o[d_][r]*=wsf[crow(r,hi)]; } }while(0)
  f32x16 pA0,pA1,pB0,pB1;
  int sl_prev=0,sl_cur=0,sl_next=SLOTB;
  #define ROT() do{sl_prev=sl_cur;sl_cur=sl_next;sl_next=(sl_next==(NSLOT-1)*SLOTB)?0:sl_next+SLOTB;}while(0)
  DMA_K(2,2*SLOTB);
  WAIT_BAR(3);
  qkt(pA0,pA1,Kbase,qr,r32,hi);asm volatile("s_nop 15\n\ts_nop 7":"+v"(pA0),"+v"(pA1));CMASK(pA0,pA1,0);
  START(pA0,pA1);
  _Pragma("unroll") for(int r=0;r<16;++r)pA1[r]=__builtin_amdgcn_exp2f(pA1[r]);
  WAIT_BAR(0);
  DMA_K(3,0);DMA_V(1,SLOTB);
  ROT();
  kload8(kf,kp0+sl_cur);
  WAIT_BAR(2);
  s16x4 vlo[8],vhi[8]; u32x4 pw0,pw1,pw2,pw3;
  #define PKW(P,B) cvtpk_s(P[B],P[B+1])
  #define PAF(k) __builtin_bit_cast(bf16x8,pw##k)
  #define VFR(i) (bf16x8){vlo[i][0],vlo[i][1],vlo[i][2],vlo[i][3],vhi[i][0],vhi[i][1],vhi[i][2],vhi[i][3]}
  #define PIN(x) asm volatile("":"+v"(x))
  #define MX3(a,b,c) __builtin_fmaxf(__builtin_fmaxf((a),(b)),(c))
  #define GAPA(MF,A0,A1,A2,A3,W0,W1,PW) do{ MF; sacc+=A0; sacc+=A1; sacc+=A2; sacc+=A3; PIN(sacc); W0; W1; PIN(PW); SBAR(); }while(0)
  #define EX(v) __builtin_amdgcn_exp2f(v)
  #define GAPB(MF,X,B) do{ MF; X[B]=EX(X[B]); X[B+1]=EX(X[B+1]); X[B+2]=EX(X[B+2]); X[B+3]=EX(X[B+3]); PIN(X); SBAR(); }while(0)
  #define VRD(i) do{ vlo[i]=vtr(vp_+(((i)>>2)*4096+((i)&3)*1024)); vhi[i]=vtr(vp_+(((i)>>2)*4096+((i)&3)*1024+512)); }while(0)
  #define KRD(G,j) do{ if(G){ kload2(kf,kp0+sl_next,j); SBAR(); } }while(0)
  #define STEP(C0,C1,P0,P1,t,GK,GV,GL) do{ SBAR(); \
    const lds_cptr vp_=vp0+sl_prev; \
    VRD(0); SBAR(); float sacc=(P0[0]+P0[1]); \
    GAPA(C0=__builtin_amdgcn_mfma_f32_32x32x16_bf16(kf[0],qr[0],zero16,0,0,0), P0[2],P0[3],P0[4],P0[5],     pw0[0]=PKW(P0,0), pw0[1]=PKW(P0,2), pw0); \
    VRD(4); SBAR(); GAPA(C1=__builtin_amdgcn_mfma_f32_32x32x16_bf16(kf[1],qr[0],zero16,0,0,0), P0[6],P0[7],P0[8],P0[9],     pw0[2]=PKW(P0,4), pw0[3]=PKW(P0,6), pw0); \
    VRD(1); SBAR(); GAPA(C0=__builtin_amdgcn_mfma_f32_32x32x16_bf16(kf[2],qr[1],C0,0,0,0),   P0[10],P0[11],P0[12],P0[13], pw1[0]=PKW(P0,8), pw1[1]=PKW(P0,10), pw1); \
    VRD(5); SBAR(); GAPA(C1=__builtin_amdgcn_mfma_f32_32x32x16_bf16(kf[3],qr[1],C1,0,0,0),   P0[14],P0[15],P1[0],P1[1],   pw1[2]=PKW(P0,12),pw1[3]=PKW(P0,14), pw1); \
    VRD(2); SBAR(); GAPA(C0=__builtin_amdgcn_mfma_f32_32x32x16_bf16(kf[4],qr[2],C0,0,0,0),   P1[2],P1[3],P1[4],P1[5],     pw2[0]=PKW(P1,0), pw2[1]=PKW(P1,2), pw2); \
    VRD(6); SBAR(); GAPA(C1=__builtin_amdgcn_mfma_f32_32x32x16_bf16(kf[5],qr[2],C1,0,0,0),   P1[6],P1[7],P1[8],P1[9],     pw2[2]=PKW(P1,4), pw2[3]=PKW(P1,6), pw2); \
    VRD(3); SBAR(); GAPA(C0=__builtin_amdgcn_mfma_f32_32x32x16_bf16(kf[6],qr[3],C0,0,0,0),   P1[10],P1[11],P1[12],P1[13], pw3[0]=PKW(P1,8), pw3[1]=PKW(P1,10), pw3); \
    VRD(7); SBAR(); GAPA(C1=__builtin_amdgcn_mfma_f32_32x32x16_bf16(kf[7],qr[3],C1,0,0,0),   P1[14],P1[15],0.f,0.f,       pw3[2]=PKW(P1,12),pw3[3]=PKW(P1,14), pw3); \
    l_reg+=sacc; \
    if(GK){DMA_K((t)+3,sl_cur);} if(GV){DMA_V((t)+1,sl_next);} \
    CMASK(C0,C1,t); \
    { float a=MX3(C0[0],C0[1],C1[0]),b=MX3(C0[2],C0[3],C1[1]); a=MX3(a,C1[2],C1[3]); \
      _Pragma("unroll") for(int r=4;r<16;r+=4){a=MX3(a,C0[r],C0[r+1]);b=MX3(b,C0[r+2],C0[r+3]);a=MX3(a,C1[r],C1[r+1]);b=MX3(b,C1[r+2],C1[r+3]);} \
      float rm=__builtin_fmaxf(a,b); { auto rr=__builtin_amdgcn_permlane32_swap(__float_as_uint(rm),__float_as_uint(rm),false,false); rm=__builtin_fmaxf(__uint_as_float(rr[0]),__uint_as_float(rr[1])); } \
      resc=false; \
      if(__builtin_expect(__any(rm>(float)THRL),0)){ const float dl=__builtin_fmaxf(rm,0.f); mhat+=dl; \
        _Pragma("unroll") for(int r=0;r<16;++r){C0[r]-=dl;C1[r]-=dl;} \
        const float f=__builtin_amdgcn_exp2f(-dl); l_reg*=f; if(hi==0)wsf[r32]=f; resc=true; } } \
    SBAR(); \
    GAPB(o[0]=__builtin_amdgcn_mfma_f32_32x32x16_bf16(PAF(0),VFR(0),o[0],0,0,0), C0,0); \
    GAPB(o[1]=__builtin_amdgcn_mfma_f32_32x32x16_bf16(PAF(0),VFR(4),o[1],0,0,0), C0,4); \
    KRD(GL,0); GAPB(o[0]=__builtin_amdgcn_mfma_f32_32x32x16_bf16(PAF(1),VFR(1),o[0],0,0,0), C0,8); \
    KRD(GL,1); GAPB(o[1]=__builtin_amdgcn_mfma_f32_32x32x16_bf16(PAF(1),VFR(5),o[1],0,0,0), C0,12); \
    KRD(GL,2); GAPB(o[0]=__builtin_amdgcn_mfma_f32_32x32x16_bf16(PAF(2),VFR(2),o[0],0,0,0), C1,0); \
    KRD(GL,3); GAPB(o[1]=__builtin_amdgcn_mfma_f32_32x32x16_bf16(PAF(2),VFR(6),o[1],0,0,0), C1,4); \
    GAPB(o[0]=__builtin_amdgcn_mfma_f32_32x32x16_bf16(PAF(3),VFR(3),o[0],0,0,0), C1,8); \
    GAPB(o[1]=__builtin_amdgcn_mfma_f32_32x32x16_bf16(PAF(3),VFR(7),o[1],0,0,0), C1,12); \
    }while(0)
  #define ENDW(tt) do{ if((tt)+3<NT){WAIT_BAR(2);} else if((tt)+2<NT){WAIT_BAR(1);} else {WAIT_BAR(0);} }while(0)
  int t=1;
  for(;t+1<NT;t+=2){
    STEP(pB0,pB1,pA0,pA1,t,(t+3<NT),(t+1<NT),(t+1<NT));       ENDW(t);   RESC(); ROT();
    STEP(pA0,pA1,pB0,pB1,t+1,(t+4<NT),(t+2<NT),(t+2<NT));     ENDW(t+1); RESC(); ROT();
  }
  STEP(pB0,pB1,pA0,pA1,NT-1,false,false,false); RESC();
  { float sacc=pB0[0]+pB0[1]; _Pragma("unroll") for(int r=2;r<16;++r)sacc+=pB0[r]; _Pragma("unroll") for(int r=0;r<16;++r)sacc+=pB1[r]; l_reg+=sacc;
    pw0=(u32x4){PKW(pB0,0),PKW(pB0,2),PKW(pB0,4),PKW(pB0,6)};pw1=(u32x4){PKW(pB0,8),PKW(pB0,10),PKW(pB0,12),PKW(pB0,14)};pw2=(u32x4){PKW(pB1,0),PKW(pB1,2),PKW(pB1,4),PKW(pB1,6)};pw3=(u32x4){PKW(pB1,8),PKW(pB1,10),PKW(pB1,12),PKW(pB1,14)};
    SBAR(); pv(o,(int)(unsigned)(uintptr_t)vp0+sl_cur,PAF(0),PAF(1),PAF(2),PAF(3)); }
  #undef PKW
  #undef PAF
  #undef VFR
  #undef PIN
  #undef MX3
  #undef GAPA
  #undef GAPB
  #undef EX
  #undef VRD
  #undef KRD
  #undef STEP
  #undef ENDW
  {auto rr=__builtin_amdgcn_permlane32_swap(__float_as_uint(l_reg),__float_as_uint(l_reg),false,false);l_reg=__uint_as_float(rr[0])+__uint_as_float(rr[1]);}
  if(MODE==1 && hi==0) LSE[qrel]=0.6931471805599453f*(mhat+__log2f(l_reg));
  if(hi==0)wsf[32+r32]=l_reg;asm volatile("s_waitcnt lgkmcnt(0)":::"memory");
  float rli[16];
  #pragma unroll
  for(int r=0;r<16;++r)rli[r]=__builtin_amdgcn_rcpf(wsf[32+crow(r,hi)]);
  bf16*Ow=O+(long)(wid*QBLK)*opitch;
  { __hip_bfloat16*stg=(__hip_bfloat16*)(shm+LDS_OST)+wid*2048;
    #pragma unroll
    for(int r=0;r<16;++r){const int orow=crow(r,hi);
      #pragma unroll
      for(int d0=0;d0<2;++d0)stg[orow*64+d0*32+r32]=__float2bfloat16(o[d0][r]*rli[r]);}
    asm volatile("s_waitcnt lgkmcnt(0)":::"memory");
    #pragma unroll
    for(int i=0;i<4;++i){const int row=i*8+(lane>>3),ch=lane&7; const u32x4 v=*(const u32x4*)(stg+row*64+ch*8); ATTN_STORE16(Ow+(long)row*opitch+ch*8,v);} }
  asm volatile("s_waitcnt lgkmcnt(0)\n\ts_barrier":::"memory");
  #undef DMA_K
  #undef DMA_V
  #undef TM
  #undef CMASK
  #undef START
  #undef RESC
  #undef ROT
}
#undef SBAR
#undef WAIT_BAR
}

constexpr int NWAVES = 8;
constexpr int NB = 4, SEQ = 4096, T = NB * SEQ, D = 1024;
constexpr int EVEN_IN = 2816, EVEN_OUT = 512, ODD_IN = 3072, ODD_OUT = 1024, DFF = 2816, NEXP = 8, DFFE = 3584;
constexpr int MOE_ROWS = 2 * T + NEXP * 256;
constexpr float EPS = 1e-6f;
constexpr size_t MiB = 1u << 20;
constexpr size_t WS_CTL = 0, CTL_ZERO_BYTES = 2 * MiB;
constexpr size_t WS_ROPE = 2 * MiB;
constexpr size_t WS_MISC = 3 * MiB;
constexpr size_t WS_KMEAN = 4 * MiB;
constexpr size_t WS_SSP = 5 * MiB;
constexpr size_t WS_WT = 8 * MiB;
constexpr size_t WT_EVEN_BYTES = 23 * MiB, WT_ODD_BYTES = 176 * MiB;
constexpr size_t WTE_IN = 0, WTE_OUT = 5 * MiB + MiB / 2, WTE_GU = 6 * MiB + MiB / 2, WTE_DN = 17 * MiB + MiB / 2;
constexpr size_t WTO_IN = 0, WTO_OUT = 6 * MiB, WTO_MGU = 8 * MiB, WTO_MD = 120 * MiB;
constexpr size_t WS_WT_EVEN0 = WS_WT, WS_WT_ODD0 = WS_WT + 2 * WT_EVEN_BYTES;
constexpr size_t WS_HN = WS_WT + 2 * WT_EVEN_BYTES + 2 * WT_ODD_BYTES;
constexpr size_t WS_P = WS_HN + 32 * MiB;
constexpr size_t WS_MIX = WS_P + 96 * MiB;
constexpr size_t WS_HID = WS_MIX + 32 * MiB;
constexpr size_t WS_END = WS_HID + 238 * MiB;
static_assert(WS_HN == 406 * MiB && WS_END == 804 * MiB, "ws map");
constexpr size_t P_UV = 0, P_QS = 16 * MiB, P_KS = 40 * MiB, P_VS = 64 * MiB, P_QM = 0, P_KM = 24 * MiB, P_VM = 48 * MiB;
constexpr size_t H_RAWP = 0, H_OG = 96 * MiB, H_LSE = 120 * MiB;
constexpr int CW_TMO = 0, CW_CODE = 1, CW_BAR = 4096;
constexpr size_t CTL_KMSUM = 256 * 1024, KMSUM_BYTES = 256 * 1024;
constexpr size_t P_CONV = 72 * MiB;
constexpr int RING_OFF = 0, RING_BYTES = 131072, LDSCTL_OFF = RING_BYTES, MISC_OFF = LDSCTL_OFF + 320, LDS_BYTES = 147456;

#define GAS __attribute__((address_space(1)))
#define LAS __attribute__((address_space(3)))
typedef unsigned short bf16;
typedef unsigned v4u __attribute__((ext_vector_type(4)));
typedef unsigned v2u __attribute__((ext_vector_type(2)));
typedef float f32x4 __attribute__((ext_vector_type(4)));
typedef GAS unsigned gu32;
#define RLX_AGENT __ATOMIC_RELAXED, __HIP_MEMORY_SCOPE_AGENT
#define LDS_WAIT() asm volatile("s_waitcnt lgkmcnt(0)" ::: "memory")
#define VM_WAIT() asm volatile("s_waitcnt vmcnt(0)" ::: "memory")
__device__ __forceinline__ unsigned f2bf(float f) { unsigned u = __builtin_bit_cast(unsigned, f); return (u + 0x7fffu + ((u >> 16) & 1u)) >> 16; }
__device__ __forceinline__ unsigned pk2(float lo, float hi) { return f2bf(lo) | (f2bf(hi) << 16); }
__device__ __forceinline__ unsigned pk4_i8(float a, float b, float c, float d) {
    const int ia = (int)rintf(__builtin_amdgcn_fmed3f(a, -127.f, 127.f)), ib = (int)rintf(__builtin_amdgcn_fmed3f(b, -127.f, 127.f)), ic = (int)rintf(__builtin_amdgcn_fmed3f(c, -127.f, 127.f)), id = (int)rintf(__builtin_amdgcn_fmed3f(d, -127.f, 127.f));
    return (unsigned)(ia & 255) | ((unsigned)(ib & 255) << 8) | ((unsigned)(ic & 255) << 16) | ((unsigned)id << 24); }
constexpr float WQ_SCALE = 127.0f / 0.140625f;
__device__ __forceinline__ float bf2f(unsigned short b) { return __builtin_bit_cast(float, ((unsigned)b) << 16); }
__device__ __forceinline__ float bflo(unsigned w) { return __builtin_bit_cast(float, w << 16); }
__device__ __forceinline__ float bfhi(unsigned w) { return __builtin_bit_cast(float, w & 0xffff0000u); }

#define XB_TMO      128
#define XB_XCNT(j)  (256  + 64 * (j))
#define XB_XSUB(j)  (1280 + 64 * (j))
#define XB_XGEN(j)  (2304 + 64 * (j))
#define XB_TOP      3328
#define XB_TOPGEN   3392
#define XCD_BAR_WORDS 3456
#define XB_SPIN_CAP (1u << 22)
__device__ __forceinline__ unsigned xb_ld(unsigned* p)              { return __hip_atomic_load(p, __ATOMIC_RELAXED, __HIP_MEMORY_SCOPE_AGENT); }
__device__ __forceinline__ unsigned xb_add(unsigned* p, unsigned v) { return __hip_atomic_fetch_add(p, v, __ATOMIC_RELAXED, __HIP_MEMORY_SCOPE_AGENT); }
__device__ __forceinline__ unsigned xb_xcc_id() { return (unsigned)__builtin_amdgcn_s_getreg((3 << 11) | 20) & 0xFu; }
#define XB_SPIN(cond, bar) do { unsigned _sp = 0; while (cond) { __builtin_amdgcn_s_sleep(1); \
    if ((++_sp & 255u) == 0u) { if (xb_ld(&(bar)[XB_TMO])) break; if (_sp > XB_SPIN_CAP) { atomicAdd(&(bar)[XB_TMO], 1u); break; } } } } while (0)
struct XcdBarrier { unsigned* bar; unsigned x; volatile LAS unsigned* st; };
__device__ __forceinline__ XcdBarrier xcd_barrier_post(unsigned* bar, volatile LAS unsigned* st, int tid) {
    XcdBarrier b; b.bar = bar; b.x = xb_xcc_id(); b.st = st;
    if (tid == 0) { unsigned* bp = bar; asm volatile("" : "+v"(bp)); (void)xb_add(&bp[XB_XCNT(b.x)], 1u); }
    return b;
}
__device__ __forceinline__ void xcd_barrier_complete(unsigned* bar, unsigned x, unsigned& nloc, unsigned& nx) {
    const unsigned G = gridDim.x * gridDim.y * gridDim.z;
    unsigned sum, cnt, mine, sp = 0u;
    for (;;) {
        sum = 0u; cnt = 0u; mine = 0u;
#pragma unroll
        for (unsigned j = 0; j < 16; ++j) { const unsigned c = xb_ld(&bar[XB_XCNT(j)]); sum += c; cnt += (c > 0u) ? 1u : 0u; mine = (j == x) ? c : mine; }
        if (sum == G) break;
        __builtin_amdgcn_s_sleep(1);
        if ((++sp & 255u) == 0u) { if (xb_ld(&bar[XB_TMO])) break; if (sp > XB_SPIN_CAP) { atomicAdd(&bar[XB_TMO], 1u); break; } }
    }
    nloc = mine > 0u ? mine : 1u; nx = cnt > 0u ? cnt : 1u;
}
__device__ __forceinline__ void xcd_barrier(const XcdBarrier& b, int tid) {
    asm volatile("s_waitcnt vmcnt(0)" ::: "memory");
    __syncthreads();
    if (tid == 0) {
        unsigned* bar = b.bar; asm volatile("" : "+v"(bar));
        __builtin_amdgcn_s_waitcnt(0);
        unsigned nloc = b.st[0], nx = b.st[1];
        if (nloc == 0u) { xcd_barrier_complete(bar, b.x, nloc, nx); b.st[0] = nloc; b.st[1] = nx; }
        const unsigned old = xb_add(&bar[XB_XSUB(b.x)], 1u);
        const unsigned gen = old / nloc;
        if (old + 1u == (gen + 1u) * nloc) {
            __builtin_amdgcn_fence(__ATOMIC_RELEASE, "agent");
            asm volatile("s_waitcnt vmcnt(0)" ::: "memory");
            const unsigned og = xb_add(&bar[XB_TOP], 1u);
            const unsigned tg = og / nx;
            if (og + 1u == (tg + 1u) * nx) xb_add(&bar[XB_TOPGEN], 1u);
            else XB_SPIN(xb_ld(&bar[XB_TOPGEN]) == tg, bar);
            __builtin_amdgcn_fence(__ATOMIC_ACQUIRE, "agent");
            xb_add(&bar[XB_XGEN(b.x)], 1u);
            asm volatile("s_waitcnt vmcnt(0)" ::: "memory");
        } else {
            XB_SPIN(xb_ld(&bar[XB_XGEN(b.x)]) == gen, bar);
            __builtin_amdgcn_fence(__ATOMIC_ACQUIRE, "agent");
            asm volatile("s_waitcnt vmcnt(0)" ::: "memory");
        }
    }
    __syncthreads();
}

struct Args { const float* in[22]; float* out; unsigned char* ws; int ph_lo, ph_hi; };
struct Frame {
    LAS unsigned char* lds; volatile LAS unsigned* MISC; gu32* ctl;
    int tid, lane, wave, G, blk;
    unsigned char* ws; float* out; const __attribute__((address_space(4))) struct Args* ap;
};
struct Route { int e1, e2; float g1, g2; };

__device__ __forceinline__ float wave_sum(float v) { v += xswz<1>(v); v += xswz<2>(v); v += xswz<4>(v); v += xswz<8>(v); v += xswz<16>(v); return xsum32(v); }
__device__ __forceinline__ float wave_max(float v) { v = fmaxf(v, xswz<1>(v)); v = fmaxf(v, xswz<2>(v)); v = fmaxf(v, xswz<4>(v)); v = fmaxf(v, xswz<8>(v)); v = fmaxf(v, xswz<16>(v)); return xmax32(v); }
__device__ __forceinline__ int wave_sumi(int v) { v += xswzi<1>(v); v += xswzi<2>(v); v += xswzi<4>(v); v += xswzi<8>(v); v += xswzi<16>(v); return xsum32i(v); }
__device__ __forceinline__ float gelu_tanh(float x) {
    const float y = 0.7978845608028654f * (x + 0.044715f * x * x * x);
    const float e = __expf(2.0f * y);
    const float th = 1.0f - 2.0f / (e + 1.0f);
    return 0.5f * x * (1.0f + th);
}

__device__ __forceinline__ int rowmap_base(int mode, int n);
__device__ __forceinline__ int rowmap(int mode, int n) {
    const int r = rowmap_base(mode & 7, n);
    if (!(mode & 8)) return r;
    const int c = r & 31; return (r & ~31) + 16 * ((c >> 2) & 1) + 4 * (c >> 3) + (c & 3);
}
__device__ __forceinline__ int rowmap_base(int mode, int n) {
    if (mode == 0) return n;
    if (mode == 3) { const int w = n & 255, wc = w >> 6, dd = w & 63, bj = dd >> 5, e = dd & 31, fq = e >> 3, nn = (e >> 2) & 1, j = e & 3; return (n & ~255) + 128 * bj + 32 * wc + 16 * nn + 4 * fq + j; }
    return 256 * (n >> 7) + (n & 127) + (mode == 2 ? 128 : 0);
}
constexpr float H8_SCALE = 8.0f;
constexpr float W8_SCALE = 64.0f;
__device__ __forceinline__ unsigned pk4_fp8(float a, float b, float c, float d) { int w = __builtin_amdgcn_cvt_pk_fp8_f32(a, b, 0, false); w = __builtin_amdgcn_cvt_pk_fp8_f32(c, d, w, true); return (unsigned)w; }
struct TItem { const float* W; bf16* WT; const float* gain; int K, N, mode, fp8, k0, n0; };
__device__ __forceinline__ void p0_item_load(const TItem& t, int lane, f32x4 (&v)[8]) {
    const float* src = t.W + (size_t)(t.k0 + (lane >> 4)) * t.N + t.n0 + (lane & 15) * 4;
#pragma unroll
    for (int i = 0; i < 8; ++i) v[i] = __builtin_nontemporal_load((const f32x4*)(src + (size_t)(4 * i) * t.N));
    if (t.gain) {
#pragma unroll
        for (int i = 0; i < 8; ++i) v[i] = v[i] * t.gain[t.k0 + 4 * i + (lane >> 4)]; }
}
__device__ __forceinline__ void p0_item_finish(const TItem& t, int lane, const f32x4 (&v)[8], LAS float* scr) {
    const int K = t.K;
#pragma unroll
    for (int i = 0; i < 8; ++i) *(LAS f32x4*)(scr + (4 * i + (lane >> 4)) * 68 + (lane & 15) * 4) = v[i];
    LDS_WAIT(); asm volatile("" ::: "memory");
    if (t.fp8 == 1) { unsigned char* d8 = (unsigned char*)t.WT + (size_t)rowmap(t.mode, t.n0 + lane) * K + t.k0;
#pragma unroll
        for (int q = 0; q < 2; ++q) { v4u o;
            o.x = pk4_fp8(scr[(16 * q + 0) * 68 + lane] * W8_SCALE, scr[(16 * q + 1) * 68 + lane] * W8_SCALE, scr[(16 * q + 2) * 68 + lane] * W8_SCALE, scr[(16 * q + 3) * 68 + lane] * W8_SCALE);
            o.y = pk4_fp8(scr[(16 * q + 4) * 68 + lane] * W8_SCALE, scr[(16 * q + 5) * 68 + lane] * W8_SCALE, scr[(16 * q + 6) * 68 + lane] * W8_SCALE, scr[(16 * q + 7) * 68 + lane] * W8_SCALE);
            o.z = pk4_fp8(scr[(16 * q + 8) * 68 + lane] * W8_SCALE, scr[(16 * q + 9) * 68 + lane] * W8_SCALE, scr[(16 * q + 10) * 68 + lane] * W8_SCALE, scr[(16 * q + 11) * 68 + lane] * W8_SCALE);
            o.w = pk4_fp8(scr[(16 * q + 12) * 68 + lane] * W8_SCALE, scr[(16 * q + 13) * 68 + lane] * W8_SCALE, scr[(16 * q + 14) * 68 + lane] * W8_SCALE, scr[(16 * q + 15) * 68 + lane] * W8_SCALE);
            *(GAS v4u*)(d8 + 16 * q) = o; }
    } else if (t.fp8 == 2) { unsigned char* d8 = (unsigned char*)t.WT + (size_t)rowmap(t.mode, t.n0 + lane) * K + t.k0;
#pragma unroll
        for (int q = 0; q < 2; ++q) { v4u o;
            o.x = pk4_i8(scr[(16 * q + 0) * 68 + lane] * WQ_SCALE, scr[(16 * q + 1) * 68 + lane] * WQ_SCALE, scr[(16 * q + 2) * 68 + lane] * WQ_SCALE, scr[(16 * q + 3) * 68 + lane] * WQ_SCALE);
            o.y = pk4_i8(scr[(16 * q + 4) * 68 + lane] * WQ_SCALE, scr[(16 * q + 5) * 68 + lane] * WQ_SCALE, scr[(16 * q + 6) * 68 + lane] * WQ_SCALE, scr[(16 * q + 7) * 68 + lane] * WQ_SCALE);
            o.z = pk4_i8(scr[(16 * q + 8) * 68 + lane] * WQ_SCALE, scr[(16 * q + 9) * 68 + lane] * WQ_SCALE, scr[(16 * q + 10) * 68 + lane] * WQ_SCALE, scr[(16 * q + 11) * 68 + lane] * WQ_SCALE);
            o.w = pk4_i8(scr[(16 * q + 12) * 68 + lane] * WQ_SCALE, scr[(16 * q + 13) * 68 + lane] * WQ_SCALE, scr[(16 * q + 14) * 68 + lane] * WQ_SCALE, scr[(16 * q + 15) * 68 + lane] * WQ_SCALE);
            *(GAS v4u*)(d8 + 16 * q) = o; }
    } else {
    bf16* dst = t.WT + (size_t)rowmap(t.mode, t.n0 + lane) * K + t.k0;
#pragma unroll
    for (int q = 0; q < 4; ++q) { v4u o;
        o.x = pk2(scr[(8 * q + 0) * 68 + lane], scr[(8 * q + 1) * 68 + lane]); o.y = pk2(scr[(8 * q + 2) * 68 + lane], scr[(8 * q + 3) * 68 + lane]);
        o.z = pk2(scr[(8 * q + 4) * 68 + lane], scr[(8 * q + 5) * 68 + lane]); o.w = pk2(scr[(8 * q + 6) * 68 + lane], scr[(8 * q + 7) * 68 + lane]);
        *(GAS v4u*)(dst + 8 * q) = o; } }
    LDS_WAIT(); asm volatile("" ::: "memory");
}
struct WDesc { const float* src; bf16* dst; const float* gain; int K, N, nbatch, mode, fp8; size_t dst_bstride; };
__device__ __forceinline__ WDesc get_desc(const Args& a, int d) {
    const int layer = d / 10, k = d % 10; unsigned char* ws = a.ws;
    bf16* we = (bf16*)(ws + WS_WT_EVEN0 + (size_t)layer * WT_EVEN_BYTES); bf16* wo = (bf16*)(ws + WS_WT_ODD0 + (size_t)layer * WT_ODD_BYTES);
    WDesc w; w.nbatch = 1; w.mode = 0; w.dst_bstride = 0; w.fp8 = 0; w.gain = nullptr;
    switch (k) {
    case 0: w.src = a.in[3] + (size_t)layer * D * EVEN_IN; w.dst = we + WTE_IN / 2; w.K = D; w.N = EVEN_IN; w.mode = 3; w.fp8 = Q_INPROJ; break;
    case 1: w.src = a.in[9] + (size_t)layer * EVEN_OUT * D; w.dst = we + WTE_OUT / 2; w.K = EVEN_OUT; w.N = D; break;
    case 2: w.src = a.in[10] + (size_t)layer * D * DFF; w.dst = we + WTE_GU / 2; w.K = D; w.N = DFF; w.mode = 1; w.fp8 = Q_FFN; break;
    case 3: w.src = a.in[11] + (size_t)layer * D * DFF; w.dst = we + WTE_GU / 2; w.K = D; w.N = DFF; w.mode = 2; w.fp8 = Q_FFN; break;
    case 4: w.src = a.in[12] + (size_t)layer * DFF * D; w.dst = we + WTE_DN / 2; w.K = DFF; w.N = D; break;
    case 5: w.src = a.in[13] + (size_t)layer * D * ODD_IN; w.dst = wo + WTO_IN / 2; w.K = D; w.N = ODD_IN; w.mode = 3; w.fp8 = Q_INPROJ; break;
    case 6: w.src = a.in[17] + (size_t)layer * ODD_OUT * D; w.dst = wo + WTO_OUT / 2; w.K = ODD_OUT; w.N = D; break;
    case 7: w.src = a.in[19] + (size_t)layer * NEXP * D * DFFE; w.dst = wo + WTO_MGU / 2; w.K = D; w.N = DFFE; w.mode = 1 | 8; w.nbatch = NEXP; w.dst_bstride = (size_t)DFFE * D; w.fp8 = 2; break;
    case 8: w.src = a.in[20] + (size_t)layer * NEXP * D * DFFE; w.dst = wo + WTO_MGU / 2; w.K = D; w.N = DFFE; w.mode = 2 | 8; w.nbatch = NEXP; w.dst_bstride = (size_t)DFFE * D; w.fp8 = 2; break;
    default: w.src = a.in[21] + (size_t)layer * NEXP * DFFE * D; w.dst = wo + WTO_MD / 2; w.K = DFFE; w.N = D; w.mode = 8; w.nbatch = NEXP; w.dst_bstride = (size_t)DFFE * D / 2; w.fp8 = 1; break;
    }
    return w;
}
__device__ __forceinline__ void p0_prologue(Frame& F, const Args& a) {
    LAS float* scr = (LAS float*)(F.lds + RING_OFF + F.wave * 16384);
    const int gw = F.blk * NWAVES + F.wave, NGW = F.G * NWAVES;
    auto locate = [&](long it, TItem& t) -> bool {
        for (int d = 0; d < 20; ++d) { const WDesc w = get_desc(a, d); const long per = (long)(w.K / 32) * (w.N / 64), n = per * w.nbatch;
            if (it < n) { const int bt = (int)(it / per), r = (int)(it % per), nblk = w.N / 64;
                t.W = w.src + (size_t)bt * w.K * w.N; t.WT = w.dst + (size_t)bt * w.dst_bstride; t.K = w.K; t.N = w.N; t.mode = w.mode; t.fp8 = w.fp8; t.gain = w.gain; t.k0 = 32 * (r / nblk); t.n0 = 64 * (r % nblk); return true; }
            it -= n; }
        return false; };
    { TItem cur, nxt; f32x4 va[8], vb[8]; long it = gw; bool have = locate(it, cur);
      if (have) p0_item_load(cur, F.lane, va);
      while (have) {
          const bool hn = locate(it + NGW, nxt);
          if (hn) p0_item_load(nxt, F.lane, vb);
          p0_item_finish(cur, F.lane, va, scr);
          if (!hn) break;
          it += NGW; const bool h2 = locate(it + NGW, cur);
          if (h2) p0_item_load(cur, F.lane, va);
          p0_item_finish(nxt, F.lane, vb, scr);
          if (!h2) break;
          it += NGW; } }
    { float* wtg = (float*)(a.ws + WS_KMEAN); const float* wsp = a.in[5];
      for (int i = F.blk * 512 + F.tid; i < 2 * 4 * 128 * 128; i += F.G * 512) { const int lg = i >> 14, j = (i >> 7) & 127, ii = i & 127; wtg[i] = (j <= ii) ? wsp[(size_t)lg * 16384 + ii * 128 + j] : 0.f; } }
    float* cs = (float*)(a.ws + WS_ROPE); float* sn = cs + SEQ * 32;
    for (int i = F.blk * 512 + F.tid; i < SEQ * 32; i += F.G * 512) { const int pos = i >> 5, j = i & 31;
        const float inv = 1.0f / powf(10000.0f, (float)j * (1.0f / 32.0f)); const float ang = (float)pos * inv;
        cs[i] = cosf(ang); sn[i] = sinf(ang); }
}

__device__ __forceinline__ void norm_phase(Frame& F, const float* xsrc, float* xdst, const float* gain, bf16* hn, bool do_combine, bool do_router, bool write_hn, const float* router_w, bool out_i8 = true) {
    unsigned char* ws = F.ws;
    const Route* route = (const Route*)(ws + WS_MISC); const int* slots = (const int*)(ws + WS_MISC + 256 * 1024); int* ccnt = (int*)(ws + WS_MISC + 384 * 1024);
    const bf16* Y = (const bf16*)(ws + WS_P);
    LAS float* wr = (LAS float*)(F.lds + RING_OFF);
    LAS int* lcnt = (LAS int*)(F.lds + RING_OFF + 32768);
    if (do_router) { for (int i = F.tid; i < 8192; i += 512) { const int d = i >> 3, e = i & 7; wr[e * 1024 + d] = router_w[i]; } }
    const int lane = F.lane;
    f32x4 gv[4];
#pragma unroll
    for (int j = 0; j < 4; ++j) gv[j] = *((const f32x4*)gain + lane + 64 * j);
    for (int c = F.blk; c < T / 64; c += F.G) {
        if (do_router) { if (F.tid < 8) lcnt[F.tid] = 0; }
        __syncthreads();
        for (int kb = 0; kb < 8; kb += 4) {
            const int rowb = c * 64 + F.wave * 8 + kb;
            f32x4 v[4][4];
#pragma unroll
            for (int r = 0; r < 4; ++r) { const f32x4* xr = (const f32x4*)(xsrc + (size_t)(rowb + r) * D) + lane;
#pragma unroll
                for (int j = 0; j < 4; ++j) v[r][j] = xr[64 * j]; }
            if (do_combine) {
                v2u ya[4][4], yb[4][4]; float g1[4], g2[4];
#pragma unroll
                for (int r = 0; r < 4; ++r) { const Route rt = route[rowb + r]; const int s1 = slots[2 * (rowb + r)], s2 = slots[2 * (rowb + r) + 1]; g1[r] = rt.g1; g2[r] = rt.g2;
                    const v2u* y1 = (const v2u*)(Y + (size_t)s1 * D) + lane; const v2u* y2 = (const v2u*)(Y + (size_t)s2 * D) + lane;
#pragma unroll
                    for (int j = 0; j < 4; ++j) { ya[r][j] = y1[64 * j]; yb[r][j] = y2[64 * j]; } }
#pragma unroll
                for (int r = 0; r < 4; ++r) { f32x4* xo = (f32x4*)(xdst + (size_t)(rowb + r) * D) + lane;
#pragma unroll
                    for (int j = 0; j < 4; ++j) { const v2u a = ya[r][j], b = yb[r][j];
                        v[r][j].x += g1[r] * bflo(a.x) + g2[r] * bflo(b.x); v[r][j].y += g1[r] * bfhi(a.x) + g2[r] * bfhi(b.x);
                        v[r][j].z += g1[r] * bflo(a.y) + g2[r] * bflo(b.y); v[r][j].w += g1[r] * bfhi(a.y) + g2[r] * bfhi(b.y);
                        xo[64 * j] = v[r][j]; } }
            }
            if (write_hn) {
                float ss[4];
#pragma unroll
                for (int r = 0; r < 4; ++r) { float a = 0.f;
#pragma unroll
                    for (int j = 0; j < 4; ++j) a += (v[r][j].x * v[r][j].x + v[r][j].y * v[r][j].y) + (v[r][j].z * v[r][j].z + v[r][j].w * v[r][j].w);
                    ss[r] = a; }
#pragma unroll
                for (int r = 0; r < 4; ++r) ss[r] = wave_sum(ss[r]);
                float mx[4];
#pragma unroll
                for (int r = 0; r < 4; ++r) { const float rstd = 1.0f / sqrtf(ss[r] * (1.0f / D) + EPS); float m = 0.f;
#pragma unroll
                    for (int j = 0; j < 4; ++j) { v[r][j] = v[r][j] * rstd * gv[j]; m = fmaxf(fmaxf(m, fmaxf(fabsf(v[r][j].x), fabsf(v[r][j].y))), fmaxf(fabsf(v[r][j].z), fabsf(v[r][j].w))); }
                    mx[r] = m; }
                if (out_i8) {
#pragma unroll
                    for (int r = 0; r < 4; ++r) mx[r] = fmaxf(wave_max(mx[r]), 1e-20f);
#pragma unroll
                    for (int r = 0; r < 4; ++r) { const float qs = 127.0f / mx[r]; unsigned* o4 = (unsigned*)((unsigned char*)hn + (size_t)(rowb + r) * D) + lane;
#pragma unroll
                        for (int j = 0; j < 4; ++j) o4[64 * j] = pk4_i8(v[r][j].x * qs, v[r][j].y * qs, v[r][j].z * qs, v[r][j].w * qs);
                        if (lane == 0) ((float*)(ws + WS_SSP))[rowb + r] = mx[r] * (1.0f / 127.0f) * (1.0f / WQ_SCALE); }
                } else {
#pragma unroll
                    for (int r = 0; r < 4; ++r) { v2u* o8 = (v2u*)(hn + (size_t)(rowb + r) * D) + lane;
#pragma unroll
                        for (int j = 0; j < 4; ++j) { v2u o; o.x = pk2(v[r][j].x, v[r][j].y); o.y = pk2(v[r][j].z, v[r][j].w); o8[64 * j] = o; }
                        if (lane == 0) ((float*)(ws + WS_SSP))[rowb + r] = 1.0f; }
                }
                if (do_router) {
#pragma unroll
                    for (int r = 0; r < 4; ++r) { const int row = rowb + r;
                        float lg[8];
#pragma unroll
                        for (int e = 0; e < 8; ++e) { float sacc = 0.f;
#pragma unroll
                            for (int j = 0; j < 4; ++j) { const f32x4 w = *((const LAS f32x4*)(wr + e * 1024) + lane + 64 * j); sacc += (v[r][j].x * w.x + v[r][j].y * w.y) + (v[r][j].z * w.z + v[r][j].w * w.w); }
                            lg[e] = sacc; }
#pragma unroll
                        for (int e = 0; e < 8; ++e) lg[e] = wave_sum(lg[e]);
                        int e1 = 0; float v1 = lg[0];
#pragma unroll
                        for (int e = 1; e < 8; ++e) if (lg[e] > v1) { v1 = lg[e]; e1 = e; }
                        int e2 = -1; float v2 = -INFINITY;
#pragma unroll
                        for (int e = 0; e < 8; ++e) if (e != e1 && lg[e] > v2) { v2 = lg[e]; e2 = e; }
                        const float g2 = 1.0f / (1.0f + __expf(v1 - v2)), g1 = 1.0f - g2;
                        if (lane == 0) { Route rr; rr.e1 = e1; rr.e2 = e2; rr.g1 = g1; rr.g2 = g2; ((Route*)route)[row] = rr; __hip_atomic_fetch_add(&lcnt[e1], 1, __ATOMIC_RELAXED, __HIP_MEMORY_SCOPE_WORKGROUP); __hip_atomic_fetch_add(&lcnt[e2], 1, __ATOMIC_RELAXED, __HIP_MEMORY_SCOPE_WORKGROUP); } }
                }
            }
        }
        __syncthreads();
        if (do_router) { if (F.tid < 8) ccnt[c * 8 + F.tid] = lcnt[F.tid]; }
        __syncthreads();
    }
}

__device__ __forceinline__ void route_phase(Frame& F, const bf16* hn, bf16* hsort) {
    unsigned char* ws = F.ws;
    const Route* route = (const Route*)(ws + WS_MISC); int* slots = (int*)(ws + WS_MISC + 256 * 1024); const int* ccnt = (const int*)(ws + WS_MISC + 384 * 1024); int* tile_base = (int*)(ws + WS_MISC + 512 * 1024);
    LAS int* tot = (LAS int*)(F.lds + RING_OFF); LAS int* bef = tot + 8; LAS int* base = tot + 16; LAS int* sl = tot + 32;
    for (int c = F.blk; c < T / 64; c += F.G) {
        { const int e = F.wave; int t = 0, b = 0;
#pragma unroll
            for (int q = 0; q < 4; ++q) { const int ch = F.lane * 4 + q; const int v = ccnt[ch * 8 + e]; t += v; b += (ch < c) ? v : 0; }
            t = wave_sumi(t); b = wave_sumi(b);
            if (F.lane == 0) { tot[e] = t; bef[e] = b; } }
        __syncthreads();
        if (F.tid == 0) { int acc = 0;
            for (int e = 0; e < 8; ++e) { base[e] = acc; if (c == 0) tile_base[e] = acc >> 8; acc += (tot[e] + 255) & ~255; }
            if (c == 0) tile_base[8] = acc >> 8; }
        __syncthreads();
        if (F.wave == 0) {
            const int row = c * 64 + F.lane; const Route r = route[row];
            int run[8];
#pragma unroll
            for (int e = 0; e < 8; ++e) run[e] = base[e] + bef[e];
#pragma unroll
            for (int k = 0; k < 2; ++k) { const int me = k ? r.e2 : r.e1; int myslot = 0;
#pragma unroll
                for (int e = 0; e < 8; ++e) { const unsigned long long m = __ballot(me == e); const int rank = __popcll(m & ((1ull << F.lane) - 1ull));
                    if (me == e) myslot = run[e] + rank; run[e] += __popcll(m); }
                slots[2 * row + k] = myslot; sl[2 * F.lane + k] = myslot; }
        }
        __syncthreads();
        { const float* rsc = (const float*)(ws + WS_SSP); float* ssc = (float*)(ws + WS_SSP + 128 * 1024);
          for (int p = F.wave; p < 128; p += NWAVES) { const int row = c * 64 + (p >> 1); const int s = sl[p];
            *((v4u*)((unsigned char*)hsort + (size_t)s * D) + F.lane) = *((const v4u*)((const unsigned char*)hn + (size_t)row * D) + F.lane);
            if (F.lane == 0) ssc[s] = rsc[row]; } }
        __syncthreads();
    }
}

__device__ __forceinline__ int srow(int s, int g) { return g == 0 ? s : (g == 1 ? ((s & 3) * 1024 + (s >> 2)) : ((s & 15) * 256 + (s >> 4))); }
__device__ __forceinline__ float rope_apply(float n, int lane, const float* cs, const float* sn, int s) {
    const float partner = __shfl_xor(n, 32); const int j = lane & 31; const float c = cs[s * 32 + j], si = sn[s * 32 + j];
    return lane < 32 ? n * c - partner * si : n * c + partner * si;
}
__device__ __forceinline__ void post_even(Frame& F, const bf16* rawp, const float* vgain, const float* qgain, const float* kgain) {
    unsigned char* ws = F.ws; bf16* UV = (bf16*)(ws + WS_P + P_UV); bf16* Qs = (bf16*)(ws + WS_P + P_QS); bf16* Ks = (bf16*)(ws + WS_P + P_KS); bf16* Vs = (bf16*)(ws + WS_P + P_VS);
    const float* cs = (const float*)(ws + WS_ROPE); const float* sn = cs + SEQ * 32;
    const int lane = F.lane; const float qg = qgain[lane], kg = kgain[lane];
    const long nitems = (long)T * 44;
    for (long it = (long)F.blk * NWAVES + F.wave; it < nitems; it += (long)F.G * NWAVES) {
        const int row = (int)(it / 44), u = (int)(it % 44), b = row >> 12, s = row & 4095;
        const float v = bf2f(rawp[(size_t)row * EVEN_IN + 64 * u + lane]);
        if (u < 4) { UV[(size_t)row * 512 + 64 * u + lane] = (bf16)f2bf(gelu_tanh(v)); }
        else if (u < 8) { const float z = gelu_tanh(v); const float ss = wave_sum(z * z); const float o = z * (1.0f / sqrtf(ss * (1.0f / 64) + EPS)) * vgain[(u - 4) * 64 + lane];
            UV[(size_t)row * 512 + 64 * u + lane] = (bf16)f2bf(o); }
        else if (u < 32) { const bool isq = u < 20; const int h = isq ? u - 8 : u - 20; const float ss = wave_sum(v * v);
            const float n = v * (1.0f / sqrtf(ss * (1.0f / 64) + EPS)) * (isq ? qg : kg); const float o = rope_apply(n, lane, cs, sn, s);
            (isq ? Qs : Ks)[((size_t)(b * 12 + h) * SEQ + srow(s, h >> 2)) * 64 + lane] = (bf16)f2bf(isq ? o * att::C2 : o); }
        else { const int h = u - 32; Vs[((size_t)(b * 12 + h) * SEQ + srow(s, h >> 2)) * 64 + lane] = (bf16)f2bf(v); }
    }
}
__device__ __forceinline__ void post_odd(Frame& F, const bf16* rawp, const float* qgain, const float* kgain) {
    unsigned char* ws = F.ws; bf16* Qm = (bf16*)(ws + WS_P + P_QM); bf16* Km = (bf16*)(ws + WS_P + P_KM); bf16* Vm = (bf16*)(ws + WS_P + P_VM);
    const float* cs = (const float*)(ws + WS_ROPE); const float* sn = cs + SEQ * 32;
    const int lane = F.lane; const float qg = qgain[lane], kg = kgain[lane];
    const long nitems = (long)T * 36;
    for (long it = (long)F.blk * NWAVES + F.wave; it < nitems; it += (long)F.G * NWAVES) {
        const int row = (int)(it / 36), u = (int)(it % 36), b = row >> 12, s = row & 4095;
        const float v = bf2f(rawp[(size_t)row * ODD_IN + 64 * u + lane]);
        if (u < 24) { const bool isq = u < 12; const int h = isq ? u : u - 12; const float ss = wave_sum(v * v);
            const float n = v * (1.0f / sqrtf(ss * (1.0f / 64) + EPS)) * (isq ? qg : kg); const float o = rope_apply(n, lane, cs, sn, s);
            (isq ? Qm : Km)[((size_t)(b * 12 + h) * SEQ + s) * 64 + lane] = (bf16)f2bf(isq ? o * att::C2 : o); }
        else { const int h = u - 24; Vm[((size_t)(b * 12 + h) * SEQ + s) * 64 + lane] = (bf16)f2bf(v); }
    }
}
__device__ __forceinline__ void kmean_phase(Frame& F) {
    const bf16* Km = (const bf16*)(F.ws + WS_P + P_KM); float* km = (float*)(F.ws + WS_KMEAN);
    for (int it = F.blk * NWAVES + F.wave; it < 48 * 16; it += F.G * NWAVES) {
        const bf16* k = Km + (size_t)it * 256 * 64 + F.lane; float s = 0.f;
        for (int r = 0; r < 256; ++r) s += bf2f(k[r * 64]);
        km[it * 64 + F.lane] = s * (1.0f / 256.0f);
    }
}

__device__ __forceinline__ void load_row64(const bf16* p, float (&q)[64]) {
    const v4u* p4 = (const v4u*)p;
#pragma unroll
    for (int i = 0; i < 8; ++i) { const v4u w = p4[i]; q[8 * i + 0] = bflo(w.x); q[8 * i + 1] = bfhi(w.x); q[8 * i + 2] = bflo(w.y); q[8 * i + 3] = bfhi(w.y); q[8 * i + 4] = bflo(w.z); q[8 * i + 5] = bfhi(w.z); q[8 * i + 6] = bflo(w.w); q[8 * i + 7] = bfhi(w.w); }
}
__device__ __forceinline__ float dot_row64(const bf16* p, const float (&q)[64]) {
    const v4u* p4 = (const v4u*)p; float s = 0.f;
#pragma unroll
    for (int i = 0; i < 8; ++i) { const v4u w = p4[i]; s += q[8 * i + 0] * bflo(w.x) + q[8 * i + 1] * bfhi(w.x) + q[8 * i + 2] * bflo(w.y) + q[8 * i + 3] * bfhi(w.y) + q[8 * i + 4] * bflo(w.z) + q[8 * i + 5] * bfhi(w.z) + q[8 * i + 6] * bflo(w.w) + q[8 * i + 7] * bfhi(w.w); }
    return s;
}
__device__ __forceinline__ void banded_naive(Frame& F) {
    unsigned char* ws = F.ws; const bf16* Qs = (const bf16*)(ws + WS_P + P_QS); const bf16* Ks = (const bf16*)(ws + WS_P + P_KS); const bf16* Vs = (const bf16*)(ws + WS_P + P_VS);
    bf16* OG = (bf16*)(ws + WS_HID + H_OG); float* LSE = (float*)(ws + WS_HID + H_LSE);
    LAS float* pl = (LAS float*)(F.lds + RING_OFF) + F.wave * 256;
    const int lane = F.lane;
    for (int it = F.blk * NWAVES + F.wave; it < 48 * SEQ; it += F.G * NWAVES) {
        const int bh = it >> 12, rp = it & 4095, b = bh / 12, h = bh % 12, g = h >> 2, dil = g == 0 ? 1 : (g == 1 ? 4 : 16), L = SEQ / dil;
        const int i = rp % L, r = rp / L, s = i * dil + r, nk = (i < 128 ? i : 128) + 1, first = rp - (nk - 1);
        float q[64]; load_row64(Qs + ((size_t)bh * SEQ + rp) * 64, q);
        float sc[3]; float m = -INFINITY;
#pragma unroll
        for (int kk = 0; kk < 3; ++kk) { const int j = lane + 64 * kk; sc[kk] = -INFINITY; if (j < nk) { sc[kk] = 0.6931471805599453f * dot_row64(Ks + ((size_t)bh * SEQ + first + j) * 64, q); } m = fmaxf(m, sc[kk]); }
        m = wave_max(m); float l = 0.f;
#pragma unroll
        for (int kk = 0; kk < 3; ++kk) { const float p = (lane + 64 * kk < nk) ? __expf(sc[kk] - m) : 0.f; pl[lane + 64 * kk] = p; l += p; }
        l = wave_sum(l); LDS_WAIT();
        float acc = 0.f; const bf16* vb = Vs + ((size_t)bh * SEQ + first) * 64 + lane;
        for (int j = 0; j < nk; ++j) acc += pl[j] * bf2f(vb[(size_t)j * 64]);
        const size_t orow = ((size_t)g * T + (size_t)b * SEQ + s) * 4 + (h & 3);
        OG[orow * 64 + lane] = (bf16)f2bf(acc / l);
        if (lane == 0) LSE[orow] = m + __logf(l);
        LDS_WAIT();
    }
}
__device__ __forceinline__ void merge_even(Frame& F, bf16* mix) {
    const bf16* OG = (const bf16*)(F.ws + WS_HID + H_OG); const float* LSE = (const float*)(F.ws + WS_HID + H_LSE);
    for (int t = F.blk * 512 + F.tid; t < T * 4 * 8; t += F.G * 512) {
        const int it = t >> 3, part = t & 7, row = it >> 2, hg = it & 3, b = row >> 12, s = row & 4095;
        const size_t i0 = ((size_t)0 * 16 + b * 4 + hg) * SEQ + srow(s, 0), i1 = ((size_t)1 * 16 + b * 4 + hg) * SEQ + srow(s, 1), i2 = ((size_t)2 * 16 + b * 4 + hg) * SEQ + srow(s, 2);
        const float l0 = LSE[i0], l1 = LSE[i1], l2 = LSE[i2]; const float m = fmaxf(l0, fmaxf(l1, l2));
        float w0 = __expf(l0 - m), w1 = __expf(l1 - m), w2 = __expf(l2 - m); const float inv = 1.0f / (w0 + w1 + w2); w0 *= inv; w1 *= inv; w2 *= inv;
        const v4u a = *(const v4u*)(OG + i0 * 64 + part * 8), bb = *(const v4u*)(OG + i1 * 64 + part * 8), c = *(const v4u*)(OG + i2 * 64 + part * 8);
        v4u o;
        o.x = pk2(w0 * bflo(a.x) + w1 * bflo(bb.x) + w2 * bflo(c.x), w0 * bfhi(a.x) + w1 * bfhi(bb.x) + w2 * bfhi(c.x));
        o.y = pk2(w0 * bflo(a.y) + w1 * bflo(bb.y) + w2 * bflo(c.y), w0 * bfhi(a.y) + w1 * bfhi(bb.y) + w2 * bfhi(c.y));
        o.z = pk2(w0 * bflo(a.z) + w1 * bflo(bb.z) + w2 * bflo(c.z), w0 * bfhi(a.z) + w1 * bfhi(bb.z) + w2 * bfhi(c.z));
        o.w = pk2(w0 * bflo(a.w) + w1 * bflo(bb.w) + w2 * bflo(c.w), w0 * bfhi(a.w) + w1 * bfhi(bb.w) + w2 * bfhi(c.w));
        *(v4u*)(mix + (size_t)row * EVEN_OUT + 256 + hg * 64 + part * 8) = o;
    }
}
__device__ __forceinline__ void gmlp_phase(Frame& F, int lp, const float* bsp, bf16* mix) {
    const bf16* UV = (const bf16*)(F.ws + WS_P + P_UV); const float* wtg = (const float*)(F.ws + WS_KMEAN) + (size_t)lp * 4 * 16384;
    LAS float* WT = (LAS float*)(F.lds + RING_OFF);
    LAS float* VL = WT + 128 * 128;
    const int tid = F.tid; int gl = -1;
    for (int unit = F.blk; unit < (T / 128) * 4; unit += F.G) {
        const int c = unit >> 2, g = unit & 3, row0 = c * 128;
        __syncthreads();
        if (g != gl) { gl = g; const f32x4* src = (const f32x4*)(wtg + (size_t)g * 16384);
#pragma unroll
            for (int q = 0; q < 8; ++q) *((LAS f32x4*)WT + tid + 512 * q) = src[tid + 512 * q]; }
        { const int j = tid >> 2, d8 = (tid & 3) * 16;
          const v4u a = *(const v4u*)(UV + (size_t)(row0 + j) * 512 + 256 + g * 64 + d8), b = *(const v4u*)(UV + (size_t)(row0 + j) * 512 + 256 + g * 64 + d8 + 8);
          LAS f32x4* vd = (LAS f32x4*)(VL + j * 64 + d8);
          vd[0] = (f32x4){bflo(a.x), bfhi(a.x), bflo(a.y), bfhi(a.y)}; vd[1] = (f32x4){bflo(a.z), bfhi(a.z), bflo(a.w), bfhi(a.w)};
          vd[2] = (f32x4){bflo(b.x), bfhi(b.x), bflo(b.y), bfhi(b.y)}; vd[3] = (f32x4){bflo(b.z), bfhi(b.z), bflo(b.w), bfhi(b.w)}; }
        __syncthreads();
        const int i0 = 4 * (tid >> 4), d0 = 4 * (tid & 15);
        f32x4 acc[4];
#pragma unroll
        for (int a = 0; a < 4; ++a) acc[a] = (f32x4){0.f, 0.f, 0.f, 0.f};
        const int jmax = i0 + 3;
        for (int j = 0; j <= jmax; ++j) { const f32x4 w = *(const LAS f32x4*)(WT + j * 128 + i0); const f32x4 v = *(const LAS f32x4*)(VL + j * 64 + d0);
            acc[0] += w.x * v; acc[1] += w.y * v; acc[2] += w.z * v; acc[3] += w.w * v; }
#pragma unroll
        for (int a = 0; a < 4; ++a) { const int i = i0 + a; const float bb = bsp[g * 128 + i]; const size_t row = row0 + i;
            const v2u uu = *(const v2u*)(UV + row * 512 + g * 64 + d0);
            v2u o; o.x = pk2(bflo(uu.x) * (acc[a].x + bb), bfhi(uu.x) * (acc[a].y + bb)); o.y = pk2(bflo(uu.y) * (acc[a].z + bb), bfhi(uu.y) * (acc[a].w + bb));
            *(v2u*)(mix + row * EVEN_OUT + g * 64 + d0) = o; }
    }
    __syncthreads();
}
__device__ __forceinline__ void moba_naive(Frame& F, bf16* mix) {
    unsigned char* ws = F.ws; const bf16* Qm = (const bf16*)(ws + WS_P + P_QM); const bf16* Km = (const bf16*)(ws + WS_P + P_KM); const bf16* Vm = (const bf16*)(ws + WS_P + P_VM);
    const float* km = (const float*)(ws + WS_KMEAN);
    LAS float* sc = (LAS float*)(F.lds + RING_OFF) + F.wave * 1024;
    const int lane = F.lane;
    for (int it = F.blk * NWAVES + F.wave; it < 48 * SEQ; it += F.G * NWAVES) {
        const int bh = it >> 12, s = it & 4095, b = bh / 12, h = bh % 12, qb = s >> 8;
        float q[64]; load_row64(Qm + ((size_t)bh * SEQ + s) * 64, q);
        float gate = -INFINITY;
        if (lane < qb) { const f32x4* kp = (const f32x4*)(km + ((size_t)bh * 16 + lane) * 64); float a = 0.f;
#pragma unroll
            for (int i = 0; i < 16; ++i) { const f32x4 w = kp[i]; a += q[4 * i] * w.x + q[4 * i + 1] * w.y + q[4 * i + 2] * w.z + q[4 * i + 3] * w.w; }
            gate = a; }
        unsigned sel = 1u << qb;
        for (int r = 0; r < 3; ++r) { float v = gate; int idx = lane;
#pragma unroll
            for (int o = 1; o < 64; o <<= 1) { const float ov = __shfl_xor(v, o); const int oi = __shfl_xor(idx, o); if (ov > v || (ov == v && oi < idx)) { v = ov; idx = oi; } }
            if (v > -INFINITY) { sel |= 1u << idx; if (lane == idx) gate = -INFINITY; } }
        int cnt = 0; float m = -INFINITY;
        for (int n = 0; n <= qb; ++n) { if (!((sel >> n) & 1u)) continue;
#pragma unroll
            for (int kk = 0; kk < 4; ++kk) { const int key = n * 256 + kk * 64 + lane; float x = -INFINITY;
                if (key <= s) x = 0.6931471805599453f * dot_row64(Km + ((size_t)bh * SEQ + key) * 64, q);
                sc[cnt * 256 + kk * 64 + lane] = x; m = fmaxf(m, x); }
            ++cnt; }
        m = wave_max(m); float l = 0.f; LDS_WAIT();
        for (int i = lane; i < cnt * 256; i += 64) { const float p = __expf(sc[i] - m); sc[i] = p; l += p; }
        l = wave_sum(l); LDS_WAIT();
        float acc = 0.f; int c2 = 0;
        for (int n = 0; n <= qb; ++n) { if (!((sel >> n) & 1u)) continue;
            const bf16* vb = Vm + ((size_t)bh * SEQ + n * 256) * 64 + lane; const int kend = (n == qb) ? (s & 255) + 1 : 256;
            for (int kk = 0; kk < kend; ++kk) acc += sc[c2 * 256 + kk] * bf2f(vb[(size_t)kk * 64]);
            ++c2; }
        mix[((size_t)b * SEQ + s) * ODD_OUT + h * 64 + lane] = (bf16)f2bf(acc / l);
        LDS_WAIT();
    }
}
__device__ __forceinline__ void conv_phase(Frame& F, const bf16* cv, const float* cw, bf16* mix) {
    for (int it = F.blk * 512 + F.tid; it < T * 32; it += F.G * 512) {
        const int row = it >> 5, c = (it & 31) * 8, s = row & 4095;
        const bf16* p = cv + (size_t)row * 768 + c;
        const v4u bg = *(const v4u*)p, c0 = *(const v4u*)(p + 256), x0 = *(const v4u*)(p + 512);
        v4u c1 = (v4u){0u, 0u, 0u, 0u}, x1 = c1, c2 = c1, x2 = c1;
        if (s >= 1) { c1 = *(const v4u*)(p + 256 - 768); x1 = *(const v4u*)(p + 512 - 768); }
        if (s >= 2) { c2 = *(const v4u*)(p + 256 - 1536); x2 = *(const v4u*)(p + 512 - 1536); }
        const f32x4 wa0 = *(const f32x4*)(cw + c), wa1 = *(const f32x4*)(cw + c + 4), wb0 = *(const f32x4*)(cw + 256 + c), wb1 = *(const f32x4*)(cw + 256 + c + 4), wc0 = *(const f32x4*)(cw + 512 + c), wc1 = *(const f32x4*)(cw + 512 + c + 4);
        const unsigned bgw[4] = {bg.x, bg.y, bg.z, bg.w}, c0w[4] = {c0.x, c0.y, c0.z, c0.w}, x0w[4] = {x0.x, x0.y, x0.z, x0.w}, c1w[4] = {c1.x, c1.y, c1.z, c1.w}, x1w[4] = {x1.x, x1.y, x1.z, x1.w}, c2w[4] = {c2.x, c2.y, c2.z, c2.w}, x2w[4] = {x2.x, x2.y, x2.z, x2.w};
        const float w0[8] = {wa0.x, wa0.y, wa0.z, wa0.w, wa1.x, wa1.y, wa1.z, wa1.w}, w1[8] = {wb0.x, wb0.y, wb0.z, wb0.w, wb1.x, wb1.y, wb1.z, wb1.w}, w2[8] = {wc0.x, wc0.y, wc0.z, wc0.w, wc1.x, wc1.y, wc1.z, wc1.w};
        unsigned ow[4];
#pragma unroll
        for (int k = 0; k < 4; ++k) {
            const float ylo = w0[2 * k] * (bflo(c2w[k]) * bflo(x2w[k])) + w1[2 * k] * (bflo(c1w[k]) * bflo(x1w[k])) + w2[2 * k] * (bflo(c0w[k]) * bflo(x0w[k]));
            const float yhi = w0[2 * k + 1] * (bfhi(c2w[k]) * bfhi(x2w[k])) + w1[2 * k + 1] * (bfhi(c1w[k]) * bfhi(x1w[k])) + w2[2 * k + 1] * (bfhi(c0w[k]) * bfhi(x0w[k]));
            ow[k] = pk2(bflo(bgw[k]) * ylo, bfhi(bgw[k]) * yhi); }
        *(v4u*)(mix + (size_t)row * ODD_OUT + 768 + c) = (v4u){ow[0], ow[1], ow[2], ow[3]};
    }
}

constexpr int CW_QMOBA = 8192;
__device__ __forceinline__ void moba_phase(Frame& F, int lp, bf16* mix) {
    unsigned char* ws = F.ws; const bf16* Qm = (const bf16*)(ws + WS_P + P_QM); const bf16* Km = (const bf16*)(ws + WS_P + P_KM); const bf16* Vm = (const bf16*)(ws + WS_P + P_VM);
    const float* km = (const float*)(ws + WS_CTL + CTL_KMSUM + (size_t)(lp & 1) * KMSUM_BYTES);
    char* shm = (char*)F.lds + RING_OFF; LAS unsigned char* l3 = F.lds + RING_OFF;
    LAS float* kml = (LAS float*)(l3 + att::LDS_KM); volatile LAS int* tkw = (volatile LAS int*)(l3 + att::LDS_TK);
    unsigned* head = (unsigned*)(F.ctl + CW_QMOBA + 64 * lp);
    const int tid = F.tid, wid = F.wave;
    for (;;) {
        if (tid == 0) { unsigned* hp = head; asm volatile("" : "+v"(hp)); tkw[0] = (int)__hip_atomic_fetch_add(hp, 1u, __ATOMIC_RELAXED, __HIP_MEMORY_SCOPE_AGENT); }
        __syncthreads();
        const int tk = __builtin_amdgcn_readfirstlane(tkw[0]);
        if (tk >= 48 * 16) break;
        const int qb = 15 - tk / 48, bh = tk % 48, b = bh / 12, h = bh % 12;
        int lane_ = F.lane; asm volatile("" : "+v"(lane_)); const int r32 = lane_ & 31, hi = lane_ >> 5;
        ((LAS v2u*)kml)[tid] = ((const v2u*)(km + (size_t)bh * 1024))[tid];
        __syncthreads();
        unsigned sel = 0u;
        { const bf16* qrow = Qm + ((size_t)bh * SEQ + qb * 256 + wid * 32 + r32) * 64 + hi * 8;
          float qf[32];
#pragma unroll
          for (int d0 = 0; d0 < 4; ++d0) { const v4u w = *(const v4u*)(qrow + d0 * 16);
              qf[8 * d0 + 0] = bflo(w.x); qf[8 * d0 + 1] = bfhi(w.x); qf[8 * d0 + 2] = bflo(w.y); qf[8 * d0 + 3] = bfhi(w.y); qf[8 * d0 + 4] = bflo(w.z); qf[8 * d0 + 5] = bfhi(w.z); qf[8 * d0 + 6] = bflo(w.w); qf[8 * d0 + 7] = bfhi(w.w); }
          float v1 = -INFINITY, v2 = -INFINITY, v3 = -INFINITY; int i1 = 0, i2 = 0, i3 = 0;
          for (int n = 0; n < qb; ++n) { float a = 0.f;
#pragma unroll
              for (int d0 = 0; d0 < 4; ++d0) { const f32x4 k0 = *(const LAS f32x4*)(kml + n * 64 + d0 * 16 + hi * 8), k1 = *(const LAS f32x4*)(kml + n * 64 + d0 * 16 + hi * 8 + 4);
                  a += qf[8 * d0 + 0] * k0.x + qf[8 * d0 + 1] * k0.y + qf[8 * d0 + 2] * k0.z + qf[8 * d0 + 3] * k0.w + qf[8 * d0 + 4] * k1.x + qf[8 * d0 + 5] * k1.y + qf[8 * d0 + 6] * k1.z + qf[8 * d0 + 7] * k1.w; }
              a = xsum32(a);
              if (a > v1) { v3 = v2; i3 = i2; v2 = v1; i2 = i1; v1 = a; i1 = n; } else if (a > v2) { v3 = v2; i3 = i2; v2 = a; i2 = n; } else if (a > v3) { v3 = a; i3 = n; } }
          if (v1 > -INFINITY) sel |= 1u << i1; if (v2 > -INFINITY) sel |= 1u << i2; if (v3 > -INFINITY) sel |= 1u << i3; }
        const size_t sb = (size_t)bh * SEQ * 64;
        att::attn_unit<0, 8, ODD_OUT>(Qm + sb, qb * 256, 0, 4 * (qb + 1), sel, mix + ((size_t)b * SEQ + qb * 256) * ODD_OUT + h * 64, nullptr, shm, tid);
    }
    __syncthreads();
}
__device__ __forceinline__ void banded_phase(Frame& F) {
    unsigned char* ws = F.ws; const bf16* Qs = (const bf16*)(ws + WS_P + P_QS); const bf16* Ks = (const bf16*)(ws + WS_P + P_KS); const bf16* Vs = (const bf16*)(ws + WS_P + P_VS);
    bf16* OG = (bf16*)(ws + WS_HID + H_OG); float* LSE = (float*)(ws + WS_HID + H_LSE);
    char* shm = (char*)F.lds + RING_OFF;
    for (int u = F.blk; u < 768; u += F.G) {
        const int g = u >> 8, rem = u & 255, b = rem >> 6, hg = (rem >> 4) & 3, u16 = rem & 15, h = g * 4 + hg, bh = b * 12 + h;
        const int dil = g == 0 ? 1 : (g == 1 ? 4 : 16), L = SEQ / dil, row0 = 256 * u16, r = row0 / L, q0s = row0 % L;
        const int tile0 = (q0s >> 6) >= 2 ? (q0s >> 6) - 2 : 0, NT = (q0s >> 6) + 4 - tile0;
        const size_t sb = ((size_t)bh * SEQ + (size_t)r * L) * 64;
        const size_t orow = ((size_t)g * 16 + b * 4 + hg) * SEQ + row0;
        att::attn_unit<1, 8, 64>(Qs + sb, q0s, tile0, NT, 0u, OG + orow * 64, LSE + orow, shm, F.tid);
    }
    __syncthreads();
}

constexpr int PH_PER_PAIR = 16, NPH = 1 + 2 * PH_PER_PAIR + 1;
__global__ void __launch_bounds__(NWAVES * 64, 2) fwd(Args args) {
    extern __shared__ __attribute__((aligned(16))) unsigned char lds[];
    const int wv0 = __builtin_amdgcn_readfirstlane((int)threadIdx.x >> 6);
#define MKFRAME() Frame F; { int t_ = TID_NOW(wv0); asm volatile("" : "+v"(t_)); int b_ = blockIdx.x; asm volatile("" : "+s"(b_)); \
    F.lds = (LAS unsigned char*)lds; F.MISC = (volatile LAS unsigned*)(F.lds + MISC_OFF); F.tid = t_; F.lane = t_ & 63; F.wave = __builtin_amdgcn_readfirstlane(t_ >> 6); \
    const __attribute__((address_space(4))) Args* ap = (const __attribute__((address_space(4))) Args*)__builtin_amdgcn_kernarg_segment_ptr(); asm volatile("" : "+s"(ap));     \
    unsigned char* w_ = ap->ws; asm volatile("" : "+s"(w_)); F.G = gridDim.x; F.blk = b_; F.ws = w_; F.out = ap->out; F.ctl = (gu32*)(w_ + WS_CTL); F.ap = ap; }
    for (int u = TID_NOW(wv0); u < (LDS_BYTES - LDSCTL_OFF) / 4; u += NWAVES * 64) ((LAS unsigned*)((LAS unsigned char*)lds + LDSCTL_OFF))[u] = 0u;
    __syncthreads();
    const int lo = args.ph_lo, hi = args.ph_hi;
    XcdBarrier bar; bar.bar = (unsigned*)(args.ws + WS_CTL) + CW_BAR; bar.x = 0; bar.st = nullptr;
    if (hi - lo > 1) bar = xcd_barrier_post((unsigned*)(args.ws + WS_CTL) + CW_BAR, (volatile LAS unsigned*)((LAS unsigned char*)lds + MISC_OFF) + 8, TID_NOW(wv0));
#ifndef PHMASK
#define PHMASK 0xFFFFFF
#endif
#define PHEN(k) (((PHMASK) >> (k)) & 1)
#ifndef PROBE_REP
#define PROBE_REP 0
#endif
#define NREP(k) ((((PROBE_REP) >> (k)) & 1) + 1)
#define IN(k) (lo <= (k) && (k) < hi)
#define SEAM(k) do { if (IN(k) && IN((k) + 1)) xcd_barrier(bar, TID_NOW(wv0)); } while (0)
#define HN ((bf16*)(F.ws + WS_HN))
#define MIX ((bf16*)(F.ws + WS_MIX))
#define HID ((bf16*)(F.ws + WS_HID))
#define RAWP ((bf16*)(F.ws + WS_HID + H_RAWP))
#define HSORT ((bf16*)(F.ws + WS_P))
#define YB ((bf16*)(F.ws + WS_P))
#define x_in (F.ap->in[0])

    if (PHEN(19) && IN(0)) { for (int rep_ = 0; rep_ < NREP(19); ++rep_) { MKFRAME(); p0_prologue(F, args); } SEAM(0); }

    for (int lp = 0; lp < 2; ++lp) {
        const int pb = 1 + lp * PH_PER_PAIR;
        const int le = 2 * lp, lo_ = 2 * lp + 1;
#define we ((const pg8::bf16_t*)(F.ws + WS_WT_EVEN0 + (size_t)lp * WT_EVEN_BYTES))
#define wo ((const pg8::bf16_t*)(F.ws + WS_WT_ODD0 + (size_t)lp * WT_ODD_BYTES))
        if (PHEN(0) && IN(pb + 0)) { { MKFRAME();
            norm_phase(F, lp == 0 ? x_in : F.out, F.out, F.ap->in[1] + (size_t)le * D, HN, lp != 0, false, true, nullptr, Q_INPROJ == 2); } SEAM(pb + 0); }
        if (PHEN(1) && IN(pb + 1)) { for (int rep_ = 0; rep_ < NREP(1); ++rep_) { MKFRAME();
            { LAS float* gt = (LAS float*)(F.lds + pg8::GAIN_TAB_OFF);
              if (F.tid < 256) gt[F.tid] = (F.ap->in[4] + (size_t)lp * 256)[F.tid]; else if (F.tid < 320) gt[F.tid] = (F.ap->in[7] + (size_t)lp * 64)[F.tid - 256]; else if (F.tid < 384) gt[F.tid] = (F.ap->in[8] + (size_t)lp * 64)[F.tid - 320];
              __syncthreads(); }
            pg8::Gemm g{HN, we + WTE_IN / 2, T, EVEN_IN, D}; pg8::StaticOrder S; S.init(T, EVEN_IN, F.G, F.blk);
            pg8::EpiHeadsEven E{(bf16*)(F.ws + WS_P + P_UV), (bf16*)(F.ws + WS_P + P_QS), F.ap->in[4] + (size_t)lp * 256, F.ap->in[7] + (size_t)lp * 64, F.ap->in[8] + (size_t)lp * 64,
                                (const float*)(F.ws + WS_ROPE), (const float*)(F.ws + WS_ROPE) + SEQ * 32, (const float*)(F.ws + WS_SSP), (const LAS float*)(F.lds + pg8::GAIN_TAB_OFF)};
            pg8::gemm_phase<pg8::EpiHeadsEven, pg8::StaticOrder, true, true, Q_INPROJ>(F.lds + RING_OFF, g, S, E, F.tid);
            } SEAM(pb + 1); }
        if (PHEN(2) && IN(pb + 2)) { for (int rep_ = 0; rep_ < NREP(2); ++rep_) { MKFRAME(); banded_phase(F); gmlp_phase(F, lp, F.ap->in[6] + (size_t)lp * 4 * 128, MIX); } SEAM(pb + 2); }
        if (PHEN(3) && IN(pb + 3)) { for (int rep_ = 0; rep_ < NREP(3); ++rep_) { MKFRAME(); merge_even(F, MIX); } SEAM(pb + 3); }
        if (PHEN(4) && IN(pb + 4)) { { MKFRAME();
            pg8::Gemm g{MIX, we + WTE_OUT / 2, T, D, EVEN_OUT}; pg8::StaticOrder S; S.init(T, D, F.G, F.blk);
            pg8::EpiF32Res E{lp == 0 ? x_in : F.out, F.out, D};
            pg8::gemm_phase<pg8::EpiF32Res, pg8::StaticOrder>(F.lds + RING_OFF, g, S, E, F.tid);
            } SEAM(pb + 4); }
        if (PHEN(5) && IN(pb + 5)) { { MKFRAME(); norm_phase(F, F.out, F.out, F.ap->in[2] + (size_t)le * D, HN, false, false, true, nullptr, Q_FFN == 2); } SEAM(pb + 5); }
        if (PHEN(6) && IN(pb + 6)) { for (int rep_ = 0; rep_ < NREP(6); ++rep_) { MKFRAME();
            pg8::Gemm g{HN, we + WTE_GU / 2, T, 2 * DFF, D}; pg8::StaticOrder S; S.init(T, 2 * DFF, F.G, F.blk);
            pg8::EpiSwiGLU E{HID, DFF, 1.0f, (const float*)(F.ws + WS_SSP)};
            pg8::gemm_phase<pg8::EpiSwiGLU, pg8::StaticOrder, true, true, Q_FFN>(F.lds + RING_OFF, g, S, E, F.tid);
            } SEAM(pb + 6); }
        if (PHEN(7) && IN(pb + 7)) { { MKFRAME();
            pg8::Gemm g{HID, we + WTE_DN / 2, T, D, DFF}; pg8::StaticOrder S; S.init(T, D, F.G, F.blk);
            pg8::EpiF32Res E{F.out, F.out, D};
            pg8::gemm_phase<pg8::EpiF32Res, pg8::StaticOrder>(F.lds + RING_OFF, g, S, E, F.tid);
            } SEAM(pb + 7); }
        if (PHEN(8) && IN(pb + 8)) { { MKFRAME(); norm_phase(F, F.out, F.out, F.ap->in[1] + (size_t)lo_ * D, HN, false, false, true, nullptr, Q_INPROJ == 2); } SEAM(pb + 8); }
        if (PHEN(9) && IN(pb + 9)) { for (int rep_ = 0; rep_ < NREP(9); ++rep_) { MKFRAME();
            { LAS float* gt = (LAS float*)(F.lds + pg8::GAIN_TAB_OFF);
              if (F.tid >= 256 && F.tid < 320) gt[F.tid] = (F.ap->in[14] + (size_t)lp * 64)[F.tid - 256]; else if (F.tid >= 320 && F.tid < 384) gt[F.tid] = (F.ap->in[15] + (size_t)lp * 64)[F.tid - 320];
              __syncthreads(); }
            pg8::Gemm g{HN, wo + WTO_IN / 2, T, ODD_IN, D}; pg8::StaticOrder S; S.init(T, ODD_IN, F.G, F.blk);
            pg8::EpiHeadsOdd E{(bf16*)(F.ws + WS_P + P_QM), (bf16*)(F.ws + WS_P + P_CONV), (float*)(F.ws + WS_CTL + CTL_KMSUM + (size_t)lp * KMSUM_BYTES),
                               F.ap->in[14] + (size_t)lp * 64, F.ap->in[15] + (size_t)lp * 64, (const float*)(F.ws + WS_ROPE), (const float*)(F.ws + WS_ROPE) + SEQ * 32, (const float*)(F.ws + WS_SSP), (const LAS float*)(F.lds + pg8::GAIN_TAB_OFF)};
            pg8::gemm_phase<pg8::EpiHeadsOdd, pg8::StaticOrder, true, true, Q_INPROJ>(F.lds + RING_OFF, g, S, E, F.tid);
            } SEAM(pb + 9); }
        if (PHEN(10) && IN(pb + 10)) { for (int rep_ = 0; rep_ < NREP(10); ++rep_) { MKFRAME(); moba_phase(F, lp + 2 * rep_, MIX); conv_phase(F, (const bf16*)(F.ws + WS_P + P_CONV), F.ap->in[16] + (size_t)lp * 3 * 256, MIX); } SEAM(pb + 10); }
        if (PHEN(11) && IN(pb + 11)) { { MKFRAME();
            pg8::Gemm g{MIX, wo + WTO_OUT / 2, T, D, ODD_OUT}; pg8::StaticOrder S; S.init(T, D, F.G, F.blk);
            pg8::EpiF32Res E{F.out, F.out, D};
            pg8::gemm_phase<pg8::EpiF32Res, pg8::StaticOrder>(F.lds + RING_OFF, g, S, E, F.tid);
            } SEAM(pb + 11); }
        if (PHEN(12) && IN(pb + 12)) { { MKFRAME(); norm_phase(F, F.out, F.out, F.ap->in[2] + (size_t)lo_ * D, HN, false, true, true, F.ap->in[18] + (size_t)lp * D * NEXP); } SEAM(pb + 12); }
        if (PHEN(13) && IN(pb + 13)) { for (int rep_ = 0; rep_ < NREP(13); ++rep_) { MKFRAME(); route_phase(F, HN, HSORT); } SEAM(pb + 13); }
        if (PHEN(14) && IN(pb + 14)) { for (int rep_ = 0; rep_ < NREP(14); ++rep_) { MKFRAME();
            const int* tbp = (const int*)(F.ws + WS_MISC + 512 * 1024);
            pg8::MoeOrder S; const int ntiles = __builtin_amdgcn_readfirstlane(tbp[8]); S.init(ntiles * 256, 2 * DFFE, F.G, F.blk);
#pragma unroll
            for (int k = 0; k < 8; ++k) S.tb[k] = __builtin_amdgcn_readfirstlane(tbp[k]);
            S.estride = (size_t)2 * DFFE * D;
            pg8::Gemm g{HSORT, wo + WTO_MGU / 2, ntiles * 256, 2 * DFFE, D};
            pg8::EpiSwiGLU8 E{(unsigned char*)HID, DFFE, 1.0f, H8_SCALE, (const float*)(F.ws + WS_SSP + 128 * 1024)};
            pg8::gemm_phase<pg8::EpiSwiGLU8, pg8::MoeOrder, true, true, 2>(F.lds + RING_OFF, g, S, E, F.tid);
            } SEAM(pb + 14); }
        if (PHEN(15) && IN(pb + 15)) { for (int rep_ = 0; rep_ < NREP(15); ++rep_) { MKFRAME();
            const int* tbp = (const int*)(F.ws + WS_MISC + 512 * 1024);
            pg8::MoeOrder S; const int ntiles = __builtin_amdgcn_readfirstlane(tbp[8]); S.init(ntiles * 256, D, F.G, F.blk);
#pragma unroll
            for (int k = 0; k < 8; ++k) S.tb[k] = __builtin_amdgcn_readfirstlane(tbp[k]);
            S.estride = (size_t)DFFE * D;
            pg8::Gemm g{HID, wo + WTO_MD / 2, ntiles * 256, D, DFFE};
            pg8::EpiBf16PlainPP E{YB, D, 1.0f / (W8_SCALE * H8_SCALE)};
            pg8::gemm_phase<pg8::EpiBf16PlainPP, pg8::MoeOrder, true, true, 1>(F.lds + RING_OFF, g, S, E, F.tid);
            } SEAM(pb + 15); }
    }
    if (PHEN(20) && IN(NPH - 1)) { MKFRAME(); norm_phase(F, F.out, F.out, F.ap->in[1], HN, true, false, false, nullptr); }
#undef IN
#undef SEAM
#undef HN
#undef MIX
#undef HID
#undef RAWP
#undef HSORT
#undef YB
#undef x_in
#undef we
#undef wo
}

extern "C" void kernel_launch(void* const* d_in, const int* in_sizes, int n_in, void* d_out, int out_size, void* d_ws, size_t ws_size, hipStream_t stream) {
    static int grid = 0;
    if (grid == 0) {
        if (n_in != 22 || out_size != T * D || ws_size < WS_END) { fprintf(stderr, "kernel_launch: unexpected shapes (n_in %d out %d ws %zu)\n", n_in, out_size, ws_size); grid = -1; return; }
        int dev = 0, cus = 0, per_cu = 0;
        if (hipGetDevice(&dev) != hipSuccess || hipDeviceGetAttribute(&cus, hipDeviceAttributeMultiprocessorCount, dev) != hipSuccess) { grid = -1; return; }
        if (hipFuncSetAttribute((const void*)fwd, hipFuncAttributeMaxDynamicSharedMemorySize, LDS_BYTES) != hipSuccess) { fprintf(stderr, "kernel_launch: hipFuncSetAttribute failed\n"); grid = -1; return; }
        if (hipOccupancyMaxActiveBlocksPerMultiprocessor(&per_cu, (const void*)fwd, NWAVES * 64, LDS_BYTES) != hipSuccess || per_cu < 1) fprintf(stderr, "kernel_launch: occupancy query says %d\n", per_cu);
        (void)hipGetLastError();
        grid = cus;
    }
    if (grid < 0) return;
    (void)hipMemsetAsync((char*)d_ws + WS_CTL, 0, CTL_ZERO_BYTES, stream);
    Args a{};
    for (int i = 0; i < 22; ++i) a.in[i] = (const float*)d_in[i];
    a.out = (float*)d_out; a.ws = (unsigned char*)d_ws;
#if MK_PER_PHASE
    for (int p = 0; p < NPH; ++p) { a.ph_lo = p; a.ph_hi = p + 1; hipLaunchKernelGGL(fwd, dim3(grid), dim3(NWAVES * 64), LDS_BYTES, stream, a); }
#else
    a.ph_lo = 0; a.ph_hi = NPH; hipLaunchKernelGGL(fwd, dim3(grid), dim3(NWAVES * 64), LDS_BYTES, stream, a);
#endif
}
```
